# Optimizing an MI355X kernel written in HIP

```python
import math
import jax, jax.numpy as jnp
from jax import lax
import numpy as np

D_MODEL = 1024
BATCH = 16
SEQ = 4096
DEPTH = 4

D_PLE = 256
D_REC = 512
REC_BLOCKS = 8
REC_BLOCK = D_REC // REC_BLOCKS
CONV_W = 4
LRU_C = 8.0
N_HEADS = 8
HEAD_DIM = 64
N_KV = 2
GQA_R = N_HEADS // N_KV
D_ATT = N_HEADS * HEAD_DIM
KV_W = N_KV * HEAD_DIM
L_CMP = 32
STRIDE_CMP = 16
CMP_HIDDEN = 256
L_SEL = 64
N_SEL = 16
WINDOW = 512
Q_BLOCK = 64
N_GROUPS = 4
EXP_PER_GROUP = 8
N_EXPERTS = N_GROUPS * EXP_PER_GROUP
TOP_K_IN_GROUP = 2
D_EXPERT = 512
MOE_CHUNK = 256
D_IN = 2 * D_REC + D_ATT + 6 * KV_W + 3 * N_HEADS
EPS = 1e-6
NEG = -1e30
BIG = 1e30

kernel_name = "hybrid_rglru_nsa_hmoe_ple"


def rmsnorm(x, g):
    xf = x.astype(jnp.float32)
    y = xf * lax.rsqrt(jnp.mean(xf * xf, axis=-1, keepdims=True) + EPS)
    return (y * g.astype(jnp.float32)).astype(x.dtype)


def masked_softmax(s, mask):
    s = jnp.where(mask, s, NEG)
    m = jnp.max(s, axis=-1, keepdims=True)
    e = jnp.where(mask, jnp.exp(s - m), 0.0)
    return e / jnp.maximum(jnp.sum(e, axis=-1, keepdims=True), 1e-30)


def alibi_slopes():
    return jnp.exp2(-8.0 * (jnp.arange(N_HEADS, dtype=jnp.float32) + 1.0) / N_HEADS)


def split_columns(z):
    sizes = (D_REC, D_REC, D_ATT, KV_W, KV_W, KV_W, KV_W, KV_W, KV_W, 3 * N_HEADS)
    out, off = [], 0
    for s in sizes:
        out.append(z[..., off:off + s])
        off += s
    return out


def rglru_branch(xr, gate, conv_w, conv_b, w_a, b_a, w_x, b_x, lam):
    B, S, C = xr.shape
    xc = lax.conv_general_dilated(xr, conv_w[:, None, :], window_strides=(1,),
                                  padding=[(CONV_W - 1, 0)],
                                  dimension_numbers=("NWC", "WIO", "NWC"),
                                  feature_group_count=C) + conv_b
    xb = xc.reshape(B, S, REC_BLOCKS, REC_BLOCK)
    r = jax.nn.sigmoid(jnp.einsum("bshi,hij->bshj", xb, w_a).reshape(B, S, C) + b_a)
    i = jax.nn.sigmoid(jnp.einsum("bshi,hij->bshj", xb, w_x).reshape(B, S, C) + b_x)
    log_a = -LRU_C * r.astype(jnp.float32) * jax.nn.softplus(-lam.astype(jnp.float32))
    a = jnp.exp(log_a)
    b = jnp.sqrt(-jnp.expm1(2.0 * log_a)) * (i * xc).astype(jnp.float32)

    def combine(left, right):
        a1, b1 = left
        a2, b2 = right
        return a1 * a2, a2 * b1 + b2

    _, h = lax.associative_scan(combine, (a, b), axis=1)
    return h.astype(xr.dtype) * jax.nn.gelu(gate)


def nsa_branch(q, kc, vc, ks, vs, kw, vw, gates, pe_k, pe_v,
               wk1, bk1, wk2, bk2, wv1, bv1, wv2, bv2):
    B, S, _ = q.shape
    dt = q.dtype

    def heads_first(t):
        return t.reshape(B, S, N_KV, HEAD_DIM).transpose(0, 2, 1, 3)

    q = q.reshape(B, S, N_KV, GQA_R, HEAD_DIM).transpose(0, 2, 3, 1, 4)
    g = jax.nn.sigmoid(gates.astype(jnp.float32)).reshape(B, S, N_KV, GQA_R, 3)
    g = g.transpose(0, 2, 3, 1, 4)
    kc, vc, ks, vs, kw, vw = [heads_first(t) for t in (kc, vc, ks, vs, kw, vw)]

    n_cmp = (S - L_CMP) // STRIDE_CMP + 1
    cmp_start = jnp.arange(n_cmp) * STRIDE_CMP
    cmp_idx = cmp_start[:, None] + jnp.arange(L_CMP)[None, :]

    def compress(t, pe, w1, b1, w2, b2):
        blocks = t[:, :, cmp_idx, :] + pe
        flat = blocks.reshape(B, N_KV, n_cmp, L_CMP * HEAD_DIM)
        return jax.nn.gelu(flat @ w1 + b1) @ w2 + b2

    k_cmp = compress(kc, pe_k, wk1, bk1, wk2, bk2)
    v_cmp = compress(vc, pe_v, wv1, bv1, wv2, bv2)
    cmp_last = cmp_start + L_CMP - 1
    cmp_center = cmp_start.astype(jnp.float32) + (L_CMP - 1) * 0.5

    n_sel = S // L_SEL
    n_top = min(N_SEL, n_sel)
    sel_start = jnp.arange(n_sel) * L_SEL
    overlap = jnp.clip(jnp.minimum(cmp_start[:, None] + L_CMP, sel_start[None, :] + L_SEL)
                       - jnp.maximum(cmp_start[:, None], sel_start[None, :]), 0)
    overlap = overlap.astype(jnp.float32) / STRIDE_CMP
    ks_blk = ks.reshape(B, N_KV, n_sel, L_SEL, HEAD_DIM)
    vs_blk = vs.reshape(B, N_KV, n_sel, L_SEL, HEAD_DIM)

    kw_pad = jnp.pad(kw, ((0, 0), (0, 0), (WINDOW, 0), (0, 0)))
    vw_pad = jnp.pad(vw, ((0, 0), (0, 0), (WINDOW, 0), (0, 0)))

    slopes = alibi_slopes().reshape(N_KV, GQA_R)[None, :, :, None, None]
    scale = HEAD_DIM ** -0.5
    n_qb = S // Q_BLOCK
    q_blk = q.reshape(B, N_KV, GQA_R, n_qb, Q_BLOCK, HEAD_DIM).transpose(3, 0, 1, 2, 4, 5)
    g_blk = g.reshape(B, N_KV, GQA_R, n_qb, Q_BLOCK, 3).transpose(3, 0, 1, 2, 4, 5)
    bi = jnp.arange(B)[:, None, None, None]
    gi = jnp.arange(N_KV)[None, :, None, None]
    j_sel = jnp.arange(n_sel)
    band = jnp.arange(WINDOW + Q_BLOCK)

    def one_block(args):
        qb, gb, blk = args
        t = blk * Q_BLOCK + jnp.arange(Q_BLOCK)
        tf = t.astype(jnp.float32)

        s = jnp.einsum("bgrqd,bgnd->bgrqn", qb, k_cmp).astype(jnp.float32) * scale
        s = s - slopes * (tf[:, None] - cmp_center[None, :])
        p_c = masked_softmax(s, cmp_last[None, :] <= t[:, None])
        o_c = jnp.einsum("bgrqn,bgnd->bgrqd", p_c.astype(dt), v_cmp)

        imp = jnp.einsum("bgrqn,nm->bgqm", p_c, overlap)
        cur = t // L_SEL
        valid = sel_start[None, :] <= t[:, None]
        forced = valid & ((j_sel[None, :] == 0) | (j_sel[None, :] == cur[:, None])
                          | (j_sel[None, :] == cur[:, None] - 1))
        score = jnp.where(forced, BIG, jnp.where(valid, imp, NEG))
        _, idx = lax.top_k(score, n_top)
        k_g = ks_blk[bi, gi, idx]
        v_g = vs_blk[bi, gi, idx]
        s_pos = idx[..., None] * L_SEL + jnp.arange(L_SEL)
        dist = t[None, None, :, None, None] - s_pos
        s = jnp.einsum("bgrqd,bgqnkd->bgrqnk", qb, k_g).astype(jnp.float32) * scale
        s = s - slopes[..., None] * dist[:, :, None].astype(jnp.float32)
        mask_s = (dist >= 0).reshape(B, N_KV, 1, Q_BLOCK, n_top * L_SEL)
        p_s = masked_softmax(s.reshape(B, N_KV, GQA_R, Q_BLOCK, n_top * L_SEL), mask_s)
        o_s = jnp.einsum("bgrqm,bgqmd->bgrqd", p_s.astype(dt),
                         v_g.reshape(B, N_KV, Q_BLOCK, n_top * L_SEL, HEAD_DIM))

        k_w = lax.dynamic_slice_in_dim(kw_pad, blk * Q_BLOCK, WINDOW + Q_BLOCK, axis=2)
        v_w = lax.dynamic_slice_in_dim(vw_pad, blk * Q_BLOCK, WINDOW + Q_BLOCK, axis=2)
        w_pos = blk * Q_BLOCK - WINDOW + band
        dw = t[:, None] - w_pos[None, :]
        mask_w = (dw >= 0) & (dw < WINDOW) & (w_pos[None, :] >= 0)
        s = jnp.einsum("bgrqd,bgkd->bgrqk", qb, k_w).astype(jnp.float32) * scale
        s = s - slopes * dw.astype(jnp.float32)
        p_w = masked_softmax(s, mask_w)
        o_w = jnp.einsum("bgrqk,bgkd->bgrqd", p_w.astype(dt), v_w)

        gb = gb.astype(dt)
        return gb[..., 0:1] * o_c + gb[..., 1:2] * o_s + gb[..., 2:3] * o_w

    out = lax.map(one_block, (q_blk, g_blk, jnp.arange(n_qb)))
    return out.transpose(1, 0, 4, 2, 3, 5).reshape(B, S, D_ATT)


def hier_moe(u, w_grp, b_grp, w_exp_r, b_exp_r, w_gate, w_up, w_down):
    B, S, D = u.shape
    N = B * S
    xt = u.reshape(N, D)
    grp_logits = (xt @ w_grp + b_grp).astype(jnp.float32)
    grp_prob = jax.nn.softmax(grp_logits, axis=-1)
    p_g, g_idx = lax.top_k(grp_prob, 1)
    exp_logits = (xt @ w_exp_r + b_exp_r).astype(jnp.float32).reshape(N, N_GROUPS, EXP_PER_GROUP)
    in_grp = exp_logits[jnp.arange(N), g_idx[:, 0]]
    top_v, top_i = lax.top_k(in_grp, TOP_K_IN_GROUP)
    gate = p_g * jax.nn.softmax(top_v, axis=-1)
    eid = g_idx * EXP_PER_GROUP + top_i

    A = N * TOP_K_IN_GROUP
    flat_e = eid.reshape(A)
    flat_tok = jnp.repeat(jnp.arange(N, dtype=jnp.int32), TOP_K_IN_GROUP)
    flat_g = gate.reshape(A)
    order = jnp.argsort(flat_e)
    se = flat_e[order]
    counts = jnp.bincount(flat_e, length=N_EXPERTS)
    starts = jnp.cumsum(counts) - counts
    padded = ((counts + MOE_CHUNK - 1) // MOE_CHUNK) * MOE_CHUNK
    pstarts = jnp.cumsum(padded) - padded
    dest = pstarts[se] + (jnp.arange(A) - starts[se])
    n_chunks = -(-A // MOE_CHUNK) + N_EXPERTS
    P = n_chunks * MOE_CHUNK
    buf_tok = jnp.full((P,), N, dtype=jnp.int32).at[dest].set(flat_tok[order])
    buf_gate = jnp.zeros((P,), jnp.float32).at[dest].set(flat_g[order])
    chunk_start = jnp.arange(n_chunks) * MOE_CHUNK
    chunk_e = jnp.minimum(jnp.sum((pstarts + padded)[None, :] <= chunk_start[:, None], axis=1),
                          N_EXPERTS - 1)
    x_pad = jnp.concatenate([xt, jnp.zeros((1, D), xt.dtype)], axis=0)

    def expert_chunk(args):
        tok, e = args
        xs = x_pad[tok]
        hdn = jax.nn.silu(xs @ w_gate[e]) * (xs @ w_up[e])
        return hdn @ w_down[e]

    y = lax.map(expert_chunk, (buf_tok.reshape(n_chunks, MOE_CHUNK), chunk_e)).reshape(P, D)
    y = y * buf_gate[:, None].astype(y.dtype)
    out = jax.ops.segment_sum(y, buf_tok, num_segments=N + 1)[:N]
    return out.reshape(B, S, D)


def setup_inputs(seed: int = 0) -> dict:
    key = jax.random.key(seed)
    ks = jax.random.split(key, 40)
    f32 = jnp.float32

    def nrm(k, shape, scale):
        return jax.random.normal(k, shape, f32) * scale

    def gain(k, shape):
        return 1.0 + 0.01 * jax.random.normal(k, shape, f32)

    a8 = jax.random.uniform(ks[10], (DEPTH, D_REC), f32, minval=0.9, maxval=0.999)
    a_base = a8 ** (1.0 / LRU_C)
    lam = jnp.log(a_base) - jnp.log1p(-a_base)
    return {
        "x": nrm(ks[0], (BATCH, SEQ, D_MODEL), 1.0),
        "p": nrm(ks[1], (DEPTH, BATCH, SEQ, D_PLE), 1.0),
        "mix_norm": gain(ks[2], (DEPTH, D_MODEL)),
        "w_in": nrm(ks[3], (DEPTH, D_MODEL, D_IN), D_MODEL ** -0.5),
        "conv_w": nrm(ks[4], (DEPTH, CONV_W, D_REC), CONV_W ** -0.5),
        "conv_b": nrm(ks[5], (DEPTH, D_REC), 0.01),
        "lru_wa": nrm(ks[6], (DEPTH, REC_BLOCKS, REC_BLOCK, REC_BLOCK), REC_BLOCK ** -0.5),
        "lru_ba": nrm(ks[7], (DEPTH, D_REC), 0.01),
        "lru_wx": nrm(ks[8], (DEPTH, REC_BLOCKS, REC_BLOCK, REC_BLOCK), REC_BLOCK ** -0.5),
        "lru_bx": nrm(ks[9], (DEPTH, D_REC), 0.01),
        "lru_lambda": lam,
        "cmp_pe_k": nrm(ks[11], (DEPTH, L_CMP, HEAD_DIM), 0.02),
        "cmp_pe_v": nrm(ks[12], (DEPTH, L_CMP, HEAD_DIM), 0.02),
        "cmp_wk1": nrm(ks[13], (DEPTH, L_CMP * HEAD_DIM, CMP_HIDDEN), (L_CMP * HEAD_DIM) ** -0.5),
        "cmp_bk1": nrm(ks[14], (DEPTH, CMP_HIDDEN), 0.01),
        "cmp_wk2": nrm(ks[15], (DEPTH, CMP_HIDDEN, HEAD_DIM), CMP_HIDDEN ** -0.5),
        "cmp_bk2": nrm(ks[16], (DEPTH, HEAD_DIM), 0.01),
        "cmp_wv1": nrm(ks[17], (DEPTH, L_CMP * HEAD_DIM, CMP_HIDDEN), (L_CMP * HEAD_DIM) ** -0.5),
        "cmp_bv1": nrm(ks[18], (DEPTH, CMP_HIDDEN), 0.01),
        "cmp_wv2": nrm(ks[19], (DEPTH, CMP_HIDDEN, HEAD_DIM), CMP_HIDDEN ** -0.5),
        "cmp_bv2": nrm(ks[20], (DEPTH, HEAD_DIM), 0.01),
        "rec_out_norm": gain(ks[21], (DEPTH, D_REC)),
        "att_out_norm": gain(ks[22], (DEPTH, D_ATT)),
        "w_out": nrm(ks[23], (DEPTH, D_REC + D_ATT, D_MODEL), (D_REC + D_ATT) ** -0.5),
        "ffn_norm": gain(ks[24], (DEPTH, D_MODEL)),
        "w_group_router": nrm(ks[25], (DEPTH, D_MODEL, N_GROUPS), D_MODEL ** -0.5),
        "b_group_router": nrm(ks[26], (DEPTH, N_GROUPS), 0.01),
        "w_expert_router": nrm(ks[27], (DEPTH, D_MODEL, N_EXPERTS), D_MODEL ** -0.5),
        "b_expert_router": nrm(ks[28], (DEPTH, N_EXPERTS), 0.01),
        "w_gate_exp": nrm(ks[29], (DEPTH, N_EXPERTS, D_MODEL, D_EXPERT), D_MODEL ** -0.5),
        "w_up_exp": nrm(ks[30], (DEPTH, N_EXPERTS, D_MODEL, D_EXPERT), D_MODEL ** -0.5),
        "w_down_exp": nrm(ks[31], (DEPTH, N_EXPERTS, D_EXPERT, D_MODEL), D_EXPERT ** -0.5),
        "ple_norm": gain(ks[32], (DEPTH, D_MODEL)),
        "w_ple_gate": nrm(ks[33], (DEPTH, D_MODEL, D_MODEL), D_MODEL ** -0.5),
        "b_ple_gate": nrm(ks[34], (DEPTH, D_MODEL), 0.01),
        "w_ple_up": nrm(ks[35], (DEPTH, D_PLE, D_MODEL), D_PLE ** -0.5),
        "final_norm": gain(ks[36], (D_MODEL,)),
    }


def reference(x, p, mix_norm, w_in, conv_w, conv_b, lru_wa, lru_ba, lru_wx, lru_bx, lru_lambda,
              cmp_pe_k, cmp_pe_v, cmp_wk1, cmp_bk1, cmp_wk2, cmp_bk2, cmp_wv1, cmp_bv1, cmp_wv2, cmp_bv2,
              rec_out_norm, att_out_norm, w_out, ffn_norm, w_group_router, b_group_router,
              w_expert_router, b_expert_router, w_gate_exp, w_up_exp, w_down_exp,
              ple_norm, w_ple_gate, b_ple_gate, w_ple_up, final_norm):
    h = x
    for i in range(DEPTH):
        u = rmsnorm(h, mix_norm[i])
        z = u @ w_in[i]
        xr, gr, q, kc, vc, ksl, vsl, kwn, vwn, ng = split_columns(z)
        rec = rglru_branch(xr, gr, conv_w[i], conv_b[i], lru_wa[i], lru_ba[i],
                           lru_wx[i], lru_bx[i], lru_lambda[i])
        att = nsa_branch(q, kc, vc, ksl, vsl, kwn, vwn, ng, cmp_pe_k[i], cmp_pe_v[i],
                         cmp_wk1[i], cmp_bk1[i], cmp_wk2[i], cmp_bk2[i],
                         cmp_wv1[i], cmp_bv1[i], cmp_wv2[i], cmp_bv2[i])
        mixed = jnp.concatenate([rmsnorm(rec, rec_out_norm[i]), rmsnorm(att, att_out_norm[i])], axis=-1)
        h = h + mixed @ w_out[i]
        h = h + hier_moe(rmsnorm(h, ffn_norm[i]), w_group_router[i], b_group_router[i],
                         w_expert_router[i], b_expert_router[i],
                         w_gate_exp[i], w_up_exp[i], w_down_exp[i])
        gate = jax.nn.sigmoid(rmsnorm(h, ple_norm[i]) @ w_ple_gate[i] + b_ple_gate[i])
        h = h + (p[i] @ w_ple_up[i]) * gate
    return rmsnorm(h, final_norm)
```

```cpp
#include <hip/hip_runtime.h>
#include <cstdio>
#include <cstdint>

#ifndef PROBE_MASK
#define PROBE_MASK 0
#endif
#define REP_(j) for (int rep_ = 0; rep_ < 1 + ((PROBE_MASK >> (j)) & 1); ++rep_)
#ifndef MK_MULTI
#define MK_MULTI 0
#endif

#define GAS __attribute__((address_space(1)))
#define LAS __attribute__((address_space(3)))
typedef unsigned short bf16;
typedef float f32x4 __attribute__((ext_vector_type(4)));
typedef float f32x2 __attribute__((ext_vector_type(2)));
typedef unsigned u32x4 __attribute__((ext_vector_type(4)));
typedef unsigned u32x2 __attribute__((ext_vector_type(2)));
typedef short bf16x8 __attribute__((ext_vector_type(8)));
typedef GAS unsigned gu32;
#define RLX_AGENT __ATOMIC_RELAXED, __HIP_MEMORY_SCOPE_AGENT
#define LDS_WAIT() asm volatile("s_waitcnt lgkmcnt(0)" ::: "memory")
#define VM_WAIT() asm volatile("s_waitcnt vmcnt(0)" ::: "memory")

constexpr int BATCH = 16, SEQ = 4096, DM = 1024, DEPTH = 4, NTOK = BATCH * SEQ;
constexpr int D_PLE = 256, D_REC = 512, NH = 8, HD = 64, NKV = 2;
constexpr int D_IN = 2328, ZP = 2560;
constexpr int ZC_XR = 0, ZC_GR = 512, ZC_Q = 1024, ZC_KC = 1536, ZC_VC = 1664, ZC_KS = 1792, ZC_VS = 1920, ZC_KW = 2048, ZC_VW = 2176, ZC_NG = 2304;
constexpr int NCMP = 255, NSELB = 64, NTOP = 16, WIN = 512;
constexpr int NEXP = 32, DEXP = 512, NSEG = 64;
constexpr float EPS = 1e-6f;
constexpr float LOG2E = 1.4426950408889634f;
constexpr int NWAVES = 8;

constexpr size_t MiB = 1u << 20;
constexpr size_t WS_CTL = 0, CTL_ZERO_BYTES = 1 * MiB;
constexpr size_t WS_BK1 = 1 * MiB;
constexpr size_t WS_C8 = WS_BK1 + 8192;
constexpr size_t WS_WRT = WS_C8 + 8192;
constexpr size_t WS_AGG = 2 * MiB;
constexpr size_t WS_CARRY = 3 * MiB;
constexpr size_t WS_W2T = 4 * MiB;
constexpr size_t WS_KCMP = 5 * MiB, WS_VCMP = 7 * MiB;
constexpr size_t WS_RS1 = 6 * MiB, WS_RS3 = 6 * MiB + 512 * 1024;
constexpr size_t WS_HIDC = 9 * MiB;
constexpr size_t WS_LTOK = 17 * MiB, WS_LGATE = 33 * MiB;
constexpr size_t WS_PB = 49 * MiB;
constexpr size_t WS_W = 81 * MiB, W_LAYER = 108 * MiB;
constexpr size_t WO_IN = 0, WO_OUT = 5 * MiB, WO_PG = 7 * MiB, WO_PU = 9 * MiB, WO_K1 = 9 * MiB + 512 * 1024, WO_V1 = 10 * MiB + 512 * 1024, WO_GU = 12 * MiB, WO_D = 76 * MiB;
constexpr size_t WS_U = 513 * MiB;
constexpr size_t WS_Z = 641 * MiB;
constexpr size_t WS_HID = WS_Z;
constexpr size_t WS_G = WS_Z + 160 * MiB;
constexpr size_t WS_MIXED = 962 * MiB;
constexpr size_t WS_HLOC = 1090 * MiB, WS_CUMA = 1154 * MiB;
constexpr size_t WS_Y0 = WS_MIXED, WS_Y1 = WS_HLOC;
constexpr size_t WS_LRS = 1218 * MiB;
constexpr size_t WS_H16 = 1234 * MiB;
constexpr size_t WS_END = 1362 * MiB;
constexpr int CW_BAR = 4096;
constexpr int CW_CNT = 16384;
constexpr int CW_BK1 = 32768;
constexpr int LDS_BYTES = 163840;
constexpr int TAB_OFF = 147456;
constexpr int MISC_OFF = 147456 + 4096;

__device__ __forceinline__ unsigned f2bf(float f) { unsigned u = __builtin_bit_cast(unsigned, f); return (u + 0x7fffu + ((u >> 16) & 1u)) >> 16; }
__device__ __forceinline__ unsigned pk2(float lo, float hi) { return f2bf(lo) | (f2bf(hi) << 16); }
__device__ __forceinline__ float bflo(unsigned u) { return __builtin_bit_cast(float, u << 16); }
__device__ __forceinline__ float bfhi(unsigned u) { return __builtin_bit_cast(float, u & 0xffff0000u); }
__device__ __forceinline__ float bf2f(bf16 b) { return __builtin_bit_cast(float, (unsigned)b << 16); }
__device__ __forceinline__ float fsigmoid(float x) { return __builtin_amdgcn_rcpf(1.f + __builtin_amdgcn_exp2f(-x * LOG2E)); }
__device__ __forceinline__ float fgelu(float x) { const float y = 1.5957691216057308f * (x + 0.044715f * x * x * x); return x * __builtin_amdgcn_rcpf(1.f + __builtin_amdgcn_exp2f(-y * LOG2E)); }
__device__ __forceinline__ int lane_id() { int x; asm volatile("v_mbcnt_lo_u32_b32 %0, -1, 0\n\tv_mbcnt_hi_u32_b32 %0, -1, %0" : "=v"(x)); return x; }
template <int CTRL> __device__ __forceinline__ float dpp_mov(float src) {
    return __builtin_bit_cast(float, __builtin_amdgcn_update_dpp(0, __builtin_bit_cast(int, src), CTRL, 0xf, 0xf, true));
}
__device__ __forceinline__ float wave_sum(float v) {
    v += dpp_mov<0xB1>(v);
    v += dpp_mov<0x4E>(v);
    v += dpp_mov<0x141>(v);
    v += dpp_mov<0x140>(v);
    const float r0 = __builtin_bit_cast(float, __builtin_amdgcn_readlane(__builtin_bit_cast(int, v), 0)), r1 = __builtin_bit_cast(float, __builtin_amdgcn_readlane(__builtin_bit_cast(int, v), 16));
    const float r2 = __builtin_bit_cast(float, __builtin_amdgcn_readlane(__builtin_bit_cast(int, v), 32)), r3 = __builtin_bit_cast(float, __builtin_amdgcn_readlane(__builtin_bit_cast(int, v), 48));
    return (r0 + r1) + (r2 + r3);
}

namespace pg8 {
#define PG8_LAS __attribute__((address_space(3)))
typedef unsigned short bf16_t;
constexpr int BM = 256, BK = 64, HALF = 128, HTB = HALF * BK * 2, STAGE_BYTES = 8 * HTB, NXCD = 8, WGM = 8;
__host__ __device__ __forceinline__ int lds_byte(int r, int c) { const int st = (r >> 4) * 2 + (c >> 5), rr = r & 15, cc = c & 31, ob = rr * 64 + cc * 2; return st * 1024 + (ob ^ (((ob >> 9) & 1) << 5)); }
__host__ __device__ __forceinline__ void stage_rc(int b, int& R, int& C) { const int st = b / 1024, sb = b % 1024, swz = sb ^ (((sb >> 9) & 1) << 5); R = (st >> 1) * 16 + swz / 64; C = (st & 1) * 32 + (swz % 64) / 2; }
__host__ __device__ __forceinline__ int perm32(int rho) { const int n = rho >> 4, i = rho & 15; return 8 * (i >> 2) + 4 * n + (i & 3); }
struct Unit { int pm, pn, a0, a1; };
__device__ __forceinline__ unsigned cvt_pk_bf16(float lo, float hi) { unsigned r; asm volatile("v_cvt_pk_bf16_f32 %0, %1, %2" : "=v"(r) : "v"(lo), "v"(hi)); return r; }

template <class Epi, class Sched>
__device__ __forceinline__ void gemm_phase(PG8_LAS unsigned char* lds, const int K, const Sched& S, const Epi& E, const int wave_s) {
    int tid_o = wave_s * 64 + lane_id(); asm volatile("" : "+v"(tid_o));
    const int tid = tid_o, wid = __builtin_amdgcn_readfirstlane(tid >> 6), lane = tid & 63, wr = wid >> 2, wc = wid & 3, fr = lane & 15, fq = lane >> 4;
    const int nt = K / BK;
    int Rr[2], Cc[2]; unsigned voffB[2];
#pragma unroll
    for (int i = 0; i < 2; ++i) { int R, C; stage_rc(tid * 16 + i * 8192, R, C); Rr[i] = R; Cc[i] = C; const int Rb = (R & ~31) + perm32(R & 31); voffB[i] = (unsigned)(Rb * K + C) * 2u; }
    const size_t kstepB = (size_t)(BK * 2), kstepA = S.kstepA();
    const size_t hstepB = (size_t)HALF * K * 2;
    const unsigned ldsw = (unsigned)wid * 1024u;
    const int aoff = lds_byte(wr * 64 + fr, fq * 8), boff = lds_byte(wc * 32 + fr, fq * 8);
#define PG8_SA(b, h) (((b) * 2 + (h)) * HTB)
#define PG8_SB(b, h) ((4 + (b) * 2 + (h)) * HTB)
#define PG8_STAGE(bufoff, gbase, voff) do { _Pragma("unroll") for (int _i = 0; _i < 2; ++_i) \
        __builtin_amdgcn_global_load_lds((const unsigned*)((const char*)(gbase) + (voff)[_i]), (PG8_LAS unsigned*)(lds + (bufoff) + ldsw + _i * 8192), 16, 0, 0); } while (0)
#define PG8_LDA(dst, b, h) do { _Pragma("unroll") for (int m = 0; m < 4; ++m) _Pragma("unroll") for (int k = 0; k < 2; ++k) dst[m][k] = *(const PG8_LAS bf16x8*)(lds + PG8_SA(b, h) + aoff + m * 2048 + k * 1024); } while (0)
#define PG8_LDB(dst, b, h) do { _Pragma("unroll") for (int n = 0; n < 2; ++n) _Pragma("unroll") for (int k = 0; k < 2; ++k) dst[n][k] = *(const PG8_LAS bf16x8*)(lds + PG8_SB(b, h) + boff + n * 2048 + k * 1024); } while (0)
#define PG8_MMA(ai, bj, At, Bt) do { __builtin_amdgcn_s_setprio(1); _Pragma("unroll") for (int m = 0; m < 4; ++m) _Pragma("unroll") for (int n = 0; n < 2; ++n) _Pragma("unroll") for (int k = 0; k < 2; ++k) \
        acc[ai][bj][m][n] = __builtin_amdgcn_mfma_f32_16x16x32_bf16(Bt[n][k], At[m][k], acc[ai][bj][m][n], 0, 0, 0); __builtin_amdgcn_s_setprio(0); } while (0)
#define PG8_WAIT_V(n) asm volatile("s_waitcnt vmcnt(" #n ")" ::: "memory")
#define PG8_WAIT_L(n) asm volatile("s_waitcnt lgkmcnt(" #n ")" ::: "memory")
#define PG8_BAR __builtin_amdgcn_s_barrier()
#define PG8_SCHED __builtin_amdgcn_sched_barrier(0)
    Unit cur, nxt; int ui = 0;
    if (!S.next(0, cur)) return;
    f32x4 acc[2][2][4][2];
#pragma unroll
    for (int a = 0; a < 2; ++a)
#pragma unroll
        for (int b = 0; b < 2; ++b)
#pragma unroll
            for (int m = 0; m < 4; ++m)
#pragma unroll
                for (int n = 0; n < 2; ++n) acc[a][b][m][n] = (f32x4){0.f, 0.f, 0.f, 0.f};
    bf16x8 At[4][2], B0[2][2], B1[2][2];
    unsigned vA[2][2], vN[2][2];
    S.a_voff(cur, Rr, Cc, vA);
    const char* cA = S.a_base(cur); const char* cB = S.b_base(cur);
    PG8_STAGE(PG8_SB(0, 0), cB, voffB); PG8_STAGE(PG8_SB(0, 1), cB + hstepB, voffB); PG8_STAGE(PG8_SA(0, 0), cA, vA[0]); PG8_STAGE(PG8_SA(0, 1), cA, vA[1]);
    if (wr == 1) PG8_BAR;
    PG8_WAIT_V(2); PG8_BAR;
    PG8_STAGE(PG8_SB(1, 0), cB + kstepB, voffB); PG8_STAGE(PG8_SA(1, 0), cA + kstepA, vA[0]); PG8_STAGE(PG8_SB(1, 1), cB + hstepB + kstepB, voffB);
    PG8_WAIT_V(6); PG8_BAR;
    for (;;) {
        const bool has_next = S.next(ui + 1, nxt);
        const char* nA = cA; const char* nB = cB;
#pragma unroll
        for (int h = 0; h < 2; ++h)
#pragma unroll
            for (int i = 0; i < 2; ++i) vN[h][i] = vA[h][i];
        if (has_next) { nA = S.a_base(nxt); nB = S.b_base(nxt); S.a_voff(nxt, Rr, Cc, vN); }
#pragma unroll 1
        for (int t = 0; t < nt; t += 2) {
            const bool last = (t == nt - 2);
            const char* a1 = cA + (size_t)(t + 1) * kstepA;
            const char* a2 = last ? nA : cA + (size_t)(t + 2) * kstepA; const char* b2 = last ? nB : cB + (size_t)(t + 2) * kstepB;
            const char* a3 = a2 + kstepA; const char* b3 = b2 + kstepB;
            unsigned v2[2][2];
#pragma unroll
            for (int h = 0; h < 2; ++h)
#pragma unroll
                for (int i = 0; i < 2; ++i) v2[h][i] = last ? vN[h][i] : vA[h][i];
            PG8_LDB(B0, 0, 0); PG8_LDB(B1, 0, 1); PG8_SCHED; PG8_LDA(At, 0, 0); PG8_STAGE(PG8_SA(1, 1), a1, vA[1]);
            PG8_WAIT_V(8); PG8_WAIT_L(0); PG8_BAR; PG8_MMA(0, 0, At, B0); PG8_MMA(0, 1, At, B1); PG8_BAR; PG8_SCHED;
            PG8_LDA(At, 0, 1); PG8_STAGE(PG8_SB(0, 0), b2, voffB); PG8_STAGE(PG8_SB(0, 1), b2 + hstepB, voffB); PG8_STAGE(PG8_SA(0, 0), a2, v2[0]);
            PG8_WAIT_V(8); PG8_WAIT_L(0); PG8_BAR; PG8_MMA(1, 0, At, B0); PG8_MMA(1, 1, At, B1); PG8_BAR; PG8_SCHED;
            PG8_LDB(B0, 1, 0); PG8_LDB(B1, 1, 1); PG8_SCHED; PG8_LDA(At, 1, 0); PG8_STAGE(PG8_SA(0, 1), a2, v2[1]);
            PG8_WAIT_V(8); PG8_WAIT_L(0); PG8_BAR; PG8_MMA(0, 0, At, B0); PG8_MMA(0, 1, At, B1); PG8_BAR; PG8_SCHED;
            PG8_LDA(At, 1, 1); PG8_STAGE(PG8_SB(1, 0), b3, voffB); PG8_STAGE(PG8_SB(1, 1), b3 + hstepB, voffB); PG8_STAGE(PG8_SA(1, 0), a3, v2[0]);
            PG8_WAIT_V(8); PG8_WAIT_L(0); PG8_BAR; PG8_MMA(1, 0, At, B0); PG8_MMA(1, 1, At, B1); PG8_BAR; PG8_SCHED;
        }
        if (wr == 0) PG8_BAR;
        E(acc, cur, wr, wc, fr, fq);
        if (!has_next) break;
#pragma unroll
        for (int a = 0; a < 2; ++a)
#pragma unroll
            for (int b = 0; b < 2; ++b)
#pragma unroll
                for (int m = 0; m < 4; ++m)
#pragma unroll
                    for (int n = 0; n < 2; ++n) acc[a][b][m][n] = (f32x4){0.f, 0.f, 0.f, 0.f};
        cur = nxt; cA = nA; cB = nB; ++ui;
#pragma unroll
        for (int h = 0; h < 2; ++h)
#pragma unroll
            for (int i = 0; i < 2; ++i) vA[h][i] = vN[h][i];
        if (wr == 1) PG8_BAR;
    }
    PG8_WAIT_V(0);
    PG8_BAR;
#undef PG8_SA
#undef PG8_SB
#undef PG8_STAGE
#undef PG8_LDA
#undef PG8_LDB
#undef PG8_MMA
#undef PG8_WAIT_V
#undef PG8_WAIT_L
#undef PG8_BAR
#undef PG8_SCHED
}

struct DenseSched {
    const bf16_t* A; const bf16_t* Bt; int lda, K; int nM, nN, nwg, G, c;
    __device__ __forceinline__ void init(const bf16_t* A_, int lda_, const bf16_t* Bt_, int M, int N, int K_, int G_, int c_) { A = A_; lda = lda_; Bt = Bt_; K = K_; nM = M / BM; nN = N / BM; nwg = nM * nN; G = G_; c = c_; }
    __device__ __forceinline__ size_t kstepA() const { return (size_t)(BK * 2); }
    __device__ __forceinline__ bool next(int i, Unit& u) const {
        const long L = (long)i * G + c; if (L >= nwg) return false;
        int wgid = (int)L; { const int q = nwg / NXCD, r = nwg % NXCD, xcd = wgid % NXCD, off = wgid / NXCD; wgid = (xcd < r ? xcd * (q + 1) : r * (q + 1) + (xcd - r) * q) + off; }
        const int nig = WGM * nN, gid = wgid / nig, fm = gid * WGM, gsz = (nM - fm) < WGM ? (nM - fm) : WGM;
        u.pm = fm + ((wgid % nig) % gsz); u.pn = (wgid % nig) / gsz; u.a0 = 0; u.a1 = 0; return true;
    }
    __device__ __forceinline__ const char* a_base(const Unit& u) const { return (const char*)A + (size_t)u.pm * BM * lda * 2; }
    __device__ __forceinline__ const char* b_base(const Unit& u) const { return (const char*)Bt + (size_t)u.pn * BM * K * 2; }
    __device__ __forceinline__ void a_voff(const Unit&, const int (&R)[2], const int (&C)[2], unsigned (&v)[2][2]) const {
#pragma unroll
        for (int h = 0; h < 2; ++h)
#pragma unroll
            for (int i = 0; i < 2; ++i) v[h][i] = (unsigned)((h * HALF + R[i]) * lda + C[i]) * 2u;
    }
};
}

#define XB_TMO      128
#define XB_XCNT(j)  (256  + 64 * (j))
#define XB_XSUB(j)  (1280 + 64 * (j))
#define XB_XGEN(j)  (2304 + 64 * (j))
#define XB_TOP      3328
#define XB_TOPGEN   3392
#define XCD_BAR_WORDS 3456
#define XB_SPIN_CAP (1u << 22)
__device__ __forceinline__ unsigned xb_ld(unsigned* p)              { return __hip_atomic_load(p, __ATOMIC_RELAXED, __HIP_MEMORY_SCOPE_AGENT); }
__device__ __forceinline__ unsigned xb_add(unsigned* p, unsigned v) { return __hip_atomic_fetch_add(p, v, __ATOMIC_RELAXED, __HIP_MEMORY_SCOPE_AGENT); }
__device__ __forceinline__ unsigned xb_xcc_id() { return (unsigned)__builtin_amdgcn_s_getreg((3 << 11) | 20) & 0xFu; }
#define XB_SPIN(cond, bar) do { unsigned _sp = 0; while (cond) { __builtin_amdgcn_s_sleep(1); \
    if ((++_sp & 255u) == 0u) { if (xb_ld(&(bar)[XB_TMO])) break; if (_sp > XB_SPIN_CAP) { atomicAdd(&(bar)[XB_TMO], 1u); break; } } } } while (0)
struct XcdBarrier { unsigned* bar; unsigned x; volatile LAS unsigned* st; int wave; };
__device__ __forceinline__ XcdBarrier xcd_barrier_post(unsigned* bar, volatile LAS unsigned* st, int wave) {
    XcdBarrier b; b.bar = bar; b.x = xb_xcc_id(); b.st = st; b.wave = wave;
    if (wave == 0 && lane_id() == 0) (void)xb_add(&bar[XB_XCNT(b.x)], 1u);
    return b;
}
__device__ __forceinline__ void xcd_barrier_complete(unsigned* bar, unsigned x, unsigned& nloc, unsigned& nx) {
    const unsigned G = gridDim.x * gridDim.y * gridDim.z;
    unsigned sum, cnt, mine, sp = 0u;
    for (;;) {
        sum = 0u; cnt = 0u; mine = 0u;
#pragma unroll
        for (unsigned j = 0; j < 16; ++j) { const unsigned c = xb_ld(&bar[XB_XCNT(j)]); sum += c; cnt += (c > 0u) ? 1u : 0u; }
        mine = xb_ld(&bar[XB_XCNT(x)]);
        if (sum == G) break;
        __builtin_amdgcn_s_sleep(1);
        if ((++sp & 255u) == 0u) { if (xb_ld(&bar[XB_TMO])) break; if (sp > XB_SPIN_CAP) { atomicAdd(&bar[XB_TMO], 1u); break; } }
    }
    nloc = mine > 0u ? mine : 1u; nx = cnt > 0u ? cnt : 1u;
}
__device__ __forceinline__ void xcd_barrier(const XcdBarrier& b) {
    asm volatile("s_waitcnt vmcnt(0)" ::: "memory");
    __syncthreads();
    if (b.wave == 0 && lane_id() == 0) {
        unsigned* bar = b.bar; asm volatile("" : "+s"(bar)); unsigned bx = b.x; asm volatile("" : "+s"(bx));
        __builtin_amdgcn_s_waitcnt(0);
        unsigned nloc = b.st[0], nx = b.st[1];
        if (nloc == 0u) { xcd_barrier_complete(bar, bx, nloc, nx); b.st[0] = nloc; b.st[1] = nx; }
        const unsigned old = xb_add(&bar[XB_XSUB(bx)], 1u);
        const unsigned gen = old / nloc;
        if (old + 1u == (gen + 1u) * nloc) {
            __builtin_amdgcn_fence(__ATOMIC_RELEASE, "agent");
            asm volatile("s_waitcnt vmcnt(0)" ::: "memory");
            const unsigned og = xb_add(&bar[XB_TOP], 1u);
            const unsigned tg = og / nx;
            if (og + 1u == (tg + 1u) * nx) xb_add(&bar[XB_TOPGEN], 1u);
            else XB_SPIN(xb_ld(&bar[XB_TOPGEN]) == tg, bar);
            __builtin_amdgcn_fence(__ATOMIC_ACQUIRE, "agent");
            xb_add(&bar[XB_XGEN(bx)], 1u);
            asm volatile("s_waitcnt vmcnt(0)" ::: "memory");
        } else {
            XB_SPIN(xb_ld(&bar[XB_XGEN(bx)]) == gen, bar);
            __builtin_amdgcn_fence(__ATOMIC_ACQUIRE, "agent");
            asm volatile("s_waitcnt vmcnt(0)" ::: "memory");
        }
    }
    __syncthreads();
}

struct Args { const float* in[37]; float* out; unsigned char* ws; int ph_lo, ph_hi; };
typedef const __attribute__((address_space(4))) Args* KArgs;
__device__ __forceinline__ KArgs ka_get() { KArgs k = (KArgs)__builtin_amdgcn_kernarg_segment_ptr(); asm volatile("" : "+s"(k)); return k; }
enum { I_X = 0, I_P, I_MIXN, I_WIN, I_CONVW, I_CONVB, I_WA, I_BA, I_WX, I_BX, I_LAM, I_PEK, I_PEV, I_WK1, I_BK1, I_WK2, I_BK2, I_WV1, I_BV1, I_WV2, I_BV2,
       I_RECN, I_ATTN, I_WOUT, I_FFNN, I_WGR, I_BGR, I_WER, I_BER, I_WGATE, I_WUP, I_WDOWN, I_PLEN, I_WPG, I_BPG, I_WPU, I_FINN };

namespace pg8 {
struct CmpSched {
    const bf16_t* z; const bf16_t* W1k; const bf16_t* W1v; int G, c;
    __device__ __forceinline__ size_t kstepA() const { return (size_t)ZP * 2; }
    __device__ __forceinline__ bool next(int i, Unit& u) const { const int L = i * G + c; if (L >= 64) return false; u.pm = L >> 1; u.pn = 0; u.a0 = L & 1; u.a1 = 0; return true; }
    __device__ __forceinline__ const char* a_base(const Unit& u) const { const int b = u.pm >> 1, g = u.pm & 1; return (const char*)(z + (size_t)b * SEQ * ZP + (u.a0 ? ZC_VC : ZC_KC) + g * 64); }
    __device__ __forceinline__ const char* b_base(const Unit& u) const { return (const char*)(u.a0 ? W1v : W1k); }
    __device__ __forceinline__ void a_voff(const Unit&, const int (&R)[2], const int (&C)[2], unsigned (&v)[2][2]) const {
#pragma unroll
        for (int h = 0; h < 2; ++h)
#pragma unroll
            for (int i = 0; i < 2; ++i) v[h][i] = (unsigned)(16 * (h * HALF + R[i]) * ZP + C[i]) * 2u;
    }
};
template <int PHASE>
struct MoeSched {
    const PG8_LAS int* tab; const bf16_t* A; const bf16_t* W; const int* ltok; int G, c;
    __device__ __forceinline__ size_t kstepA() const { return (size_t)(BK * 2); }
    __device__ __forceinline__ bool next(int i, Unit& u) const {
        const int TT = tab[64]; int rt, pn;
        if (G == 256) { const int x = c & 7, y = c >> 3, Q = (TT + 7) >> 3, rl = i * 8 + (y >> 2); pn = y & 3; if (rl >= Q) return false; rt = x * Q + rl; }
        else { const int L = i * G + c; rt = L >> 2; pn = L & 3; }
        if (rt >= TT) return false;
        int lo = 0, hi = 64;
        while (hi - lo > 1) { const int mid = (lo + hi) >> 1; if (tab[mid] <= rt) lo = mid; else hi = mid; }
        u.pm = rt; u.pn = pn; u.a0 = lo; u.a1 = rt - tab[lo]; return true;
    }
    __device__ __forceinline__ const char* a_base(const Unit& u) const { return PHASE == 1 ? (const char*)A : (const char*)A + (size_t)u.pm * BM * DEXP * 2; }
    __device__ __forceinline__ const char* b_base(const Unit& u) const {
        const int e = u.a0 & 31;
        return PHASE == 1 ? (const char*)W + ((size_t)e * 1024 + (size_t)u.pn * BM) * 1024 * 2 : (const char*)W + ((size_t)e * 1024 + (size_t)u.pn * BM) * DEXP * 2;
    }
    __device__ __forceinline__ void a_voff(const Unit& u, const int (&R)[2], const int (&C)[2], unsigned (&v)[2][2]) const {
        if (PHASE == 1) {
            const int cnt = tab[80 + u.a0];
#pragma unroll
            for (int h = 0; h < 2; ++h)
#pragma unroll
                for (int i = 0; i < 2; ++i) { const int rank = u.a1 * BM + h * HALF + R[i]; const int tok = rank < cnt ? ltok[(size_t)u.a0 * NTOK + rank] : 0; v[h][i] = (unsigned)(tok * DM + C[i]) * 2u; }
        } else {
#pragma unroll
            for (int h = 0; h < 2; ++h)
#pragma unroll
                for (int i = 0; i < 2; ++i) v[h][i] = (unsigned)((h * HALF + R[i]) * DEXP + C[i]) * 2u;
        }
    }
};

template <int ACT  > struct EpiBf16 {
    bf16_t* O; int ldc; const float* bias; size_t a0_stride; int a0_bias_stride;
    const float* rs;
    __device__ __forceinline__ void operator()(const f32x4 (&acc)[2][2][4][2], const Unit& u, int wr, int wc, int fr, int fq) const {
        const int row0 = u.pm * BM + wr * 64 + fr, col0 = u.pn * BM + wc * 32 + 8 * fq;
        bf16_t* base = O + (size_t)u.a0 * a0_stride; const float* bs = bias ? bias + u.a0 * a0_bias_stride : nullptr;
        float rsv[2][4];
#pragma unroll
        for (int ai = 0; ai < 2; ++ai)
#pragma unroll
            for (int m = 0; m < 4; ++m) rsv[ai][m] = rs ? rs[row0 + ai * HALF + m * 16] : 1.f;
        f32x4 bv[2][2];
#pragma unroll
        for (int bj = 0; bj < 2; ++bj)
#pragma unroll
            for (int n = 0; n < 2; ++n) bv[bj][n] = bs ? *(const f32x4*)(bs + col0 + bj * HALF + 4 * n) : (f32x4){0.f, 0.f, 0.f, 0.f};
#pragma unroll
        for (int ai = 0; ai < 2; ++ai)
#pragma unroll
            for (int m = 0; m < 4; ++m) { bf16_t* rowp = base + (size_t)(row0 + ai * HALF + m * 16) * ldc + col0; const float sc = rsv[ai][m];
#pragma unroll
                for (int bj = 0; bj < 2; ++bj) { f32x4 v0 = acc[ai][bj][m][0], v1 = acc[ai][bj][m][1];
                    if (rs) { v0 *= sc; v1 *= sc; }
                    v0 += bv[bj][0]; v1 += bv[bj][1];
                    if (ACT == 1) { for (int e = 0; e < 4; ++e) { v0[e] = fgelu(v0[e]); v1[e] = fgelu(v1[e]); } }
                    if (ACT == 2) { for (int e = 0; e < 4; ++e) { v0[e] = fsigmoid(v0[e]); v1[e] = fsigmoid(v1[e]); } }
                    u32x4 w; w.x = cvt_pk_bf16(v0[0], v0[1]); w.y = cvt_pk_bf16(v0[2], v0[3]); w.z = cvt_pk_bf16(v1[0], v1[1]); w.w = cvt_pk_bf16(v1[2], v1[3]);
                    *(u32x4*)(rowp + bj * HALF) = w; } }
    }
};
struct EpiResid {
    bf16_t* h;
    __device__ __forceinline__ void operator()(const f32x4 (&acc)[2][2][4][2], const Unit& u, int wr, int wc, int fr, int fq) const {
        const int row0 = u.pm * BM + wr * 64 + fr, col0 = u.pn * BM + wc * 32 + 8 * fq;
#pragma unroll
        for (int ai = 0; ai < 2; ++ai) {
            bf16_t* rp0 = h + (size_t)(row0 + ai * HALF) * DM + col0;
            u32x4 hv[4][2];
#pragma unroll
            for (int m = 0; m < 4; ++m)
#pragma unroll
                for (int bj = 0; bj < 2; ++bj) hv[m][bj] = *(const u32x4*)(rp0 + (size_t)m * 16 * DM + bj * HALF);
#pragma unroll
            for (int m = 0; m < 4; ++m)
#pragma unroll
                for (int bj = 0; bj < 2; ++bj) { const u32x4 x = hv[m][bj]; const f32x4 a0 = acc[ai][bj][m][0], a1 = acc[ai][bj][m][1];
                    u32x4 w; w.x = cvt_pk_bf16(bflo(x.x) + a0[0], bfhi(x.x) + a0[1]); w.y = cvt_pk_bf16(bflo(x.y) + a0[2], bfhi(x.y) + a0[3]); w.z = cvt_pk_bf16(bflo(x.z) + a1[0], bfhi(x.z) + a1[1]); w.w = cvt_pk_bf16(bflo(x.w) + a1[2], bfhi(x.w) + a1[3]);
                    *(u32x4*)(rp0 + (size_t)m * 16 * DM + bj * HALF) = w; }
            asm volatile("" ::: "memory");
        }
    }
};
struct EpiPleB {
    const bf16_t* h; bf16_t* hn; const bf16_t* Gt;
    __device__ __forceinline__ void operator()(const f32x4 (&acc)[2][2][4][2], const Unit& u, int wr, int wc, int fr, int fq) const {
        const int row0 = u.pm * BM + wr * 64 + fr, col0 = u.pn * BM + wc * 32 + 8 * fq;
#pragma unroll
        for (int ai = 0; ai < 2; ++ai) {
            const size_t ro0 = (size_t)(row0 + ai * HALF) * DM + col0;
            u32x4 hv[4][2], gv[4][2];
#pragma unroll
            for (int m = 0; m < 4; ++m)
#pragma unroll
                for (int bj = 0; bj < 2; ++bj) { hv[m][bj] = *(const u32x4*)(h + ro0 + (size_t)m * 16 * DM + bj * HALF); gv[m][bj] = *(const u32x4*)(Gt + ro0 + (size_t)m * 16 * DM + bj * HALF); }
#pragma unroll
            for (int m = 0; m < 4; ++m)
#pragma unroll
                for (int bj = 0; bj < 2; ++bj) { const u32x4 x = hv[m][bj], g = gv[m][bj]; const f32x4 a0 = acc[ai][bj][m][0], a1 = acc[ai][bj][m][1];
                    u32x4 w; w.x = cvt_pk_bf16(bflo(x.x) + a0[0] * bflo(g.x), bfhi(x.x) + a0[1] * bfhi(g.x)); w.y = cvt_pk_bf16(bflo(x.y) + a0[2] * bflo(g.y), bfhi(x.y) + a0[3] * bfhi(g.y));
                    w.z = cvt_pk_bf16(bflo(x.z) + a1[0] * bflo(g.z), bfhi(x.z) + a1[1] * bfhi(g.z)); w.w = cvt_pk_bf16(bflo(x.w) + a1[2] * bflo(g.w), bfhi(x.w) + a1[3] * bfhi(g.w));
                    *(u32x4*)(hn + ro0 + (size_t)m * 16 * DM + bj * HALF) = w; }
            asm volatile("" ::: "memory");
        }
    }
};
struct EpiSwiglu {
    bf16_t* Hd; const PG8_LAS int* tab; const float* lrs;
    __device__ __forceinline__ void operator()(const f32x4 (&acc)[2][2][4][2], const Unit& u, int wr, int wc, int fr, int fq) const {
        const int row0 = u.pm * BM + wr * 64 + fr, col0 = u.pn * HALF + wc * 32 + 8 * fq; const int seg = u.a0, cnt = tab[80 + seg];
        float rsv[2][4];
#pragma unroll
        for (int ai = 0; ai < 2; ++ai)
#pragma unroll
            for (int m = 0; m < 4; ++m) { const int rank = u.a1 * BM + ai * HALF + wr * 64 + m * 16 + fr; const float v = lrs[(size_t)seg * NTOK + (rank < cnt ? rank : 0)]; rsv[ai][m] = rank < cnt ? v : 0.f; }
#pragma unroll
        for (int ai = 0; ai < 2; ++ai)
#pragma unroll
            for (int m = 0; m < 4; ++m) { const float rs = rsv[ai][m];
                float r[8];
#pragma unroll
                for (int n = 0; n < 2; ++n)
#pragma unroll
                    for (int e = 0; e < 4; ++e) { const float gt = acc[ai][0][m][n][e] * rs, up = acc[ai][1][m][n][e] * rs; r[4 * n + e] = gt * fsigmoid(gt) * up; }
                u32x4 w; w.x = cvt_pk_bf16(r[0], r[1]); w.y = cvt_pk_bf16(r[2], r[3]); w.z = cvt_pk_bf16(r[4], r[5]); w.w = cvt_pk_bf16(r[6], r[7]);
                *(u32x4*)(Hd + (size_t)(row0 + ai * HALF + m * 16) * DEXP + col0) = w; }
    }
};
struct EpiMoeDown {
    const PG8_LAS int* tab; const int* ltok; const float* lgate; bf16_t* y0; bf16_t* y1;
    __device__ __forceinline__ void operator()(const f32x4 (&acc)[2][2][4][2], const Unit& u, int wr, int wc, int fr, int fq) const {
        const int seg = u.a0, cnt = tab[80 + seg]; bf16_t* yb = (seg >= 32) ? y1 : y0;
        const int col0 = u.pn * BM + wc * 32 + 8 * fq;
        int tk[2][4]; float gtv[2][4];
#pragma unroll
        for (int ai = 0; ai < 2; ++ai)
#pragma unroll
            for (int m = 0; m < 4; ++m) { const int rank = u.a1 * BM + ai * HALF + wr * 64 + m * 16 + fr; const size_t o = (size_t)seg * NTOK + (rank < cnt ? rank : 0); tk[ai][m] = ltok[o]; gtv[ai][m] = lgate[o]; }
#pragma unroll
        for (int ai = 0; ai < 2; ++ai)
#pragma unroll
            for (int m = 0; m < 4; ++m) { const int rank = u.a1 * BM + ai * HALF + wr * 64 + m * 16 + fr;
                if (rank < cnt) { const int tok = tk[ai][m]; const float gt = gtv[ai][m];
#pragma unroll
                    for (int bj = 0; bj < 2; ++bj) { const f32x4 v0 = acc[ai][bj][m][0] * gt, v1 = acc[ai][bj][m][1] * gt;
                        u32x4 w; w.x = cvt_pk_bf16(v0[0], v0[1]); w.y = cvt_pk_bf16(v0[2], v0[3]); w.z = cvt_pk_bf16(v1[0], v1[1]); w.w = cvt_pk_bf16(v1[2], v1[3]);
                        *(u32x4*)(yb + (size_t)tok * DM + col0 + bj * HALF) = w; } } }
    }
};
}

struct TrItem { const float* W; const float* gain; bf16* WT; int K, N, dest_row0, k0, n0; float cs; };
__device__ __forceinline__ void tr_load(const TrItem& t, f32x4 (&v)[8], int lane) {
    const int c4 = lane & 7, kr = lane >> 3; const bool ok = t.n0 + 4 * c4 < t.N;
#pragma unroll
    for (int i = 0; i < 8; ++i) v[i] = ok ? *(const f32x4*)(t.W + (size_t)(t.k0 + 8 * i + kr) * t.N + t.n0 + 4 * c4) : (f32x4){0.f, 0.f, 0.f, 0.f};
}
__device__ __forceinline__ void tr_store(const TrItem& t, const f32x4 (&v)[8], LAS float* scr, int lane) {
    const int c4 = lane & 7, kr = lane >> 3;
#pragma unroll
    for (int i = 0; i < 8; ++i) { const int kk = 8 * i + kr; const float gsc = (t.gain ? t.gain[t.k0 + kk] : 1.f) * t.cs; LAS float* d = scr + kk * 33 + 4 * c4;
        d[0] = v[i].x * gsc; d[1] = v[i].y * gsc; d[2] = v[i].z * gsc; d[3] = v[i].w * gsc; }
    LDS_WAIT();
    const int c = lane & 7;
#pragma unroll
    for (int j = 0; j < 4; ++j) { const int n = (lane >> 3) + 8 * j; const LAS float* sp = scr + (8 * c) * 33 + n;
        u32x4 o; o.x = pk2(sp[0], sp[33]); o.y = pk2(sp[66], sp[99]); o.z = pk2(sp[132], sp[165]); o.w = pk2(sp[198], sp[231]);
        *(u32x4*)(t.WT + (size_t)(t.dest_row0 + n) * t.K + t.k0 + 8 * c) = o; }
    LDS_WAIT();
}
constexpr int IT_IN = 16 * 80, IT_OUT = 16 * 32, IT_PG = 16 * 32, IT_PU = 4 * 32, IT_K1 = 32 * 8, IT_V1 = 32 * 8, IT_E = 768;
constexpr int IT_LAYER = IT_IN + IT_OUT + IT_PG + IT_PU + IT_K1 + IT_V1 + NEXP * IT_E;

constexpr int IT_SMALL = IT_IN + IT_OUT + IT_PG + IT_PU + IT_K1 + IT_V1;
template <int MODE>
__device__ __forceinline__ void tr_run(KArgs args, LAS float* scr, int lane, int q0, int qstep, int Lsel) {
    unsigned char* ws = args->ws;
    const int nq = MODE == 0 ? DEPTH * IT_SMALL : NEXP * IT_E;
#define Q2IT_(q) (MODE == 0 ? ((q) / IT_SMALL) * IT_LAYER + (q) % IT_SMALL : Lsel * IT_LAYER + IT_SMALL + (q))
#define TR_DECODE(it_, t_) do { const int L = (it_) / IT_LAYER; int r = (it_) % IT_LAYER; unsigned char* wl = ws + WS_W + (size_t)L * W_LAYER; t_.cs = 1.f; t_.gain = nullptr; \
        if (r < IT_IN) { const int kb = r / 80, nb = r % 80; t_.W = args->in[I_WIN] + (size_t)L * DM * D_IN; t_.K = DM; t_.N = D_IN; t_.gain = args->in[I_MIXN] + L * DM; t_.WT = (bf16*)(wl + WO_IN); t_.dest_row0 = 32 * nb; t_.k0 = 64 * kb; t_.n0 = 32 * nb; \
            t_.cs = (32 * nb >= ZC_Q && 32 * nb < ZC_KC) ? 0.125f * LOG2E : 1.f; break; } r -= IT_IN; \
        if (r < IT_OUT) { const int kb = r / 32, nb = r % 32; t_.W = args->in[I_WOUT] + (size_t)L * DM * DM; t_.K = DM; t_.N = DM; t_.gain = kb < 8 ? args->in[I_RECN] + L * 512 : args->in[I_ATTN] + L * 512 - 512; t_.WT = (bf16*)(wl + WO_OUT); t_.dest_row0 = 32 * nb; t_.k0 = 64 * kb; t_.n0 = 32 * nb; break; } r -= IT_OUT; \
        if (r < IT_PG) { const int kb = r / 32, nb = r % 32; t_.W = args->in[I_WPG] + (size_t)L * DM * DM; t_.K = DM; t_.N = DM; t_.gain = args->in[I_PLEN] + L * DM; t_.WT = (bf16*)(wl + WO_PG); t_.dest_row0 = 32 * nb; t_.k0 = 64 * kb; t_.n0 = 32 * nb; break; } r -= IT_PG; \
        if (r < IT_PU) { const int kb = r / 32, nb = r % 32; t_.W = args->in[I_WPU] + (size_t)L * D_PLE * DM; t_.K = D_PLE; t_.N = DM; t_.WT = (bf16*)(wl + WO_PU); t_.dest_row0 = 32 * nb; t_.k0 = 64 * kb; t_.n0 = 32 * nb; break; } r -= IT_PU; \
        if (r < IT_K1) { const int kb = r / 8, nb = r % 8; t_.W = args->in[I_WK1] + (size_t)L * 2048 * 256; t_.K = 2048; t_.N = 256; t_.WT = (bf16*)(wl + WO_K1); t_.dest_row0 = 32 * nb; t_.k0 = 64 * kb; t_.n0 = 32 * nb; break; } r -= IT_K1; \
        if (r < IT_V1) { const int kb = r / 8, nb = r % 8; t_.W = args->in[I_WV1] + (size_t)L * 2048 * 256; t_.K = 2048; t_.N = 256; t_.WT = (bf16*)(wl + WO_V1); t_.dest_row0 = 32 * nb; t_.k0 = 64 * kb; t_.n0 = 32 * nb; break; } r -= IT_V1; \
        const int e = r / IT_E; int rr = r % IT_E; \
        if (rr < 512) { const int up = rr >> 8; rr &= 255; const int kb = rr / 16, nb = rr % 16, n0 = 32 * nb;     \
            t_.W = (up ? args->in[I_WUP] : args->in[I_WGATE]) + ((size_t)L * NEXP + e) * DM * DEXP; t_.K = DM; t_.N = DEXP; t_.gain = args->in[I_FFNN] + L * DM; t_.WT = (bf16*)(wl + WO_GU) + (size_t)e * 1024 * 1024; \
            t_.dest_row0 = 256 * (n0 >> 7) + (n0 & 127) + 128 * up; t_.k0 = 64 * kb; t_.n0 = n0; } \
        else { rr -= 512; const int kb = rr / 32, nb = rr % 32; t_.W = args->in[I_WDOWN] + ((size_t)L * NEXP + e) * DEXP * DM; t_.K = DEXP; t_.N = DM; t_.WT = (bf16*)(wl + WO_D) + (size_t)e * 1024 * DEXP; t_.dest_row0 = 32 * nb; t_.k0 = 64 * kb; t_.n0 = 32 * nb; } \
    } while (0)
    int q = q0; TrItem cur; f32x4 vc[8];
    if (q < nq) { TR_DECODE(Q2IT_(q), cur); tr_load(cur, vc, lane); }
    while (q < nq) {
        const int qn = q + qstep; TrItem nxt; f32x4 vn[8];
        const bool hn = qn < nq;
        if (hn) { TR_DECODE(Q2IT_(qn), nxt); tr_load(nxt, vn, lane); }
        tr_store(cur, vc, scr, lane);
        if (hn) { cur = nxt;
#pragma unroll
            for (int i = 0; i < 8; ++i) vc[i] = vn[i]; }
        q = qn; }
#undef TR_DECODE
#undef Q2IT_
}
__device__ __forceinline__ void phase_prologue(KArgs args, LAS unsigned char* lds, int G, int bid, int tid, int wave, int lane) {
    unsigned char* ws = args->ws;
    LAS float* scr = (LAS float*)(lds + wave * 16384);
    const int gw = bid * NWAVES + wave, NGW = G * NWAVES;
    tr_run<0>(args, scr, lane, gw, NGW, 0);
    const int gt = bid * (NWAVES * 64) + tid, NGT = G * NWAVES * 64;
    float* c8 = (float*)(ws + WS_C8); float* wrt = (float*)(ws + WS_WRT);
    for (int i = gt; i < DEPTH * 512; i += NGT) { const float lam = args->in[I_LAM][i]; c8[i] = -8.f * log1pf(expf(-lam)) * LOG2E; }
    for (int i = gt; i < DEPTH * 36 * 1024; i += NGT) { const int L = i / (36 * 1024), j = (i / 1024) % 36, k = i % 1024;
        const float w = (j < 32 ? args->in[I_WER][((size_t)L * DM + k) * 32 + j] : args->in[I_WGR][((size_t)L * DM + k) * 4 + (j - 32)]) * args->in[I_FFNN][L * DM + k];
        const unsigned hi = f2bf(w), lo = f2bf(w - bf2f((bf16)hi));
        ((bf16*)wrt)[((size_t)(L * 2 + 0) * 36 + j) * 1024 + k] = (bf16)hi; ((bf16*)wrt)[((size_t)(L * 2 + 1) * 36 + j) * 1024 + k] = (bf16)lo; }
    { bf16* w2t = (bf16*)(ws + WS_W2T);
      for (int i = gt; i < DEPTH * 2 * 64 * 256; i += NGT) { const int L = i >> 15, kv = (i >> 14) & 1, n = (i >> 8) & 63, k = i & 255;
          w2t[i] = (bf16)f2bf((kv ? args->in[I_WV2] : args->in[I_WK2])[((size_t)L * 256 + k) * 64 + n]); } }
    if (bid < 8) { const int pair = bid, L = pair >> 1, kv = pair & 1, j = tid & 255, half = tid >> 8;
        const float* pe = (kv ? args->in[I_PEV] : args->in[I_PEK]) + L * 2048 + 1024 * half; const float* w1 = (kv ? args->in[I_WV1] : args->in[I_WK1]) + ((size_t)L * 2048 + 1024 * half) * 256 + j;
        float s0 = 0.f, s1 = 0.f, s2 = 0.f, s3 = 0.f;
#pragma unroll 4
        for (int k = 0; k < 1024; k += 4) { s0 += pe[k] * w1[(size_t)k * 256]; s1 += pe[k + 1] * w1[(size_t)(k + 1) * 256]; s2 += pe[k + 2] * w1[(size_t)(k + 2) * 256]; s3 += pe[k + 3] * w1[(size_t)(k + 3) * 256]; }
        LAS float* red = (LAS float*)(lds + 8 * 16384);
        if (half) red[j] = (s0 + s1) + (s2 + s3);
        __syncthreads();
        if (!half) ((float*)(ws + WS_BK1))[pair * 256 + j] = (kv ? args->in[I_BV1] : args->in[I_BK1])[L * 256 + j] + ((s0 + s1) + (s2 + s3)) + red[j]; }
}

__device__ __forceinline__ void store_row_bf16(bf16* orow, const f32x4 (&v)[4], float sc, int lane) {
    unsigned long long* o8 = (unsigned long long*)orow + lane;
#pragma unroll
    for (int j = 0; j < 4; ++j) o8[64 * j] = (unsigned long long)pk2(v[j].x * sc, v[j].y * sc) | ((unsigned long long)pk2(v[j].z * sc, v[j].w * sc) << 32);
}
__device__ __forceinline__ float row_ss_bf16(const u32x2 (&v)[4]) { float s = 0.f;
#pragma unroll
    for (int j = 0; j < 4; ++j) { const float a = bflo(v[j].x), b = bfhi(v[j].x), c = bflo(v[j].y), d = bfhi(v[j].y); s += (a * a + b * b) + (c * c + d * d); }
    return s; }
__device__ __forceinline__ void store_row_bf16_from16(bf16* orow, const u32x2 (&v)[4], float sc, int lane) {
    u32x2* o8 = (u32x2*)orow + lane;
#pragma unroll
    for (int j = 0; j < 4; ++j) { u32x2 w; w.x = pk2(bflo(v[j].x) * sc, bfhi(v[j].x) * sc); w.y = pk2(bflo(v[j].y) * sc, bfhi(v[j].y) * sc); o8[64 * j] = w; }
}
__device__ __forceinline__ float ss_u4(const u32x4& v) {
    const float a = bflo(v.x), b = bfhi(v.x), c = bflo(v.y), d = bfhi(v.y), e = bflo(v.z), f = bfhi(v.z), g = bflo(v.w), h = bfhi(v.w);
    return ((a * a + b * b) + (c * c + d * d)) + ((e * e + f * f) + (g * g + h * h)); }
__device__ __forceinline__ u32x4 scale_u4(const u32x4& v, float sc) { u32x4 w;
    w.x = pg8::cvt_pk_bf16(bflo(v.x) * sc, bfhi(v.x) * sc); w.y = pg8::cvt_pk_bf16(bflo(v.y) * sc, bfhi(v.y) * sc); w.z = pg8::cvt_pk_bf16(bflo(v.z) * sc, bfhi(v.z) * sc); w.w = pg8::cvt_pk_bf16(bflo(v.w) * sc, bfhi(v.w) * sc); return w; }
__device__ __forceinline__ u32x4 add3_u4(const u32x4& h, const u32x4& a, const u32x4& b) { u32x4 w;
    w.x = pg8::cvt_pk_bf16(bflo(h.x) + bflo(a.x) + bflo(b.x), bfhi(h.x) + bfhi(a.x) + bfhi(b.x)); w.y = pg8::cvt_pk_bf16(bflo(h.y) + bflo(a.y) + bflo(b.y), bfhi(h.y) + bfhi(a.y) + bfhi(b.y));
    w.z = pg8::cvt_pk_bf16(bflo(h.z) + bflo(a.z) + bflo(b.z), bfhi(h.z) + bfhi(a.z) + bfhi(b.z)); w.w = pg8::cvt_pk_bf16(bflo(h.w) + bflo(a.w) + bflo(b.w), bfhi(h.w) + bfhi(a.w) + bfhi(b.w)); return w; }
__device__ __forceinline__ void phase_norm1(const float* x, bf16* H, float* rs, int gw, int NGW, int lane) {
    if (x) {
        constexpr int NR = 2;
        for (int m0 = gw * NR; m0 < NTOK; m0 += NGW * NR) { f32x4 v[NR][4];
#pragma unroll
            for (int r = 0; r < NR; ++r)
#pragma unroll
                for (int j = 0; j < 4; ++j) v[r][j] = ((const f32x4*)(x + (size_t)(m0 + r) * DM))[lane + 64 * j];
#pragma unroll
            for (int r = 0; r < NR; ++r) { float s = 0.f;
#pragma unroll
                for (int j = 0; j < 4; ++j) s += (v[r][j].x * v[r][j].x + v[r][j].y * v[r][j].y) + (v[r][j].z * v[r][j].z + v[r][j].w * v[r][j].w);
                const float rstd = rsqrtf(wave_sum(s) * (1.f / DM) + EPS);
                store_row_bf16(H + (size_t)(m0 + r) * DM, v[r], 1.f, lane); if (lane == 0) rs[m0 + r] = rstd; } }
    } else {
        constexpr int NR = 4;
        for (int m0 = gw * NR; m0 < NTOK; m0 += NGW * NR) { u32x4 v[NR][2];
#pragma unroll
            for (int r = 0; r < NR; ++r)
#pragma unroll
                for (int j = 0; j < 2; ++j) v[r][j] = ((const u32x4*)(H + (size_t)(m0 + r) * DM))[lane + 64 * j];
            float rr[NR];
#pragma unroll
            for (int r = 0; r < NR; ++r) rr[r] = rsqrtf(wave_sum(ss_u4(v[r][0]) + ss_u4(v[r][1])) * (1.f / DM) + EPS);
            if (lane == 0) *(f32x4*)(rs + m0) = (f32x4){rr[0], rr[1], rr[2], rr[3]}; }
    }
}
__device__ __forceinline__ void phase_final(const bf16* H, float* out, const float* gain, int gw, int NGW, int lane) {
    constexpr int NR = 4;
    f32x4 gv[2][2];
#pragma unroll
    for (int j = 0; j < 2; ++j) { gv[j][0] = ((const f32x4*)gain)[2 * lane + 128 * j]; gv[j][1] = ((const f32x4*)gain)[2 * lane + 128 * j + 1]; }
    for (int m0 = gw * NR; m0 < NTOK; m0 += NGW * NR) { u32x4 v[NR][2];
#pragma unroll
        for (int r = 0; r < NR; ++r)
#pragma unroll
            for (int j = 0; j < 2; ++j) v[r][j] = ((const u32x4*)(H + (size_t)(m0 + r) * DM))[lane + 64 * j];
#pragma unroll
        for (int r = 0; r < NR; ++r) { const float rstd = rsqrtf(wave_sum(ss_u4(v[r][0]) + ss_u4(v[r][1])) * (1.f / DM) + EPS);
            f32x4* xr = (f32x4*)(out + (size_t)(m0 + r) * DM);
#pragma unroll
            for (int j = 0; j < 2; ++j) { const u32x4 w = v[r][j];
                xr[2 * lane + 128 * j] = (f32x4){bflo(w.x), bfhi(w.x), bflo(w.y), bfhi(w.y)} * rstd * gv[j][0];
                xr[2 * lane + 128 * j + 1] = (f32x4){bflo(w.z), bfhi(w.z), bflo(w.w), bfhi(w.w)} * rstd * gv[j][1]; } } }
}
__device__ __forceinline__ void phase_norm3(bf16* H, const bf16* y0, const bf16* y1, float* rs, const float* pL, bf16* pb, int gw, int NGW, int lane) {
    constexpr int NR = 4;
    for (int m0 = gw * NR; m0 < NTOK; m0 += NGW * NR) { u32x4 hv[NR][2], av[NR][2], bv[NR][2]; f32x4 pv[NR];
#pragma unroll
        for (int r = 0; r < NR; ++r) { const size_t ro = (size_t)(m0 + r) * DM;
#pragma unroll
            for (int j = 0; j < 2; ++j) { hv[r][j] = ((const u32x4*)(H + ro))[lane + 64 * j]; av[r][j] = ((const u32x4*)(y0 + ro))[lane + 64 * j]; bv[r][j] = ((const u32x4*)(y1 + ro))[lane + 64 * j]; }
            pv[r] = ((const f32x4*)(pL + (size_t)(m0 + r) * D_PLE))[lane]; }
        float rr[NR];
#pragma unroll
        for (int r = 0; r < NR; ++r) { const size_t ro = (size_t)(m0 + r) * DM;
            const u32x4 w0 = add3_u4(hv[r][0], av[r][0], bv[r][0]), w1 = add3_u4(hv[r][1], av[r][1], bv[r][1]);
            ((u32x4*)(H + ro))[lane] = w0; ((u32x4*)(H + ro))[lane + 64] = w1;
            rr[r] = rsqrtf(wave_sum(ss_u4(w0) + ss_u4(w1)) * (1.f / DM) + EPS);
            u32x2 q; q.x = pg8::cvt_pk_bf16(pv[r].x, pv[r].y); q.y = pg8::cvt_pk_bf16(pv[r].z, pv[r].w);
            ((u32x2*)(pb + (size_t)(m0 + r) * D_PLE))[lane] = q; }
        if (lane == 0) *(f32x4*)(rs + m0) = (f32x4){rr[0], rr[1], rr[2], rr[3]}; }
}
constexpr int N2_PITCH = 2064, N2_WL = 36 * N2_PITCH;
__device__ __forceinline__ void phase_norm2(KArgs args, const bf16* H, int L, LAS unsigned char* lds, int G, int bid, int tid, int wave, int lane) {
    unsigned char* ws = args->ws;
    { const u32x4* src = (const u32x4*)(ws + WS_WRT + (size_t)L * 2 * 36 * 2048);
      for (int i = tid; i < 2 * 36 * 128; i += NWAVES * 64) { const int hl = i / (36 * 128), row = (i >> 7) % 36, c = i & 127; *(LAS u32x4*)(lds + hl * N2_WL + row * N2_PITCH + c * 16) = src[i]; } }
    __syncthreads();
    gu32* cnt = (gu32*)(ws + WS_CTL) + CW_CNT + L * 64;
    int* ltok = (int*)(ws + WS_LTOK); float* lgate = (float*)(ws + WS_LGATE); float* lrs = (float*)(ws + WS_LRS);
    const float* bgr = args->in[I_BGR] + L * 4; const float* ber = args->in[I_BER] + L * 32;
    const int gw = bid * NWAVES + wave, NGW = G * NWAVES, fr = lane & 15, fq = lane >> 4;
    const int arow[3] = {8 * (fr >> 2) + (fr & 3), 8 * (fr >> 2) + (fr & 3) + 4, 32 + (fr & 3)};
    for (int grp = gw; grp < NTOK / 16; grp += NGW) {
        const int tok = grp * 16 + fr;
        const bf16* hrow = H + (size_t)tok * DM + 8 * fq;
        f32x4 acc[3]; float ss = 0.f;
#pragma unroll
        for (int t3 = 0; t3 < 3; ++t3) acc[t3] = (f32x4){0.f, 0.f, 0.f, 0.f};
#pragma unroll 8
        for (int kk = 0; kk < 32; ++kk) {
            const u32x4 xh = *(const u32x4*)(hrow + 32 * kk);
            { const float a0 = bflo(xh.x), a1 = bfhi(xh.x), a2 = bflo(xh.y), a3 = bfhi(xh.y), a4 = bflo(xh.z), a5 = bfhi(xh.z), a6 = bflo(xh.w), a7 = bfhi(xh.w);
              ss += (a0 * a0 + a1 * a1) + (a2 * a2 + a3 * a3) + (a4 * a4 + a5 * a5) + (a6 * a6 + a7 * a7); }
            const bf16x8 bh = __builtin_bit_cast(bf16x8, xh);
#pragma unroll
            for (int t3 = 0; t3 < 3; ++t3) { const bf16x8 ah = *(const LAS bf16x8*)(lds + arow[t3] * N2_PITCH + 64 * kk + 16 * fq), al = *(const LAS bf16x8*)(lds + N2_WL + arow[t3] * N2_PITCH + 64 * kk + 16 * fq);
                acc[t3] = __builtin_amdgcn_mfma_f32_16x16x32_bf16(ah, bh, acc[t3], 0, 0, 0); acc[t3] = __builtin_amdgcn_mfma_f32_16x16x32_bf16(al, bh, acc[t3], 0, 0, 0); }
        }
        ss += __builtin_bit_cast(float, __builtin_amdgcn_ds_bpermute((lane ^ 16) << 2, __builtin_bit_cast(int, ss)));
        ss += __builtin_bit_cast(float, __builtin_amdgcn_ds_bpermute((lane ^ 32) << 2, __builtin_bit_cast(int, ss)));
        const float rstd = rsqrtf(ss * (1.f / DM) + EPS);
        float gl[4]; int gi = 0;
#pragma unroll
        for (int j = 0; j < 4; ++j) gl[j] = acc[2][j] * rstd + bgr[j];
        float gmax = gl[0];
#pragma unroll
        for (int j = 1; j < 4; ++j) if (gl[j] > gmax) { gmax = gl[j]; gi = j; }
        if (fq == gi) {
            float den = 0.f;
#pragma unroll
            for (int j = 0; j < 4; ++j) den += expf(gl[j] - gmax);
            const float pg = 1.f / den;
            float b1 = -3.0e38f, b2 = -3.0e38f; int j1 = 0, j2 = 0;
#pragma unroll
            for (int e = 0; e < 8; ++e) { const float x = (e < 4 ? acc[0][e & 3] : acc[1][e & 3]) * rstd + ber[gi * 8 + e];
                if (x > b1) { b2 = b1; j2 = j1; b1 = x; j1 = e; } else if (x > b2) { b2 = x; j2 = e; } }
            const float w1 = 1.f / (1.f + expf(b2 - b1)), w2 = 1.f - w1;
            const int s0 = gi * 8 + j1, s1 = 32 + gi * 8 + j2;
            const unsigned r0 = __hip_atomic_fetch_add(cnt + s0, 1u, RLX_AGENT), r1 = __hip_atomic_fetch_add(cnt + s1, 1u, RLX_AGENT);
            ltok[(size_t)s0 * NTOK + r0] = tok; lgate[(size_t)s0 * NTOK + r0] = pg * w1; lrs[(size_t)s0 * NTOK + r0] = rstd;
            ltok[(size_t)s1 * NTOK + r1] = tok; lgate[(size_t)s1 * NTOK + r1] = pg * w2; lrs[(size_t)s1 * NTOK + r1] = rstd;
        }
    }
}
template <int CTRL> __device__ __forceinline__ float dpp_row_shr(float old, float src) {
    return __builtin_bit_cast(float, __builtin_amdgcn_update_dpp(__builtin_bit_cast(int, old), __builtin_bit_cast(int, src), CTRL, 0xf, 0xf, false));
}
__device__ __forceinline__ void rec1_unit(KArgs args, int L, int unit, LAS unsigned char* lds, int wave, int lane) {
    unsigned char* ws = args->ws;
    const bf16* z = (const bf16*)(ws + WS_Z);
    bf16* hloc = (bf16*)(ws + WS_HLOC); bf16* cumA = (bf16*)(ws + WS_CUMA); float* agg = (float*)(ws + WS_AGG);
    const int b = unit >> 4, chk = unit & 15, t0 = chk * 256, fr = lane & 15, q = lane >> 4, hb = wave;
    const float* Wa = args->in[I_WA] + ((size_t)(L * 8 + hb)) * 4096; const float* Wx = args->in[I_WX] + ((size_t)(L * 8 + hb)) * 4096;
    LAS unsigned char* wl = lds + wave * 16384;
#pragma unroll 1
    for (int f = 0; f < 16; ++f) { const int mat = f >> 3, n = (f >> 1) & 3, kk = f & 1; const float* W = mat ? Wx : Wa;
        const int jout = 8 * (fr >> 2) + (fr & 3) + 4 * (n & 1) + 32 * (n >> 1); const float* wp = W + (32 * kk + 8 * q) * 64 + jout;
        u32x4 w; w.x = pk2(wp[0], wp[64]); w.y = pk2(wp[128], wp[192]); w.z = pk2(wp[256], wp[320]); w.w = pk2(wp[384], wp[448]);
        *(LAS u32x4*)(wl + f * 1024 + lane * 16) = w; }
    LAS float* ct = (LAS float*)(lds + 131072 + wave * 2048);
    { const int c = 64 * hb + lane; const float* cw = args->in[I_CONVW] + (size_t)L * 4 * 512;
      ct[lane * 8 + 0] = cw[c]; ct[lane * 8 + 1] = cw[512 + c]; ct[lane * 8 + 2] = cw[1024 + c]; ct[lane * 8 + 3] = cw[1536 + c];
      ct[lane * 8 + 4] = args->in[I_CONVB][L * 512 + c]; ct[lane * 8 + 5] = args->in[I_BA][L * 512 + c]; ct[lane * 8 + 6] = args->in[I_BX][L * 512 + c];
      ct[lane * 8 + 7] = ((const float*)(ws + WS_C8))[L * 512 + c]; }
    LDS_WAIT();
    float Acar[2][8], Hcar[2][8];
#pragma unroll
    for (int kk = 0; kk < 2; ++kk)
#pragma unroll
        for (int e = 0; e < 8; ++e) { Acar[kk][e] = 1.f; Hcar[kk][e] = 0.f; }
    const bf16* zb = z + (size_t)(b * SEQ) * ZP + ZC_XR + 64 * hb;
    const int bidx15 = ((lane & ~15) | 15) << 2;
#pragma unroll 1
    for (int tile = 0; tile < 16; ++tile) {
        const int t = t0 + tile * 16 + fr; const bool edge = (t0 + tile * 16) == 0;
        u32x4 xb[2];
#pragma unroll
        for (int kk = 0; kk < 2; ++kk) {
            float xc[8];
#pragma unroll
            for (int e = 0; e < 8; ++e) xc[e] = ct[(32 * kk + 8 * q + e) * 8 + 4];
#pragma unroll
            for (int j = 0; j < 4; ++j) { const int tt = t - 3 + j;
                u32x4 raw = *(const u32x4*)(zb + (size_t)(tt > 0 ? tt : 0) * ZP + 32 * kk + 8 * q);
                if (edge && tt < 0) raw = (u32x4){0u, 0u, 0u, 0u};
                const float xv[8] = {bflo(raw.x), bfhi(raw.x), bflo(raw.y), bfhi(raw.y), bflo(raw.z), bfhi(raw.z), bflo(raw.w), bfhi(raw.w)};
#pragma unroll
                for (int e = 0; e < 8; ++e) xc[e] += ct[(32 * kk + 8 * q + e) * 8 + j] * xv[e]; }
            xb[kk].x = pk2(xc[0], xc[1]); xb[kk].y = pk2(xc[2], xc[3]); xb[kk].z = pk2(xc[4], xc[5]); xb[kk].w = pk2(xc[6], xc[7]);
        }
        asm volatile("" ::: "memory");
#pragma unroll
        for (int kh = 0; kh < 2; ++kh) {
            f32x4 racc[2], iacc[2];
#pragma unroll
            for (int nn = 0; nn < 2; ++nn) { racc[nn] = (f32x4){0.f, 0.f, 0.f, 0.f}; iacc[nn] = (f32x4){0.f, 0.f, 0.f, 0.f};
#pragma unroll
                for (int kk = 0; kk < 2; ++kk) { const int n = 2 * kh + nn;
                    const bf16x8 fa = *(const LAS bf16x8*)(wl + ((0 * 4 + n) * 2 + kk) * 1024 + lane * 16), fx = *(const LAS bf16x8*)(wl + ((1 * 4 + n) * 2 + kk) * 1024 + lane * 16);
                    const bf16x8 xk = __builtin_bit_cast(bf16x8, xb[kk]);
                    racc[nn] = __builtin_amdgcn_mfma_f32_16x16x32_bf16(fa, xk, racc[nn], 0, 0, 0); iacc[nn] = __builtin_amdgcn_mfma_f32_16x16x32_bf16(fx, xk, iacc[nn], 0, 0, 0); } }
            const unsigned xw[4] = {xb[kh].x, xb[kh].y, xb[kh].z, xb[kh].w};
            float hv[8], av[8];
#pragma unroll
            for (int e = 0; e < 8; ++e) {
                const int nn = e >> 2, jj = e & 3; const int cb = (32 * kh + 8 * q + e) * 8;
                const float xcv = (e & 1) ? bfhi(xw[e >> 1]) : bflo(xw[e >> 1]);
                const float r = fsigmoid(racc[nn][jj] + ct[cb + 5]), ig = fsigmoid(iacc[nn][jj] + ct[cb + 6]);
                float a = __builtin_amdgcn_exp2f(ct[cb + 7] * r);
                float bb = sqrtf(fmaxf(1.f - a * a, 0.f)) * (ig * xcv);
#define REC_SCAN_STEP(N_) asm volatile("s_nop 1\n\tv_fmac_f32_dpp %0, %0, %1 row_shr:" #N_ " row_mask:0xf bank_mask:0xf\n\ts_nop 1\n\tv_mul_f32_dpp %1, %1, %1 row_shr:" #N_ " row_mask:0xf bank_mask:0xf" : "+v"(bb), "+v"(a))
                REC_SCAN_STEP(1); REC_SCAN_STEP(2); REC_SCAN_STEP(4); REC_SCAN_STEP(8);
#undef REC_SCAN_STEP
                const float hl = a * Hcar[kh][e] + bb, ca = a * Acar[kh][e];
                hv[e] = hl; av[e] = ca;
                Hcar[kh][e] = __builtin_bit_cast(float, __builtin_amdgcn_ds_bpermute(bidx15, __builtin_bit_cast(int, hl))); Acar[kh][e] = __builtin_bit_cast(float, __builtin_amdgcn_ds_bpermute(bidx15, __builtin_bit_cast(int, ca)));
            }
            const size_t o = (size_t)(b * SEQ + t) * D_REC + 64 * hb + 32 * kh + 8 * q;
            u32x4 w; w.x = pk2(hv[0], hv[1]); w.y = pk2(hv[2], hv[3]); w.z = pk2(hv[4], hv[5]); w.w = pk2(hv[6], hv[7]);
            *(u32x4*)(hloc + o) = w;
            w.x = pk2(av[0], av[1]); w.y = pk2(av[2], av[3]); w.z = pk2(av[4], av[5]); w.w = pk2(av[6], av[7]);
            *(u32x4*)(cumA + o) = w;
            asm volatile("" ::: "memory");
        }
    }
    if (fr == 0) {
#pragma unroll
        for (int kk = 0; kk < 2; ++kk)
#pragma unroll
            for (int e = 0; e < 8; ++e) { const int c = 64 * hb + 32 * kk + 8 * q + e; float* ap = agg + ((size_t)(b * 16 + chk) * 512 + c) * 2; ap[0] = Acar[kk][e]; ap[1] = Hcar[kk][e]; }
    }
}
__device__ __forceinline__ void rec2_rows(KArgs args, int gw, int NGW, int lane) {
    unsigned char* ws = args->ws;
    const bf16* z = (const bf16*)(ws + WS_Z); const bf16* hloc = (const bf16*)(ws + WS_HLOC); const bf16* cumA = (const bf16*)(ws + WS_CUMA);
    const float* carry = (const float*)(ws + WS_CARRY); bf16* mixed = (bf16*)(ws + WS_MIXED);
    constexpr int NR = 4;
    for (int m0 = gw * NR; m0 < NTOK; m0 += NGW * NR) {
        const int b = m0 >> 12, chk = (m0 & 4095) >> 8;
        u32x4 hl[NR], ca[NR], gr[NR];
#pragma unroll
        for (int r = 0; r < NR; ++r) { const size_t m = (size_t)(m0 + r); hl[r] = *(const u32x4*)(hloc + m * D_REC + 8 * lane); ca[r] = *(const u32x4*)(cumA + m * D_REC + 8 * lane); gr[r] = *(const u32x4*)(z + m * ZP + ZC_GR + 8 * lane); }
        const f32x4 c0 = *(const f32x4*)(carry + (size_t)(b * 16 + chk) * 512 + 8 * lane), c1 = *(const f32x4*)(carry + (size_t)(b * 16 + chk) * 512 + 8 * lane + 4);
#pragma unroll
        for (int r = 0; r < NR; ++r) { float v[8];
            v[0] = (bflo(hl[r].x) + bflo(ca[r].x) * c0.x) * fgelu(bflo(gr[r].x)); v[1] = (bfhi(hl[r].x) + bfhi(ca[r].x) * c0.y) * fgelu(bfhi(gr[r].x));
            v[2] = (bflo(hl[r].y) + bflo(ca[r].y) * c0.z) * fgelu(bflo(gr[r].y)); v[3] = (bfhi(hl[r].y) + bfhi(ca[r].y) * c0.w) * fgelu(bfhi(gr[r].y));
            v[4] = (bflo(hl[r].z) + bflo(ca[r].z) * c1.x) * fgelu(bflo(gr[r].z)); v[5] = (bfhi(hl[r].z) + bfhi(ca[r].z) * c1.y) * fgelu(bfhi(gr[r].z));
            v[6] = (bflo(hl[r].w) + bflo(ca[r].w) * c1.z) * fgelu(bflo(gr[r].w)); v[7] = (bfhi(hl[r].w) + bfhi(ca[r].w) * c1.w) * fgelu(bfhi(gr[r].w));
            float s = 0.f;
#pragma unroll
            for (int e = 0; e < 8; ++e) s += v[e] * v[e];
            const float rstd = rsqrtf(wave_sum(s) * (1.f / D_REC) + EPS);
            u32x4 w; w.x = pk2(v[0] * rstd, v[1] * rstd); w.y = pk2(v[2] * rstd, v[3] * rstd); w.z = pk2(v[4] * rstd, v[5] * rstd); w.w = pk2(v[6] * rstd, v[7] * rstd);
            *(u32x4*)(mixed + (size_t)(m0 + r) * DM + 8 * lane) = w; }
    }
}
__device__ __forceinline__ void phase_mid(KArgs args, int L, int G, int bid, int tid, int wave, int lane) {
    unsigned char* ws = args->ws;
    const float* agg = (const float*)(ws + WS_AGG); float* carry = (float*)(ws + WS_CARRY);
    const int gt = bid * (NWAVES * 64) + tid, NGT = G * NWAVES * 64;
    for (int i = gt; i < BATCH * 512; i += NGT) { const int b = i >> 9, c = i & 511; float Ak[16], Hk[16];
#pragma unroll
        for (int k = 0; k < 16; ++k) { const size_t o = (size_t)(b * 16 + k) * 512 + c; Ak[k] = agg[o * 2]; Hk[k] = agg[o * 2 + 1]; }
        float H = 0.f;
#pragma unroll
        for (int k = 0; k < 16; ++k) { carry[(size_t)(b * 16 + k) * 512 + c] = H; H = Ak[k] * H + Hk[k]; } }
    const bf16* hid = (const bf16*)(ws + WS_HIDC); const bf16* w2t = (const bf16*)(ws + WS_W2T);
    const int gw = bid * NWAVES + wave, NGW = G * NWAVES, fr = lane & 15, fq = lane >> 4;
    for (int task = gw; task < 2 * 512; task += NGW) {
        const int kv = task >> 9, grp = task & 511;
        const bf16* ar = hid + ((size_t)kv * 8192 + grp * 16 + fr) * 256 + 8 * fq;
        const bf16* br = w2t + ((size_t)(L * 2 + kv) * 64 + fr) * 256 + 8 * fq;
        const float* b2 = (kv ? args->in[I_BV2] : args->in[I_BK2]) + L * 64;
        f32x4 acc[4];
#pragma unroll
        for (int nt = 0; nt < 4; ++nt) { const float bb = b2[16 * nt + fr]; acc[nt] = (f32x4){bb, bb, bb, bb}; }
#pragma unroll
        for (int kk = 0; kk < 8; ++kk) { const bf16x8 a = *(const bf16x8*)(ar + 32 * kk);
#pragma unroll
            for (int nt = 0; nt < 4; ++nt) { const bf16x8 bfr = *(const bf16x8*)(br + (size_t)(16 * nt) * 256 + 32 * kk); acc[nt] = __builtin_amdgcn_mfma_f32_16x16x32_bf16(a, bfr, acc[nt], 0, 0, 0); } }
        bf16* outp = (bf16*)(ws + (kv ? WS_VCMP : WS_KCMP));
#pragma unroll
        for (int jj = 0; jj < 4; ++jj) { const int row = grp * 16 + 4 * fq + jj; const bool real = (row & 255) != 255;
#pragma unroll
            for (int nt = 0; nt < 4; ++nt) outp[(size_t)row * 64 + 16 * nt + fr] = real ? (bf16)f2bf(acc[nt][jj]) : (bf16)0; }
    }
}

typedef float f32x16 __attribute__((ext_vector_type(16)));
typedef short s16x4 __attribute__((ext_vector_type(4)));
typedef float f32x2_t __attribute__((ext_vector_type(2)));
typedef __bf16 bf16x2_t __attribute__((ext_vector_type(2)));
__device__ __forceinline__ unsigned cvtpk(float lo, float hi) { f32x2_t v = {lo, hi}; bf16x2_t b = __builtin_convertvector(v, bf16x2_t); return __builtin_bit_cast(unsigned, b); }
__device__ __forceinline__ void xhalf_pair(float m, float& lo, float& hi) {
    unsigned a = __builtin_bit_cast(unsigned, m), b = a; asm volatile("" : "+v"(b));
    auto rr = __builtin_amdgcn_permlane32_swap(a, b, false, false);
    unsigned r0 = rr[0], r1 = rr[1]; asm volatile("" : "+v"(r0), "+v"(r1));
    lo = __builtin_bit_cast(float, r0); hi = __builtin_bit_cast(float, r1);
}
__device__ __forceinline__ float xhalf_max(float m) { float a, b; xhalf_pair(m, a, b); return fmaxf(a, b); }
__device__ __forceinline__ float xhalf_sum(float m) { float a, b; xhalf_pair(m, a, b); return a + b; }
__device__ __forceinline__ s16x4 vtr(const LAS unsigned char* p) { return __builtin_bit_cast(s16x4, __builtin_amdgcn_ds_read_tr16_b64_v4i16((LAS s16x4*)p)); }
constexpr int ATT_NS = 4, ATT_PD = 3;
constexpr int ATT_IMP = 65536, ATT_SC = ATT_IMP + 4 * 64 * 65 * 4, ATT_MASK = ATT_SC + 64 * 65 * 4, ATT_UNION = ATT_MASK + 512, ATT_RED = ATT_UNION + 64;
static_assert(ATT_RED + 2048 <= MISC_OFF, "attention LDS map");
#define CI_(i) (((i) & 3) + 8 * ((i) >> 2))
__device__ __forceinline__ float max3f(float a, float b, float c) { float r; asm("v_max3_f32 %0, %1, %2, %3" : "=v"(r) : "v"(a), "v"(b), "v"(c)); return r; }

struct AttState { f32x16 O[2]; float m, l; bool fresh; };
__device__ __forceinline__ void att_stage(LAS unsigned char* lds, int slot, const char* kp, const char* vp, unsigned pitch, int wave, int lane) {
    const int key = 8 * wave + (lane >> 3), pc = lane & 7;
    const char* ks = kp + (size_t)key * pitch + ((pc ^ ((key >> 1) & 7)) << 4);
    const char* vs = vp + (size_t)key * pitch + ((pc ^ ((key & 3) << 1)) << 4);
    const unsigned dk = (unsigned)(unsigned long)(lds + slot * 16384 + wave * 1024), dv = dk + 8192u; unsigned keep;
    asm volatile("s_mov_b32 %0, m0\n\ts_mov_b32 m0, %2\n\ts_nop 0\n\tglobal_load_lds_dwordx4 %1, off\n\ts_mov_b32 m0, %0" : "=&s"(keep) : "v"(ks), "s"(dk) : "memory");
    asm volatile("s_mov_b32 %0, m0\n\ts_mov_b32 m0, %2\n\ts_nop 0\n\tglobal_load_lds_dwordx4 %1, off\n\ts_mov_b32 m0, %0" : "=&s"(keep) : "v"(vs), "s"(dv) : "memory");
}
__device__ __forceinline__ void att_qk64(const LAS unsigned char* Kb, const bf16x8 (&qf)[4], float sF, float cb, int rq, int h, f32x16& S0, f32x16& S1) {
    const LAS unsigned char* rowp = Kb + rq * 128; const int sw = (rq >> 1) & 7;
    bf16x8 kf[2][4];
#pragma unroll
    for (int sub = 0; sub < 2; ++sub)
#pragma unroll
        for (int s4 = 0; s4 < 4; ++s4) kf[sub][s4] = *(const LAS bf16x8*)(rowp + sub * 4096 + (((2 * s4 + h) ^ sw) << 4));
    const float base = cb + sF * (float)(4 * h);
    { const f32x2 d01 = {0.f, sF}, d23 = {sF + sF, 3.f * sF};
#pragma unroll
      for (int q4 = 0; q4 < 4; ++q4) { const float bq = fmaf(sF, (float)(8 * q4), base), bq1 = fmaf(sF, (float)(8 * q4 + 32), base);
          const f32x2 bb = {bq, bq}, bc = {bq1, bq1}; const f32x2 lo = bb + d01, hi = bb + d23, lo1 = bc + d01, hi1 = bc + d23;
          S0[4 * q4] = lo.x; S0[4 * q4 + 1] = lo.y; S0[4 * q4 + 2] = hi.x; S0[4 * q4 + 3] = hi.y; S1[4 * q4] = lo1.x; S1[4 * q4 + 1] = lo1.y; S1[4 * q4 + 2] = hi1.x; S1[4 * q4 + 3] = hi1.y; } }
    __builtin_amdgcn_sched_barrier(0);
#pragma unroll
    for (int s4 = 0; s4 < 4; ++s4) { S0 = __builtin_amdgcn_mfma_f32_32x32x16_bf16(kf[0][s4], qf[s4], S0, 0, 0, 0); S1 = __builtin_amdgcn_mfma_f32_32x32x16_bf16(kf[1][s4], qf[s4], S1, 0, 0, 0); }
    __builtin_amdgcn_sched_barrier(0);
}
__device__ __forceinline__ void att_mask(int sub, int h, int lim_lo, int lim_hi, f32x16& S) {
    const int hi2 = lim_hi - 32 * sub - 4 * h, lo2 = lim_lo - 32 * sub - 4 * h;
#pragma unroll
    for (int i = 0; i < 16; ++i) S[i] = (CI_(i) <= hi2 && CI_(i) > lo2) ? S[i] : -__builtin_inff();
}
template <bool IMP>
__device__ __forceinline__ void att_softmax_pv64(const bool MASKED, const LAS unsigned char* Vb, int lim_lo, int lim_hi, f32x16& S0, f32x16& S1, AttState& st, int h, int lane, LAS float* irow = nullptr, int ct = 0) {
    const int qd = (lane & 15) >> 2, pp = lane & 3, blk = (lane >> 4) & 1;
    const LAS unsigned char* vrow = Vb + (4 * h + qd) * 128 + (pp & 1) * 8;
    bf16x8 vf[2][4];
#pragma unroll
    for (int dt = 0; dt < 2; ++dt) { const int coff = ((dt * 4 + blk * 2 + (pp >> 1)) ^ (qd << 1)) << 4;
#pragma unroll
        for (int ks = 0; ks < 4; ++ks) { const s16x4 lo = vtr(vrow + coff + (16 * ks) * 128), hi = vtr(vrow + coff + (16 * ks + 8) * 128);
            vf[dt][ks] = __builtin_shufflevector(lo, hi, 0, 1, 2, 3, 4, 5, 6, 7); } }
    __builtin_amdgcn_sched_barrier(0);
    if (MASKED) { att_mask(0, h, lim_lo, lim_hi, S0); att_mask(1, h, lim_lo, lim_hi, S1); }
    float mx = max3f(S0[0], S0[1], S0[2]), my = max3f(S1[0], S1[1], S1[2]);
    mx = max3f(mx, S0[3], S0[4]); my = max3f(my, S1[3], S1[4]); mx = max3f(mx, S0[5], S0[6]); my = max3f(my, S1[5], S1[6]); mx = max3f(mx, S0[7], S0[8]); my = max3f(my, S1[7], S1[8]);
    mx = max3f(mx, S0[9], S0[10]); my = max3f(my, S1[9], S1[10]); mx = max3f(mx, S0[11], S0[12]); my = max3f(my, S1[11], S1[12]); mx = max3f(mx, S0[13], S0[14]); my = max3f(my, S1[13], S1[14]);
    mx = xhalf_max(max3f(mx, my, max3f(S0[15], S1[15], S1[15])));
    const bool fin = mx > -1e30f;
    const bool rb = fin && (mx > 8.f || st.fresh);
    if (__any(rb)) { const float d = rb ? mx : 0.f; const float corr = st.fresh ? 1.f : __builtin_amdgcn_exp2f(-d); st.l *= corr; st.m += d;
#pragma unroll
        for (int i = 0; i < 16; ++i) { st.O[0][i] *= corr; st.O[1][i] *= corr; S0[i] -= d; S1[i] -= d; }
        if (IMP) { if (h == 0 && corr != 1.f) { for (int j = 0; j < 64; ++j) irow[j] *= corr; } }
    }
    st.fresh = st.fresh && !fin;
    float ps = 0.f, pt = 0.f;
#pragma unroll
    for (int i = 0; i < 16; ++i) { S0[i] = __builtin_amdgcn_exp2f(S0[i]); S1[i] = __builtin_amdgcn_exp2f(S1[i]); ps += S0[i]; pt += S1[i]; }
    st.l += ps + pt;
    if (IMP) {
        float prev3 = 0.f; const int partner = (lane ^ 32) << 2;
#pragma unroll
        for (int f = 0; f < 8; ++f) { const f32x16& S_ = (f >> 2) ? S1 : S0; const int q4 = f & 3; const float p3 = S_[4 * q4 + 3];
            const float own = 2.f * (S_[4 * q4] + S_[4 * q4 + 1] + S_[4 * q4 + 2]) + p3;
            const float inc = __builtin_bit_cast(float, __builtin_amdgcn_ds_bpermute(partner, __builtin_bit_cast(int, h ? prev3 : p3)));
            irow[16 * ct + 2 * f + h] = own + inc;
            prev3 = p3; }
        if (h && ct < 3) __hip_atomic_fetch_add(irow + 16 * ct + 16, prev3, __ATOMIC_RELAXED, __HIP_MEMORY_SCOPE_WORKGROUP); }
    u32x4 pk[4];
#pragma unroll
    for (int s2 = 0; s2 < 2; ++s2) { pk[s2].x = cvtpk(S0[8 * s2], S0[8 * s2 + 1]); pk[s2].y = cvtpk(S0[8 * s2 + 2], S0[8 * s2 + 3]); pk[s2].z = cvtpk(S0[8 * s2 + 4], S0[8 * s2 + 5]); pk[s2].w = cvtpk(S0[8 * s2 + 6], S0[8 * s2 + 7]);
        pk[2 + s2].x = cvtpk(S1[8 * s2], S1[8 * s2 + 1]); pk[2 + s2].y = cvtpk(S1[8 * s2 + 2], S1[8 * s2 + 3]); pk[2 + s2].z = cvtpk(S1[8 * s2 + 4], S1[8 * s2 + 5]); pk[2 + s2].w = cvtpk(S1[8 * s2 + 6], S1[8 * s2 + 7]); }
    __builtin_amdgcn_sched_barrier(0);
#pragma unroll
    for (int ks = 0; ks < 4; ++ks)
#pragma unroll
        for (int dt = 0; dt < 2; ++dt) st.O[dt] = __builtin_amdgcn_mfma_f32_32x32x16_bf16(vf[dt][ks], __builtin_bit_cast(bf16x8, pk[ks]), st.O[dt], 0, 0, 0);
    __builtin_amdgcn_sched_barrier(0);
}
__device__ __forceinline__ void att_state_reset(AttState& st) {
#pragma unroll
    for (int i = 0; i < 16; ++i) { st.O[0][i] = 0.f; st.O[1][i] = 0.f; }
    st.m = 0.f; st.l = 0.f; st.fresh = true;
}
#define ATT_WAIT_BAR() asm volatile("s_waitcnt vmcnt(0) lgkmcnt(0)\n\ts_barrier" ::: "memory")
#define ATT_WAIT_BAR_PD() asm volatile("s_waitcnt vmcnt(4) lgkmcnt(0)\n\ts_barrier" ::: "memory")
#define ATT_WAIT_BAR_2() asm volatile("s_waitcnt vmcnt(2) lgkmcnt(0)\n\ts_barrier" ::: "memory")

__device__ __forceinline__ int opq_v(int x) { asm volatile("" : "+v"(x)); return x; }
__device__ __forceinline__ int opq_s(int x) { asm volatile("" : "+s"(x)); return x; }
#define ATT_IDS const int lane = opq_v(lane0), wave = opq_s(wave0); const int r = wave >> 1, th = wave & 1, rq = lane & 31, h = lane >> 5, tl = 32 * th + rq, t = qb * 64 + tl, tok = b * SEQ + t; (void)r; (void)t; (void)tok;
__device__ __forceinline__ void att_unit_mfma(KArgs args, int b, int qb, LAS unsigned char* lds, int wave0, int lane0, int tid0) {
    unsigned char* ws = args->ws;
    const bf16* z = (const bf16*)(ws + WS_Z); bf16* mixed = (bf16*)(ws + WS_MIXED);
    LAS float* imp = (LAS float*)(lds + ATT_IMP);
    LAS float* sc = (LAS float*)(lds + ATT_SC);
    LAS unsigned* maskw = (LAS unsigned*)(lds + ATT_MASK);
    LAS unsigned* unionw = (LAS unsigned*)(lds + ATT_UNION);
    LAS float* red = (LAS float*)(lds + ATT_RED);
    unsigned OUTP[16];
    const unsigned ZPB = ZP * 2;
#pragma unroll 1
    for (int g = 0; g < 2; ++g) {
        const int hd = 4 * g + (wave0 >> 1);
        bf16x8 qf[4]; float slope2, g0, g1, g2;
        { ATT_IDS const int tid = opq_v(tid0);
          const bf16* zrow = z + (size_t)tok * ZP;
#pragma unroll
          for (int s4 = 0; s4 < 4; ++s4) qf[s4] = *(const bf16x8*)(zrow + ZC_Q + hd * 64 + 16 * s4 + 8 * h);
          slope2 = exp2f(-(float)(hd + 1)) * LOG2E;
          g0 = fsigmoid(bf2f(zrow[ZC_NG + hd * 3 + 0])); g1 = fsigmoid(bf2f(zrow[ZC_NG + hd * 3 + 1])); g2 = fsigmoid(bf2f(zrow[ZC_NG + hd * 3 + 2]));
          LAS float* row = imp + (r * 64 + tl) * 65 + 32 * h;
#pragma unroll
          for (int j = 0; j < 32; ++j) row[j] = 0.f;
          if (tid < 128) maskw[tid] = 0u;
          if (tid < 2) unionw[tid] = 0u; }
        AttState st;
        { ATT_IDS
        const int jlo = qb - 8 > 0 ? qb - 8 : 0, nw = qb - jlo + 1;
        const int nk = (4 * qb + 3) < 255 ? (4 * qb + 3) : 255, nc = (nk + 63) >> 6, nA = nw + nc;
        const int nmax_t = (t >= 31) ? ((t - 31) >> 4) : -1;
        const char* kwb = (const char*)(z + (size_t)(b * SEQ) * ZP + ZC_KW + g * 64);
        const char* kcb = (const char*)(ws + WS_KCMP) + (size_t)((b * 2 + g) * 256) * 128; const char* vcb = (const char*)(ws + WS_VCMP) + (size_t)((b * 2 + g) * 256) * 128;
        const float sF = 16.f * slope2;
        float il_c = 0.f;
        LAS float* irow = imp + (r * 64 + tl) * 65;
#define ATT_STAGE_A(idx_) do { int ix_ = (idx_) < nA ? (idx_) : nA - 1; const int sl_ = (idx_) & 3; \
            if (ix_ < nw) { const char* kp_ = kwb + (size_t)(64 * (qb - ix_)) * ZPB; att_stage(lds, sl_, kp_, kp_ + (ZC_VW - ZC_KW) * 2, ZPB, wave, lane); } \
            else { ix_ -= nw; const size_t o_ = (size_t)(nc - 1 - ix_) * 64 * 128; att_stage(lds, sl_, kcb + o_, vcb + o_, 128, wave, lane); } } while (0)
        att_state_reset(st);
        ATT_STAGE_A(0); ATT_STAGE_A(1); ATT_STAGE_A(2);
        f32x16 Sa, Sb;
#pragma unroll 1
        for (int i = 0; i < nA; ++i) {
            ATT_WAIT_BAR_PD();
            ATT_STAGE_A(i + ATT_PD);
            const LAS unsigned char* Kb = lds + (i & 3) * 16384; const LAS unsigned char* Vb = Kb + 8192;
            if (i < nw) {
                const int j = qb - i;
                att_qk64(Kb, qf, slope2, slope2 * (float)(64 * j) - st.m, rq, h, Sa, Sb);
                att_softmax_pv64<false>((j == qb) || (j == qb - 8), Vb, (j == qb - 8) ? tl : -1, (j == qb) ? tl : 63, Sa, Sb, st, h, lane);
                if (i == nw - 1) { const float lt = xhalf_sum(st.l); const float go = g2 / fmaxf(lt, 1e-30f);
#pragma unroll
                    for (int k = 0; k < 8; ++k) { OUTP[k] = cvtpk(st.O[0][2 * k] * go, st.O[0][2 * k + 1] * go); OUTP[8 + k] = cvtpk(st.O[1][2 * k] * go, st.O[1][2 * k + 1] * go); }
                    att_state_reset(st); }
            } else {
                const int ct = nc - 1 - (i - nw);
                att_qk64(Kb, qf, sF, sF * (float)(64 * ct) - st.m, rq, h, Sa, Sb);
                att_softmax_pv64<true>(true, Vb, -1, nmax_t - 64 * ct, Sa, Sb, st, h, lane, irow, ct);
                if (i == nA - 1) { const float lt = xhalf_sum(st.l); il_c = 1.f / fmaxf(lt, 1e-30f); const float go = g0 * il_c;
                    if (h == 0) ((LAS float*)(lds + ATT_SC))[r * 64 + tl] = il_c;
#pragma unroll
                    for (int k = 0; k < 8; ++k) { OUTP[k] = cvtpk(bflo(OUTP[k]) + st.O[0][2 * k] * go, bfhi(OUTP[k]) + st.O[0][2 * k + 1] * go); OUTP[8 + k] = cvtpk(bflo(OUTP[8 + k]) + st.O[1][2 * k] * go, bfhi(OUTP[8 + k]) + st.O[1][2 * k + 1] * go); } }
            }
        }
#undef ATT_STAGE_A
        }
        ATT_WAIT_BAR();
        { const int tid = opq_v(tid0); const int stok = tid >> 3, e8 = tid & 7; const LAS float* ilc = (const LAS float*)(lds + ATT_SC);
          unsigned key[8];
#pragma unroll
          for (int k = 0; k < 8; ++k) { const int j = 8 * e8 + k; const float v = imp[(0 * 64 + stok) * 65 + j] * ilc[stok] + imp[(1 * 64 + stok) * 65 + j] * ilc[64 + stok] + imp[(2 * 64 + stok) * 65 + j] * ilc[128 + stok] + imp[(3 * 64 + stok) * 65 + j] * ilc[192 + stok];
              const bool valid = j <= qb, forced = valid && (j == 0 || j == qb || j == qb - 1);
              const unsigned bits_ = __builtin_bit_cast(unsigned, forced ? 1e30f : (valid ? v : -1e30f));
              key[k] = ((bits_ ^ ((bits_ >> 31) ? 0xFFFFFFFFu : 0x80000000u)) & ~63u) | (unsigned)(63 - j); }
          unsigned T = 0u;
#pragma unroll 1
          for (int bit = 31; bit >= 0; --bit) { const unsigned cand = T | (1u << bit); int c = 0;
#pragma unroll
              for (int k = 0; k < 8; ++k) c += key[k] >= cand ? 1 : 0;
              c += __builtin_amdgcn_update_dpp(0, c, 0xB1, 0xf, 0xf, true);
              c += __builtin_amdgcn_update_dpp(0, c, 0x4E, 0xf, 0xf, true);
              c += __builtin_amdgcn_update_dpp(0, c, 0x141, 0xf, 0xf, true);
              T = c >= NTOP ? cand : T; }
          unsigned bits = 0u;
#pragma unroll
          for (int k = 0; k < 8; ++k) bits |= (key[k] >= T && 8 * e8 + k <= qb) ? (1u << k) : 0u;
          if (bits) { __hip_atomic_fetch_or(maskw + stok * 2 + (e8 >> 2), bits << (8 * (e8 & 3)), __ATOMIC_RELAXED, __HIP_MEMORY_SCOPE_WORKGROUP); __hip_atomic_fetch_or(unionw + (e8 >> 2), bits << (8 * (e8 & 3)), __ATOMIC_RELAXED, __HIP_MEMORY_SCOPE_WORKGROUP); }
        }
        __syncthreads();
        { ATT_IDS
        const unsigned mlo = maskw[tl * 2], mhi = maskw[tl * 2 + 1];
        unsigned long long un = ((unsigned long long)unionw[1] << 32) | unionw[0];
        const char* ksb = (const char*)(z + (size_t)(b * SEQ) * ZP + ZC_KS + g * 64);
        att_state_reset(st);
        int jq[4];
#pragma unroll
        for (int p = 0; p < 4; ++p) { if (un) { jq[p] = 63 - __builtin_clzll(un); un &= ~(1ull << jq[p]); } else jq[p] = -1; }
        int jlast = jq[0];
#pragma unroll
        for (int p = 0; p < 3; ++p) { if (jq[p] >= 0) jlast = jq[p]; const char* kp_ = ksb + (size_t)(64 * jlast) * ZPB; att_stage(lds, p, kp_, kp_ + (ZC_VS - ZC_KS) * 2, ZPB, wave, lane); }
        f32x16 Sa, Sb;
#pragma unroll 1
        for (int i = 0; jq[0] >= 0; ++i) {
            ATT_WAIT_BAR_PD();
            { if (jq[3] >= 0) jlast = jq[3]; const char* kp_ = ksb + (size_t)(64 * jlast) * ZPB; att_stage(lds, (i + 3) & 3, kp_, kp_ + (ZC_VS - ZC_KS) * 2, ZPB, wave, lane); }
            const LAS unsigned char* Kb = lds + (i & 3) * 16384; const LAS unsigned char* Vb = Kb + 8192;
            const int j = jq[0];
            const bool bit = ((j < 32 ? (mlo >> j) : (mhi >> (j - 32))) & 1u) != 0u;
            att_qk64(Kb, qf, slope2, bit ? slope2 * (float)(64 * j) - st.m : -__builtin_inff(), rq, h, Sa, Sb);
            att_softmax_pv64<false>(j == qb, Vb, -1, tl, Sa, Sb, st, h, lane);
            jq[0] = jq[1]; jq[1] = jq[2]; jq[2] = jq[3];
            if (un) { jq[3] = 63 - __builtin_clzll(un); un &= ~(1ull << jq[3]); } else jq[3] = -1;
        }
        { const float lt = xhalf_sum(st.l); const float go = g1 / fmaxf(lt, 1e-30f);
          float ss = 0.f;
#pragma unroll
          for (int i = 0; i < 8; ++i) { const float a0 = bflo(OUTP[i]) + st.O[0][2 * i] * go, a1 = bfhi(OUTP[i]) + st.O[0][2 * i + 1] * go, c0 = bflo(OUTP[8 + i]) + st.O[1][2 * i] * go, c1 = bfhi(OUTP[8 + i]) + st.O[1][2 * i + 1] * go;
              ss += (a0 * a0 + a1 * a1) + (c0 * c0 + c1 * c1); OUTP[i] = cvtpk(a0, a1); OUTP[8 + i] = cvtpk(c0, c1); }
          ss = xhalf_sum(ss);
          if (h == 0) red[hd * 64 + tl] = ss;
          if (g == 0) { bf16* orow = mixed + (size_t)tok * DM + 512 + hd * 64;
#pragma unroll
              for (int dt = 0; dt < 2; ++dt)
#pragma unroll
                  for (int q4 = 0; q4 < 4; ++q4) { u32x2 w; w.x = OUTP[8 * dt + 2 * q4]; w.y = OUTP[8 * dt + 2 * q4 + 1]; *(u32x2*)(orow + 32 * dt + 8 * q4 + 4 * h) = w; } } }
        }
        ATT_WAIT_BAR();
    }
    ATT_IDS
    float tot = 0.f;
#pragma unroll
    for (int h2 = 0; h2 < 8; ++h2) tot += red[h2 * 64 + tl];
    const float rstd = rsqrtf(tot * (1.f / 512.f) + EPS);
    { bf16* orow = mixed + (size_t)tok * DM + 512 + (4 + r) * 64;
#pragma unroll
      for (int dt = 0; dt < 2; ++dt)
#pragma unroll
          for (int q4 = 0; q4 < 4; ++q4) { u32x2 w; const unsigned p0 = OUTP[8 * dt + 2 * q4], p1 = OUTP[8 * dt + 2 * q4 + 1];
              w.x = cvtpk(bflo(p0) * rstd, bfhi(p0) * rstd); w.y = cvtpk(bflo(p1) * rstd, bfhi(p1) * rstd);
              *(u32x2*)(orow + 32 * dt + 8 * q4 + 4 * h) = w; } }
    { bf16* orow = mixed + (size_t)tok * DM + 512 + r * 64;
#pragma unroll
      for (int dt = 0; dt < 2; ++dt)
#pragma unroll
          for (int q4 = 0; q4 < 4; ++q4) { u32x2 w = *(const u32x2*)(orow + 32 * dt + 8 * q4 + 4 * h);
              w.x = cvtpk(bflo(w.x) * rstd, bfhi(w.x) * rstd); w.y = cvtpk(bflo(w.y) * rstd, bfhi(w.y) * rstd);
              *(u32x2*)(orow + 32 * dt + 8 * q4 + 4 * h) = w; } }
    __syncthreads();
}

constexpr int NPH_LAYER = 11, PH_FINAL = 1 + DEPTH * NPH_LAYER, N_PHASES = PH_FINAL + 1;
__global__ void __launch_bounds__(NWAVES * 64, 2) fwd_kernel(Args args) {
    extern __shared__ __attribute__((aligned(16))) unsigned char lds_raw[];
    LAS unsigned char* lds = (LAS unsigned char*)lds_raw;
    volatile LAS unsigned* MISC = (volatile LAS unsigned*)(lds + MISC_OFF);
    const int G0 = gridDim.x, bid0 = blockIdx.x;
    const int wave_s = __builtin_amdgcn_readfirstlane(threadIdx.x >> 6);
#define PHASE_IDS KArgs ka = ka_get(); int G = G0, bid = bid0; asm volatile("" : "+s"(G), "+s"(bid)); unsigned char* ws = ka->ws; (void)ws; int tid = wave_s * 64 + lane_id(); asm volatile("" : "+v"(tid)); const int lane = tid & 63, wave = wave_s; const int gw = bid * NWAVES + wave, NGW = G * NWAVES; (void)lane; (void)gw; (void)NGW;
    if (wave_s == 0) MISC[lane_id()] = 0u;
    __syncthreads();
#if MK_MULTI
#define GRID_BAR() do { } while (0)
#else
    XcdBarrier bar = xcd_barrier_post((unsigned*)(args.ws + WS_CTL) + CW_BAR, MISC + 8, wave_s);
#define GRID_BAR() xcd_barrier(bar)
#endif
#ifndef PH_MASK
#define PH_MASK 0xFFFF
#endif
#define IN(k) (ka_get()->ph_lo <= (k) && (k) < ka_get()->ph_hi)
#define EN(j) ((PH_MASK >> (j)) & 1)
#define SEAM(k) do { if (IN(k) && IN((k) + 1)) GRID_BAR(); } while (0)
#define HC_ ((bf16*)(ws + ((L & 1) ? WS_U : WS_H16)))
#define HN_ ((bf16*)(ws + ((L & 1) ? WS_H16 : WS_U)))
#define Z_ ((bf16*)(ws + WS_Z))
#define MIXED_ ((bf16*)(ws + WS_MIXED))
#define WL_ (ws + WS_W + (size_t)L * W_LAYER)

    if (EN(11) && IN(0)) { PHASE_IDS REP_(11) { phase_prologue(ka, lds, G, bid, tid, wave, lane); __syncthreads(); } SEAM(0); }

    for (int L = 0; L < DEPTH; ++L) {
        const int P = 1 + L * NPH_LAYER;
        if (EN(0) && IN(P + 0)) { PHASE_IDS REP_(0) phase_norm1(L == 0 ? ka->in[I_X] : nullptr, HC_, (float*)(ws + WS_RS1), gw, NGW, lane); SEAM(P + 0); }
        if (EN(1) && IN(P + 1)) {
            PHASE_IDS
            pg8::DenseSched S; S.init(HC_, DM, (const bf16*)(WL_ + WO_IN), NTOK, ZP, DM, G, bid);
            pg8::EpiBf16<0> E{Z_, ZP, nullptr, 0, 0, (const float*)(ws + WS_RS1)};
            REP_(1) pg8::gemm_phase(lds, DM, S, E, wave_s);
            SEAM(P + 1);
        }
        if (EN(2) && IN(P + 2)) {
            { PHASE_IDS
            if (EN(12)) REP_(2) for (int unit = bid; unit < BATCH * 16; unit += G) rec1_unit(ka, L, unit, lds, wave, lane);
            { const int ncv = G > 64 ? G - 64 : G, mycv = G > 64 ? bid - 64 : bid;
              if (mycv >= 0) tr_run<1>(ka, (LAS float*)(lds + wave * 16384), lane, mycv * NWAVES + wave, ncv * NWAVES, L); }
            }
            __syncthreads();
            if (EN(13)) { PHASE_IDS
            pg8::CmpSched S{Z_, (const bf16*)(WL_ + WO_K1), (const bf16*)(WL_ + WO_V1), G, bid};
            pg8::EpiBf16<1> E{(bf16*)(ws + WS_HIDC), 256, (const float*)(ws + WS_BK1) + L * 512, (size_t)8192 * 256, 256, nullptr};
            REP_(2) pg8::gemm_phase(lds, 2048, S, E, wave_s); }
            SEAM(P + 2);
        }
        if (EN(3) && IN(P + 3)) { PHASE_IDS REP_(3) phase_mid(ka, L, G, bid, tid, wave, lane); SEAM(P + 3); }
        if (EN(4) && IN(P + 4)) {
            PHASE_IDS
            if (wave >= 4) __builtin_amdgcn_s_setprio(2);
            REP_(4)
            if (G == 256) { for (int i = 0; i < 4; ++i) att_unit_mfma(ka, 2 * (bid & 7) + (i >> 1), (i & 1) ? 63 - (bid >> 3) : (bid >> 3), lds, wave, lane, tid); }
            else { for (int unit = bid; unit < BATCH * 64; unit += G) att_unit_mfma(ka, unit >> 6, unit & 63, lds, wave, lane, tid); }
            __builtin_amdgcn_s_setprio(0);
            REP_(12) rec2_rows(ka, gw, NGW, lane);
            SEAM(P + 4);
        }
        if (EN(5) && IN(P + 5)) {
            PHASE_IDS
            pg8::DenseSched S; S.init(MIXED_, DM, (const bf16*)(WL_ + WO_OUT), NTOK, DM, DM, G, bid);
            pg8::EpiResid E{HC_};
            pg8::gemm_phase(lds, DM, S, E, wave_s);
            SEAM(P + 5);
        }
        if (EN(6) && IN(P + 6)) { PHASE_IDS phase_norm2(ka, HC_, L, lds, G, bid, tid, wave, lane); SEAM(P + 6); }
        if ((EN(7) || EN(8)) && (IN(P + 7) || IN(P + 8))) {
            LAS int* tab = (LAS int*)(lds + TAB_OFF);
            { PHASE_IDS
            __syncthreads();
            if (tid < 64) { const int c = (int)__hip_atomic_load((gu32*)(ws + WS_CTL) + CW_CNT + L * 64 + tid, RLX_AGENT); tab[80 + tid] = c; tab[160 + tid] = (c + 255) >> 8; }
            __syncthreads();
            if (tid == 0) { int s = 0; for (int i = 0; i < 64; ++i) { tab[i] = s; s += tab[160 + i]; } tab[64] = s; }
            __syncthreads(); }
            if (EN(7) && IN(P + 7)) { PHASE_IDS
                pg8::MoeSched<1> S{tab, HC_, (const bf16*)(WL_ + WO_GU), (const int*)(ws + WS_LTOK), G, bid};
                pg8::EpiSwiglu E{(bf16*)(ws + WS_HID), tab, (const float*)(ws + WS_LRS)};
                REP_(7) pg8::gemm_phase(lds, DM, S, E, wave_s);
                SEAM(P + 7);
            }
            if (EN(8) && IN(P + 8)) { PHASE_IDS
                pg8::MoeSched<2> S{tab, (const bf16*)(ws + WS_HID), (const bf16*)(WL_ + WO_D), (const int*)(ws + WS_LTOK), G, bid};
                pg8::EpiMoeDown E{tab, (const int*)(ws + WS_LTOK), (const float*)(ws + WS_LGATE), (bf16*)(ws + WS_Y0), (bf16*)(ws + WS_Y1)};
                REP_(8) pg8::gemm_phase(lds, DEXP, S, E, wave_s);
                SEAM(P + 8);
            }
        }
        if (EN(9) && IN(P + 9)) { PHASE_IDS phase_norm3(HC_, (const bf16*)(ws + WS_Y0), (const bf16*)(ws + WS_Y1), (float*)(ws + WS_RS3), ka->in[I_P] + (size_t)L * NTOK * D_PLE, (bf16*)(ws + WS_PB), gw, NGW, lane); SEAM(P + 9); }
        if (EN(10) && IN(P + 10)) {
            if (EN(14)) { PHASE_IDS pg8::DenseSched S; S.init(HC_, DM, (const bf16*)(WL_ + WO_PG), NTOK, DM, DM, G, bid);
              pg8::EpiBf16<2> E{(bf16*)(ws + WS_G), DM, ka->in[I_BPG] + L * DM, 0, 0, (const float*)(ws + WS_RS3)};
              REP_(10) pg8::gemm_phase(lds, DM, S, E, wave_s); }
            __syncthreads();
            if (EN(15)) { PHASE_IDS pg8::DenseSched S; S.init((const bf16*)(ws + WS_PB), D_PLE, (const bf16*)(WL_ + WO_PU), NTOK, DM, D_PLE, G, bid);
              pg8::EpiPleB E{HC_, HN_, (const bf16*)(ws + WS_G)};
              REP_(15) pg8::gemm_phase(lds, D_PLE, S, E, wave_s); }
            SEAM(P + 10);
        }
    }
    if (IN(PH_FINAL)) { PHASE_IDS REP_(13) phase_final((const bf16*)(ws + ((DEPTH & 1) ? WS_U : WS_H16)), ka->out, ka->in[I_FINN], gw, NGW, lane); }
#undef IN
#undef SEAM
}

extern "C" void kernel_launch(void* const* d_in, const int* in_sizes, int n_in, void* d_out, int out_size, void* d_ws, size_t ws_size, hipStream_t stream) {
    static int grid = 0;
    if (grid == 0) {
        if (n_in != 37 || in_sizes[0] != NTOK * DM || out_size != NTOK * DM || ws_size < WS_END) {
            fprintf(stderr, "kernel_launch: unexpected shapes (n_in %d, in0 %d, out %d, ws %zu < %zu); nothing launched\n", n_in, n_in > 0 ? in_sizes[0] : -1, out_size, ws_size, (size_t)WS_END); grid = -1; return; }
        int dev = 0, cus = 0, per_cu = 0;
        if (hipGetDevice(&dev) != hipSuccess || hipDeviceGetAttribute(&cus, hipDeviceAttributeMultiprocessorCount, dev) != hipSuccess) { grid = -1; return; }
        if (hipFuncSetAttribute((const void*)fwd_kernel, hipFuncAttributeMaxDynamicSharedMemorySize, LDS_BYTES) != hipSuccess) { fprintf(stderr, "kernel_launch: hipFuncSetAttribute failed\n"); grid = -1; return; }
        if (hipOccupancyMaxActiveBlocksPerMultiprocessor(&per_cu, (const void*)fwd_kernel, NWAVES * 64, LDS_BYTES) != hipSuccess || per_cu < 1)
            fprintf(stderr, "kernel_launch: note: occupancy query reports %d workgroups per CU\n", per_cu);
        (void)hipGetLastError();
        grid = cus;
    }
    if (grid < 0) return;
    if (hipMemsetAsync((char*)d_ws + WS_CTL, 0, CTL_ZERO_BYTES, stream) != hipSuccess) return;
    Args a{};
    for (int i = 0; i < 37; ++i) a.in[i] = (const float*)d_in[i];
    a.out = (float*)d_out; a.ws = (unsigned char*)d_ws;
#if MK_MULTI
    for (int p = 0; p < N_PHASES; ++p) { a.ph_lo = p; a.ph_hi = p + 1; hipLaunchKernelGGL(fwd_kernel, dim3(grid), dim3(NWAVES * 64), LDS_BYTES, stream, a); }
#else
    a.ph_lo = 0; a.ph_hi = N_PHASES;
    hipLaunchKernelGGL(fwd_kernel, dim3(grid), dim3(NWAVES * 64), LDS_BYTES, stream, a);
#endif
    const hipError_t le = hipPeekAtLastError();
    if (le != hipSuccess) fprintf(stderr, "kernel_launch: launch failed: %s\n", hipGetErrorName(le));
}
```

```cpp
#include <hip/hip_runtime.h>
#include <cstdio>
#include <cstdint>

#ifndef PROBE_MASK
#define PROBE_MASK 0
#endif
#define REP_(j) for (int rep_ = 0; rep_ < 1 + ((PROBE_MASK >> (j)) & 1); ++rep_)
#ifndef MK_MULTI
#define MK_MULTI 0
#endif

#define GAS __attribute__((address_space(1)))
#define LAS __attribute__((address_space(3)))
typedef unsigned short bf16;
typedef float f32x4 __attribute__((ext_vector_type(4)));
typedef float f32x2 __attribute__((ext_vector_type(2)));
typedef unsigned u32x4 __attribute__((ext_vector_type(4)));
typedef unsigned u32x2 __attribute__((ext_vector_type(2)));
typedef short bf16x8 __attribute__((ext_vector_type(8)));
typedef GAS unsigned gu32;
#define RLX_AGENT __ATOMIC_RELAXED, __HIP_MEMORY_SCOPE_AGENT
#define LDS_WAIT() asm volatile("s_waitcnt lgkmcnt(0)" ::: "memory")
#define VM_WAIT() asm volatile("s_waitcnt vmcnt(0)" ::: "memory")

constexpr int BATCH = 16, SEQ = 4096, DM = 1024, DEPTH = 4, NTOK = BATCH * SEQ;
constexpr int D_PLE = 256, D_REC = 512, NH = 8, HD = 64, NKV = 2;
constexpr int D_IN = 2328, ZP = 2560;
constexpr int ZC_XR = 0, ZC_GR = 512, ZC_Q = 1024, ZC_KC = 1536, ZC_VC = 1664, ZC_KS = 1792, ZC_VS = 1920, ZC_KW = 2048, ZC_VW = 2176, ZC_NG = 2304;
constexpr int NCMP = 255, NSELB = 64, NTOP = 16, WIN = 512;
constexpr int NEXP = 32, DEXP = 512, NSEG = 64;
constexpr float EPS = 1e-6f;
constexpr float LOG2E = 1.4426950408889634f;
constexpr int NWAVES = 8;

constexpr size_t MiB = 1u << 20;
constexpr size_t WS_CTL = 0, CTL_ZERO_BYTES = 1 * MiB;
constexpr size_t WS_BK1 = 1 * MiB;
constexpr size_t WS_C8 = WS_BK1 + 8192;
constexpr size_t WS_WRT = WS_C8 + 8192;
constexpr size_t WS_AGG = 2 * MiB;
constexpr size_t WS_CARRY = 3 * MiB;
constexpr size_t WS_W2T = 4 * MiB;
constexpr size_t WS_KCMP = 5 * MiB, WS_VCMP = 7 * MiB;
constexpr size_t WS_RS1 = 6 * MiB, WS_RS3 = 6 * MiB + 512 * 1024;
constexpr size_t WS_HIDC = 9 * MiB;
constexpr size_t WS_LTOK = 17 * MiB, WS_LGATE = 33 * MiB;
constexpr size_t WS_PB = 49 * MiB;
constexpr size_t WS_W = 81 * MiB, W_LAYER = 108 * MiB;
constexpr size_t WO_IN = 0, WO_OUT = 5 * MiB, WO_PG = 7 * MiB, WO_PU = 9 * MiB, WO_K1 = 9 * MiB + 512 * 1024, WO_V1 = 10 * MiB + 512 * 1024, WO_GU = 12 * MiB, WO_D = 76 * MiB;
constexpr size_t WS_U = 513 * MiB;
constexpr size_t WS_Z = 641 * MiB;
constexpr size_t WS_HID = WS_Z;
constexpr size_t WS_G = WS_Z + 160 * MiB;
constexpr size_t WS_MIXED = 962 * MiB;
constexpr size_t WS_HLOC = 1090 * MiB, WS_CUMA = 1154 * MiB;
constexpr size_t WS_Y0 = WS_MIXED, WS_Y1 = WS_HLOC;
constexpr size_t WS_LRS = 1218 * MiB;
constexpr size_t WS_H16 = 1234 * MiB;
constexpr size_t WS_END = 1362 * MiB;
constexpr int CW_BAR = 4096;
constexpr int CW_CNT = 16384;
constexpr int CW_BK1 = 32768;
constexpr int LDS_BYTES = 163840;
constexpr int TAB_OFF = 147456;
constexpr int MISC_OFF = 147456 + 4096;

typedef float pk2_f32x2 __attribute__((ext_vector_type(2)));
typedef __bf16 pk2_bf16x2 __attribute__((ext_vector_type(2)));
__device__ __forceinline__ unsigned pk2(float lo, float hi) { const pk2_f32x2 v = {lo, hi}; return __builtin_bit_cast(unsigned, __builtin_convertvector(v, pk2_bf16x2)); }
__device__ __forceinline__ unsigned f2bf(float f) { return pk2(f, 0.f) & 0xffffu; }
__device__ __forceinline__ float bflo(unsigned u) { return __builtin_bit_cast(float, u << 16); }
__device__ __forceinline__ float bfhi(unsigned u) { return __builtin_bit_cast(float, u & 0xffff0000u); }
__device__ __forceinline__ float bf2f(bf16 b) { return __builtin_bit_cast(float, (unsigned)b << 16); }
__device__ __forceinline__ float fsigmoid(float x) { return __builtin_amdgcn_rcpf(1.f + __builtin_amdgcn_exp2f(-x * LOG2E)); }
__device__ __forceinline__ float fgelu(float x) { const float y = 1.5957691216057308f * (x + 0.044715f * x * x * x); return x * __builtin_amdgcn_rcpf(1.f + __builtin_amdgcn_exp2f(-y * LOG2E)); }
__device__ __forceinline__ int lane_id() { int x; asm volatile("v_mbcnt_lo_u32_b32 %0, -1, 0\n\tv_mbcnt_hi_u32_b32 %0, -1, %0" : "=v"(x)); return x; }
template <int CTRL> __device__ __forceinline__ float dpp_mov(float src) {
    return __builtin_bit_cast(float, __builtin_amdgcn_update_dpp(0, __builtin_bit_cast(int, src), CTRL, 0xf, 0xf, true));
}
__device__ __forceinline__ float wave_sum(float v) {
    v += dpp_mov<0xB1>(v);
    v += dpp_mov<0x4E>(v);
    v += dpp_mov<0x141>(v);
    v += dpp_mov<0x140>(v);
    const float r0 = __builtin_bit_cast(float, __builtin_amdgcn_readlane(__builtin_bit_cast(int, v), 0)), r1 = __builtin_bit_cast(float, __builtin_amdgcn_readlane(__builtin_bit_cast(int, v), 16));
    const float r2 = __builtin_bit_cast(float, __builtin_amdgcn_readlane(__builtin_bit_cast(int, v), 32)), r3 = __builtin_bit_cast(float, __builtin_amdgcn_readlane(__builtin_bit_cast(int, v), 48));
    return (r0 + r1) + (r2 + r3);
}

namespace pg8 {
#define PG8_LAS __attribute__((address_space(3)))
typedef unsigned short bf16_t;
constexpr int BM = 256, BK = 64, HALF = 128, HTB = HALF * BK * 2, STAGE_BYTES = 8 * HTB, NXCD = 8, WGM = 8;
__host__ __device__ __forceinline__ int lds_byte(int r, int c) { const int st = (r >> 4) * 2 + (c >> 5), rr = r & 15, cc = c & 31, ob = rr * 64 + cc * 2; return st * 1024 + (ob ^ (((ob >> 9) & 1) << 5)); }
__host__ __device__ __forceinline__ void stage_rc(int b, int& R, int& C) { const int st = b / 1024, sb = b % 1024, swz = sb ^ (((sb >> 9) & 1) << 5); R = (st >> 1) * 16 + swz / 64; C = (st & 1) * 32 + (swz % 64) / 2; }
__host__ __device__ __forceinline__ int perm32(int rho) { const int n = rho >> 4, i = rho & 15; return 8 * (i >> 2) + 4 * n + (i & 3); }
struct Unit { int pm, pn, a0, a1; };
__device__ __forceinline__ unsigned cvt_pk_bf16(float lo, float hi) { unsigned r; asm volatile("v_cvt_pk_bf16_f32 %0, %1, %2" : "=v"(r) : "v"(lo), "v"(hi)); return r; }

template <class Epi, class Sched>
__device__ __forceinline__ void gemm_phase(PG8_LAS unsigned char* lds, const int K, const Sched& S, const Epi& E, const int wave_s) {
    int tid_o = wave_s * 64 + lane_id(); asm volatile("" : "+v"(tid_o));
    const int tid = tid_o, wid = __builtin_amdgcn_readfirstlane(tid >> 6), lane = tid & 63, wr = wid >> 2, wc = wid & 3, fr = lane & 15, fq = lane >> 4;
    const int nt = K / BK;
    int Rr[2], Cc[2]; unsigned voffB[2];
#pragma unroll
    for (int i = 0; i < 2; ++i) { int R, C; stage_rc(tid * 16 + i * 8192, R, C); Rr[i] = R; Cc[i] = C; const int Rb = (R & ~31) + perm32(R & 31); voffB[i] = (unsigned)(Rb * K + C) * 2u; }
    const size_t kstepB = (size_t)(BK * 2), kstepA = S.kstepA();
    const size_t hstepB = (size_t)HALF * K * 2;
    const unsigned ldsw = (unsigned)wid * 1024u;
    const int aoff = lds_byte(wr * 64 + fr, fq * 8), boff = lds_byte(wc * 32 + fr, fq * 8);
#define PG8_SA(b, h) (((b) * 2 + (h)) * HTB)
#define PG8_SB(b, h) ((4 + (b) * 2 + (h)) * HTB)
#define PG8_STAGE(bufoff, gbase, voff) do { _Pragma("unroll") for (int _i = 0; _i < 2; ++_i) \
        __builtin_amdgcn_global_load_lds((const unsigned*)((const char*)(gbase) + (voff)[_i]), (PG8_LAS unsigned*)(lds + (bufoff) + ldsw + _i * 8192), 16, 0, 0); } while (0)
#define PG8_LDA(dst, b, h) do { _Pragma("unroll") for (int m = 0; m < 4; ++m) _Pragma("unroll") for (int k = 0; k < 2; ++k) dst[m][k] = *(const PG8_LAS bf16x8*)(lds + PG8_SA(b, h) + aoff + m * 2048 + k * 1024); } while (0)
#define PG8_LDB(dst, b, h) do { _Pragma("unroll") for (int n = 0; n < 2; ++n) _Pragma("unroll") for (int k = 0; k < 2; ++k) dst[n][k] = *(const PG8_LAS bf16x8*)(lds + PG8_SB(b, h) + boff + n * 2048 + k * 1024); } while (0)
#define PG8_MMA(ai, bj, At, Bt) do { __builtin_amdgcn_s_setprio(1); _Pragma("unroll") for (int m = 0; m < 4; ++m) _Pragma("unroll") for (int n = 0; n < 2; ++n) _Pragma("unroll") for (int k = 0; k < 2; ++k) \
        acc[ai][bj][m][n] = __builtin_amdgcn_mfma_f32_16x16x32_bf16(Bt[n][k], At[m][k], acc[ai][bj][m][n], 0, 0, 0); __builtin_amdgcn_s_setprio(0); } while (0)
#define PG8_WAIT_V(n) asm volatile("s_waitcnt vmcnt(" #n ")" ::: "memory")
#define PG8_WAIT_L(n) asm volatile("s_waitcnt lgkmcnt(" #n ")" ::: "memory")
#define PG8_BAR __builtin_amdgcn_s_barrier()
#define PG8_SCHED __builtin_amdgcn_sched_barrier(0)
    Unit cur, nxt; int ui = 0;
    if (!S.next(0, cur)) return;
    f32x4 acc[2][2][4][2];
#pragma unroll
    for (int a = 0; a < 2; ++a)
#pragma unroll
        for (int b = 0; b < 2; ++b)
#pragma unroll
            for (int m = 0; m < 4; ++m)
#pragma unroll
                for (int n = 0; n < 2; ++n) acc[a][b][m][n] = (f32x4){0.f, 0.f, 0.f, 0.f};
    bf16x8 At[4][2], B0[2][2], B1[2][2];
    unsigned vA[2][2], vN[2][2];
    S.a_voff(cur, Rr, Cc, vA);
    const char* cA = S.a_base(cur); const char* cB = S.b_base(cur);
    PG8_STAGE(PG8_SB(0, 0), cB, voffB); PG8_STAGE(PG8_SB(0, 1), cB + hstepB, voffB); PG8_STAGE(PG8_SA(0, 0), cA, vA[0]); PG8_STAGE(PG8_SA(0, 1), cA, vA[1]);
    if (wr == 1) PG8_BAR;
    PG8_WAIT_V(2); PG8_BAR;
    PG8_STAGE(PG8_SB(1, 0), cB + kstepB, voffB); PG8_STAGE(PG8_SA(1, 0), cA + kstepA, vA[0]); PG8_STAGE(PG8_SB(1, 1), cB + hstepB + kstepB, voffB);
    PG8_WAIT_V(6); PG8_BAR;
    for (;;) {
        const bool has_next = S.next(ui + 1, nxt);
        const char* nA = cA; const char* nB = cB;
#pragma unroll
        for (int h = 0; h < 2; ++h)
#pragma unroll
            for (int i = 0; i < 2; ++i) vN[h][i] = vA[h][i];
        if (has_next) { nA = S.a_base(nxt); nB = S.b_base(nxt); S.a_voff(nxt, Rr, Cc, vN); }
#pragma unroll 1
        for (int t = 0; t < nt; t += 2) {
            const bool last = (t == nt - 2);
            const char* a1 = cA + (size_t)(t + 1) * kstepA;
            const char* a2 = last ? nA : cA + (size_t)(t + 2) * kstepA; const char* b2 = last ? nB : cB + (size_t)(t + 2) * kstepB;
            const char* a3 = a2 + kstepA; const char* b3 = b2 + kstepB;
            unsigned v2[2][2];
#pragma unroll
            for (int h = 0; h < 2; ++h)
#pragma unroll
                for (int i = 0; i < 2; ++i) v2[h][i] = last ? vN[h][i] : vA[h][i];
            PG8_LDB(B0, 0, 0); PG8_LDB(B1, 0, 1); PG8_SCHED; PG8_LDA(At, 0, 0); PG8_STAGE(PG8_SA(1, 1), a1, vA[1]);
            PG8_WAIT_V(8); PG8_WAIT_L(0); PG8_BAR; PG8_MMA(0, 0, At, B0); PG8_MMA(0, 1, At, B1); PG8_BAR; PG8_SCHED;
            PG8_LDA(At, 0, 1); PG8_STAGE(PG8_SB(0, 0), b2, voffB); PG8_STAGE(PG8_SB(0, 1), b2 + hstepB, voffB); PG8_STAGE(PG8_SA(0, 0), a2, v2[0]);
            PG8_WAIT_V(8); PG8_WAIT_L(0); PG8_BAR; PG8_MMA(1, 0, At, B0); PG8_MMA(1, 1, At, B1); PG8_BAR; PG8_SCHED;
            PG8_LDB(B0, 1, 0); PG8_LDB(B1, 1, 1); PG8_SCHED; PG8_LDA(At, 1, 0); PG8_STAGE(PG8_SA(0, 1), a2, v2[1]);
            PG8_WAIT_V(8); PG8_WAIT_L(0); PG8_BAR; PG8_MMA(0, 0, At, B0); PG8_MMA(0, 1, At, B1); PG8_BAR; PG8_SCHED;
            PG8_LDA(At, 1, 1); PG8_STAGE(PG8_SB(1, 0), b3, voffB); PG8_STAGE(PG8_SB(1, 1), b3 + hstepB, voffB); PG8_STAGE(PG8_SA(1, 0), a3, v2[0]);
            PG8_WAIT_V(8); PG8_WAIT_L(0); PG8_BAR; PG8_MMA(1, 0, At, B0); PG8_MMA(1, 1, At, B1); PG8_BAR; PG8_SCHED;
        }
        if (wr == 0) PG8_BAR;
        E(acc, cur, wr, wc, fr, fq);
        if (!has_next) break;
#pragma unroll
        for (int a = 0; a < 2; ++a)
#pragma unroll
            for (int b = 0; b < 2; ++b)
#pragma unroll
                for (int m = 0; m < 4; ++m)
#pragma unroll
                    for (int n = 0; n < 2; ++n) acc[a][b][m][n] = (f32x4){0.f, 0.f, 0.f, 0.f};
        cur = nxt; cA = nA; cB = nB; ++ui;
#pragma unroll
        for (int h = 0; h < 2; ++h)
#pragma unroll
            for (int i = 0; i < 2; ++i) vA[h][i] = vN[h][i];
        if (wr == 1) PG8_BAR;
    }
    PG8_WAIT_V(0);
    PG8_BAR;
#undef PG8_SA
#undef PG8_SB
#undef PG8_STAGE
#undef PG8_LDA
#undef PG8_LDB
#undef PG8_MMA
#undef PG8_WAIT_V
#undef PG8_WAIT_L
#undef PG8_BAR
#undef PG8_SCHED
}

struct DenseSched {
    const bf16_t* A; const bf16_t* Bt; int lda, K; int nM, nN, nwg, G, c;
    __device__ __forceinline__ void init(const bf16_t* A_, int lda_, const bf16_t* Bt_, int M, int N, int K_, int G_, int c_) { A = A_; lda = lda_; Bt = Bt_; K = K_; nM = M / BM; nN = N / BM; nwg = nM * nN; G = G_; c = c_; }
    __device__ __forceinline__ size_t kstepA() const { return (size_t)(BK * 2); }
    __device__ __forceinline__ bool next(int i, Unit& u) const {
        const long L = (long)i * G + c; if (L >= nwg) return false;
        int wgid = (int)L; { const int q = nwg / NXCD, r = nwg % NXCD, xcd = wgid % NXCD, off = wgid / NXCD; wgid = (xcd < r ? xcd * (q + 1) : r * (q + 1) + (xcd - r) * q) + off; }
        const int nig = WGM * nN, gid = wgid / nig, fm = gid * WGM, gsz = (nM - fm) < WGM ? (nM - fm) : WGM;
        u.pm = fm + ((wgid % nig) % gsz); u.pn = (wgid % nig) / gsz; u.a0 = 0; u.a1 = 0; return true;
    }
    __device__ __forceinline__ const char* a_base(const Unit& u) const { return (const char*)A + (size_t)u.pm * BM * lda * 2; }
    __device__ __forceinline__ const char* b_base(const Unit& u) const { return (const char*)Bt + (size_t)u.pn * BM * K * 2; }
    __device__ __forceinline__ void a_voff(const Unit&, const int (&R)[2], const int (&C)[2], unsigned (&v)[2][2]) const {
#pragma unroll
        for (int h = 0; h < 2; ++h)
#pragma unroll
            for (int i = 0; i < 2; ++i) v[h][i] = (unsigned)((h * HALF + R[i]) * lda + C[i]) * 2u;
    }
};
}

#define XB_TMO      128
#define XB_XCNT(j)  (256  + 64 * (j))
#define XB_XSUB(j)  (1280 + 64 * (j))
#define XB_XGEN(j)  (2304 + 64 * (j))
#define XB_TOP      3328
#define XB_TOPGEN   3392
#define XCD_BAR_WORDS 3456
#define XB_SPIN_CAP (1u << 22)
__device__ __forceinline__ unsigned xb_ld(unsigned* p)              { return __hip_atomic_load(p, __ATOMIC_RELAXED, __HIP_MEMORY_SCOPE_AGENT); }
__device__ __forceinline__ unsigned xb_add(unsigned* p, unsigned v) { return __hip_atomic_fetch_add(p, v, __ATOMIC_RELAXED, __HIP_MEMORY_SCOPE_AGENT); }
__device__ __forceinline__ unsigned xb_xcc_id() { return (unsigned)__builtin_amdgcn_s_getreg((3 << 11) | 20) & 0xFu; }
#define XB_SPIN(cond, bar) do { unsigned _sp = 0; while (cond) { __builtin_amdgcn_s_sleep(1); \
    if ((++_sp & 255u) == 0u) { if (xb_ld(&(bar)[XB_TMO])) break; if (_sp > XB_SPIN_CAP) { atomicAdd(&(bar)[XB_TMO], 1u); break; } } } } while (0)
struct XcdBarrier { unsigned* bar; unsigned x; volatile LAS unsigned* st; int wave; };
__device__ __forceinline__ XcdBarrier xcd_barrier_post(unsigned* bar, volatile LAS unsigned* st, int wave) {
    XcdBarrier b; b.bar = bar; b.x = xb_xcc_id(); b.st = st; b.wave = wave;
    if (wave == 0 && lane_id() == 0) (void)xb_add(&bar[XB_XCNT(b.x)], 1u);
    return b;
}
__device__ __forceinline__ void xcd_barrier_complete(unsigned* bar, unsigned x, unsigned& nloc, unsigned& nx) {
    const unsigned G = gridDim.x * gridDim.y * gridDim.z;
    unsigned sum, cnt, mine, sp = 0u;
    for (;;) {
        sum = 0u; cnt = 0u; mine = 0u;
#pragma unroll
        for (unsigned j = 0; j < 16; ++j) { const unsigned c = xb_ld(&bar[XB_XCNT(j)]); sum += c; cnt += (c > 0u) ? 1u : 0u; }
        mine = xb_ld(&bar[XB_XCNT(x)]);
        if (sum == G) break;
        __builtin_amdgcn_s_sleep(1);
        if ((++sp & 255u) == 0u) { if (xb_ld(&bar[XB_TMO])) break; if (sp > XB_SPIN_CAP) { atomicAdd(&bar[XB_TMO], 1u); break; } }
    }
    nloc = mine > 0u ? mine : 1u; nx = cnt > 0u ? cnt : 1u;
}
__device__ __forceinline__ void xcd_barrier(const XcdBarrier& b) {
    asm volatile("s_waitcnt vmcnt(0)" ::: "memory");
    __syncthreads();
    if (b.wave == 0 && lane_id() == 0) {
        unsigned* bar = b.bar; asm volatile("" : "+s"(bar)); unsigned bx = b.x; asm volatile("" : "+s"(bx));
        __builtin_amdgcn_s_waitcnt(0);
        unsigned nloc = b.st[0], nx = b.st[1];
        if (nloc == 0u) { xcd_barrier_complete(bar, bx, nloc, nx); b.st[0] = nloc; b.st[1] = nx; }
        const unsigned old = xb_add(&bar[XB_XSUB(bx)], 1u);
        const unsigned gen = old / nloc;
        if (old + 1u == (gen + 1u) * nloc) {
            __builtin_amdgcn_fence(__ATOMIC_RELEASE, "agent");
            asm volatile("s_waitcnt vmcnt(0)" ::: "memory");
            const unsigned og = xb_add(&bar[XB_TOP], 1u);
            const unsigned tg = og / nx;
            if (og + 1u == (tg + 1u) * nx) xb_add(&bar[XB_TOPGEN], 1u);
            else XB_SPIN(xb_ld(&bar[XB_TOPGEN]) == tg, bar);
            __builtin_amdgcn_fence(__ATOMIC_ACQUIRE, "agent");
            xb_add(&bar[XB_XGEN(bx)], 1u);
            asm volatile("s_waitcnt vmcnt(0)" ::: "memory");
        } else {
            XB_SPIN(xb_ld(&bar[XB_XGEN(bx)]) == gen, bar);
            __builtin_amdgcn_fence(__ATOMIC_ACQUIRE, "agent");
            asm volatile("s_waitcnt vmcnt(0)" ::: "memory");
        }
    }
    __syncthreads();
}

struct Args { const float* in[37]; float* out; unsigned char* ws; int ph_lo, ph_hi; };
typedef const __attribute__((address_space(4))) Args* KArgs;
__device__ __forceinline__ KArgs ka_get() { KArgs k = (KArgs)__builtin_amdgcn_kernarg_segment_ptr(); asm volatile("" : "+s"(k)); return k; }
enum { I_X = 0, I_P, I_MIXN, I_WIN, I_CONVW, I_CONVB, I_WA, I_BA, I_WX, I_BX, I_LAM, I_PEK, I_PEV, I_WK1, I_BK1, I_WK2, I_BK2, I_WV1, I_BV1, I_WV2, I_BV2,
       I_RECN, I_ATTN, I_WOUT, I_FFNN, I_WGR, I_BGR, I_WER, I_BER, I_WGATE, I_WUP, I_WDOWN, I_PLEN, I_WPG, I_BPG, I_WPU, I_FINN };

namespace pg8 {
struct CmpSched {
    const bf16_t* z; const bf16_t* W1k; const bf16_t* W1v; int G, c;
    __device__ __forceinline__ size_t kstepA() const { return (size_t)ZP * 2; }
    __device__ __forceinline__ bool next(int i, Unit& u) const { const int L = i * G + c; if (L >= 64) return false; u.pm = L >> 1; u.pn = 0; u.a0 = L & 1; u.a1 = 0; return true; }
    __device__ __forceinline__ const char* a_base(const Unit& u) const { const int b = u.pm >> 1, g = u.pm & 1; return (const char*)(z + (size_t)b * SEQ * ZP + (u.a0 ? ZC_VC : ZC_KC) + g * 64); }
    __device__ __forceinline__ const char* b_base(const Unit& u) const { return (const char*)(u.a0 ? W1v : W1k); }
    __device__ __forceinline__ void a_voff(const Unit&, const int (&R)[2], const int (&C)[2], unsigned (&v)[2][2]) const {
#pragma unroll
        for (int h = 0; h < 2; ++h)
#pragma unroll
            for (int i = 0; i < 2; ++i) v[h][i] = (unsigned)(16 * (h * HALF + R[i]) * ZP + C[i]) * 2u;
    }
};
template <int PHASE>
struct MoeSched {
    const PG8_LAS int* tab; const bf16_t* A; const bf16_t* W; const int* ltok; int G, c;
    __device__ __forceinline__ size_t kstepA() const { return (size_t)(BK * 2); }
    __device__ __forceinline__ bool next(int i, Unit& u) const {
        const int TT = tab[64]; int rt, pn;
        if (G == 256) { const int x = c & 7, y = c >> 3, Q = (TT + 7) >> 3, rl = i * 8 + (y >> 2); pn = y & 3; if (rl >= Q) return false; rt = x * Q + rl; }
        else { const int L = i * G + c; rt = L >> 2; pn = L & 3; }
        if (rt >= TT) return false;
        int lo = 0, hi = 64;
        while (hi - lo > 1) { const int mid = (lo + hi) >> 1; if (tab[mid] <= rt) lo = mid; else hi = mid; }
        u.pm = rt; u.pn = pn; u.a0 = lo; u.a1 = rt - tab[lo]; return true;
    }
    __device__ __forceinline__ const char* a_base(const Unit& u) const { return PHASE == 1 ? (const char*)A : (const char*)A + (size_t)u.pm * BM * DEXP * 2; }
    __device__ __forceinline__ const char* b_base(const Unit& u) const {
        const int e = u.a0 & 31;
        return PHASE == 1 ? (const char*)W + ((size_t)e * 1024 + (size_t)u.pn * BM) * 1024 * 2 : (const char*)W + ((size_t)e * 1024 + (size_t)u.pn * BM) * DEXP * 2;
    }
    __device__ __forceinline__ void a_voff(const Unit& u, const int (&R)[2], const int (&C)[2], unsigned (&v)[2][2]) const {
        if (PHASE == 1) {
            const int cnt = tab[80 + u.a0];
#pragma unroll
            for (int h = 0; h < 2; ++h)
#pragma unroll
                for (int i = 0; i < 2; ++i) { const int rank = u.a1 * BM + h * HALF + R[i]; const int tok = rank < cnt ? ltok[(size_t)u.a0 * NTOK + rank] : 0; v[h][i] = (unsigned)(tok * DM + C[i]) * 2u; }
        } else {
#pragma unroll
            for (int h = 0; h < 2; ++h)
#pragma unroll
                for (int i = 0; i < 2; ++i) v[h][i] = (unsigned)((h * HALF + R[i]) * DEXP + C[i]) * 2u;
        }
    }
};

template <int ACT  > struct EpiBf16 {
    bf16_t* O; int ldc; const float* bias; size_t a0_stride; int a0_bias_stride;
    const float* rs;
    __device__ __forceinline__ void operator()(const f32x4 (&acc)[2][2][4][2], const Unit& u, int wr, int wc, int fr, int fq) const {
        const int row0 = u.pm * BM + wr * 64 + fr, col0 = u.pn * BM + wc * 32 + 8 * fq;
        bf16_t* base = O + (size_t)u.a0 * a0_stride; const float* bs = bias ? bias + u.a0 * a0_bias_stride : nullptr;
        float rsv[2][4];
#pragma unroll
        for (int ai = 0; ai < 2; ++ai)
#pragma unroll
            for (int m = 0; m < 4; ++m) rsv[ai][m] = rs ? rs[row0 + ai * HALF + m * 16] : 1.f;
        f32x4 bv[2][2];
#pragma unroll
        for (int bj = 0; bj < 2; ++bj)
#pragma unroll
            for (int n = 0; n < 2; ++n) bv[bj][n] = bs ? *(const f32x4*)(bs + col0 + bj * HALF + 4 * n) : (f32x4){0.f, 0.f, 0.f, 0.f};
#pragma unroll
        for (int ai = 0; ai < 2; ++ai)
#pragma unroll
            for (int m = 0; m < 4; ++m) { bf16_t* rowp = base + (size_t)(row0 + ai * HALF + m * 16) * ldc + col0; const float sc = rsv[ai][m];
#pragma unroll
                for (int bj = 0; bj < 2; ++bj) { f32x4 v0 = acc[ai][bj][m][0], v1 = acc[ai][bj][m][1];
                    if (rs) { v0 *= sc; v1 *= sc; }
                    v0 += bv[bj][0]; v1 += bv[bj][1];
                    if (ACT == 1) { for (int e = 0; e < 4; ++e) { v0[e] = fgelu(v0[e]); v1[e] = fgelu(v1[e]); } }
                    if (ACT == 2) { for (int e = 0; e < 4; ++e) { v0[e] = fsigmoid(v0[e]); v1[e] = fsigmoid(v1[e]); } }
                    u32x4 w; w.x = cvt_pk_bf16(v0[0], v0[1]); w.y = cvt_pk_bf16(v0[2], v0[3]); w.z = cvt_pk_bf16(v1[0], v1[1]); w.w = cvt_pk_bf16(v1[2], v1[3]);
                    *(u32x4*)(rowp + bj * HALF) = w; } }
    }
};
struct EpiResid {
    bf16_t* h;
    __device__ __forceinline__ void operator()(const f32x4 (&acc)[2][2][4][2], const Unit& u, int wr, int wc, int fr, int fq) const {
        const int row0 = u.pm * BM + wr * 64 + fr, col0 = u.pn * BM + wc * 32 + 8 * fq;
#pragma unroll
        for (int ai = 0; ai < 2; ++ai) {
            bf16_t* rp0 = h + (size_t)(row0 + ai * HALF) * DM + col0;
            u32x4 hv[4][2];
#pragma unroll
            for (int m = 0; m < 4; ++m)
#pragma unroll
                for (int bj = 0; bj < 2; ++bj) hv[m][bj] = *(const u32x4*)(rp0 + (size_t)m * 16 * DM + bj * HALF);
#pragma unroll
            for (int m = 0; m < 4; ++m)
#pragma unroll
                for (int bj = 0; bj < 2; ++bj) { const u32x4 x = hv[m][bj]; const f32x4 a0 = acc[ai][bj][m][0], a1 = acc[ai][bj][m][1];
                    u32x4 w; w.x = cvt_pk_bf16(bflo(x.x) + a0[0], bfhi(x.x) + a0[1]); w.y = cvt_pk_bf16(bflo(x.y) + a0[2], bfhi(x.y) + a0[3]); w.z = cvt_pk_bf16(bflo(x.z) + a1[0], bfhi(x.z) + a1[1]); w.w = cvt_pk_bf16(bflo(x.w) + a1[2], bfhi(x.w) + a1[3]);
                    *(u32x4*)(rp0 + (size_t)m * 16 * DM + bj * HALF) = w; }
            asm volatile("" ::: "memory");
        }
    }
};
struct EpiPleB {
    const bf16_t* h; bf16_t* hn; const bf16_t* Gt;
    __device__ __forceinline__ void operator()(const f32x4 (&acc)[2][2][4][2], const Unit& u, int wr, int wc, int fr, int fq) const {
        const int row0 = u.pm * BM + wr * 64 + fr, col0 = u.pn * BM + wc * 32 + 8 * fq;
#pragma unroll
        for (int ai = 0; ai < 2; ++ai) {
            const size_t ro0 = (size_t)(row0 + ai * HALF) * DM + col0;
            u32x4 hv[4][2], gv[4][2];
#pragma unroll
            for (int m = 0; m < 4; ++m)
#pragma unroll
                for (int bj = 0; bj < 2; ++bj) { hv[m][bj] = *(const u32x4*)(h + ro0 + (size_t)m * 16 * DM + bj * HALF); gv[m][bj] = *(const u32x4*)(Gt + ro0 + (size_t)m * 16 * DM + bj * HALF); }
#pragma unroll
            for (int m = 0; m < 4; ++m)
#pragma unroll
                for (int bj = 0; bj < 2; ++bj) { const u32x4 x = hv[m][bj], g = gv[m][bj]; const f32x4 a0 = acc[ai][bj][m][0], a1 = acc[ai][bj][m][1];
                    u32x4 w; w.x = cvt_pk_bf16(bflo(x.x) + a0[0] * bflo(g.x), bfhi(x.x) + a0[1] * bfhi(g.x)); w.y = cvt_pk_bf16(bflo(x.y) + a0[2] * bflo(g.y), bfhi(x.y) + a0[3] * bfhi(g.y));
                    w.z = cvt_pk_bf16(bflo(x.z) + a1[0] * bflo(g.z), bfhi(x.z) + a1[1] * bfhi(g.z)); w.w = cvt_pk_bf16(bflo(x.w) + a1[2] * bflo(g.w), bfhi(x.w) + a1[3] * bfhi(g.w));
                    *(u32x4*)(hn + ro0 + (size_t)m * 16 * DM + bj * HALF) = w; }
            asm volatile("" ::: "memory");
        }
    }
};
struct EpiSwiglu {
    bf16_t* Hd; const PG8_LAS int* tab; const float* lrs;
    __device__ __forceinline__ void operator()(const f32x4 (&acc)[2][2][4][2], const Unit& u, int wr, int wc, int fr, int fq) const {
        const int row0 = u.pm * BM + wr * 64 + fr, col0 = u.pn * HALF + wc * 32 + 8 * fq; const int seg = u.a0, cnt = tab[80 + seg];
        float rsv[2][4];
#pragma unroll
        for (int ai = 0; ai < 2; ++ai)
#pragma unroll
            for (int m = 0; m < 4; ++m) { const int rank = u.a1 * BM + ai * HALF + wr * 64 + m * 16 + fr; const float v = lrs[(size_t)seg * NTOK + (rank < cnt ? rank : 0)]; rsv[ai][m] = rank < cnt ? v : 0.f; }
#pragma unroll
        for (int ai = 0; ai < 2; ++ai)
#pragma unroll
            for (int m = 0; m < 4; ++m) { const float rs = rsv[ai][m];
                float r[8];
#pragma unroll
                for (int n = 0; n < 2; ++n)
#pragma unroll
                    for (int e = 0; e < 4; ++e) { const float gt = acc[ai][0][m][n][e] * rs, up = acc[ai][1][m][n][e] * rs; r[4 * n + e] = gt * fsigmoid(gt) * up; }
                u32x4 w; w.x = cvt_pk_bf16(r[0], r[1]); w.y = cvt_pk_bf16(r[2], r[3]); w.z = cvt_pk_bf16(r[4], r[5]); w.w = cvt_pk_bf16(r[6], r[7]);
                *(u32x4*)(Hd + (size_t)(row0 + ai * HALF + m * 16) * DEXP + col0) = w; }
    }
};
struct EpiMoeDown {
    const PG8_LAS int* tab; const int* ltok; const float* lgate; bf16_t* y0; bf16_t* y1;
    __device__ __forceinline__ void operator()(const f32x4 (&acc)[2][2][4][2], const Unit& u, int wr, int wc, int fr, int fq) const {
        const int seg = u.a0, cnt = tab[80 + seg]; bf16_t* yb = (seg >= 32) ? y1 : y0;
        const int col0 = u.pn * BM + wc * 32 + 8 * fq;
        int tk[2][4]; float gtv[2][4];
#pragma unroll
        for (int ai = 0; ai < 2; ++ai)
#pragma unroll
            for (int m = 0; m < 4; ++m) { const int rank = u.a1 * BM + ai * HALF + wr * 64 + m * 16 + fr; const size_t o = (size_t)seg * NTOK + (rank < cnt ? rank : 0); tk[ai][m] = ltok[o]; gtv[ai][m] = lgate[o]; }
#pragma unroll
        for (int ai = 0; ai < 2; ++ai)
#pragma unroll
            for (int m = 0; m < 4; ++m) { const int rank = u.a1 * BM + ai * HALF + wr * 64 + m * 16 + fr;
                if (rank < cnt) { const int tok = tk[ai][m]; const float gt = gtv[ai][m];
#pragma unroll
                    for (int bj = 0; bj < 2; ++bj) { const f32x4 v0 = acc[ai][bj][m][0] * gt, v1 = acc[ai][bj][m][1] * gt;
                        u32x4 w; w.x = cvt_pk_bf16(v0[0], v0[1]); w.y = cvt_pk_bf16(v0[2], v0[3]); w.z = cvt_pk_bf16(v1[0], v1[1]); w.w = cvt_pk_bf16(v1[2], v1[3]);
                        *(u32x4*)(yb + (size_t)tok * DM + col0 + bj * HALF) = w; } } }
    }
};
}

struct TrItem { const float* W; const float* gain; bf16* WT; int K, N, dest_row0, k0, n0; float cs; };
__device__ __forceinline__ void tr_load(const TrItem& t, f32x4 (&v)[8], int lane) {
    const int c4 = lane & 7, kr = lane >> 3; const bool ok = t.n0 + 4 * c4 < t.N;
#pragma unroll
    for (int i = 0; i < 8; ++i) v[i] = ok ? *(const f32x4*)(t.W + (size_t)(t.k0 + 8 * i + kr) * t.N + t.n0 + 4 * c4) : (f32x4){0.f, 0.f, 0.f, 0.f};
}
__device__ __forceinline__ void tr_store(const TrItem& t, const f32x4 (&v)[8], LAS float* scr, int lane) {
    const int c4 = lane & 7, kr = lane >> 3;
#pragma unroll
    for (int i = 0; i < 8; ++i) { const int kk = 8 * i + kr; const float gsc = (t.gain ? t.gain[t.k0 + kk] : 1.f) * t.cs; LAS float* d = scr + kk * 33 + 4 * c4;
        d[0] = v[i].x * gsc; d[1] = v[i].y * gsc; d[2] = v[i].z * gsc; d[3] = v[i].w * gsc; }
    LDS_WAIT();
    const int c = lane & 7;
#pragma unroll
    for (int j = 0; j < 4; ++j) { const int n = (lane >> 3) + 8 * j; const LAS float* sp = scr + (8 * c) * 33 + n;
        u32x4 o; o.x = pk2(sp[0], sp[33]); o.y = pk2(sp[66], sp[99]); o.z = pk2(sp[132], sp[165]); o.w = pk2(sp[198], sp[231]);
        *(u32x4*)(t.WT + (size_t)(t.dest_row0 + n) * t.K + t.k0 + 8 * c) = o; }
    LDS_WAIT();
}
constexpr int IT_IN = 16 * 80, IT_OUT = 16 * 32, IT_PG = 16 * 32, IT_PU = 4 * 32, IT_K1 = 32 * 8, IT_V1 = 32 * 8, IT_E = 768;
constexpr int IT_LAYER = IT_IN + IT_OUT + IT_PG + IT_PU + IT_K1 + IT_V1 + NEXP * IT_E;

constexpr int IT_SMALL = IT_IN + IT_OUT + IT_PG + IT_PU + IT_K1 + IT_V1;
template <int MODE>
__device__ __forceinline__ void tr_run(KArgs args, LAS float* scr, int lane, int q0, int qstep, int Lsel) {
    unsigned char* ws = args->ws;
    const int nq = MODE == 0 ? DEPTH * IT_SMALL : NEXP * IT_E;
#define Q2IT_(q) (MODE == 0 ? ((q) / IT_SMALL) * IT_LAYER + (q) % IT_SMALL : Lsel * IT_LAYER + IT_SMALL + (q))
#define TR_DECODE(it_, t_) do { const int L = (it_) / IT_LAYER; int r = (it_) % IT_LAYER; unsigned char* wl = ws + WS_W + (size_t)L * W_LAYER; t_.cs = 1.f; t_.gain = nullptr; \
        if (r < IT_IN) { const int kb = r / 80, nb = r % 80; t_.W = args->in[I_WIN] + (size_t)L * DM * D_IN; t_.K = DM; t_.N = D_IN; t_.gain = args->in[I_MIXN] + L * DM; t_.WT = (bf16*)(wl + WO_IN); t_.dest_row0 = 32 * nb; t_.k0 = 64 * kb; t_.n0 = 32 * nb; \
            t_.cs = (32 * nb >= ZC_Q && 32 * nb < ZC_KC) ? 0.125f * LOG2E : 1.f; break; } r -= IT_IN; \
        if (r < IT_OUT) { const int kb = r / 32, nb = r % 32; t_.W = args->in[I_WOUT] + (size_t)L * DM * DM; t_.K = DM; t_.N = DM; t_.gain = kb < 8 ? args->in[I_RECN] + L * 512 : args->in[I_ATTN] + L * 512 - 512; t_.WT = (bf16*)(wl + WO_OUT); t_.dest_row0 = 32 * nb; t_.k0 = 64 * kb; t_.n0 = 32 * nb; break; } r -= IT_OUT; \
        if (r < IT_PG) { const int kb = r / 32, nb = r % 32; t_.W = args->in[I_WPG] + (size_t)L * DM * DM; t_.K = DM; t_.N = DM; t_.gain = args->in[I_PLEN] + L * DM; t_.WT = (bf16*)(wl + WO_PG); t_.dest_row0 = 32 * nb; t_.k0 = 64 * kb; t_.n0 = 32 * nb; break; } r -= IT_PG; \
        if (r < IT_PU) { const int kb = r / 32, nb = r % 32; t_.W = args->in[I_WPU] + (size_t)L * D_PLE * DM; t_.K = D_PLE; t_.N = DM; t_.WT = (bf16*)(wl + WO_PU); t_.dest_row0 = 32 * nb; t_.k0 = 64 * kb; t_.n0 = 32 * nb; break; } r -= IT_PU; \
        if (r < IT_K1) { const int kb = r / 8, nb = r % 8; t_.W = args->in[I_WK1] + (size_t)L * 2048 * 256; t_.K = 2048; t_.N = 256; t_.WT = (bf16*)(wl + WO_K1); t_.dest_row0 = 32 * nb; t_.k0 = 64 * kb; t_.n0 = 32 * nb; break; } r -= IT_K1; \
        if (r < IT_V1) { const int kb = r / 8, nb = r % 8; t_.W = args->in[I_WV1] + (size_t)L * 2048 * 256; t_.K = 2048; t_.N = 256; t_.WT = (bf16*)(wl + WO_V1); t_.dest_row0 = 32 * nb; t_.k0 = 64 * kb; t_.n0 = 32 * nb; break; } r -= IT_V1; \
        const int e = r / IT_E; int rr = r % IT_E; \
        if (rr < 512) { const int up = rr >> 8; rr &= 255; const int kb = rr / 16, nb = rr % 16, n0 = 32 * nb;     \
            t_.W = (up ? args->in[I_WUP] : args->in[I_WGATE]) + ((size_t)L * NEXP + e) * DM * DEXP; t_.K = DM; t_.N = DEXP; t_.gain = args->in[I_FFNN] + L * DM; t_.WT = (bf16*)(wl + WO_GU) + (size_t)e * 1024 * 1024; \
            t_.dest_row0 = 256 * (n0 >> 7) + (n0 & 127) + 128 * up; t_.k0 = 64 * kb; t_.n0 = n0; } \
        else { rr -= 512; const int kb = rr / 32, nb = rr % 32; t_.W = args->in[I_WDOWN] + ((size_t)L * NEXP + e) * DEXP * DM; t_.K = DEXP; t_.N = DM; t_.WT = (bf16*)(wl + WO_D) + (size_t)e * 1024 * DEXP; t_.dest_row0 = 32 * nb; t_.k0 = 64 * kb; t_.n0 = 32 * nb; } \
    } while (0)
    int q = q0; TrItem cur; f32x4 vc[8];
    if (q < nq) { TR_DECODE(Q2IT_(q), cur); tr_load(cur, vc, lane); }
    while (q < nq) {
        const int qn = q + qstep; TrItem nxt; f32x4 vn[8];
        const bool hn = qn < nq;
        if (hn) { TR_DECODE(Q2IT_(qn), nxt); tr_load(nxt, vn, lane); }
        tr_store(cur, vc, scr, lane);
        if (hn) { cur = nxt;
#pragma unroll
            for (int i = 0; i < 8; ++i) vc[i] = vn[i]; }
        q = qn; }
#undef TR_DECODE
#undef Q2IT_
}
__device__ __forceinline__ void phase_prologue(KArgs args, LAS unsigned char* lds, int G, int bid, int tid, int wave, int lane) {
    unsigned char* ws = args->ws;
    LAS float* scr = (LAS float*)(lds + wave * 16384);
    const int gw = bid * NWAVES + wave, NGW = G * NWAVES;
    tr_run<0>(args, scr, lane, gw, NGW, 0);
    const int gt = bid * (NWAVES * 64) + tid, NGT = G * NWAVES * 64;
    float* c8 = (float*)(ws + WS_C8); float* wrt = (float*)(ws + WS_WRT);
    for (int i = gt; i < DEPTH * 512; i += NGT) { const float lam = args->in[I_LAM][i]; c8[i] = -8.f * log1pf(expf(-lam)) * LOG2E; }
    for (int i = gt; i < DEPTH * 36 * 1024; i += NGT) { const int L = i / (36 * 1024), j = (i / 1024) % 36, k = i % 1024;
        const float w = (j < 32 ? args->in[I_WER][((size_t)L * DM + k) * 32 + j] : args->in[I_WGR][((size_t)L * DM + k) * 4 + (j - 32)]) * args->in[I_FFNN][L * DM + k];
        const unsigned hi = f2bf(w), lo = f2bf(w - bf2f((bf16)hi));
        ((bf16*)wrt)[((size_t)(L * 2 + 0) * 36 + j) * 1024 + k] = (bf16)hi; ((bf16*)wrt)[((size_t)(L * 2 + 1) * 36 + j) * 1024 + k] = (bf16)lo; }
    { bf16* w2t = (bf16*)(ws + WS_W2T);
      for (int i = gt; i < DEPTH * 2 * 64 * 256; i += NGT) { const int L = i >> 15, kv = (i >> 14) & 1, n = (i >> 8) & 63, k = i & 255;
          w2t[i] = (bf16)f2bf((kv ? args->in[I_WV2] : args->in[I_WK2])[((size_t)L * 256 + k) * 64 + n]); } }
    if (bid < 8) { const int pair = bid, L = pair >> 1, kv = pair & 1, j = tid & 255, half = tid >> 8;
        const float* pe = (kv ? args->in[I_PEV] : args->in[I_PEK]) + L * 2048 + 1024 * half; const float* w1 = (kv ? args->in[I_WV1] : args->in[I_WK1]) + ((size_t)L * 2048 + 1024 * half) * 256 + j;
        float s0 = 0.f, s1 = 0.f, s2 = 0.f, s3 = 0.f;
#pragma unroll 4
        for (int k = 0; k < 1024; k += 4) { s0 += pe[k] * w1[(size_t)k * 256]; s1 += pe[k + 1] * w1[(size_t)(k + 1) * 256]; s2 += pe[k + 2] * w1[(size_t)(k + 2) * 256]; s3 += pe[k + 3] * w1[(size_t)(k + 3) * 256]; }
        LAS float* red = (LAS float*)(lds + 8 * 16384);
        if (half) red[j] = (s0 + s1) + (s2 + s3);
        __syncthreads();
        if (!half) ((float*)(ws + WS_BK1))[pair * 256 + j] = (kv ? args->in[I_BV1] : args->in[I_BK1])[L * 256 + j] + ((s0 + s1) + (s2 + s3)) + red[j]; }
}

__device__ __forceinline__ void store_row_bf16(bf16* orow, const f32x4 (&v)[4], float sc, int lane) {
    unsigned long long* o8 = (unsigned long long*)orow + lane;
#pragma unroll
    for (int j = 0; j < 4; ++j) o8[64 * j] = (unsigned long long)pk2(v[j].x * sc, v[j].y * sc) | ((unsigned long long)pk2(v[j].z * sc, v[j].w * sc) << 32);
}
__device__ __forceinline__ float row_ss_bf16(const u32x2 (&v)[4]) { float s = 0.f;
#pragma unroll
    for (int j = 0; j < 4; ++j) { const float a = bflo(v[j].x), b = bfhi(v[j].x), c = bflo(v[j].y), d = bfhi(v[j].y); s += (a * a + b * b) + (c * c + d * d); }
    return s; }
__device__ __forceinline__ void store_row_bf16_from16(bf16* orow, const u32x2 (&v)[4], float sc, int lane) {
    u32x2* o8 = (u32x2*)orow + lane;
#pragma unroll
    for (int j = 0; j < 4; ++j) { u32x2 w; w.x = pk2(bflo(v[j].x) * sc, bfhi(v[j].x) * sc); w.y = pk2(bflo(v[j].y) * sc, bfhi(v[j].y) * sc); o8[64 * j] = w; }
}
__device__ __forceinline__ float ss_u4(const u32x4& v) {
    const float a = bflo(v.x), b = bfhi(v.x), c = bflo(v.y), d = bfhi(v.y), e = bflo(v.z), f = bfhi(v.z), g = bflo(v.w), h = bfhi(v.w);
    return ((a * a + b * b) + (c * c + d * d)) + ((e * e + f * f) + (g * g + h * h)); }
__device__ __forceinline__ u32x4 scale_u4(const u32x4& v, float sc) { u32x4 w;
    w.x = pg8::cvt_pk_bf16(bflo(v.x) * sc, bfhi(v.x) * sc); w.y = pg8::cvt_pk_bf16(bflo(v.y) * sc, bfhi(v.y) * sc); w.z = pg8::cvt_pk_bf16(bflo(v.z) * sc, bfhi(v.z) * sc); w.w = pg8::cvt_pk_bf16(bflo(v.w) * sc, bfhi(v.w) * sc); return w; }
__device__ __forceinline__ u32x4 add3_u4(const u32x4& h, const u32x4& a, const u32x4& b) { u32x4 w;
    w.x = pg8::cvt_pk_bf16(bflo(h.x) + bflo(a.x) + bflo(b.x), bfhi(h.x) + bfhi(a.x) + bfhi(b.x)); w.y = pg8::cvt_pk_bf16(bflo(h.y) + bflo(a.y) + bflo(b.y), bfhi(h.y) + bfhi(a.y) + bfhi(b.y));
    w.z = pg8::cvt_pk_bf16(bflo(h.z) + bflo(a.z) + bflo(b.z), bfhi(h.z) + bfhi(a.z) + bfhi(b.z)); w.w = pg8::cvt_pk_bf16(bflo(h.w) + bflo(a.w) + bflo(b.w), bfhi(h.w) + bfhi(a.w) + bfhi(b.w)); return w; }
__device__ __forceinline__ void phase_norm1(const float* x, bf16* H, float* rs, int gw, int NGW, int lane) {
    if (x) {
        constexpr int NR = 2;
        for (int m0 = gw * NR; m0 < NTOK; m0 += NGW * NR) { f32x4 v[NR][4];
#pragma unroll
            for (int r = 0; r < NR; ++r)
#pragma unroll
                for (int j = 0; j < 4; ++j) v[r][j] = ((const f32x4*)(x + (size_t)(m0 + r) * DM))[lane + 64 * j];
#pragma unroll
            for (int r = 0; r < NR; ++r) { float s = 0.f;
#pragma unroll
                for (int j = 0; j < 4; ++j) s += (v[r][j].x * v[r][j].x + v[r][j].y * v[r][j].y) + (v[r][j].z * v[r][j].z + v[r][j].w * v[r][j].w);
                const float rstd = rsqrtf(wave_sum(s) * (1.f / DM) + EPS);
                store_row_bf16(H + (size_t)(m0 + r) * DM, v[r], 1.f, lane); if (lane == 0) rs[m0 + r] = rstd; } }
    } else {
        constexpr int NR = 4;
        for (int m0 = gw * NR; m0 < NTOK; m0 += NGW * NR) { u32x4 v[NR][2];
#pragma unroll
            for (int r = 0; r < NR; ++r)
#pragma unroll
                for (int j = 0; j < 2; ++j) v[r][j] = ((const u32x4*)(H + (size_t)(m0 + r) * DM))[lane + 64 * j];
            float rr[NR];
#pragma unroll
            for (int r = 0; r < NR; ++r) rr[r] = rsqrtf(wave_sum(ss_u4(v[r][0]) + ss_u4(v[r][1])) * (1.f / DM) + EPS);
            if (lane == 0) *(f32x4*)(rs + m0) = (f32x4){rr[0], rr[1], rr[2], rr[3]}; }
    }
}
__device__ __forceinline__ void phase_final(const bf16* H, float* out, const float* gain, int gw, int NGW, int lane) {
    constexpr int NR = 4;
    f32x4 gv[2][2];
#pragma unroll
    for (int j = 0; j < 2; ++j) { gv[j][0] = ((const f32x4*)gain)[2 * lane + 128 * j]; gv[j][1] = ((const f32x4*)gain)[2 * lane + 128 * j + 1]; }
    for (int m0 = gw * NR; m0 < NTOK; m0 += NGW * NR) { u32x4 v[NR][2];
#pragma unroll
        for (int r = 0; r < NR; ++r)
#pragma unroll
            for (int j = 0; j < 2; ++j) v[r][j] = ((const u32x4*)(H + (size_t)(m0 + r) * DM))[lane + 64 * j];
#pragma unroll
        for (int r = 0; r < NR; ++r) { const float rstd = rsqrtf(wave_sum(ss_u4(v[r][0]) + ss_u4(v[r][1])) * (1.f / DM) + EPS);
            f32x4* xr = (f32x4*)(out + (size_t)(m0 + r) * DM);
#pragma unroll
            for (int j = 0; j < 2; ++j) { const u32x4 w = v[r][j];
                xr[2 * lane + 128 * j] = (f32x4){bflo(w.x), bfhi(w.x), bflo(w.y), bfhi(w.y)} * rstd * gv[j][0];
                xr[2 * lane + 128 * j + 1] = (f32x4){bflo(w.z), bfhi(w.z), bflo(w.w), bfhi(w.w)} * rstd * gv[j][1]; } } }
}
__device__ __forceinline__ void phase_norm3(bf16* H, const bf16* y0, const bf16* y1, float* rs, const float* pL, bf16* pb, int gw, int NGW, int lane) {
    constexpr int NR = 4;
    for (int m0 = gw * NR; m0 < NTOK; m0 += NGW * NR) { u32x4 hv[NR][2], av[NR][2], bv[NR][2]; f32x4 pv[NR];
#pragma unroll
        for (int r = 0; r < NR; ++r) { const size_t ro = (size_t)(m0 + r) * DM;
#pragma unroll
            for (int j = 0; j < 2; ++j) { hv[r][j] = ((const u32x4*)(H + ro))[lane + 64 * j]; av[r][j] = ((const u32x4*)(y0 + ro))[lane + 64 * j]; bv[r][j] = ((const u32x4*)(y1 + ro))[lane + 64 * j]; }
            pv[r] = ((const f32x4*)(pL + (size_t)(m0 + r) * D_PLE))[lane]; }
        float rr[NR];
#pragma unroll
        for (int r = 0; r < NR; ++r) { const size_t ro = (size_t)(m0 + r) * DM;
            const u32x4 w0 = add3_u4(hv[r][0], av[r][0], bv[r][0]), w1 = add3_u4(hv[r][1], av[r][1], bv[r][1]);
            ((u32x4*)(H + ro))[lane] = w0; ((u32x4*)(H + ro))[lane + 64] = w1;
            rr[r] = rsqrtf(wave_sum(ss_u4(w0) + ss_u4(w1)) * (1.f / DM) + EPS);
            u32x2 q; q.x = pg8::cvt_pk_bf16(pv[r].x, pv[r].y); q.y = pg8::cvt_pk_bf16(pv[r].z, pv[r].w);
            ((u32x2*)(pb + (size_t)(m0 + r) * D_PLE))[lane] = q; }
        if (lane == 0) *(f32x4*)(rs + m0) = (f32x4){rr[0], rr[1], rr[2], rr[3]}; }
}
constexpr int N2_PITCH = 2064, N2_WL = 36 * N2_PITCH;
__device__ __forceinline__ void phase_norm2(KArgs args, const bf16* H, int L, LAS unsigned char* lds, int G, int bid, int tid, int wave, int lane) {
    unsigned char* ws = args->ws;
    { const u32x4* src = (const u32x4*)(ws + WS_WRT + (size_t)L * 2 * 36 * 2048);
      for (int i = tid; i < 2 * 36 * 128; i += NWAVES * 64) { const int hl = i / (36 * 128), row = (i >> 7) % 36, c = i & 127; *(LAS u32x4*)(lds + hl * N2_WL + row * N2_PITCH + c * 16) = src[i]; } }
    __syncthreads();
    gu32* cnt = (gu32*)(ws + WS_CTL) + CW_CNT + L * 64;
    int* ltok = (int*)(ws + WS_LTOK); float* lgate = (float*)(ws + WS_LGATE); float* lrs = (float*)(ws + WS_LRS);
    const float* bgr = args->in[I_BGR] + L * 4; const float* ber = args->in[I_BER] + L * 32;
    const int gw = bid * NWAVES + wave, NGW = G * NWAVES, fr = lane & 15, fq = lane >> 4;
    const int arow[3] = {8 * (fr >> 2) + (fr & 3), 8 * (fr >> 2) + (fr & 3) + 4, 32 + (fr & 3)};
    for (int grp = gw; grp < NTOK / 16; grp += NGW) {
        const int tok = grp * 16 + fr;
        const bf16* hrow = H + (size_t)tok * DM + 8 * fq;
        f32x4 acc[3]; float ss = 0.f;
#pragma unroll
        for (int t3 = 0; t3 < 3; ++t3) acc[t3] = (f32x4){0.f, 0.f, 0.f, 0.f};
#pragma unroll 8
        for (int kk = 0; kk < 32; ++kk) {
            const u32x4 xh = *(const u32x4*)(hrow + 32 * kk);
            { const float a0 = bflo(xh.x), a1 = bfhi(xh.x), a2 = bflo(xh.y), a3 = bfhi(xh.y), a4 = bflo(xh.z), a5 = bfhi(xh.z), a6 = bflo(xh.w), a7 = bfhi(xh.w);
              ss += (a0 * a0 + a1 * a1) + (a2 * a2 + a3 * a3) + (a4 * a4 + a5 * a5) + (a6 * a6 + a7 * a7); }
            const bf16x8 bh = __builtin_bit_cast(bf16x8, xh);
#pragma unroll
            for (int t3 = 0; t3 < 3; ++t3) { const bf16x8 ah = *(const LAS bf16x8*)(lds + arow[t3] * N2_PITCH + 64 * kk + 16 * fq), al = *(const LAS bf16x8*)(lds + N2_WL + arow[t3] * N2_PITCH + 64 * kk + 16 * fq);
                acc[t3] = __builtin_amdgcn_mfma_f32_16x16x32_bf16(ah, bh, acc[t3], 0, 0, 0); acc[t3] = __builtin_amdgcn_mfma_f32_16x16x32_bf16(al, bh, acc[t3], 0, 0, 0); }
        }
        ss += __builtin_bit_cast(float, __builtin_amdgcn_ds_bpermute((lane ^ 16) << 2, __builtin_bit_cast(int, ss)));
        ss += __builtin_bit_cast(float, __builtin_amdgcn_ds_bpermute((lane ^ 32) << 2, __builtin_bit_cast(int, ss)));
        const float rstd = rsqrtf(ss * (1.f / DM) + EPS);
        float gl[4]; int gi = 0;
#pragma unroll
        for (int j = 0; j < 4; ++j) gl[j] = acc[2][j] * rstd + bgr[j];
        float gmax = gl[0];
#pragma unroll
        for (int j = 1; j < 4; ++j) if (gl[j] > gmax) { gmax = gl[j]; gi = j; }
        if (fq == gi) {
            float den = 0.f;
#pragma unroll
            for (int j = 0; j < 4; ++j) den += expf(gl[j] - gmax);
            const float pg = 1.f / den;
            float b1 = -3.0e38f, b2 = -3.0e38f; int j1 = 0, j2 = 0;
#pragma unroll
            for (int e = 0; e < 8; ++e) { const float x = (e < 4 ? acc[0][e & 3] : acc[1][e & 3]) * rstd + ber[gi * 8 + e];
                if (x > b1) { b2 = b1; j2 = j1; b1 = x; j1 = e; } else if (x > b2) { b2 = x; j2 = e; } }
            const float w1 = 1.f / (1.f + expf(b2 - b1)), w2 = 1.f - w1;
            const int s0 = gi * 8 + j1, s1 = 32 + gi * 8 + j2;
            const unsigned r0 = __hip_atomic_fetch_add(cnt + s0, 1u, RLX_AGENT), r1 = __hip_atomic_fetch_add(cnt + s1, 1u, RLX_AGENT);
            ltok[(size_t)s0 * NTOK + r0] = tok; lgate[(size_t)s0 * NTOK + r0] = pg * w1; lrs[(size_t)s0 * NTOK + r0] = rstd;
            ltok[(size_t)s1 * NTOK + r1] = tok; lgate[(size_t)s1 * NTOK + r1] = pg * w2; lrs[(size_t)s1 * NTOK + r1] = rstd;
        }
    }
}
template <int CTRL> __device__ __forceinline__ float dpp_row_shr(float old, float src) {
    return __builtin_bit_cast(float, __builtin_amdgcn_update_dpp(__builtin_bit_cast(int, old), __builtin_bit_cast(int, src), CTRL, 0xf, 0xf, false));
}
__device__ __forceinline__ void rec1_unit(KArgs args, int L, int unit, LAS unsigned char* lds, int wave, int lane) {
    unsigned char* ws = args->ws;
    const bf16* z = (const bf16*)(ws + WS_Z);
    bf16* hloc = (bf16*)(ws + WS_HLOC); bf16* cumA = (bf16*)(ws + WS_CUMA); float* agg = (float*)(ws + WS_AGG);
    const int b = unit >> 4, chk = unit & 15, t0 = chk * 256, fr = lane & 15, q = lane >> 4, hb = wave;
    const float* Wa = args->in[I_WA] + ((size_t)(L * 8 + hb)) * 4096; const float* Wx = args->in[I_WX] + ((size_t)(L * 8 + hb)) * 4096;
    LAS unsigned char* wl = lds + wave * 16384;
#pragma unroll 1
    for (int f = 0; f < 16; ++f) { const int mat = f >> 3, n = (f >> 1) & 3, kk = f & 1; const float* W = mat ? Wx : Wa;
        const int jout = 8 * (fr >> 2) + (fr & 3) + 4 * (n & 1) + 32 * (n >> 1); const float* wp = W + (32 * kk + 8 * q) * 64 + jout;
        u32x4 w; w.x = pk2(wp[0], wp[64]); w.y = pk2(wp[128], wp[192]); w.z = pk2(wp[256], wp[320]); w.w = pk2(wp[384], wp[448]);
        *(LAS u32x4*)(wl + f * 1024 + lane * 16) = w; }
    LAS float* ct = (LAS float*)(lds + 131072 + wave * 2048);
    { const int c = 64 * hb + lane; const float* cw = args->in[I_CONVW] + (size_t)L * 4 * 512;
      ct[lane * 8 + 0] = cw[c]; ct[lane * 8 + 1] = cw[512 + c]; ct[lane * 8 + 2] = cw[1024 + c]; ct[lane * 8 + 3] = cw[1536 + c];
      ct[lane * 8 + 4] = args->in[I_CONVB][L * 512 + c]; ct[lane * 8 + 5] = args->in[I_BA][L * 512 + c]; ct[lane * 8 + 6] = args->in[I_BX][L * 512 + c];
      ct[lane * 8 + 7] = ((const float*)(ws + WS_C8))[L * 512 + c]; }
    LDS_WAIT();
    float Acar[2][8], Hcar[2][8];
#pragma unroll
    for (int kk = 0; kk < 2; ++kk)
#pragma unroll
        for (int e = 0; e < 8; ++e) { Acar[kk][e] = 1.f; Hcar[kk][e] = 0.f; }
    const bf16* zb = z + (size_t)(b * SEQ) * ZP + ZC_XR + 64 * hb;
    const int bidx15 = ((lane & ~15) | 15) << 2;
    u32x4 rawc[2][4];
#define REC_LOAD_TILE(dst_, tile_) do { const int t_ = t0 + (tile_) * 16 + fr; _Pragma("unroll") for (int kk_ = 0; kk_ < 2; ++kk_) _Pragma("unroll") for (int j_ = 0; j_ < 4; ++j_) { const int tt_ = t_ - 3 + j_; \
        dst_[kk_][j_] = *(const u32x4*)(zb + (size_t)(tt_ > 0 ? tt_ : 0) * ZP + 32 * kk_ + 8 * q); } } while (0)
    REC_LOAD_TILE(rawc, 0);
#pragma unroll 1
    for (int tile = 0; tile < 16; ++tile) {
        const int t = t0 + tile * 16 + fr; const bool edge = (t0 + tile * 16) == 0;
        u32x4 rawn[2][4];
        REC_LOAD_TILE(rawn, tile < 15 ? tile + 1 : 15);
        u32x4 xb[2];
#pragma unroll
        for (int kk = 0; kk < 2; ++kk) {
            float xc[8];
#pragma unroll
            for (int e = 0; e < 8; ++e) xc[e] = ct[(32 * kk + 8 * q + e) * 8 + 4];
#pragma unroll
            for (int j = 0; j < 4; ++j) { const int tt = t - 3 + j;
                u32x4 raw = rawc[kk][j];
                if (edge && tt < 0) raw = (u32x4){0u, 0u, 0u, 0u};
                const float xv[8] = {bflo(raw.x), bfhi(raw.x), bflo(raw.y), bfhi(raw.y), bflo(raw.z), bfhi(raw.z), bflo(raw.w), bfhi(raw.w)};
#pragma unroll
                for (int e = 0; e < 8; ++e) xc[e] += ct[(32 * kk + 8 * q + e) * 8 + j] * xv[e]; }
            xb[kk].x = pk2(xc[0], xc[1]); xb[kk].y = pk2(xc[2], xc[3]); xb[kk].z = pk2(xc[4], xc[5]); xb[kk].w = pk2(xc[6], xc[7]);
        }
        asm volatile("" ::: "memory");
#pragma unroll
        for (int kh = 0; kh < 2; ++kh) {
            f32x4 racc[2], iacc[2];
#pragma unroll
            for (int nn = 0; nn < 2; ++nn) { racc[nn] = (f32x4){0.f, 0.f, 0.f, 0.f}; iacc[nn] = (f32x4){0.f, 0.f, 0.f, 0.f};
#pragma unroll
                for (int kk = 0; kk < 2; ++kk) { const int n = 2 * kh + nn;
                    const bf16x8 fa = *(const LAS bf16x8*)(wl + ((0 * 4 + n) * 2 + kk) * 1024 + lane * 16), fx = *(const LAS bf16x8*)(wl + ((1 * 4 + n) * 2 + kk) * 1024 + lane * 16);
                    const bf16x8 xk = __builtin_bit_cast(bf16x8, xb[kk]);
                    racc[nn] = __builtin_amdgcn_mfma_f32_16x16x32_bf16(fa, xk, racc[nn], 0, 0, 0); iacc[nn] = __builtin_amdgcn_mfma_f32_16x16x32_bf16(fx, xk, iacc[nn], 0, 0, 0); } }
            const unsigned xw[4] = {xb[kh].x, xb[kh].y, xb[kh].z, xb[kh].w};
            float hv[8], av[8];
#pragma unroll
            for (int e = 0; e < 8; ++e) {
                const int nn = e >> 2, jj = e & 3; const int cb = (32 * kh + 8 * q + e) * 8;
                const float xcv = (e & 1) ? bfhi(xw[e >> 1]) : bflo(xw[e >> 1]);
                const float r = fsigmoid(racc[nn][jj] + ct[cb + 5]), ig = fsigmoid(iacc[nn][jj] + ct[cb + 6]);
                float a = __builtin_amdgcn_exp2f(ct[cb + 7] * r);
                float bb = __builtin_amdgcn_sqrtf(fmaxf(1.f - a * a, 0.f)) * (ig * xcv);
#define REC_SCAN_STEP(N_) asm volatile("s_nop 1\n\tv_fmac_f32_dpp %0, %0, %1 row_shr:" #N_ " row_mask:0xf bank_mask:0xf\n\ts_nop 1\n\tv_mul_f32_dpp %1, %1, %1 row_shr:" #N_ " row_mask:0xf bank_mask:0xf" : "+v"(bb), "+v"(a))
                REC_SCAN_STEP(1); REC_SCAN_STEP(2); REC_SCAN_STEP(4); REC_SCAN_STEP(8);
#undef REC_SCAN_STEP
                const float hl = a * Hcar[kh][e] + bb, ca = a * Acar[kh][e];
                hv[e] = hl; av[e] = ca;
                Hcar[kh][e] = __builtin_bit_cast(float, __builtin_amdgcn_ds_bpermute(bidx15, __builtin_bit_cast(int, hl))); Acar[kh][e] = __builtin_bit_cast(float, __builtin_amdgcn_ds_bpermute(bidx15, __builtin_bit_cast(int, ca)));
            }
            const size_t o = (size_t)(b * SEQ + t) * D_REC + 64 * hb + 32 * kh + 8 * q;
            u32x4 w; w.x = pk2(hv[0], hv[1]); w.y = pk2(hv[2], hv[3]); w.z = pk2(hv[4], hv[5]); w.w = pk2(hv[6], hv[7]);
            *(u32x4*)(hloc + o) = w;
            w.x = pk2(av[0], av[1]); w.y = pk2(av[2], av[3]); w.z = pk2(av[4], av[5]); w.w = pk2(av[6], av[7]);
            *(u32x4*)(cumA + o) = w;
            asm volatile("" ::: "memory");
        }
#pragma unroll
        for (int kk = 0; kk < 2; ++kk)
#pragma unroll
            for (int j = 0; j < 4; ++j) rawc[kk][j] = rawn[kk][j];
    }
#undef REC_LOAD_TILE
    if (fr == 0) {
#pragma unroll
        for (int kk = 0; kk < 2; ++kk)
#pragma unroll
            for (int e = 0; e < 8; ++e) { const int c = 64 * hb + 32 * kk + 8 * q + e; float* ap = agg + ((size_t)(b * 16 + chk) * 512 + c) * 2; ap[0] = Acar[kk][e]; ap[1] = Hcar[kk][e]; }
    }
}
__device__ __forceinline__ void rec2_rows(KArgs args, int gw, int NGW, int lane) {
    unsigned char* ws = args->ws;
    const bf16* z = (const bf16*)(ws + WS_Z); const bf16* hloc = (const bf16*)(ws + WS_HLOC); const bf16* cumA = (const bf16*)(ws + WS_CUMA);
    const float* carry = (const float*)(ws + WS_CARRY); bf16* mixed = (bf16*)(ws + WS_MIXED);
    constexpr int NR = 4;
    for (int m0 = gw * NR; m0 < NTOK; m0 += NGW * NR) {
        const int b = m0 >> 12, chk = (m0 & 4095) >> 8;
        u32x4 hl[NR], ca[NR], gr[NR];
#pragma unroll
        for (int r = 0; r < NR; ++r) { const size_t m = (size_t)(m0 + r); hl[r] = *(const u32x4*)(hloc + m * D_REC + 8 * lane); ca[r] = *(const u32x4*)(cumA + m * D_REC + 8 * lane); gr[r] = *(const u32x4*)(z + m * ZP + ZC_GR + 8 * lane); }
        const f32x4 c0 = *(const f32x4*)(carry + (size_t)(b * 16 + chk) * 512 + 8 * lane), c1 = *(const f32x4*)(carry + (size_t)(b * 16 + chk) * 512 + 8 * lane + 4);
#pragma unroll
        for (int r = 0; r < NR; ++r) { float v[8];
            v[0] = (bflo(hl[r].x) + bflo(ca[r].x) * c0.x) * fgelu(bflo(gr[r].x)); v[1] = (bfhi(hl[r].x) + bfhi(ca[r].x) * c0.y) * fgelu(bfhi(gr[r].x));
            v[2] = (bflo(hl[r].y) + bflo(ca[r].y) * c0.z) * fgelu(bflo(gr[r].y)); v[3] = (bfhi(hl[r].y) + bfhi(ca[r].y) * c0.w) * fgelu(bfhi(gr[r].y));
            v[4] = (bflo(hl[r].z) + bflo(ca[r].z) * c1.x) * fgelu(bflo(gr[r].z)); v[5] = (bfhi(hl[r].z) + bfhi(ca[r].z) * c1.y) * fgelu(bfhi(gr[r].z));
            v[6] = (bflo(hl[r].w) + bflo(ca[r].w) * c1.z) * fgelu(bflo(gr[r].w)); v[7] = (bfhi(hl[r].w) + bfhi(ca[r].w) * c1.w) * fgelu(bfhi(gr[r].w));
            float s = 0.f;
#pragma unroll
            for (int e = 0; e < 8; ++e) s += v[e] * v[e];
            const float rstd = rsqrtf(wave_sum(s) * (1.f / D_REC) + EPS);
            u32x4 w; w.x = pk2(v[0] * rstd, v[1] * rstd); w.y = pk2(v[2] * rstd, v[3] * rstd); w.z = pk2(v[4] * rstd, v[5] * rstd); w.w = pk2(v[6] * rstd, v[7] * rstd);
            *(u32x4*)(mixed + (size_t)(m0 + r) * DM + 8 * lane) = w; }
    }
}
__device__ __forceinline__ void phase_mid(KArgs args, int L, int G, int bid, int tid, int wave, int lane) {
    unsigned char* ws = args->ws;
    const float* agg = (const float*)(ws + WS_AGG); float* carry = (float*)(ws + WS_CARRY);
    const int gt = bid * (NWAVES * 64) + tid, NGT = G * NWAVES * 64;
    for (int i = gt; i < BATCH * 512; i += NGT) { const int b = i >> 9, c = i & 511; float Ak[16], Hk[16];
#pragma unroll
        for (int k = 0; k < 16; ++k) { const size_t o = (size_t)(b * 16 + k) * 512 + c; Ak[k] = agg[o * 2]; Hk[k] = agg[o * 2 + 1]; }
        float H = 0.f;
#pragma unroll
        for (int k = 0; k < 16; ++k) { carry[(size_t)(b * 16 + k) * 512 + c] = H; H = Ak[k] * H + Hk[k]; } }
    const bf16* hid = (const bf16*)(ws + WS_HIDC); const bf16* w2t = (const bf16*)(ws + WS_W2T);
    const int gw = bid * NWAVES + wave, NGW = G * NWAVES, fr = lane & 15, fq = lane >> 4;
    for (int task = gw; task < 2 * 512; task += NGW) {
        const int kv = task >> 9, grp = task & 511;
        const bf16* ar = hid + ((size_t)kv * 8192 + grp * 16 + fr) * 256 + 8 * fq;
        const bf16* br = w2t + ((size_t)(L * 2 + kv) * 64 + fr) * 256 + 8 * fq;
        const float* b2 = (kv ? args->in[I_BV2] : args->in[I_BK2]) + L * 64;
        f32x4 acc[4];
#pragma unroll
        for (int nt = 0; nt < 4; ++nt) { const float bb = b2[16 * nt + fr]; acc[nt] = (f32x4){bb, bb, bb, bb}; }
#pragma unroll
        for (int kk = 0; kk < 8; ++kk) { const bf16x8 a = *(const bf16x8*)(ar + 32 * kk);
#pragma unroll
            for (int nt = 0; nt < 4; ++nt) { const bf16x8 bfr = *(const bf16x8*)(br + (size_t)(16 * nt) * 256 + 32 * kk); acc[nt] = __builtin_amdgcn_mfma_f32_16x16x32_bf16(a, bfr, acc[nt], 0, 0, 0); } }
        bf16* outp = (bf16*)(ws + (kv ? WS_VCMP : WS_KCMP));
#pragma unroll
        for (int jj = 0; jj < 4; ++jj) { const int row = grp * 16 + 4 * fq + jj; const bool real = (row & 255) != 255;
#pragma unroll
            for (int nt = 0; nt < 4; ++nt) outp[(size_t)row * 64 + 16 * nt + fr] = real ? (bf16)f2bf(acc[nt][jj]) : (bf16)0; }
    }
}

typedef float f32x16 __attribute__((ext_vector_type(16)));
typedef short s16x4 __attribute__((ext_vector_type(4)));
typedef float f32x2_t __attribute__((ext_vector_type(2)));
typedef __bf16 bf16x2_t __attribute__((ext_vector_type(2)));
__device__ __forceinline__ unsigned cvtpk(float lo, float hi) { f32x2_t v = {lo, hi}; bf16x2_t b = __builtin_convertvector(v, bf16x2_t); return __builtin_bit_cast(unsigned, b); }
__device__ __forceinline__ void xhalf_pair(float m, float& lo, float& hi) {
    unsigned a = __builtin_bit_cast(unsigned, m), b = a; asm volatile("" : "+v"(b));
    auto rr = __builtin_amdgcn_permlane32_swap(a, b, false, false);
    unsigned r0 = rr[0], r1 = rr[1]; asm volatile("" : "+v"(r0), "+v"(r1));
    lo = __builtin_bit_cast(float, r0); hi = __builtin_bit_cast(float, r1);
}
__device__ __forceinline__ float xhalf_max(float m) { float a, b; xhalf_pair(m, a, b); return fmaxf(a, b); }
__device__ __forceinline__ float xhalf_sum(float m) { float a, b; xhalf_pair(m, a, b); return a + b; }
__device__ __forceinline__ s16x4 vtr(const LAS unsigned char* p) { return __builtin_bit_cast(s16x4, __builtin_amdgcn_ds_read_tr16_b64_v4i16((LAS s16x4*)p)); }
constexpr int ATT_NS = 4, ATT_PD = 3;
constexpr int ATT_IMP = 65536, ATT_SC = ATT_IMP + 4 * 64 * 65 * 4, ATT_MASK = ATT_SC + 64 * 65 * 4, ATT_UNION = ATT_MASK + 512, ATT_RED = ATT_UNION + 64;
static_assert(ATT_RED + 2048 <= MISC_OFF, "attention LDS map");
#define CI_(i) (((i) & 3) + 8 * ((i) >> 2))
__device__ __forceinline__ float max3f(float a, float b, float c) { float r; asm("v_max3_f32 %0, %1, %2, %3" : "=v"(r) : "v"(a), "v"(b), "v"(c)); return r; }

struct AttState { f32x16 O[2]; float m, l; bool fresh; };
__device__ __forceinline__ void att_stage(LAS unsigned char* lds, int slot, const char* kp, const char* vp, unsigned pitch, int wave, int lane) {
    const int key = 8 * wave + (lane >> 3), pc = lane & 7;
    const char* ks = kp + (size_t)key * pitch + ((pc ^ ((key >> 1) & 7)) << 4);
    const char* vs = vp + (size_t)key * pitch + ((pc ^ ((key & 3) << 1)) << 4);
    const unsigned dk = (unsigned)(unsigned long)(lds + slot * 16384 + wave * 1024), dv = dk + 8192u; unsigned keep;
    asm volatile("s_mov_b32 %0, m0\n\ts_mov_b32 m0, %2\n\ts_nop 0\n\tglobal_load_lds_dwordx4 %1, off\n\ts_mov_b32 m0, %0" : "=&s"(keep) : "v"(ks), "s"(dk) : "memory");
    asm volatile("s_mov_b32 %0, m0\n\ts_mov_b32 m0, %2\n\ts_nop 0\n\tglobal_load_lds_dwordx4 %1, off\n\ts_mov_b32 m0, %0" : "=&s"(keep) : "v"(vs), "s"(dv) : "memory");
}
__device__ __forceinline__ void att_qk64(const LAS unsigned char* Kb, const bf16x8 (&qf)[4], float sF, float cb, int rq, int h, f32x16& S0, f32x16& S1) {
    const LAS unsigned char* rowp = Kb + rq * 128; const int sw = (rq >> 1) & 7;
    bf16x8 kf[2][4];
#pragma unroll
    for (int sub = 0; sub < 2; ++sub)
#pragma unroll
        for (int s4 = 0; s4 < 4; ++s4) kf[sub][s4] = *(const LAS bf16x8*)(rowp + sub * 4096 + (((2 * s4 + h) ^ sw) << 4));
    const float base = cb + sF * (float)(4 * h);
    { const f32x2 d01 = {0.f, sF}, d23 = {sF + sF, 3.f * sF};
#pragma unroll
      for (int q4 = 0; q4 < 4; ++q4) { const float bq = fmaf(sF, (float)(8 * q4), base), bq1 = fmaf(sF, (float)(8 * q4 + 32), base);
          const f32x2 bb = {bq, bq}, bc = {bq1, bq1}; const f32x2 lo = bb + d01, hi = bb + d23, lo1 = bc + d01, hi1 = bc + d23;
          S0[4 * q4] = lo.x; S0[4 * q4 + 1] = lo.y; S0[4 * q4 + 2] = hi.x; S0[4 * q4 + 3] = hi.y; S1[4 * q4] = lo1.x; S1[4 * q4 + 1] = lo1.y; S1[4 * q4 + 2] = hi1.x; S1[4 * q4 + 3] = hi1.y; } }
    __builtin_amdgcn_sched_barrier(0);
#pragma unroll
    for (int s4 = 0; s4 < 4; ++s4) { S0 = __builtin_amdgcn_mfma_f32_32x32x16_bf16(kf[0][s4], qf[s4], S0, 0, 0, 0); S1 = __builtin_amdgcn_mfma_f32_32x32x16_bf16(kf[1][s4], qf[s4], S1, 0, 0, 0); }
    __builtin_amdgcn_sched_barrier(0);
}
__device__ __forceinline__ void att_mask(int sub, int h, int lim_lo, int lim_hi, f32x16& S) {
    const int hi2 = lim_hi - 32 * sub - 4 * h, lo2 = lim_lo - 32 * sub - 4 * h;
#pragma unroll
    for (int i = 0; i < 16; ++i) S[i] = (CI_(i) <= hi2 && CI_(i) > lo2) ? S[i] : -__builtin_inff();
}
template <bool IMP>
__device__ __forceinline__ void att_softmax_pv64(const bool MASKED, const LAS unsigned char* Vb, int lim_lo, int lim_hi, f32x16& S0, f32x16& S1, AttState& st, int h, int lane, LAS float* irow = nullptr, int ct = 0) {
    const int qd = (lane & 15) >> 2, pp = lane & 3, blk = (lane >> 4) & 1;
    const LAS unsigned char* vrow = Vb + (4 * h + qd) * 128 + (pp & 1) * 8;
    bf16x8 vf[2][4];
#pragma unroll
    for (int dt = 0; dt < 2; ++dt) { const int coff = ((dt * 4 + blk * 2 + (pp >> 1)) ^ (qd << 1)) << 4;
#pragma unroll
        for (int ks = 0; ks < 4; ++ks) { const s16x4 lo = vtr(vrow + coff + (16 * ks) * 128), hi = vtr(vrow + coff + (16 * ks + 8) * 128);
            vf[dt][ks] = __builtin_shufflevector(lo, hi, 0, 1, 2, 3, 4, 5, 6, 7); } }
    __builtin_amdgcn_sched_barrier(0);
    if (MASKED) { att_mask(0, h, lim_lo, lim_hi, S0); att_mask(1, h, lim_lo, lim_hi, S1); }
    float mx = max3f(S0[0], S0[1], S0[2]), my = max3f(S1[0], S1[1], S1[2]);
    mx = max3f(mx, S0[3], S0[4]); my = max3f(my, S1[3], S1[4]); mx = max3f(mx, S0[5], S0[6]); my = max3f(my, S1[5], S1[6]); mx = max3f(mx, S0[7], S0[8]); my = max3f(my, S1[7], S1[8]);
    mx = max3f(mx, S0[9], S0[10]); my = max3f(my, S1[9], S1[10]); mx = max3f(mx, S0[11], S0[12]); my = max3f(my, S1[11], S1[12]); mx = max3f(mx, S0[13], S0[14]); my = max3f(my, S1[13], S1[14]);
    mx = xhalf_max(max3f(mx, my, max3f(S0[15], S1[15], S1[15])));
    const bool fin = mx > -1e30f;
    const bool rb = fin && (mx > 8.f || st.fresh);
    if (__any(rb)) { const float d = rb ? mx : 0.f; const float corr = st.fresh ? 1.f : __builtin_amdgcn_exp2f(-d); st.l *= corr; st.m += d;
#pragma unroll
        for (int i = 0; i < 16; ++i) { st.O[0][i] *= corr; st.O[1][i] *= corr; S0[i] -= d; S1[i] -= d; }
        if (IMP) { if (h == 0 && corr != 1.f) { for (int j = 0; j < 64; ++j) irow[j] *= corr; } }
    }
    st.fresh = st.fresh && !fin;
    float ps = 0.f, pt = 0.f;
#pragma unroll
    for (int i = 0; i < 16; ++i) { S0[i] = __builtin_amdgcn_exp2f(S0[i]); S1[i] = __builtin_amdgcn_exp2f(S1[i]); ps += S0[i]; pt += S1[i]; }
    st.l += ps + pt;
    if (IMP) {
        float prev3 = 0.f; const int partner = (lane ^ 32) << 2;
#pragma unroll
        for (int f = 0; f < 8; ++f) { const f32x16& S_ = (f >> 2) ? S1 : S0; const int q4 = f & 3; const float p3 = S_[4 * q4 + 3];
            const float own = 2.f * (S_[4 * q4] + S_[4 * q4 + 1] + S_[4 * q4 + 2]) + p3;
            const float inc = __builtin_bit_cast(float, __builtin_amdgcn_ds_bpermute(partner, __builtin_bit_cast(int, h ? prev3 : p3)));
            irow[16 * ct + 2 * f + h] = own + inc;
            prev3 = p3; }
        if (h && ct < 3) __hip_atomic_fetch_add(irow + 16 * ct + 16, prev3, __ATOMIC_RELAXED, __HIP_MEMORY_SCOPE_WORKGROUP); }
    u32x4 pk[4];
#pragma unroll
    for (int s2 = 0; s2 < 2; ++s2) { pk[s2].x = cvtpk(S0[8 * s2], S0[8 * s2 + 1]); pk[s2].y = cvtpk(S0[8 * s2 + 2], S0[8 * s2 + 3]); pk[s2].z = cvtpk(S0[8 * s2 + 4], S0[8 * s2 + 5]); pk[s2].w = cvtpk(S0[8 * s2 + 6], S0[8 * s2 + 7]);
        pk[2 + s2].x = cvtpk(S1[8 * s2], S1[8 * s2 + 1]); pk[2 + s2].y = cvtpk(S1[8 * s2 + 2], S1[8 * s2 + 3]); pk[2 + s2].z = cvtpk(S1[8 * s2 + 4], S1[8 * s2 + 5]); pk[2 + s2].w = cvtpk(S1[8 * s2 + 6], S1[8 * s2 + 7]); }
    __builtin_amdgcn_sched_barrier(0);
#pragma unroll
    for (int ks = 0; ks < 4; ++ks)
#pragma unroll
        for (int dt = 0; dt < 2; ++dt) st.O[dt] = __builtin_amdgcn_mfma_f32_32x32x16_bf16(vf[dt][ks], __builtin_bit_cast(bf16x8, pk[ks]), st.O[dt], 0, 0, 0);
    __builtin_amdgcn_sched_barrier(0);
}
__device__ __forceinline__ void att_state_reset(AttState& st) {
#pragma unroll
    for (int i = 0; i < 16; ++i) { st.O[0][i] = 0.f; st.O[1][i] = 0.f; }
    st.m = 0.f; st.l = 0.f; st.fresh = true;
}
#define ATT_WAIT_BAR() asm volatile("s_waitcnt vmcnt(0) lgkmcnt(0)\n\ts_barrier" ::: "memory")
#define ATT_WAIT_BAR_PD() asm volatile("s_waitcnt vmcnt(4) lgkmcnt(0)\n\ts_barrier" ::: "memory")
#define ATT_WAIT_BAR_2() asm volatile("s_waitcnt vmcnt(2) lgkmcnt(0)\n\ts_barrier" ::: "memory")

__device__ __forceinline__ int opq_v(int x) { asm volatile("" : "+v"(x)); return x; }
__device__ __forceinline__ int opq_s(int x) { asm volatile("" : "+s"(x)); return x; }
#define ATT_IDS const int lane = opq_v(lane0), wave = opq_s(wave0); const int r = wave >> 1, th = wave & 1, rq = lane & 31, h = lane >> 5, tl = 32 * th + rq, t = qb * 64 + tl, tok = b * SEQ + t; (void)r; (void)t; (void)tok;
__device__ __forceinline__ void att_unit_mfma(KArgs args, int b, int qb, LAS unsigned char* lds, int wave0, int lane0, int tid0) {
    unsigned char* ws = args->ws;
    const bf16* z = (const bf16*)(ws + WS_Z); bf16* mixed = (bf16*)(ws + WS_MIXED);
    LAS float* imp = (LAS float*)(lds + ATT_IMP);
    LAS float* sc = (LAS float*)(lds + ATT_SC);
    LAS unsigned* maskw = (LAS unsigned*)(lds + ATT_MASK);
    LAS unsigned* unionw = (LAS unsigned*)(lds + ATT_UNION);
    LAS float* red = (LAS float*)(lds + ATT_RED);
    unsigned OUTP[16];
    const unsigned ZPB = ZP * 2;
#pragma unroll 1
    for (int g = 0; g < 2; ++g) {
        const int hd = 4 * g + (wave0 >> 1);
        bf16x8 qf[4]; float slope2, g0, g1, g2;
        { ATT_IDS const int tid = opq_v(tid0);
          const bf16* zrow = z + (size_t)tok * ZP;
#pragma unroll
          for (int s4 = 0; s4 < 4; ++s4) qf[s4] = *(const bf16x8*)(zrow + ZC_Q + hd * 64 + 16 * s4 + 8 * h);
          slope2 = exp2f(-(float)(hd + 1)) * LOG2E;
          g0 = fsigmoid(bf2f(zrow[ZC_NG + hd * 3 + 0])); g1 = fsigmoid(bf2f(zrow[ZC_NG + hd * 3 + 1])); g2 = fsigmoid(bf2f(zrow[ZC_NG + hd * 3 + 2]));
          LAS float* row = imp + (r * 64 + tl) * 65 + 32 * h;
#pragma unroll
          for (int j = 0; j < 32; ++j) row[j] = 0.f;
          if (tid < 128) maskw[tid] = 0u;
          if (tid < 2) unionw[tid] = 0u; }
        AttState st;
        { ATT_IDS
        const int jlo = qb - 8 > 0 ? qb - 8 : 0, nw = qb - jlo + 1;
        const int nk = (4 * qb + 3) < 255 ? (4 * qb + 3) : 255, nc = (nk + 63) >> 6, nA = nw + nc;
        const int nmax_t = (t >= 31) ? ((t - 31) >> 4) : -1;
        const char* kwb = (const char*)(z + (size_t)(b * SEQ) * ZP + ZC_KW + g * 64);
        const char* kcb = (const char*)(ws + WS_KCMP) + (size_t)((b * 2 + g) * 256) * 128; const char* vcb = (const char*)(ws + WS_VCMP) + (size_t)((b * 2 + g) * 256) * 128;
        const float sF = 16.f * slope2;
        float il_c = 0.f;
        LAS float* irow = imp + (r * 64 + tl) * 65;
#define ATT_STAGE_A(idx_) do { int ix_ = (idx_) < nA ? (idx_) : nA - 1; const int sl_ = (idx_) & 3; \
            if (ix_ < nw) { const char* kp_ = kwb + (size_t)(64 * (qb - ix_)) * ZPB; att_stage(lds, sl_, kp_, kp_ + (ZC_VW - ZC_KW) * 2, ZPB, wave, lane); } \
            else { ix_ -= nw; const size_t o_ = (size_t)(nc - 1 - ix_) * 64 * 128; att_stage(lds, sl_, kcb + o_, vcb + o_, 128, wave, lane); } } while (0)
        att_state_reset(st);
        ATT_STAGE_A(0); ATT_STAGE_A(1); ATT_STAGE_A(2);
        f32x16 Sa, Sb;
#pragma unroll 1
        for (int i = 0; i < nA; ++i) {
            ATT_WAIT_BAR_PD();
            ATT_STAGE_A(i + ATT_PD);
            const LAS unsigned char* Kb = lds + (i & 3) * 16384; const LAS unsigned char* Vb = Kb + 8192;
            if (i < nw) {
                const int j = qb - i;
                att_qk64(Kb, qf, slope2, slope2 * (float)(64 * j) - st.m, rq, h, Sa, Sb);
                att_softmax_pv64<false>((j == qb) || (j == qb - 8), Vb, (j == qb - 8) ? tl : -1, (j == qb) ? tl : 63, Sa, Sb, st, h, lane);
                if (i == nw - 1) { const float lt = xhalf_sum(st.l); const float go = g2 / fmaxf(lt, 1e-30f);
#pragma unroll
                    for (int k = 0; k < 8; ++k) { OUTP[k] = cvtpk(st.O[0][2 * k] * go, st.O[0][2 * k + 1] * go); OUTP[8 + k] = cvtpk(st.O[1][2 * k] * go, st.O[1][2 * k + 1] * go); }
                    att_state_reset(st); }
            } else {
                const int ct = nc - 1 - (i - nw);
                att_qk64(Kb, qf, sF, sF * (float)(64 * ct) - st.m, rq, h, Sa, Sb);
                att_softmax_pv64<true>(true, Vb, -1, nmax_t - 64 * ct, Sa, Sb, st, h, lane, irow, ct);
                if (i == nA - 1) { const float lt = xhalf_sum(st.l); il_c = 1.f / fmaxf(lt, 1e-30f); const float go = g0 * il_c;
                    if (h == 0) ((LAS float*)(lds + ATT_SC))[r * 64 + tl] = il_c;
#pragma unroll
                    for (int k = 0; k < 8; ++k) { OUTP[k] = cvtpk(bflo(OUTP[k]) + st.O[0][2 * k] * go, bfhi(OUTP[k]) + st.O[0][2 * k + 1] * go); OUTP[8 + k] = cvtpk(bflo(OUTP[8 + k]) + st.O[1][2 * k] * go, bfhi(OUTP[8 + k]) + st.O[1][2 * k + 1] * go); } }
            }
        }
#undef ATT_STAGE_A
        }
        ATT_WAIT_BAR();
        { const int tid = opq_v(tid0); const int stok = tid >> 3, e8 = tid & 7; const LAS float* ilc = (const LAS float*)(lds + ATT_SC);
          unsigned key[8];
#pragma unroll
          for (int k = 0; k < 8; ++k) { const int j = 8 * e8 + k; const float v = imp[(0 * 64 + stok) * 65 + j] * ilc[stok] + imp[(1 * 64 + stok) * 65 + j] * ilc[64 + stok] + imp[(2 * 64 + stok) * 65 + j] * ilc[128 + stok] + imp[(3 * 64 + stok) * 65 + j] * ilc[192 + stok];
              const bool valid = j <= qb, forced = valid && (j == 0 || j == qb || j == qb - 1);
              const unsigned bits_ = __builtin_bit_cast(unsigned, forced ? 1e30f : (valid ? v : -1e30f));
              key[k] = ((bits_ ^ ((bits_ >> 31) ? 0xFFFFFFFFu : 0x80000000u)) & ~63u) | (unsigned)(63 - j); }
          unsigned T = 0u;
#pragma unroll 1
          for (int bit = 31; bit >= 0; --bit) { const unsigned cand = T | (1u << bit); int c = 0;
#pragma unroll
              for (int k = 0; k < 8; ++k) c += key[k] >= cand ? 1 : 0;
              c += __builtin_amdgcn_update_dpp(0, c, 0xB1, 0xf, 0xf, true);
              c += __builtin_amdgcn_update_dpp(0, c, 0x4E, 0xf, 0xf, true);
              c += __builtin_amdgcn_update_dpp(0, c, 0x141, 0xf, 0xf, true);
              T = c >= NTOP ? cand : T; }
          unsigned bits = 0u;
#pragma unroll
          for (int k = 0; k < 8; ++k) bits |= (key[k] >= T && 8 * e8 + k <= qb) ? (1u << k) : 0u;
          if (bits) { __hip_atomic_fetch_or(maskw + stok * 2 + (e8 >> 2), bits << (8 * (e8 & 3)), __ATOMIC_RELAXED, __HIP_MEMORY_SCOPE_WORKGROUP); __hip_atomic_fetch_or(unionw + (e8 >> 2), bits << (8 * (e8 & 3)), __ATOMIC_RELAXED, __HIP_MEMORY_SCOPE_WORKGROUP); }
        }
        __syncthreads();
        { ATT_IDS
        const unsigned mlo = maskw[tl * 2], mhi = maskw[tl * 2 + 1];
        unsigned long long un = ((unsigned long long)unionw[1] << 32) | unionw[0];
        const char* ksb = (const char*)(z + (size_t)(b * SEQ) * ZP + ZC_KS + g * 64);
        att_state_reset(st);
        int jq[4];
#pragma unroll
        for (int p = 0; p < 4; ++p) { if (un) { jq[p] = 63 - __builtin_clzll(un); un &= ~(1ull << jq[p]); } else jq[p] = -1; }
        int jlast = jq[0];
#pragma unroll
        for (int p = 0; p < 3; ++p) { if (jq[p] >= 0) jlast = jq[p]; const char* kp_ = ksb + (size_t)(64 * jlast) * ZPB; att_stage(lds, p, kp_, kp_ + (ZC_VS - ZC_KS) * 2, ZPB, wave, lane); }
        f32x16 Sa, Sb;
#pragma unroll 1
        for (int i = 0; jq[0] >= 0; ++i) {
            ATT_WAIT_BAR_PD();
            { if (jq[3] >= 0) jlast = jq[3]; const char* kp_ = ksb + (size_t)(64 * jlast) * ZPB; att_stage(lds, (i + 3) & 3, kp_, kp_ + (ZC_VS - ZC_KS) * 2, ZPB, wave, lane); }
            const LAS unsigned char* Kb = lds + (i & 3) * 16384; const LAS unsigned char* Vb = Kb + 8192;
            const int j = jq[0];
            const bool bit = ((j < 32 ? (mlo >> j) : (mhi >> (j - 32))) & 1u) != 0u;
            att_qk64(Kb, qf, slope2, bit ? slope2 * (float)(64 * j) - st.m : -__builtin_inff(), rq, h, Sa, Sb);
            att_softmax_pv64<false>(j == qb, Vb, -1, tl, Sa, Sb, st, h, lane);
            jq[0] = jq[1]; jq[1] = jq[2]; jq[2] = jq[3];
            if (un) { jq[3] = 63 - __builtin_clzll(un); un &= ~(1ull << jq[3]); } else jq[3] = -1;
        }
        { const float lt = xhalf_sum(st.l); const float go = g1 / fmaxf(lt, 1e-30f);
          float ss = 0.f;
#pragma unroll
          for (int i = 0; i < 8; ++i) { const float a0 = bflo(OUTP[i]) + st.O[0][2 * i] * go, a1 = bfhi(OUTP[i]) + st.O[0][2 * i + 1] * go, c0 = bflo(OUTP[8 + i]) + st.O[1][2 * i] * go, c1 = bfhi(OUTP[8 + i]) + st.O[1][2 * i + 1] * go;
              ss += (a0 * a0 + a1 * a1) + (c0 * c0 + c1 * c1); OUTP[i] = cvtpk(a0, a1); OUTP[8 + i] = cvtpk(c0, c1); }
          ss = xhalf_sum(ss);
          if (h == 0) red[hd * 64 + tl] = ss;
          if (g == 0) { bf16* orow = mixed + (size_t)tok * DM + 512 + hd * 64;
#pragma unroll
              for (int dt = 0; dt < 2; ++dt)
#pragma unroll
                  for (int q4 = 0; q4 < 4; ++q4) { u32x2 w; w.x = OUTP[8 * dt + 2 * q4]; w.y = OUTP[8 * dt + 2 * q4 + 1]; *(u32x2*)(orow + 32 * dt + 8 * q4 + 4 * h) = w; } } }
        }
        ATT_WAIT_BAR();
    }
    ATT_IDS
    float tot = 0.f;
#pragma unroll
    for (int h2 = 0; h2 < 8; ++h2) tot += red[h2 * 64 + tl];
    const float rstd = rsqrtf(tot * (1.f / 512.f) + EPS);
    { bf16* orow = mixed + (size_t)tok * DM + 512 + (4 + r) * 64;
#pragma unroll
      for (int dt = 0; dt < 2; ++dt)
#pragma unroll
          for (int q4 = 0; q4 < 4; ++q4) { u32x2 w; const unsigned p0 = OUTP[8 * dt + 2 * q4], p1 = OUTP[8 * dt + 2 * q4 + 1];
              w.x = cvtpk(bflo(p0) * rstd, bfhi(p0) * rstd); w.y = cvtpk(bflo(p1) * rstd, bfhi(p1) * rstd);
              *(u32x2*)(orow + 32 * dt + 8 * q4 + 4 * h) = w; } }
    { bf16* orow = mixed + (size_t)tok * DM + 512 + r * 64;
#pragma unroll
      for (int dt = 0; dt < 2; ++dt)
#pragma unroll
          for (int q4 = 0; q4 < 4; ++q4) { u32x2 w = *(const u32x2*)(orow + 32 * dt + 8 * q4 + 4 * h);
              w.x = cvtpk(bflo(w.x) * rstd, bfhi(w.x) * rstd); w.y = cvtpk(bflo(w.y) * rstd, bfhi(w.y) * rstd);
              *(u32x2*)(orow + 32 * dt + 8 * q4 + 4 * h) = w; } }
    __syncthreads();
}

constexpr int NPH_LAYER = 11, PH_FINAL = 1 + DEPTH * NPH_LAYER, N_PHASES = PH_FINAL + 1;
__global__ void __launch_bounds__(NWAVES * 64, 2) fwd_kernel(Args args) {
    extern __shared__ __attribute__((aligned(16))) unsigned char lds_raw[];
    LAS unsigned char* lds = (LAS unsigned char*)lds_raw;
    volatile LAS unsigned* MISC = (volatile LAS unsigned*)(lds + MISC_OFF);
    const int G0 = gridDim.x, bid0 = blockIdx.x;
    const int wave_s = __builtin_amdgcn_readfirstlane(threadIdx.x >> 6);
#define PHASE_IDS KArgs ka = ka_get(); int G = G0, bid = bid0; asm volatile("" : "+s"(G), "+s"(bid)); unsigned char* ws = ka->ws; (void)ws; int tid = wave_s * 64 + lane_id(); asm volatile("" : "+v"(tid)); const int lane = tid & 63, wave = wave_s; const int gw = bid * NWAVES + wave, NGW = G * NWAVES; (void)lane; (void)gw; (void)NGW;
    if (wave_s == 0) MISC[lane_id()] = 0u;
    __syncthreads();
#if MK_MULTI
#define GRID_BAR() do { } while (0)
#else
    XcdBarrier bar = xcd_barrier_post((unsigned*)(args.ws + WS_CTL) + CW_BAR, MISC + 8, wave_s);
#define GRID_BAR() xcd_barrier(bar)
#endif
#ifndef PH_MASK
#define PH_MASK 0xFFFF
#endif
#define IN(k) (ka_get()->ph_lo <= (k) && (k) < ka_get()->ph_hi)
#define EN(j) ((PH_MASK >> (j)) & 1)
#define SEAM(k) do { if (IN(k) && IN((k) + 1)) GRID_BAR(); } while (0)
#define HC_ ((bf16*)(ws + ((L & 1) ? WS_U : WS_H16)))
#define HN_ ((bf16*)(ws + ((L & 1) ? WS_H16 : WS_U)))
#define Z_ ((bf16*)(ws + WS_Z))
#define MIXED_ ((bf16*)(ws + WS_MIXED))
#define WL_ (ws + WS_W + (size_t)L * W_LAYER)

    if (EN(11) && IN(0)) { PHASE_IDS REP_(11) { phase_prologue(ka, lds, G, bid, tid, wave, lane); __syncthreads(); } SEAM(0); }

    for (int L = 0; L < DEPTH; ++L) {
        const int P = 1 + L * NPH_LAYER;
        if (EN(0) && IN(P + 0)) { PHASE_IDS REP_(0) phase_norm1(L == 0 ? ka->in[I_X] : nullptr, HC_, (float*)(ws + WS_RS1), gw, NGW, lane); SEAM(P + 0); }
        if (EN(1) && IN(P + 1)) {
            PHASE_IDS
            pg8::DenseSched S; S.init(HC_, DM, (const bf16*)(WL_ + WO_IN), NTOK, ZP, DM, G, bid);
            pg8::EpiBf16<0> E{Z_, ZP, nullptr, 0, 0, (const float*)(ws + WS_RS1)};
            REP_(1) pg8::gemm_phase(lds, DM, S, E, wave_s);
            SEAM(P + 1);
        }
        if (EN(2) && IN(P + 2)) {
            { PHASE_IDS
            if (EN(12)) REP_(2) for (int unit = bid; unit < BATCH * 16; unit += G) rec1_unit(ka, L, unit, lds, wave, lane);
            { const int ncv = G > 64 ? G - 64 : G, mycv = G > 64 ? bid - 64 : bid;
              if (mycv >= 0) tr_run<1>(ka, (LAS float*)(lds + wave * 16384), lane, mycv * NWAVES + wave, ncv * NWAVES, L); }
            }
            __syncthreads();
            if (EN(13)) { PHASE_IDS
            pg8::CmpSched S{Z_, (const bf16*)(WL_ + WO_K1), (const bf16*)(WL_ + WO_V1), G, bid};
            pg8::EpiBf16<1> E{(bf16*)(ws + WS_HIDC), 256, (const float*)(ws + WS_BK1) + L * 512, (size_t)8192 * 256, 256, nullptr};
            REP_(2) pg8::gemm_phase(lds, 2048, S, E, wave_s); }
            SEAM(P + 2);
        }
        if (EN(3) && IN(P + 3)) { PHASE_IDS REP_(3) phase_mid(ka, L, G, bid, tid, wave, lane); SEAM(P + 3); }
        if (EN(4) && IN(P + 4)) {
            PHASE_IDS
            REP_(4)
            if (G == 256) { for (int i = 0; i < 4; ++i) att_unit_mfma(ka, 2 * (bid & 7) + (i >> 1), (i & 1) ? 63 - (bid >> 3) : (bid >> 3), lds, wave, lane, tid); }
            else { for (int unit = bid; unit < BATCH * 64; unit += G) att_unit_mfma(ka, unit >> 6, unit & 63, lds, wave, lane, tid); }
            REP_(12) rec2_rows(ka, gw, NGW, lane);
            SEAM(P + 4);
        }
        if (EN(5) && IN(P + 5)) {
            PHASE_IDS
            pg8::DenseSched S; S.init(MIXED_, DM, (const bf16*)(WL_ + WO_OUT), NTOK, DM, DM, G, bid);
            pg8::EpiResid E{HC_};
            pg8::gemm_phase(lds, DM, S, E, wave_s);
            SEAM(P + 5);
        }
        if (EN(6) && IN(P + 6)) { PHASE_IDS phase_norm2(ka, HC_, L, lds, G, bid, tid, wave, lane); SEAM(P + 6); }
        if ((EN(7) || EN(8)) && (IN(P + 7) || IN(P + 8))) {
            LAS int* tab = (LAS int*)(lds + TAB_OFF);
            { PHASE_IDS
            __syncthreads();
            if (tid < 64) { const int c = (int)__hip_atomic_load((gu32*)(ws + WS_CTL) + CW_CNT + L * 64 + tid, RLX_AGENT); tab[80 + tid] = c; tab[160 + tid] = (c + 255) >> 8; }
            __syncthreads();
            if (tid == 0) { int s = 0; for (int i = 0; i < 64; ++i) { tab[i] = s; s += tab[160 + i]; } tab[64] = s; }
            __syncthreads(); }
            if (EN(7) && IN(P + 7)) { PHASE_IDS
                pg8::MoeSched<1> S{tab, HC_, (const bf16*)(WL_ + WO_GU), (const int*)(ws + WS_LTOK), G, bid};
                pg8::EpiSwiglu E{(bf16*)(ws + WS_HID), tab, (const float*)(ws + WS_LRS)};
                REP_(7) pg8::gemm_phase(lds, DM, S, E, wave_s);
                SEAM(P + 7);
            }
            if (EN(8) && IN(P + 8)) { PHASE_IDS
                pg8::MoeSched<2> S{tab, (const bf16*)(ws + WS_HID), (const bf16*)(WL_ + WO_D), (const int*)(ws + WS_LTOK), G, bid};
                pg8::EpiMoeDown E{tab, (const int*)(ws + WS_LTOK), (const float*)(ws + WS_LGATE), (bf16*)(ws + WS_Y0), (bf16*)(ws + WS_Y1)};
                REP_(8) pg8::gemm_phase(lds, DEXP, S, E, wave_s);
                SEAM(P + 8);
            }
        }
        if (EN(9) && IN(P + 9)) { PHASE_IDS phase_norm3(HC_, (const bf16*)(ws + WS_Y0), (const bf16*)(ws + WS_Y1), (float*)(ws + WS_RS3), ka->in[I_P] + (size_t)L * NTOK * D_PLE, (bf16*)(ws + WS_PB), gw, NGW, lane); SEAM(P + 9); }
        if (EN(10) && IN(P + 10)) {
            if (EN(14)) { PHASE_IDS pg8::DenseSched S; S.init(HC_, DM, (const bf16*)(WL_ + WO_PG), NTOK, DM, DM, G, bid);
              pg8::EpiBf16<2> E{(bf16*)(ws + WS_G), DM, ka->in[I_BPG] + L * DM, 0, 0, (const float*)(ws + WS_RS3)};
              REP_(10) pg8::gemm_phase(lds, DM, S, E, wave_s); }
            __syncthreads();
            if (EN(15)) { PHASE_IDS pg8::DenseSched S; S.init((const bf16*)(ws + WS_PB), D_PLE, (const bf16*)(WL_ + WO_PU), NTOK, DM, D_PLE, G, bid);
              pg8::EpiPleB E{HC_, HN_, (const bf16*)(ws + WS_G)};
              pg8::gemm_phase(lds, D_PLE, S, E, wave_s); }
            SEAM(P + 10);
        }
    }
    if (IN(PH_FINAL)) { PHASE_IDS phase_final((const bf16*)(ws + ((DEPTH & 1) ? WS_U : WS_H16)), ka->out, ka->in[I_FINN], gw, NGW, lane); }
#undef IN
#undef SEAM
}

extern "C" void kernel_launch(void* const* d_in, const int* in_sizes, int n_in, void* d_out, int out_size, void* d_ws, size_t ws_size, hipStream_t stream) {
    static int grid = 0;
    if (grid == 0) {
        if (n_in != 37 || in_sizes[0] != NTOK * DM || out_size != NTOK * DM || ws_size < WS_END) {
            fprintf(stderr, "kernel_launch: unexpected shapes (n_in %d, in0 %d, out %d, ws %zu < %zu); nothing launched\n", n_in, n_in > 0 ? in_sizes[0] : -1, out_size, ws_size, (size_t)WS_END); grid = -1; return; }
        int dev = 0, cus = 0, per_cu = 0;
        if (hipGetDevice(&dev) != hipSuccess || hipDeviceGetAttribute(&cus, hipDeviceAttributeMultiprocessorCount, dev) != hipSuccess) { grid = -1; return; }
        if (hipFuncSetAttribute((const void*)fwd_kernel, hipFuncAttributeMaxDynamicSharedMemorySize, LDS_BYTES) != hipSuccess) { fprintf(stderr, "kernel_launch: hipFuncSetAttribute failed\n"); grid = -1; return; }
        if (hipOccupancyMaxActiveBlocksPerMultiprocessor(&per_cu, (const void*)fwd_kernel, NWAVES * 64, LDS_BYTES) != hipSuccess || per_cu < 1)
            fprintf(stderr, "kernel_launch: note: occupancy query reports %d workgroups per CU\n", per_cu);
        (void)hipGetLastError();
        grid = cus;
    }
    if (grid < 0) return;
    if (hipMemsetAsync((char*)d_ws + WS_CTL, 0, CTL_ZERO_BYTES, stream) != hipSuccess) return;
    Args a{};
    for (int i = 0; i < 37; ++i) a.in[i] = (const float*)d_in[i];
    a.out = (float*)d_out; a.ws = (unsigned char*)d_ws;
#if MK_MULTI
    for (int p = 0; p < N_PHASES; ++p) { a.ph_lo = p; a.ph_hi = p + 1; hipLaunchKernelGGL(fwd_kernel, dim3(grid), dim3(NWAVES * 64), LDS_BYTES, stream, a); }
#else
    a.ph_lo = 0; a.ph_hi = N_PHASES;
    hipLaunchKernelGGL(fwd_kernel, dim3(grid), dim3(NWAVES * 64), LDS_BYTES, stream, a);
#endif
    const hipError_t le = hipPeekAtLastError();
    if (le != hipSuccess) fprintf(stderr, "kernel_launch: launch failed: %s\n", hipGetErrorName(le));
}
```

```cpp
#include <hip/hip_runtime.h>
#include <cstdio>
#include <cstdint>

#ifndef PROBE_MASK
#define PROBE_MASK 0
#endif
#define REP_(j) for (int rep_ = 0; rep_ < 1 + ((PROBE_MASK >> (j)) & 1); ++rep_)
#ifndef MK_MULTI
#define MK_MULTI 0
#endif

#define GAS __attribute__((address_space(1)))
#define LAS __attribute__((address_space(3)))
typedef unsigned short bf16;
typedef float f32x4 __attribute__((ext_vector_type(4)));
typedef float f32x2 __attribute__((ext_vector_type(2)));
typedef unsigned u32x4 __attribute__((ext_vector_type(4)));
typedef unsigned u32x2 __attribute__((ext_vector_type(2)));
typedef short bf16x8 __attribute__((ext_vector_type(8)));
typedef GAS unsigned gu32;
#define RLX_AGENT __ATOMIC_RELAXED, __HIP_MEMORY_SCOPE_AGENT
#define LDS_WAIT() asm volatile("s_waitcnt lgkmcnt(0)" ::: "memory")
#define VM_WAIT() asm volatile("s_waitcnt vmcnt(0)" ::: "memory")

constexpr int BATCH = 16, SEQ = 4096, DM = 1024, DEPTH = 4, NTOK = BATCH * SEQ;
constexpr int D_PLE = 256, D_REC = 512, NH = 8, HD = 64, NKV = 2;
constexpr int D_IN = 2328, ZP = 2560;
constexpr int ZC_XR = 0, ZC_GR = 512, ZC_Q = 1024, ZC_KC = 1536, ZC_VC = 1664, ZC_KS = 1792, ZC_VS = 1920, ZC_KW = 2048, ZC_VW = 2176, ZC_NG = 2304;
constexpr int NCMP = 255, NSELB = 64, NTOP = 16, WIN = 512;
constexpr int NEXP = 32, DEXP = 512, NSEG = 64;
constexpr float EPS = 1e-6f;
constexpr float LOG2E = 1.4426950408889634f;
constexpr int NWAVES = 8;

constexpr size_t MiB = 1u << 20;
constexpr size_t WS_CTL = 0, CTL_ZERO_BYTES = 1 * MiB;
constexpr size_t WS_BK1 = 1 * MiB;
constexpr size_t WS_C8 = WS_BK1 + 8192;
constexpr size_t WS_WRT = WS_C8 + 8192;
constexpr size_t WS_AGG = 2 * MiB;
constexpr size_t WS_CARRY = 3 * MiB;
constexpr size_t WS_W2T = 4 * MiB;
constexpr size_t WS_KCMP = 5 * MiB, WS_VCMP = 7 * MiB;
constexpr size_t WS_RS1 = 6 * MiB, WS_RS3 = 6 * MiB + 512 * 1024;
constexpr size_t WS_HIDC = 9 * MiB;
constexpr size_t WS_LTOK = 17 * MiB, WS_LGATE = 33 * MiB;
constexpr size_t WS_PB = 49 * MiB;
constexpr size_t WS_W = 81 * MiB, W_LAYER = 108 * MiB;
constexpr size_t WO_IN = 0, WO_OUT = 5 * MiB, WO_PG = 7 * MiB, WO_PU = 9 * MiB, WO_K1 = 9 * MiB + 512 * 1024, WO_V1 = 10 * MiB + 512 * 1024, WO_GU = 12 * MiB, WO_D = 76 * MiB;
constexpr size_t WS_U = 513 * MiB;
constexpr size_t WS_Z = 641 * MiB;
constexpr size_t WS_HID = WS_Z;
constexpr size_t WS_G = WS_Z + 160 * MiB;
constexpr size_t WS_MIXED = 962 * MiB;
constexpr size_t WS_HLOC = 1090 * MiB, WS_CUMA = 1154 * MiB;
constexpr size_t WS_Y0 = WS_MIXED, WS_Y1 = WS_HLOC;
constexpr size_t WS_LRS = 1218 * MiB;
constexpr size_t WS_H16 = 1234 * MiB;
constexpr size_t WS_END = 1362 * MiB;
constexpr int CW_BAR = 4096;
constexpr int CW_CNT = 16384;
constexpr int CW_BK1 = 32768;
constexpr int LDS_BYTES = 163840;
constexpr int TAB_OFF = 147456;
constexpr int MISC_OFF = 147456 + 4096;

typedef float pk2_f32x2 __attribute__((ext_vector_type(2)));
typedef __bf16 pk2_bf16x2 __attribute__((ext_vector_type(2)));
__device__ __forceinline__ unsigned pk2(float lo, float hi) { const pk2_f32x2 v = {lo, hi}; return __builtin_bit_cast(unsigned, __builtin_convertvector(v, pk2_bf16x2)); }
__device__ __forceinline__ unsigned f2bf(float f) { return pk2(f, 0.f) & 0xffffu; }
__device__ __forceinline__ float bflo(unsigned u) { return __builtin_bit_cast(float, u << 16); }
__device__ __forceinline__ float bfhi(unsigned u) { return __builtin_bit_cast(float, u & 0xffff0000u); }
__device__ __forceinline__ float bf2f(bf16 b) { return __builtin_bit_cast(float, (unsigned)b << 16); }
__device__ __forceinline__ float fsigmoid(float x) { return __builtin_amdgcn_rcpf(1.f + __builtin_amdgcn_exp2f(-x * LOG2E)); }
__device__ __forceinline__ float fgelu(float x) { const float y = 1.5957691216057308f * (x + 0.044715f * x * x * x); return x * __builtin_amdgcn_rcpf(1.f + __builtin_amdgcn_exp2f(-y * LOG2E)); }
__device__ __forceinline__ int lane_id() { int x; asm volatile("v_mbcnt_lo_u32_b32 %0, -1, 0\n\tv_mbcnt_hi_u32_b32 %0, -1, %0" : "=v"(x)); return x; }
template <int CTRL> __device__ __forceinline__ float dpp_mov(float src) {
    return __builtin_bit_cast(float, __builtin_amdgcn_update_dpp(0, __builtin_bit_cast(int, src), CTRL, 0xf, 0xf, true));
}
__device__ __forceinline__ float wave_sum(float v) {
    v += dpp_mov<0xB1>(v);
    v += dpp_mov<0x4E>(v);
    v += dpp_mov<0x141>(v);
    v += dpp_mov<0x140>(v);
    const float r0 = __builtin_bit_cast(float, __builtin_amdgcn_readlane(__builtin_bit_cast(int, v), 0)), r1 = __builtin_bit_cast(float, __builtin_amdgcn_readlane(__builtin_bit_cast(int, v), 16));
    const float r2 = __builtin_bit_cast(float, __builtin_amdgcn_readlane(__builtin_bit_cast(int, v), 32)), r3 = __builtin_bit_cast(float, __builtin_amdgcn_readlane(__builtin_bit_cast(int, v), 48));
    return (r0 + r1) + (r2 + r3);
}

namespace pg8 {
#define PG8_LAS __attribute__((address_space(3)))
typedef unsigned short bf16_t;
constexpr int BM = 256, BK = 64, HALF = 128, HTB = HALF * BK * 2, STAGE_BYTES = 8 * HTB, NXCD = 8, WGM = 8;
__host__ __device__ __forceinline__ int lds_byte(int r, int c) { const int st = (r >> 4) * 2 + (c >> 5), rr = r & 15, cc = c & 31, ob = rr * 64 + cc * 2; return st * 1024 + (ob ^ (((ob >> 9) & 1) << 5)); }
__host__ __device__ __forceinline__ void stage_rc(int b, int& R, int& C) { const int st = b / 1024, sb = b % 1024, swz = sb ^ (((sb >> 9) & 1) << 5); R = (st >> 1) * 16 + swz / 64; C = (st & 1) * 32 + (swz % 64) / 2; }
__host__ __device__ __forceinline__ int perm32(int rho) { const int n = rho >> 4, i = rho & 15; return 8 * (i >> 2) + 4 * n + (i & 3); }
struct Unit { int pm, pn, a0, a1; };
__device__ __forceinline__ unsigned cvt_pk_bf16(float lo, float hi) { unsigned r; asm volatile("v_cvt_pk_bf16_f32 %0, %1, %2" : "=v"(r) : "v"(lo), "v"(hi)); return r; }

template <class Epi, class Sched>
__device__ __forceinline__ void gemm_phase(PG8_LAS unsigned char* lds, const int K, const Sched& S, const Epi& E, const int wave_s) {
    int tid_o = wave_s * 64 + lane_id(); asm volatile("" : "+v"(tid_o));
    const int tid = tid_o, wid = __builtin_amdgcn_readfirstlane(tid >> 6), lane = tid & 63, wr = wid >> 2, wc = wid & 3, fr = lane & 15, fq = lane >> 4;
    const int nt = K / BK;
    int Rr[2], Cc[2]; unsigned voffB[2];
#pragma unroll
    for (int i = 0; i < 2; ++i) { int R, C; stage_rc(tid * 16 + i * 8192, R, C); Rr[i] = R; Cc[i] = C; const int Rb = (R & ~31) + perm32(R & 31); voffB[i] = (unsigned)(Rb * K + C) * 2u; }
    const size_t kstepB = (size_t)(BK * 2), kstepA = S.kstepA();
    const size_t hstepB = (size_t)HALF * K * 2;
    const unsigned ldsw = (unsigned)wid * 1024u;
    const int aoff = lds_byte(wr * 64 + fr, fq * 8), boff = lds_byte(wc * 32 + fr, fq * 8);
#define PG8_SA(b, h) (((b) * 2 + (h)) * HTB)
#define PG8_SB(b, h) ((4 + (b) * 2 + (h)) * HTB)
#define PG8_STAGE(bufoff, gbase, voff) do { _Pragma("unroll") for (int _i = 0; _i < 2; ++_i) \
        __builtin_amdgcn_global_load_lds((const unsigned*)((const char*)(gbase) + (voff)[_i]), (PG8_LAS unsigned*)(lds + (bufoff) + ldsw + _i * 8192), 16, 0, 0); } while (0)
#define PG8_LDA(dst, b, h) do { _Pragma("unroll") for (int m = 0; m < 4; ++m) _Pragma("unroll") for (int k = 0; k < 2; ++k) dst[m][k] = *(const PG8_LAS bf16x8*)(lds + PG8_SA(b, h) + aoff + m * 2048 + k * 1024); } while (0)
#define PG8_LDB(dst, b, h) do { _Pragma("unroll") for (int n = 0; n < 2; ++n) _Pragma("unroll") for (int k = 0; k < 2; ++k) dst[n][k] = *(const PG8_LAS bf16x8*)(lds + PG8_SB(b, h) + boff + n * 2048 + k * 1024); } while (0)
#define PG8_MMA(ai, bj, At, Bt) do { __builtin_amdgcn_s_setprio(1); _Pragma("unroll") for (int m = 0; m < 4; ++m) _Pragma("unroll") for (int n = 0; n < 2; ++n) _Pragma("unroll") for (int k = 0; k < 2; ++k) \
        acc[ai][bj][m][n] = __builtin_amdgcn_mfma_f32_16x16x32_bf16(Bt[n][k], At[m][k], acc[ai][bj][m][n], 0, 0, 0); __builtin_amdgcn_s_setprio(0); } while (0)
#define PG8_WAIT_V(n) asm volatile("s_waitcnt vmcnt(" #n ")" ::: "memory")
#define PG8_WAIT_L(n) asm volatile("s_waitcnt lgkmcnt(" #n ")" ::: "memory")
#define PG8_BAR __builtin_amdgcn_s_barrier()
#define PG8_SCHED __builtin_amdgcn_sched_barrier(0)
    Unit cur, nxt; int ui = 0;
    if (!S.next(0, cur)) return;
    f32x4 acc[2][2][4][2];
#pragma unroll
    for (int a = 0; a < 2; ++a)
#pragma unroll
        for (int b = 0; b < 2; ++b)
#pragma unroll
            for (int m = 0; m < 4; ++m)
#pragma unroll
                for (int n = 0; n < 2; ++n) acc[a][b][m][n] = (f32x4){0.f, 0.f, 0.f, 0.f};
    bf16x8 At[4][2], B0[2][2], B1[2][2];
    unsigned vA[2][2], vN[2][2];
    S.a_voff(cur, Rr, Cc, vA);
    const char* cA = S.a_base(cur); const char* cB = S.b_base(cur);
    PG8_STAGE(PG8_SB(0, 0), cB, voffB); PG8_STAGE(PG8_SB(0, 1), cB + hstepB, voffB); PG8_STAGE(PG8_SA(0, 0), cA, vA[0]); PG8_STAGE(PG8_SA(0, 1), cA, vA[1]);
    if (wr == 1) PG8_BAR;
    PG8_WAIT_V(2); PG8_BAR;
    PG8_STAGE(PG8_SB(1, 0), cB + kstepB, voffB); PG8_STAGE(PG8_SA(1, 0), cA + kstepA, vA[0]); PG8_STAGE(PG8_SB(1, 1), cB + hstepB + kstepB, voffB);
    PG8_WAIT_V(6); PG8_BAR;
    for (;;) {
        const bool has_next = S.next(ui + 1, nxt);
        const char* nA = cA; const char* nB = cB;
#pragma unroll
        for (int h = 0; h < 2; ++h)
#pragma unroll
            for (int i = 0; i < 2; ++i) vN[h][i] = vA[h][i];
        if (has_next) { nA = S.a_base(nxt); nB = S.b_base(nxt); S.a_voff(nxt, Rr, Cc, vN); }
#pragma unroll 1
        for (int t = 0; t < nt; t += 2) {
            const bool last = (t == nt - 2);
            const char* a1 = cA + (size_t)(t + 1) * kstepA;
            const char* a2 = last ? nA : cA + (size_t)(t + 2) * kstepA; const char* b2 = last ? nB : cB + (size_t)(t + 2) * kstepB;
            const char* a3 = a2 + kstepA; const char* b3 = b2 + kstepB;
            unsigned v2[2][2];
#pragma unroll
            for (int h = 0; h < 2; ++h)
#pragma unroll
                for (int i = 0; i < 2; ++i) v2[h][i] = last ? vN[h][i] : vA[h][i];
            PG8_LDB(B0, 0, 0); PG8_LDB(B1, 0, 1); PG8_SCHED; PG8_LDA(At, 0, 0); PG8_STAGE(PG8_SA(1, 1), a1, vA[1]);
            PG8_WAIT_V(8); PG8_WAIT_L(0); PG8_BAR; PG8_MMA(0, 0, At, B0); PG8_MMA(0, 1, At, B1); PG8_BAR; PG8_SCHED;
            PG8_LDA(At, 0, 1); PG8_STAGE(PG8_SB(0, 0), b2, voffB); PG8_STAGE(PG8_SB(0, 1), b2 + hstepB, voffB); PG8_STAGE(PG8_SA(0, 0), a2, v2[0]);
            PG8_WAIT_V(8); PG8_WAIT_L(0); PG8_BAR; PG8_MMA(1, 0, At, B0); PG8_MMA(1, 1, At, B1); PG8_BAR; PG8_SCHED;
            PG8_LDB(B0, 1, 0); PG8_LDB(B1, 1, 1); PG8_SCHED; PG8_LDA(At, 1, 0); PG8_STAGE(PG8_SA(0, 1), a2, v2[1]);
            PG8_WAIT_V(8); PG8_WAIT_L(0); PG8_BAR; PG8_MMA(0, 0, At, B0); PG8_MMA(0, 1, At, B1); PG8_BAR; PG8_SCHED;
            PG8_LDA(At, 1, 1); PG8_STAGE(PG8_SB(1, 0), b3, voffB); PG8_STAGE(PG8_SB(1, 1), b3 + hstepB, voffB); PG8_STAGE(PG8_SA(1, 0), a3, v2[0]);
            PG8_WAIT_V(8); PG8_WAIT_L(0); PG8_BAR; PG8_MMA(1, 0, At, B0); PG8_MMA(1, 1, At, B1); PG8_BAR; PG8_SCHED;
        }
        if (wr == 0) PG8_BAR;
        E(acc, cur, wr, wc, fr, fq);
        if (!has_next) break;
#pragma unroll
        for (int a = 0; a < 2; ++a)
#pragma unroll
            for (int b = 0; b < 2; ++b)
#pragma unroll
                for (int m = 0; m < 4; ++m)
#pragma unroll
                    for (int n = 0; n < 2; ++n) acc[a][b][m][n] = (f32x4){0.f, 0.f, 0.f, 0.f};
        cur = nxt; cA = nA; cB = nB; ++ui;
#pragma unroll
        for (int h = 0; h < 2; ++h)
#pragma unroll
            for (int i = 0; i < 2; ++i) vA[h][i] = vN[h][i];
        if (wr == 1) PG8_BAR;
    }
    PG8_WAIT_V(0);
    PG8_BAR;
#undef PG8_SA
#undef PG8_SB
#undef PG8_STAGE
#undef PG8_LDA
#undef PG8_LDB
#undef PG8_MMA
#undef PG8_WAIT_V
#undef PG8_WAIT_L
#undef PG8_BAR
#undef PG8_SCHED
}

struct DenseSched {
    const bf16_t* A; const bf16_t* Bt; int lda, K; int nM, nN, nwg, G, c;
    __device__ __forceinline__ void init(const bf16_t* A_, int lda_, const bf16_t* Bt_, int M, int N, int K_, int G_, int c_) { A = A_; lda = lda_; Bt = Bt_; K = K_; nM = M / BM; nN = N / BM; nwg = nM * nN; G = G_; c = c_; }
    __device__ __forceinline__ size_t kstepA() const { return (size_t)(BK * 2); }
    __device__ __forceinline__ bool next(int i, Unit& u) const {
        const long L = (long)i * G + c; if (L >= nwg) return false;
        int wgid = (int)L; { const int q = nwg / NXCD, r = nwg % NXCD, xcd = wgid % NXCD, off = wgid / NXCD; wgid = (xcd < r ? xcd * (q + 1) : r * (q + 1) + (xcd - r) * q) + off; }
        const int nig = WGM * nN, gid = wgid / nig, fm = gid * WGM, gsz = (nM - fm) < WGM ? (nM - fm) : WGM;
        u.pm = fm + ((wgid % nig) % gsz); u.pn = (wgid % nig) / gsz; u.a0 = 0; u.a1 = 0; return true;
    }
    __device__ __forceinline__ const char* a_base(const Unit& u) const { return (const char*)A + (size_t)u.pm * BM * lda * 2; }
    __device__ __forceinline__ const char* b_base(const Unit& u) const { return (const char*)Bt + (size_t)u.pn * BM * K * 2; }
    __device__ __forceinline__ void a_voff(const Unit&, const int (&R)[2], const int (&C)[2], unsigned (&v)[2][2]) const {
#pragma unroll
        for (int h = 0; h < 2; ++h)
#pragma unroll
            for (int i = 0; i < 2; ++i) v[h][i] = (unsigned)((h * HALF + R[i]) * lda + C[i]) * 2u;
    }
};
}

#define XB_TMO      128
#define XB_XCNT(j)  (256  + 64 * (j))
#define XB_XSUB(j)  (1280 + 64 * (j))
#define XB_XGEN(j)  (2304 + 64 * (j))
#define XB_TOP      3328
#define XB_TOPGEN   3392
#define XCD_BAR_WORDS 3456
#define XB_SPIN_CAP (1u << 22)
__device__ __forceinline__ unsigned xb_ld(unsigned* p)              { return __hip_atomic_load(p, __ATOMIC_RELAXED, __HIP_MEMORY_SCOPE_AGENT); }
__device__ __forceinline__ unsigned xb_add(unsigned* p, unsigned v) { return __hip_atomic_fetch_add(p, v, __ATOMIC_RELAXED, __HIP_MEMORY_SCOPE_AGENT); }
__device__ __forceinline__ unsigned xb_xcc_id() { return (unsigned)__builtin_amdgcn_s_getreg((3 << 11) | 20) & 0xFu; }
#define XB_SPIN(cond, bar) do { unsigned _sp = 0; while (cond) { __builtin_amdgcn_s_sleep(1); \
    if ((++_sp & 255u) == 0u) { if (xb_ld(&(bar)[XB_TMO])) break; if (_sp > XB_SPIN_CAP) { atomicAdd(&(bar)[XB_TMO], 1u); break; } } } } while (0)
struct XcdBarrier { unsigned* bar; unsigned x; volatile LAS unsigned* st; int wave; };
__device__ __forceinline__ XcdBarrier xcd_barrier_post(unsigned* bar, volatile LAS unsigned* st, int wave) {
    XcdBarrier b; b.bar = bar; b.x = xb_xcc_id(); b.st = st; b.wave = wave;
    if (wave == 0 && lane_id() == 0) (void)xb_add(&bar[XB_XCNT(b.x)], 1u);
    return b;
}
__device__ __forceinline__ void xcd_barrier_complete(unsigned* bar, unsigned x, unsigned& nloc, unsigned& nx) {
    const unsigned G = gridDim.x * gridDim.y * gridDim.z;
    unsigned sum, cnt, mine, sp = 0u;
    for (;;) {
        sum = 0u; cnt = 0u; mine = 0u;
#pragma unroll
        for (unsigned j = 0; j < 16; ++j) { const unsigned c = xb_ld(&bar[XB_XCNT(j)]); sum += c; cnt += (c > 0u) ? 1u : 0u; }
        mine = xb_ld(&bar[XB_XCNT(x)]);
        if (sum == G) break;
        __builtin_amdgcn_s_sleep(1);
        if ((++sp & 255u) == 0u) { if (xb_ld(&bar[XB_TMO])) break; if (sp > XB_SPIN_CAP) { atomicAdd(&bar[XB_TMO], 1u); break; } }
    }
    nloc = mine > 0u ? mine : 1u; nx = cnt > 0u ? cnt : 1u;
}
__device__ __forceinline__ void xcd_barrier(const XcdBarrier& b) {
    asm volatile("s_waitcnt vmcnt(0)" ::: "memory");
    __syncthreads();
    if (b.wave == 0 && lane_id() == 0) {
        unsigned* bar = b.bar; asm volatile("" : "+s"(bar)); unsigned bx = b.x; asm volatile("" : "+s"(bx));
        __builtin_amdgcn_s_waitcnt(0);
        unsigned nloc = b.st[0], nx = b.st[1];
        if (nloc == 0u) { xcd_barrier_complete(bar, bx, nloc, nx); b.st[0] = nloc; b.st[1] = nx; }
        const unsigned old = xb_add(&bar[XB_XSUB(bx)], 1u);
        const unsigned gen = old / nloc;
        if (old + 1u == (gen + 1u) * nloc) {
            __builtin_amdgcn_fence(__ATOMIC_RELEASE, "agent");
            asm volatile("s_waitcnt vmcnt(0)" ::: "memory");
            const unsigned og = xb_add(&bar[XB_TOP], 1u);
            const unsigned tg = og / nx;
            if (og + 1u == (tg + 1u) * nx) xb_add(&bar[XB_TOPGEN], 1u);
            else XB_SPIN(xb_ld(&bar[XB_TOPGEN]) == tg, bar);
            __builtin_amdgcn_fence(__ATOMIC_ACQUIRE, "agent");
            xb_add(&bar[XB_XGEN(bx)], 1u);
            asm volatile("s_waitcnt vmcnt(0)" ::: "memory");
        } else {
            XB_SPIN(xb_ld(&bar[XB_XGEN(bx)]) == gen, bar);
            __builtin_amdgcn_fence(__ATOMIC_ACQUIRE, "agent");
            asm volatile("s_waitcnt vmcnt(0)" ::: "memory");
        }
    }
    __syncthreads();
}

struct Args { const float* in[37]; float* out; unsigned char* ws; int ph_lo, ph_hi; };
typedef const __attribute__((address_space(4))) Args* KArgs;
__device__ __forceinline__ KArgs ka_get() { KArgs k = (KArgs)__builtin_amdgcn_kernarg_segment_ptr(); asm volatile("" : "+s"(k)); return k; }
enum { I_X = 0, I_P, I_MIXN, I_WIN, I_CONVW, I_CONVB, I_WA, I_BA, I_WX, I_BX, I_LAM, I_PEK, I_PEV, I_WK1, I_BK1, I_WK2, I_BK2, I_WV1, I_BV1, I_WV2, I_BV2,
       I_RECN, I_ATTN, I_WOUT, I_FFNN, I_WGR, I_BGR, I_WER, I_BER, I_WGATE, I_WUP, I_WDOWN, I_PLEN, I_WPG, I_BPG, I_WPU, I_FINN };

namespace pg8 {
struct CmpSched {
    const bf16_t* z; const bf16_t* W1k; const bf16_t* W1v; int G, c;
    __device__ __forceinline__ size_t kstepA() const { return (size_t)ZP * 2; }
    __device__ __forceinline__ bool next(int i, Unit& u) const { const int L = i * G + c; if (L >= 64) return false; u.pm = L >> 1; u.pn = 0; u.a0 = L & 1; u.a1 = 0; return true; }
    __device__ __forceinline__ const char* a_base(const Unit& u) const { const int b = u.pm >> 1, g = u.pm & 1; return (const char*)(z + (size_t)b * SEQ * ZP + (u.a0 ? ZC_VC : ZC_KC) + g * 64); }
    __device__ __forceinline__ const char* b_base(const Unit& u) const { return (const char*)(u.a0 ? W1v : W1k); }
    __device__ __forceinline__ void a_voff(const Unit&, const int (&R)[2], const int (&C)[2], unsigned (&v)[2][2]) const {
#pragma unroll
        for (int h = 0; h < 2; ++h)
#pragma unroll
            for (int i = 0; i < 2; ++i) v[h][i] = (unsigned)(16 * (h * HALF + R[i]) * ZP + C[i]) * 2u;
    }
};
template <int PHASE>
struct MoeSched {
    const PG8_LAS int* tab; const bf16_t* A; const bf16_t* W; const int* ltok; int G, c;
    __device__ __forceinline__ size_t kstepA() const { return (size_t)(BK * 2); }
    __device__ __forceinline__ bool next(int i, Unit& u) const {
        const int TT = tab[64]; int rt, pn;
        if (G == 256) { const int x = c & 7, y = c >> 3, Q = (TT + 7) >> 3, rl = i * 8 + (y >> 2); pn = y & 3; if (rl >= Q) return false; rt = x * Q + rl; }
        else { const int L = i * G + c; rt = L >> 2; pn = L & 3; }
        if (rt >= TT) return false;
        int lo = 0, hi = 64;
        while (hi - lo > 1) { const int mid = (lo + hi) >> 1; if (tab[mid] <= rt) lo = mid; else hi = mid; }
        u.pm = rt; u.pn = pn; u.a0 = lo; u.a1 = rt - tab[lo]; return true;
    }
    __device__ __forceinline__ const char* a_base(const Unit& u) const { return PHASE == 1 ? (const char*)A : (const char*)A + (size_t)u.pm * BM * DEXP * 2; }
    __device__ __forceinline__ const char* b_base(const Unit& u) const {
        const int e = u.a0 & 31;
        return PHASE == 1 ? (const char*)W + ((size_t)e * 1024 + (size_t)u.pn * BM) * 1024 * 2 : (const char*)W + ((size_t)e * 1024 + (size_t)u.pn * BM) * DEXP * 2;
    }
    __device__ __forceinline__ void a_voff(const Unit& u, const int (&R)[2], const int (&C)[2], unsigned (&v)[2][2]) const {
        if (PHASE == 1) {
            const int cnt = tab[80 + u.a0];
#pragma unroll
            for (int h = 0; h < 2; ++h)
#pragma unroll
                for (int i = 0; i < 2; ++i) { const int rank = u.a1 * BM + h * HALF + R[i]; const int tok = rank < cnt ? ltok[(size_t)u.a0 * NTOK + rank] : 0; v[h][i] = (unsigned)(tok * DM + C[i]) * 2u; }
        } else {
#pragma unroll
            for (int h = 0; h < 2; ++h)
#pragma unroll
                for (int i = 0; i < 2; ++i) v[h][i] = (unsigned)((h * HALF + R[i]) * DEXP + C[i]) * 2u;
        }
    }
};

template <int ACT  > struct EpiBf16 {
    bf16_t* O; int ldc; const float* bias; size_t a0_stride; int a0_bias_stride;
    const float* rs;
    __device__ __forceinline__ void operator()(const f32x4 (&acc)[2][2][4][2], const Unit& u, int wr, int wc, int fr, int fq) const {
        const int row0 = u.pm * BM + wr * 64 + fr, col0 = u.pn * BM + wc * 32 + 8 * fq;
        bf16_t* base = O + (size_t)u.a0 * a0_stride; const float* bs = bias ? bias + u.a0 * a0_bias_stride : nullptr;
        float rsv[2][4];
#pragma unroll
        for (int ai = 0; ai < 2; ++ai)
#pragma unroll
            for (int m = 0; m < 4; ++m) rsv[ai][m] = rs ? rs[row0 + ai * HALF + m * 16] : 1.f;
        f32x4 bv[2][2];
#pragma unroll
        for (int bj = 0; bj < 2; ++bj)
#pragma unroll
            for (int n = 0; n < 2; ++n) bv[bj][n] = bs ? *(const f32x4*)(bs + col0 + bj * HALF + 4 * n) : (f32x4){0.f, 0.f, 0.f, 0.f};
#pragma unroll
        for (int ai = 0; ai < 2; ++ai)
#pragma unroll
            for (int m = 0; m < 4; ++m) { bf16_t* rowp = base + (size_t)(row0 + ai * HALF + m * 16) * ldc + col0; const float sc = rsv[ai][m];
#pragma unroll
                for (int bj = 0; bj < 2; ++bj) { f32x4 v0 = acc[ai][bj][m][0], v1 = acc[ai][bj][m][1];
                    if (rs) { v0 *= sc; v1 *= sc; }
                    v0 += bv[bj][0]; v1 += bv[bj][1];
                    if (ACT == 1) { for (int e = 0; e < 4; ++e) { v0[e] = fgelu(v0[e]); v1[e] = fgelu(v1[e]); } }
                    if (ACT == 2) { for (int e = 0; e < 4; ++e) { v0[e] = fsigmoid(v0[e]); v1[e] = fsigmoid(v1[e]); } }
                    u32x4 w; w.x = cvt_pk_bf16(v0[0], v0[1]); w.y = cvt_pk_bf16(v0[2], v0[3]); w.z = cvt_pk_bf16(v1[0], v1[1]); w.w = cvt_pk_bf16(v1[2], v1[3]);
                    *(u32x4*)(rowp + bj * HALF) = w; } }
    }
};
struct EpiResid {
    bf16_t* h;
    __device__ __forceinline__ void operator()(const f32x4 (&acc)[2][2][4][2], const Unit& u, int wr, int wc, int fr, int fq) const {
        const int row0 = u.pm * BM + wr * 64 + fr, col0 = u.pn * BM + wc * 32 + 8 * fq;
#pragma unroll
        for (int ai = 0; ai < 2; ++ai) {
            bf16_t* rp0 = h + (size_t)(row0 + ai * HALF) * DM + col0;
            u32x4 hv[4][2];
#pragma unroll
            for (int m = 0; m < 4; ++m)
#pragma unroll
                for (int bj = 0; bj < 2; ++bj) hv[m][bj] = *(const u32x4*)(rp0 + (size_t)m * 16 * DM + bj * HALF);
#pragma unroll
            for (int m = 0; m < 4; ++m)
#pragma unroll
                for (int bj = 0; bj < 2; ++bj) { const u32x4 x = hv[m][bj]; const f32x4 a0 = acc[ai][bj][m][0], a1 = acc[ai][bj][m][1];
                    u32x4 w; w.x = cvt_pk_bf16(bflo(x.x) + a0[0], bfhi(x.x) + a0[1]); w.y = cvt_pk_bf16(bflo(x.y) + a0[2], bfhi(x.y) + a0[3]); w.z = cvt_pk_bf16(bflo(x.z) + a1[0], bfhi(x.z) + a1[1]); w.w = cvt_pk_bf16(bflo(x.w) + a1[2], bfhi(x.w) + a1[3]);
                    *(u32x4*)(rp0 + (size_t)m * 16 * DM + bj * HALF) = w; }
            asm volatile("" ::: "memory");
        }
    }
};
struct EpiPleB {
    const bf16_t* h; bf16_t* hn; const bf16_t* Gt;
    __device__ __forceinline__ void operator()(const f32x4 (&acc)[2][2][4][2], const Unit& u, int wr, int wc, int fr, int fq) const {
        const int row0 = u.pm * BM + wr * 64 + fr, col0 = u.pn * BM + wc * 32 + 8 * fq;
#pragma unroll
        for (int ai = 0; ai < 2; ++ai) {
            const size_t ro0 = (size_t)(row0 + ai * HALF) * DM + col0;
            u32x4 hv[4][2], gv[4][2];
#pragma unroll
            for (int m = 0; m < 4; ++m)
#pragma unroll
                for (int bj = 0; bj < 2; ++bj) { hv[m][bj] = *(const u32x4*)(h + ro0 + (size_t)m * 16 * DM + bj * HALF); gv[m][bj] = *(const u32x4*)(Gt + ro0 + (size_t)m * 16 * DM + bj * HALF); }
#pragma unroll
            for (int m = 0; m < 4; ++m)
#pragma unroll
                for (int bj = 0; bj < 2; ++bj) { const u32x4 x = hv[m][bj], g = gv[m][bj]; const f32x4 a0 = acc[ai][bj][m][0], a1 = acc[ai][bj][m][1];
                    u32x4 w; w.x = cvt_pk_bf16(bflo(x.x) + a0[0] * bflo(g.x), bfhi(x.x) + a0[1] * bfhi(g.x)); w.y = cvt_pk_bf16(bflo(x.y) + a0[2] * bflo(g.y), bfhi(x.y) + a0[3] * bfhi(g.y));
                    w.z = cvt_pk_bf16(bflo(x.z) + a1[0] * bflo(g.z), bfhi(x.z) + a1[1] * bfhi(g.z)); w.w = cvt_pk_bf16(bflo(x.w) + a1[2] * bflo(g.w), bfhi(x.w) + a1[3] * bfhi(g.w));
                    *(u32x4*)(hn + ro0 + (size_t)m * 16 * DM + bj * HALF) = w; }
            asm volatile("" ::: "memory");
        }
    }
};
struct EpiSwiglu {
    bf16_t* Hd; const PG8_LAS int* tab; const float* lrs;
    __device__ __forceinline__ void operator()(const f32x4 (&acc)[2][2][4][2], const Unit& u, int wr, int wc, int fr, int fq) const {
        const int row0 = u.pm * BM + wr * 64 + fr, col0 = u.pn * HALF + wc * 32 + 8 * fq; const int seg = u.a0, cnt = tab[80 + seg];
        float rsv[2][4];
#pragma unroll
        for (int ai = 0; ai < 2; ++ai)
#pragma unroll
            for (int m = 0; m < 4; ++m) { const int rank = u.a1 * BM + ai * HALF + wr * 64 + m * 16 + fr; const float v = lrs[(size_t)seg * NTOK + (rank < cnt ? rank : 0)]; rsv[ai][m] = rank < cnt ? v : 0.f; }
#pragma unroll
        for (int ai = 0; ai < 2; ++ai)
#pragma unroll
            for (int m = 0; m < 4; ++m) { const float rs = rsv[ai][m];
                float r[8];
#pragma unroll
                for (int n = 0; n < 2; ++n)
#pragma unroll
                    for (int e = 0; e < 4; ++e) { const float gt = acc[ai][0][m][n][e] * rs, up = acc[ai][1][m][n][e] * rs; r[4 * n + e] = gt * fsigmoid(gt) * up; }
                u32x4 w; w.x = cvt_pk_bf16(r[0], r[1]); w.y = cvt_pk_bf16(r[2], r[3]); w.z = cvt_pk_bf16(r[4], r[5]); w.w = cvt_pk_bf16(r[6], r[7]);
                *(u32x4*)(Hd + (size_t)(row0 + ai * HALF + m * 16) * DEXP + col0) = w; }
    }
};
struct EpiMoeDown {
    const PG8_LAS int* tab; const int* ltok; const float* lgate; bf16_t* y0; bf16_t* y1;
    __device__ __forceinline__ void operator()(const f32x4 (&acc)[2][2][4][2], const Unit& u, int wr, int wc, int fr, int fq) const {
        const int seg = u.a0, cnt = tab[80 + seg]; bf16_t* yb = (seg >= 32) ? y1 : y0;
        const int col0 = u.pn * BM + wc * 32 + 8 * fq;
        int tk[2][4]; float gtv[2][4];
#pragma unroll
        for (int ai = 0; ai < 2; ++ai)
#pragma unroll
            for (int m = 0; m < 4; ++m) { const int rank = u.a1 * BM + ai * HALF + wr * 64 + m * 16 + fr; const size_t o = (size_t)seg * NTOK + (rank < cnt ? rank : 0); tk[ai][m] = ltok[o]; gtv[ai][m] = lgate[o]; }
#pragma unroll
        for (int ai = 0; ai < 2; ++ai)
#pragma unroll
            for (int m = 0; m < 4; ++m) { const int rank = u.a1 * BM + ai * HALF + wr * 64 + m * 16 + fr;
                if (rank < cnt) { const int tok = tk[ai][m]; const float gt = gtv[ai][m];
#pragma unroll
                    for (int bj = 0; bj < 2; ++bj) { const f32x4 v0 = acc[ai][bj][m][0] * gt, v1 = acc[ai][bj][m][1] * gt;
                        u32x4 w; w.x = cvt_pk_bf16(v0[0], v0[1]); w.y = cvt_pk_bf16(v0[2], v0[3]); w.z = cvt_pk_bf16(v1[0], v1[1]); w.w = cvt_pk_bf16(v1[2], v1[3]);
                        *(u32x4*)(yb + (size_t)tok * DM + col0 + bj * HALF) = w; } } }
    }
};
}

struct TrItem { const float* W; const float* gain; bf16* WT; int K, N, dest_row0, k0, n0; float cs; };
__device__ __forceinline__ void tr_load(const TrItem& t, f32x4 (&v)[8], int lane) {
    const int c4 = lane & 7, kr = lane >> 3; const bool ok = t.n0 + 4 * c4 < t.N;
#pragma unroll
    for (int i = 0; i < 8; ++i) v[i] = ok ? *(const f32x4*)(t.W + (size_t)(t.k0 + 8 * i + kr) * t.N + t.n0 + 4 * c4) : (f32x4){0.f, 0.f, 0.f, 0.f};
}
__device__ __forceinline__ void tr_store(const TrItem& t, const f32x4 (&v)[8], LAS float* scr, int lane) {
    const int c4 = lane & 7, kr = lane >> 3;
#pragma unroll
    for (int i = 0; i < 8; ++i) { const int kk = 8 * i + kr; const float gsc = (t.gain ? t.gain[t.k0 + kk] : 1.f) * t.cs; LAS float* d = scr + kk * 33 + 4 * c4;
        d[0] = v[i].x * gsc; d[1] = v[i].y * gsc; d[2] = v[i].z * gsc; d[3] = v[i].w * gsc; }
    LDS_WAIT();
    const int c = lane & 7;
#pragma unroll
    for (int j = 0; j < 4; ++j) { const int n = (lane >> 3) + 8 * j; const LAS float* sp = scr + (8 * c) * 33 + n;
        u32x4 o; o.x = pk2(sp[0], sp[33]); o.y = pk2(sp[66], sp[99]); o.z = pk2(sp[132], sp[165]); o.w = pk2(sp[198], sp[231]);
        *(u32x4*)(t.WT + (size_t)(t.dest_row0 + n) * t.K + t.k0 + 8 * c) = o; }
    LDS_WAIT();
}
constexpr int IT_IN = 16 * 80, IT_OUT = 16 * 32, IT_PG = 16 * 32, IT_PU = 4 * 32, IT_K1 = 32 * 8, IT_V1 = 32 * 8, IT_E = 768;
constexpr int IT_LAYER = IT_IN + IT_OUT + IT_PG + IT_PU + IT_K1 + IT_V1 + NEXP * IT_E;

constexpr int IT_SMALL = IT_IN + IT_OUT + IT_PG + IT_PU + IT_K1 + IT_V1;
template <int MODE>
__device__ __forceinline__ void tr_run(KArgs args, LAS float* scr, int lane, int q0, int qstep, int Lsel) {
    unsigned char* ws = args->ws;
    const int nq = MODE == 0 ? DEPTH * IT_SMALL : NEXP * IT_E;
#define Q2IT_(q) (MODE == 0 ? ((q) / IT_SMALL) * IT_LAYER + (q) % IT_SMALL : Lsel * IT_LAYER + IT_SMALL + (q))
#define TR_DECODE(it_, t_) do { const int L = (it_) / IT_LAYER; int r = (it_) % IT_LAYER; unsigned char* wl = ws + WS_W + (size_t)L * W_LAYER; t_.cs = 1.f; t_.gain = nullptr; \
        if (r < IT_IN) { const int kb = r / 80, nb = r % 80; t_.W = args->in[I_WIN] + (size_t)L * DM * D_IN; t_.K = DM; t_.N = D_IN; t_.gain = args->in[I_MIXN] + L * DM; t_.WT = (bf16*)(wl + WO_IN); t_.dest_row0 = 32 * nb; t_.k0 = 64 * kb; t_.n0 = 32 * nb; \
            t_.cs = (32 * nb >= ZC_Q && 32 * nb < ZC_KC) ? 0.125f * LOG2E : 1.f; break; } r -= IT_IN; \
        if (r < IT_OUT) { const int kb = r / 32, nb = r % 32; t_.W = args->in[I_WOUT] + (size_t)L * DM * DM; t_.K = DM; t_.N = DM; t_.gain = kb < 8 ? args->in[I_RECN] + L * 512 : args->in[I_ATTN] + L * 512 - 512; t_.WT = (bf16*)(wl + WO_OUT); t_.dest_row0 = 32 * nb; t_.k0 = 64 * kb; t_.n0 = 32 * nb; break; } r -= IT_OUT; \
        if (r < IT_PG) { const int kb = r / 32, nb = r % 32; t_.W = args->in[I_WPG] + (size_t)L * DM * DM; t_.K = DM; t_.N = DM; t_.gain = args->in[I_PLEN] + L * DM; t_.WT = (bf16*)(wl + WO_PG); t_.dest_row0 = 32 * nb; t_.k0 = 64 * kb; t_.n0 = 32 * nb; break; } r -= IT_PG; \
        if (r < IT_PU) { const int kb = r / 32, nb = r % 32; t_.W = args->in[I_WPU] + (size_t)L * D_PLE * DM; t_.K = D_PLE; t_.N = DM; t_.WT = (bf16*)(wl + WO_PU); t_.dest_row0 = 32 * nb; t_.k0 = 64 * kb; t_.n0 = 32 * nb; break; } r -= IT_PU; \
        if (r < IT_K1) { const int kb = r / 8, nb = r % 8; t_.W = args->in[I_WK1] + (size_t)L * 2048 * 256; t_.K = 2048; t_.N = 256; t_.WT = (bf16*)(wl + WO_K1); t_.dest_row0 = 32 * nb; t_.k0 = 64 * kb; t_.n0 = 32 * nb; break; } r -= IT_K1; \
        if (r < IT_V1) { const int kb = r / 8, nb = r % 8; t_.W = args->in[I_WV1] + (size_t)L * 2048 * 256; t_.K = 2048; t_.N = 256; t_.WT = (bf16*)(wl + WO_V1); t_.dest_row0 = 32 * nb; t_.k0 = 64 * kb; t_.n0 = 32 * nb; break; } r -= IT_V1; \
        const int e = r / IT_E; int rr = r % IT_E; \
        if (rr < 512) { const int up = rr >> 8; rr &= 255; const int kb = rr / 16, nb = rr % 16, n0 = 32 * nb;     \
            t_.W = (up ? args->in[I_WUP] : args->in[I_WGATE]) + ((size_t)L * NEXP + e) * DM * DEXP; t_.K = DM; t_.N = DEXP; t_.gain = args->in[I_FFNN] + L * DM; t_.WT = (bf16*)(wl + WO_GU) + (size_t)e * 1024 * 1024; \
            t_.dest_row0 = 256 * (n0 >> 7) + (n0 & 127) + 128 * up; t_.k0 = 64 * kb; t_.n0 = n0; } \
        else { rr -= 512; const int kb = rr / 32, nb = rr % 32; t_.W = args->in[I_WDOWN] + ((size_t)L * NEXP + e) * DEXP * DM; t_.K = DEXP; t_.N = DM; t_.WT = (bf16*)(wl + WO_D) + (size_t)e * 1024 * DEXP; t_.dest_row0 = 32 * nb; t_.k0 = 64 * kb; t_.n0 = 32 * nb; } \
    } while (0)
    int q = q0; TrItem cur; f32x4 vc[8];
    if (q < nq) { TR_DECODE(Q2IT_(q), cur); tr_load(cur, vc, lane); }
    while (q < nq) {
        const int qn = q + qstep; TrItem nxt; f32x4 vn[8];
        const bool hn = qn < nq;
        if (hn) { TR_DECODE(Q2IT_(qn), nxt); tr_load(nxt, vn, lane); }
        tr_store(cur, vc, scr, lane);
        if (hn) { cur = nxt;
#pragma unroll
            for (int i = 0; i < 8; ++i) vc[i] = vn[i]; }
        q = qn; }
#undef TR_DECODE
#undef Q2IT_
}
__device__ __forceinline__ void phase_prologue(KArgs args, LAS unsigned char* lds, int G, int bid, int tid, int wave, int lane) {
    unsigned char* ws = args->ws;
    LAS float* scr = (LAS float*)(lds + wave * 16384);
    const int gw = bid * NWAVES + wave, NGW = G * NWAVES;
    tr_run<0>(args, scr, lane, gw, NGW, 0);
    const int gt = bid * (NWAVES * 64) + tid, NGT = G * NWAVES * 64;
    float* c8 = (float*)(ws + WS_C8); float* wrt = (float*)(ws + WS_WRT);
    for (int i = gt; i < DEPTH * 512; i += NGT) { const float lam = args->in[I_LAM][i]; c8[i] = -8.f * log1pf(expf(-lam)) * LOG2E; }
    for (int i = gt; i < DEPTH * 36 * 1024; i += NGT) { const int L = i / (36 * 1024), j = (i / 1024) % 36, k = i % 1024;
        const float w = (j < 32 ? args->in[I_WER][((size_t)L * DM + k) * 32 + j] : args->in[I_WGR][((size_t)L * DM + k) * 4 + (j - 32)]) * args->in[I_FFNN][L * DM + k];
        const unsigned hi = f2bf(w), lo = f2bf(w - bf2f((bf16)hi));
        ((bf16*)wrt)[((size_t)(L * 2 + 0) * 36 + j) * 1024 + k] = (bf16)hi; ((bf16*)wrt)[((size_t)(L * 2 + 1) * 36 + j) * 1024 + k] = (bf16)lo; }
    { bf16* w2t = (bf16*)(ws + WS_W2T);
      for (int i = gt; i < DEPTH * 2 * 64 * 256; i += NGT) { const int L = i >> 15, kv = (i >> 14) & 1, n = (i >> 8) & 63, k = i & 255;
          w2t[i] = (bf16)f2bf((kv ? args->in[I_WV2] : args->in[I_WK2])[((size_t)L * 256 + k) * 64 + n]); } }
    if (bid < 8) { const int pair = bid, L = pair >> 1, kv = pair & 1, j = tid & 255, half = tid >> 8;
        const float* pe = (kv ? args->in[I_PEV] : args->in[I_PEK]) + L * 2048 + 1024 * half; const float* w1 = (kv ? args->in[I_WV1] : args->in[I_WK1]) + ((size_t)L * 2048 + 1024 * half) * 256 + j;
        float s0 = 0.f, s1 = 0.f, s2 = 0.f, s3 = 0.f;
#pragma unroll 4
        for (int k = 0; k < 1024; k += 4) { s0 += pe[k] * w1[(size_t)k * 256]; s1 += pe[k + 1] * w1[(size_t)(k + 1) * 256]; s2 += pe[k + 2] * w1[(size_t)(k + 2) * 256]; s3 += pe[k + 3] * w1[(size_t)(k + 3) * 256]; }
        LAS float* red = (LAS float*)(lds + 8 * 16384);
        if (half) red[j] = (s0 + s1) + (s2 + s3);
        __syncthreads();
        if (!half) ((float*)(ws + WS_BK1))[pair * 256 + j] = (kv ? args->in[I_BV1] : args->in[I_BK1])[L * 256 + j] + ((s0 + s1) + (s2 + s3)) + red[j]; }
}

__device__ __forceinline__ void store_row_bf16(bf16* orow, const f32x4 (&v)[4], float sc, int lane) {
    unsigned long long* o8 = (unsigned long long*)orow + lane;
#pragma unroll
    for (int j = 0; j < 4; ++j) o8[64 * j] = (unsigned long long)pk2(v[j].x * sc, v[j].y * sc) | ((unsigned long long)pk2(v[j].z * sc, v[j].w * sc) << 32);
}
__device__ __forceinline__ float row_ss_bf16(const u32x2 (&v)[4]) { float s = 0.f;
#pragma unroll
    for (int j = 0; j < 4; ++j) { const float a = bflo(v[j].x), b = bfhi(v[j].x), c = bflo(v[j].y), d = bfhi(v[j].y); s += (a * a + b * b) + (c * c + d * d); }
    return s; }
__device__ __forceinline__ void store_row_bf16_from16(bf16* orow, const u32x2 (&v)[4], float sc, int lane) {
    u32x2* o8 = (u32x2*)orow + lane;
#pragma unroll
    for (int j = 0; j < 4; ++j) { u32x2 w; w.x = pk2(bflo(v[j].x) * sc, bfhi(v[j].x) * sc); w.y = pk2(bflo(v[j].y) * sc, bfhi(v[j].y) * sc); o8[64 * j] = w; }
}
__device__ __forceinline__ float ss_u4(const u32x4& v) {
    const float a = bflo(v.x), b = bfhi(v.x), c = bflo(v.y), d = bfhi(v.y), e = bflo(v.z), f = bfhi(v.z), g = bflo(v.w), h = bfhi(v.w);
    return ((a * a + b * b) + (c * c + d * d)) + ((e * e + f * f) + (g * g + h * h)); }
__device__ __forceinline__ u32x4 scale_u4(const u32x4& v, float sc) { u32x4 w;
    w.x = pg8::cvt_pk_bf16(bflo(v.x) * sc, bfhi(v.x) * sc); w.y = pg8::cvt_pk_bf16(bflo(v.y) * sc, bfhi(v.y) * sc); w.z = pg8::cvt_pk_bf16(bflo(v.z) * sc, bfhi(v.z) * sc); w.w = pg8::cvt_pk_bf16(bflo(v.w) * sc, bfhi(v.w) * sc); return w; }
__device__ __forceinline__ u32x4 add3_u4(const u32x4& h, const u32x4& a, const u32x4& b) { u32x4 w;
    w.x = pg8::cvt_pk_bf16(bflo(h.x) + bflo(a.x) + bflo(b.x), bfhi(h.x) + bfhi(a.x) + bfhi(b.x)); w.y = pg8::cvt_pk_bf16(bflo(h.y) + bflo(a.y) + bflo(b.y), bfhi(h.y) + bfhi(a.y) + bfhi(b.y));
    w.z = pg8::cvt_pk_bf16(bflo(h.z) + bflo(a.z) + bflo(b.z), bfhi(h.z) + bfhi(a.z) + bfhi(b.z)); w.w = pg8::cvt_pk_bf16(bflo(h.w) + bflo(a.w) + bflo(b.w), bfhi(h.w) + bfhi(a.w) + bfhi(b.w)); return w; }
__device__ __forceinline__ void phase_norm1(const float* x, bf16* H, float* rs, int gw, int NGW, int lane) {
    if (x) {
        constexpr int NR = 2;
        for (int m0 = gw * NR; m0 < NTOK; m0 += NGW * NR) { f32x4 v[NR][4];
#pragma unroll
            for (int r = 0; r < NR; ++r)
#pragma unroll
                for (int j = 0; j < 4; ++j) v[r][j] = ((const f32x4*)(x + (size_t)(m0 + r) * DM))[lane + 64 * j];
#pragma unroll
            for (int r = 0; r < NR; ++r) { float s = 0.f;
#pragma unroll
                for (int j = 0; j < 4; ++j) s += (v[r][j].x * v[r][j].x + v[r][j].y * v[r][j].y) + (v[r][j].z * v[r][j].z + v[r][j].w * v[r][j].w);
                const float rstd = rsqrtf(wave_sum(s) * (1.f / DM) + EPS);
                store_row_bf16(H + (size_t)(m0 + r) * DM, v[r], 1.f, lane); if (lane == 0) rs[m0 + r] = rstd; } }
    } else {
        constexpr int NR = 4;
        for (int m0 = gw * NR; m0 < NTOK; m0 += NGW * NR) { u32x4 v[NR][2];
#pragma unroll
            for (int r = 0; r < NR; ++r)
#pragma unroll
                for (int j = 0; j < 2; ++j) v[r][j] = ((const u32x4*)(H + (size_t)(m0 + r) * DM))[lane + 64 * j];
            float rr[NR];
#pragma unroll
            for (int r = 0; r < NR; ++r) rr[r] = rsqrtf(wave_sum(ss_u4(v[r][0]) + ss_u4(v[r][1])) * (1.f / DM) + EPS);
            if (lane == 0) *(f32x4*)(rs + m0) = (f32x4){rr[0], rr[1], rr[2], rr[3]}; }
    }
}
__device__ __forceinline__ void phase_final(const bf16* H, float* out, const float* gain, int gw, int NGW, int lane) {
    constexpr int NR = 4;
    f32x4 gv[2][2];
#pragma unroll
    for (int j = 0; j < 2; ++j) { gv[j][0] = ((const f32x4*)gain)[2 * lane + 128 * j]; gv[j][1] = ((const f32x4*)gain)[2 * lane + 128 * j + 1]; }
    for (int m0 = gw * NR; m0 < NTOK; m0 += NGW * NR) { u32x4 v[NR][2];
#pragma unroll
        for (int r = 0; r < NR; ++r)
#pragma unroll
            for (int j = 0; j < 2; ++j) v[r][j] = ((const u32x4*)(H + (size_t)(m0 + r) * DM))[lane + 64 * j];
#pragma unroll
        for (int r = 0; r < NR; ++r) { const float rstd = rsqrtf(wave_sum(ss_u4(v[r][0]) + ss_u4(v[r][1])) * (1.f / DM) + EPS);
            f32x4* xr = (f32x4*)(out + (size_t)(m0 + r) * DM);
#pragma unroll
            for (int j = 0; j < 2; ++j) { const u32x4 w = v[r][j];
                xr[2 * lane + 128 * j] = (f32x4){bflo(w.x), bfhi(w.x), bflo(w.y), bfhi(w.y)} * rstd * gv[j][0];
                xr[2 * lane + 128 * j + 1] = (f32x4){bflo(w.z), bfhi(w.z), bflo(w.w), bfhi(w.w)} * rstd * gv[j][1]; } } }
}
__device__ __forceinline__ void phase_norm3(bf16* H, const bf16* y0, const bf16* y1, float* rs, const float* pL, bf16* pb, int gw, int NGW, int lane) {
    constexpr int NR = 4;
    for (int m0 = gw * NR; m0 < NTOK; m0 += NGW * NR) { u32x4 hv[NR][2], av[NR][2], bv[NR][2]; f32x4 pv[NR];
#pragma unroll
        for (int r = 0; r < NR; ++r) { const size_t ro = (size_t)(m0 + r) * DM;
#pragma unroll
            for (int j = 0; j < 2; ++j) { hv[r][j] = ((const u32x4*)(H + ro))[lane + 64 * j]; av[r][j] = ((const u32x4*)(y0 + ro))[lane + 64 * j]; bv[r][j] = ((const u32x4*)(y1 + ro))[lane + 64 * j]; }
            pv[r] = ((const f32x4*)(pL + (size_t)(m0 + r) * D_PLE))[lane]; }
        float rr[NR];
#pragma unroll
        for (int r = 0; r < NR; ++r) { const size_t ro = (size_t)(m0 + r) * DM;
            const u32x4 w0 = add3_u4(hv[r][0], av[r][0], bv[r][0]), w1 = add3_u4(hv[r][1], av[r][1], bv[r][1]);
            ((u32x4*)(H + ro))[lane] = w0; ((u32x4*)(H + ro))[lane + 64] = w1;
            rr[r] = rsqrtf(wave_sum(ss_u4(w0) + ss_u4(w1)) * (1.f / DM) + EPS);
            u32x2 q; q.x = pg8::cvt_pk_bf16(pv[r].x, pv[r].y); q.y = pg8::cvt_pk_bf16(pv[r].z, pv[r].w);
            ((u32x2*)(pb + (size_t)(m0 + r) * D_PLE))[lane] = q; }
        if (lane == 0) *(f32x4*)(rs + m0) = (f32x4){rr[0], rr[1], rr[2], rr[3]}; }
}
constexpr int N2_PITCH = 2064, N2_WL = 36 * N2_PITCH;
__device__ __forceinline__ void phase_norm2(KArgs args, const bf16* H, int L, LAS unsigned char* lds, int G, int bid, int tid, int wave, int lane) {
    unsigned char* ws = args->ws;
    { const u32x4* src = (const u32x4*)(ws + WS_WRT + (size_t)L * 2 * 36 * 2048);
      for (int i = tid; i < 2 * 36 * 128; i += NWAVES * 64) { const int hl = i / (36 * 128), row = (i >> 7) % 36, c = i & 127; *(LAS u32x4*)(lds + hl * N2_WL + row * N2_PITCH + c * 16) = src[i]; } }
    __syncthreads();
    gu32* cnt = (gu32*)(ws + WS_CTL) + CW_CNT + L * 64;
    int* ltok = (int*)(ws + WS_LTOK); float* lgate = (float*)(ws + WS_LGATE); float* lrs = (float*)(ws + WS_LRS);
    const float* bgr = args->in[I_BGR] + L * 4; const float* ber = args->in[I_BER] + L * 32;
    const int gw = bid * NWAVES + wave, NGW = G * NWAVES, fr = lane & 15, fq = lane >> 4;
    const int arow[3] = {8 * (fr >> 2) + (fr & 3), 8 * (fr >> 2) + (fr & 3) + 4, 32 + (fr & 3)};
    for (int grp = gw; grp < NTOK / 16; grp += NGW) {
        const int tok = grp * 16 + fr;
        const bf16* hrow = H + (size_t)tok * DM + 8 * fq;
        f32x4 acc[3]; float ss = 0.f;
#pragma unroll
        for (int t3 = 0; t3 < 3; ++t3) acc[t3] = (f32x4){0.f, 0.f, 0.f, 0.f};
#pragma unroll 1
        for (int k0 = 0; k0 < 32; k0 += 16) {
        u32x4 xhv[16];
#pragma unroll
        for (int kq = 0; kq < 16; ++kq) xhv[kq] = *(const u32x4*)(hrow + 32 * (k0 + kq));
#pragma unroll
        for (int kq = 0; kq < 16; ++kq) { const int kk = k0 + kq;
            const u32x4 xh = xhv[kq];
            { const float a0 = bflo(xh.x), a1 = bfhi(xh.x), a2 = bflo(xh.y), a3 = bfhi(xh.y), a4 = bflo(xh.z), a5 = bfhi(xh.z), a6 = bflo(xh.w), a7 = bfhi(xh.w);
              ss += (a0 * a0 + a1 * a1) + (a2 * a2 + a3 * a3) + (a4 * a4 + a5 * a5) + (a6 * a6 + a7 * a7); }
            const bf16x8 bh = __builtin_bit_cast(bf16x8, xh);
#pragma unroll
            for (int t3 = 0; t3 < 3; ++t3) { const bf16x8 ah = *(const LAS bf16x8*)(lds + arow[t3] * N2_PITCH + 64 * kk + 16 * fq), al = *(const LAS bf16x8*)(lds + N2_WL + arow[t3] * N2_PITCH + 64 * kk + 16 * fq);
                acc[t3] = __builtin_amdgcn_mfma_f32_16x16x32_bf16(ah, bh, acc[t3], 0, 0, 0); acc[t3] = __builtin_amdgcn_mfma_f32_16x16x32_bf16(al, bh, acc[t3], 0, 0, 0); }
        }
        }
        ss += __builtin_bit_cast(float, __builtin_amdgcn_ds_bpermute((lane ^ 16) << 2, __builtin_bit_cast(int, ss)));
        ss += __builtin_bit_cast(float, __builtin_amdgcn_ds_bpermute((lane ^ 32) << 2, __builtin_bit_cast(int, ss)));
        const float rstd = rsqrtf(ss * (1.f / DM) + EPS);
        float gl[4]; int gi = 0;
#pragma unroll
        for (int j = 0; j < 4; ++j) gl[j] = acc[2][j] * rstd + bgr[j];
        float gmax = gl[0];
#pragma unroll
        for (int j = 1; j < 4; ++j) if (gl[j] > gmax) { gmax = gl[j]; gi = j; }
        if (fq == gi) {
            float den = 0.f;
#pragma unroll
            for (int j = 0; j < 4; ++j) den += expf(gl[j] - gmax);
            const float pg = 1.f / den;
            float b1 = -3.0e38f, b2 = -3.0e38f; int j1 = 0, j2 = 0;
#pragma unroll
            for (int e = 0; e < 8; ++e) { const float x = (e < 4 ? acc[0][e & 3] : acc[1][e & 3]) * rstd + ber[gi * 8 + e];
                if (x > b1) { b2 = b1; j2 = j1; b1 = x; j1 = e; } else if (x > b2) { b2 = x; j2 = e; } }
            const float w1 = 1.f / (1.f + expf(b2 - b1)), w2 = 1.f - w1;
            const int s0 = gi * 8 + j1, s1 = 32 + gi * 8 + j2;
            const unsigned r0 = __hip_atomic_fetch_add(cnt + s0, 1u, RLX_AGENT), r1 = __hip_atomic_fetch_add(cnt + s1, 1u, RLX_AGENT);
            ltok[(size_t)s0 * NTOK + r0] = tok; lgate[(size_t)s0 * NTOK + r0] = pg * w1; lrs[(size_t)s0 * NTOK + r0] = rstd;
            ltok[(size_t)s1 * NTOK + r1] = tok; lgate[(size_t)s1 * NTOK + r1] = pg * w2; lrs[(size_t)s1 * NTOK + r1] = rstd;
        }
    }
}
template <int CTRL> __device__ __forceinline__ float dpp_row_shr(float old, float src) {
    return __builtin_bit_cast(float, __builtin_amdgcn_update_dpp(__builtin_bit_cast(int, old), __builtin_bit_cast(int, src), CTRL, 0xf, 0xf, false));
}
__device__ __forceinline__ void rec1_unit(KArgs args, int L, int unit, LAS unsigned char* lds, int wave, int lane) {
    unsigned char* ws = args->ws;
    const bf16* z = (const bf16*)(ws + WS_Z);
    bf16* hloc = (bf16*)(ws + WS_HLOC); bf16* cumA = (bf16*)(ws + WS_CUMA); float* agg = (float*)(ws + WS_AGG);
    const int b = unit >> 4, chk = unit & 15, t0 = chk * 256, fr = lane & 15, q = lane >> 4, hb = wave;
    const float* Wa = args->in[I_WA] + ((size_t)(L * 8 + hb)) * 4096; const float* Wx = args->in[I_WX] + ((size_t)(L * 8 + hb)) * 4096;
    LAS unsigned char* wl = lds + wave * 16384;
#pragma unroll 1
    for (int f = 0; f < 16; ++f) { const int mat = f >> 3, n = (f >> 1) & 3, kk = f & 1; const float* W = mat ? Wx : Wa;
        const int jout = 8 * (fr >> 2) + (fr & 3) + 4 * (n & 1) + 32 * (n >> 1); const float* wp = W + (32 * kk + 8 * q) * 64 + jout;
        u32x4 w; w.x = pk2(wp[0], wp[64]); w.y = pk2(wp[128], wp[192]); w.z = pk2(wp[256], wp[320]); w.w = pk2(wp[384], wp[448]);
        *(LAS u32x4*)(wl + f * 1024 + lane * 16) = w; }
    LAS float* ct = (LAS float*)(lds + 131072 + wave * 2048);
    { const int c = 64 * hb + lane; const float* cw = args->in[I_CONVW] + (size_t)L * 4 * 512;
      ct[lane * 8 + 0] = cw[c]; ct[lane * 8 + 1] = cw[512 + c]; ct[lane * 8 + 2] = cw[1024 + c]; ct[lane * 8 + 3] = cw[1536 + c];
      ct[lane * 8 + 4] = args->in[I_CONVB][L * 512 + c]; ct[lane * 8 + 5] = args->in[I_BA][L * 512 + c]; ct[lane * 8 + 6] = args->in[I_BX][L * 512 + c];
      ct[lane * 8 + 7] = ((const float*)(ws + WS_C8))[L * 512 + c]; }
    LDS_WAIT();
    float Acar[2][8], Hcar[2][8];
#pragma unroll
    for (int kk = 0; kk < 2; ++kk)
#pragma unroll
        for (int e = 0; e < 8; ++e) { Acar[kk][e] = 1.f; Hcar[kk][e] = 0.f; }
    const bf16* zb = z + (size_t)(b * SEQ) * ZP + ZC_XR + 64 * hb;
    const int bidx15 = ((lane & ~15) | 15) << 2;
    u32x4 rawc[2][4];
#define REC_LOAD_TILE(dst_, tile_) do { const int t_ = t0 + (tile_) * 16 + fr; _Pragma("unroll") for (int kk_ = 0; kk_ < 2; ++kk_) _Pragma("unroll") for (int j_ = 0; j_ < 4; ++j_) { const int tt_ = t_ - 3 + j_; \
        dst_[kk_][j_] = *(const u32x4*)(zb + (size_t)(tt_ > 0 ? tt_ : 0) * ZP + 32 * kk_ + 8 * q); } } while (0)
    REC_LOAD_TILE(rawc, 0);
#pragma unroll 1
    for (int tile = 0; tile < 16; ++tile) {
        const int t = t0 + tile * 16 + fr; const bool edge = (t0 + tile * 16) == 0;
        u32x4 rawn[2][4];
        REC_LOAD_TILE(rawn, tile < 15 ? tile + 1 : 15);
        u32x4 xb[2];
#pragma unroll
        for (int kk = 0; kk < 2; ++kk) {
            float xc[8];
#pragma unroll
            for (int e = 0; e < 8; ++e) xc[e] = ct[(32 * kk + 8 * q + e) * 8 + 4];
#pragma unroll
            for (int j = 0; j < 4; ++j) { const int tt = t - 3 + j;
                u32x4 raw = rawc[kk][j];
                if (edge && tt < 0) raw = (u32x4){0u, 0u, 0u, 0u};
                const float xv[8] = {bflo(raw.x), bfhi(raw.x), bflo(raw.y), bfhi(raw.y), bflo(raw.z), bfhi(raw.z), bflo(raw.w), bfhi(raw.w)};
#pragma unroll
                for (int e = 0; e < 8; ++e) xc[e] += ct[(32 * kk + 8 * q + e) * 8 + j] * xv[e]; }
            xb[kk].x = pk2(xc[0], xc[1]); xb[kk].y = pk2(xc[2], xc[3]); xb[kk].z = pk2(xc[4], xc[5]); xb[kk].w = pk2(xc[6], xc[7]);
        }
        asm volatile("" ::: "memory");
#pragma unroll
        for (int kh = 0; kh < 2; ++kh) {
            f32x4 racc[2], iacc[2];
#pragma unroll
            for (int nn = 0; nn < 2; ++nn) { racc[nn] = (f32x4){0.f, 0.f, 0.f, 0.f}; iacc[nn] = (f32x4){0.f, 0.f, 0.f, 0.f};
#pragma unroll
                for (int kk = 0; kk < 2; ++kk) { const int n = 2 * kh + nn;
                    const bf16x8 fa = *(const LAS bf16x8*)(wl + ((0 * 4 + n) * 2 + kk) * 1024 + lane * 16), fx = *(const LAS bf16x8*)(wl + ((1 * 4 + n) * 2 + kk) * 1024 + lane * 16);
                    const bf16x8 xk = __builtin_bit_cast(bf16x8, xb[kk]);
                    racc[nn] = __builtin_amdgcn_mfma_f32_16x16x32_bf16(fa, xk, racc[nn], 0, 0, 0); iacc[nn] = __builtin_amdgcn_mfma_f32_16x16x32_bf16(fx, xk, iacc[nn], 0, 0, 0); } }
            const unsigned xw[4] = {xb[kh].x, xb[kh].y, xb[kh].z, xb[kh].w};
            float hv[8], av[8];
#pragma unroll
            for (int e = 0; e < 8; ++e) {
                const int nn = e >> 2, jj = e & 3; const int cb = (32 * kh + 8 * q + e) * 8;
                const float xcv = (e & 1) ? bfhi(xw[e >> 1]) : bflo(xw[e >> 1]);
                const float r = fsigmoid(racc[nn][jj] + ct[cb + 5]), ig = fsigmoid(iacc[nn][jj] + ct[cb + 6]);
                float a = __builtin_amdgcn_exp2f(ct[cb + 7] * r);
                float bb = __builtin_amdgcn_sqrtf(fmaxf(1.f - a * a, 0.f)) * (ig * xcv);
#define REC_SCAN_STEP(N_) asm volatile("s_nop 1\n\tv_fmac_f32_dpp %0, %0, %1 row_shr:" #N_ " row_mask:0xf bank_mask:0xf\n\ts_nop 1\n\tv_mul_f32_dpp %1, %1, %1 row_shr:" #N_ " row_mask:0xf bank_mask:0xf" : "+v"(bb), "+v"(a))
                REC_SCAN_STEP(1); REC_SCAN_STEP(2); REC_SCAN_STEP(4); REC_SCAN_STEP(8);
#undef REC_SCAN_STEP
                const float hl = a * Hcar[kh][e] + bb, ca = a * Acar[kh][e];
                hv[e] = hl; av[e] = ca;
                Hcar[kh][e] = __builtin_bit_cast(float, __builtin_amdgcn_ds_bpermute(bidx15, __builtin_bit_cast(int, hl))); Acar[kh][e] = __builtin_bit_cast(float, __builtin_amdgcn_ds_bpermute(bidx15, __builtin_bit_cast(int, ca)));
            }
            const size_t o = (size_t)(b * SEQ + t) * D_REC + 64 * hb + 32 * kh + 8 * q;
            u32x4 w; w.x = pk2(hv[0], hv[1]); w.y = pk2(hv[2], hv[3]); w.z = pk2(hv[4], hv[5]); w.w = pk2(hv[6], hv[7]);
            *(u32x4*)(hloc + o) = w;
            w.x = pk2(av[0], av[1]); w.y = pk2(av[2], av[3]); w.z = pk2(av[4], av[5]); w.w = pk2(av[6], av[7]);
            *(u32x4*)(cumA + o) = w;
            asm volatile("" ::: "memory");
        }
#pragma unroll
        for (int kk = 0; kk < 2; ++kk)
#pragma unroll
            for (int j = 0; j < 4; ++j) rawc[kk][j] = rawn[kk][j];
    }
#undef REC_LOAD_TILE
    if (fr == 0) {
#pragma unroll
        for (int kk = 0; kk < 2; ++kk)
#pragma unroll
            for (int e = 0; e < 8; ++e) { const int c = 64 * hb + 32 * kk + 8 * q + e; float* ap = agg + ((size_t)(b * 16 + chk) * 512 + c) * 2; ap[0] = Acar[kk][e]; ap[1] = Hcar[kk][e]; }
    }
}
__device__ __forceinline__ void rec2_rows(KArgs args, int gw, int NGW, int lane) {
    unsigned char* ws = args->ws;
    const bf16* z = (const bf16*)(ws + WS_Z); const bf16* hloc = (const bf16*)(ws + WS_HLOC); const bf16* cumA = (const bf16*)(ws + WS_CUMA);
    const float* carry = (const float*)(ws + WS_CARRY); bf16* mixed = (bf16*)(ws + WS_MIXED);
    constexpr int NR = 4;
    for (int m0 = gw * NR; m0 < NTOK; m0 += NGW * NR) {
        const int b = m0 >> 12, chk = (m0 & 4095) >> 8;
        u32x4 hl[NR], ca[NR], gr[NR];
#pragma unroll
        for (int r = 0; r < NR; ++r) { const size_t m = (size_t)(m0 + r); hl[r] = *(const u32x4*)(hloc + m * D_REC + 8 * lane); ca[r] = *(const u32x4*)(cumA + m * D_REC + 8 * lane); gr[r] = *(const u32x4*)(z + m * ZP + ZC_GR + 8 * lane); }
        const f32x4 c0 = *(const f32x4*)(carry + (size_t)(b * 16 + chk) * 512 + 8 * lane), c1 = *(const f32x4*)(carry + (size_t)(b * 16 + chk) * 512 + 8 * lane + 4);
#pragma unroll
        for (int r = 0; r < NR; ++r) { float v[8];
            v[0] = (bflo(hl[r].x) + bflo(ca[r].x) * c0.x) * fgelu(bflo(gr[r].x)); v[1] = (bfhi(hl[r].x) + bfhi(ca[r].x) * c0.y) * fgelu(bfhi(gr[r].x));
            v[2] = (bflo(hl[r].y) + bflo(ca[r].y) * c0.z) * fgelu(bflo(gr[r].y)); v[3] = (bfhi(hl[r].y) + bfhi(ca[r].y) * c0.w) * fgelu(bfhi(gr[r].y));
            v[4] = (bflo(hl[r].z) + bflo(ca[r].z) * c1.x) * fgelu(bflo(gr[r].z)); v[5] = (bfhi(hl[r].z) + bfhi(ca[r].z) * c1.y) * fgelu(bfhi(gr[r].z));
            v[6] = (bflo(hl[r].w) + bflo(ca[r].w) * c1.z) * fgelu(bflo(gr[r].w)); v[7] = (bfhi(hl[r].w) + bfhi(ca[r].w) * c1.w) * fgelu(bfhi(gr[r].w));
            float s = 0.f;
#pragma unroll
            for (int e = 0; e < 8; ++e) s += v[e] * v[e];
            const float rstd = rsqrtf(wave_sum(s) * (1.f / D_REC) + EPS);
            u32x4 w; w.x = pk2(v[0] * rstd, v[1] * rstd); w.y = pk2(v[2] * rstd, v[3] * rstd); w.z = pk2(v[4] * rstd, v[5] * rstd); w.w = pk2(v[6] * rstd, v[7] * rstd);
            *(u32x4*)(mixed + (size_t)(m0 + r) * DM + 8 * lane) = w; }
    }
}
__device__ __forceinline__ void phase_mid(KArgs args, int L, int G, int bid, int tid, int wave, int lane) {
    unsigned char* ws = args->ws;
    const float* agg = (const float*)(ws + WS_AGG); float* carry = (float*)(ws + WS_CARRY);
    const int gt = bid * (NWAVES * 64) + tid, NGT = G * NWAVES * 64;
    for (int i = gt; i < BATCH * 512; i += NGT) { const int b = i >> 9, c = i & 511; float Ak[16], Hk[16];
#pragma unroll
        for (int k = 0; k < 16; ++k) { const size_t o = (size_t)(b * 16 + k) * 512 + c; Ak[k] = agg[o * 2]; Hk[k] = agg[o * 2 + 1]; }
        float H = 0.f;
#pragma unroll
        for (int k = 0; k < 16; ++k) { carry[(size_t)(b * 16 + k) * 512 + c] = H; H = Ak[k] * H + Hk[k]; } }
    const bf16* hid = (const bf16*)(ws + WS_HIDC); const bf16* w2t = (const bf16*)(ws + WS_W2T);
    const int gw = bid * NWAVES + wave, NGW = G * NWAVES, fr = lane & 15, fq = lane >> 4;
    for (int task = gw; task < 2 * 512; task += NGW) {
        const int kv = task >> 9, grp = task & 511;
        const bf16* ar = hid + ((size_t)kv * 8192 + grp * 16 + fr) * 256 + 8 * fq;
        const bf16* br = w2t + ((size_t)(L * 2 + kv) * 64 + fr) * 256 + 8 * fq;
        const float* b2 = (kv ? args->in[I_BV2] : args->in[I_BK2]) + L * 64;
        f32x4 acc[4];
#pragma unroll
        for (int nt = 0; nt < 4; ++nt) { const float bb = b2[16 * nt + fr]; acc[nt] = (f32x4){bb, bb, bb, bb}; }
#pragma unroll
        for (int kk = 0; kk < 8; ++kk) { const bf16x8 a = *(const bf16x8*)(ar + 32 * kk);
#pragma unroll
            for (int nt = 0; nt < 4; ++nt) { const bf16x8 bfr = *(const bf16x8*)(br + (size_t)(16 * nt) * 256 + 32 * kk); acc[nt] = __builtin_amdgcn_mfma_f32_16x16x32_bf16(a, bfr, acc[nt], 0, 0, 0); } }
        bf16* outp = (bf16*)(ws + (kv ? WS_VCMP : WS_KCMP));
#pragma unroll
        for (int jj = 0; jj < 4; ++jj) { const int row = grp * 16 + 4 * fq + jj; const bool real = (row & 255) != 255;
#pragma unroll
            for (int nt = 0; nt < 4; ++nt) outp[(size_t)row * 64 + 16 * nt + fr] = real ? (bf16)f2bf(acc[nt][jj]) : (bf16)0; }
    }
}

typedef float f32x16 __attribute__((ext_vector_type(16)));
typedef short s16x4 __attribute__((ext_vector_type(4)));
typedef float f32x2_t __attribute__((ext_vector_type(2)));
typedef __bf16 bf16x2_t __attribute__((ext_vector_type(2)));
__device__ __forceinline__ unsigned cvtpk(float lo, float hi) { f32x2_t v = {lo, hi}; bf16x2_t b = __builtin_convertvector(v, bf16x2_t); return __builtin_bit_cast(unsigned, b); }
__device__ __forceinline__ void xhalf_pair(float m, float& lo, float& hi) {
    unsigned a = __builtin_bit_cast(unsigned, m), b = a; asm volatile("" : "+v"(b));
    auto rr = __builtin_amdgcn_permlane32_swap(a, b, false, false);
    unsigned r0 = rr[0], r1 = rr[1]; asm volatile("" : "+v"(r0), "+v"(r1));
    lo = __builtin_bit_cast(float, r0); hi = __builtin_bit_cast(float, r1);
}
__device__ __forceinline__ float xhalf_max(float m) { float a, b; xhalf_pair(m, a, b); return fmaxf(a, b); }
__device__ __forceinline__ float xhalf_sum(float m) { float a, b; xhalf_pair(m, a, b); return a + b; }
__device__ __forceinline__ s16x4 vtr(const LAS unsigned char* p) { return __builtin_bit_cast(s16x4, __builtin_amdgcn_ds_read_tr16_b64_v4i16((LAS s16x4*)p)); }
constexpr int ATT_NS = 4, ATT_PD = 3;
constexpr int ATT_IMP = 65536, ATT_SC = ATT_IMP + 4 * 64 * 65 * 4, ATT_MASK = ATT_SC + 64 * 65 * 4, ATT_UNION = ATT_MASK + 512, ATT_RED = ATT_UNION + 64;
static_assert(ATT_RED + 2048 <= MISC_OFF, "attention LDS map");
#define CI_(i) (((i) & 3) + 8 * ((i) >> 2))
__device__ __forceinline__ float max3f(float a, float b, float c) { float r; asm("v_max3_f32 %0, %1, %2, %3" : "=v"(r) : "v"(a), "v"(b), "v"(c)); return r; }

struct AttState { f32x16 O[2]; float m, l; bool fresh; };
__device__ __forceinline__ void att_stage(LAS unsigned char* lds, int slot, const char* kp, const char* vp, unsigned pitch, int wave, int lane) {
    const int key = 8 * wave + (lane >> 3), pc = lane & 7;
    const char* ks = kp + (size_t)key * pitch + ((pc ^ ((key >> 1) & 7)) << 4);
    const char* vs = vp + (size_t)key * pitch + ((pc ^ ((key & 3) << 1)) << 4);
    const unsigned dk = (unsigned)(unsigned long)(lds + slot * 16384 + wave * 1024), dv = dk + 8192u; unsigned keep;
    asm volatile("s_mov_b32 %0, m0\n\ts_mov_b32 m0, %2\n\ts_nop 0\n\tglobal_load_lds_dwordx4 %1, off\n\ts_mov_b32 m0, %0" : "=&s"(keep) : "v"(ks), "s"(dk) : "memory");
    asm volatile("s_mov_b32 %0, m0\n\ts_mov_b32 m0, %2\n\ts_nop 0\n\tglobal_load_lds_dwordx4 %1, off\n\ts_mov_b32 m0, %0" : "=&s"(keep) : "v"(vs), "s"(dv) : "memory");
}
__device__ __forceinline__ void att_qk64(const LAS unsigned char* Kb, const bf16x8 (&qf)[4], float sF, float cb, int rq, int h, f32x16& S0, f32x16& S1) {
    const LAS unsigned char* rowp = Kb + rq * 128; const int sw = (rq >> 1) & 7;
    bf16x8 kf[2][4];
#pragma unroll
    for (int sub = 0; sub < 2; ++sub)
#pragma unroll
        for (int s4 = 0; s4 < 4; ++s4) kf[sub][s4] = *(const LAS bf16x8*)(rowp + sub * 4096 + (((2 * s4 + h) ^ sw) << 4));
    const float base = cb + sF * (float)(4 * h);
    { const f32x2 d01 = {0.f, sF}, d23 = {sF + sF, 3.f * sF};
#pragma unroll
      for (int q4 = 0; q4 < 4; ++q4) { const float bq = fmaf(sF, (float)(8 * q4), base), bq1 = fmaf(sF, (float)(8 * q4 + 32), base);
          const f32x2 bb = {bq, bq}, bc = {bq1, bq1}; const f32x2 lo = bb + d01, hi = bb + d23, lo1 = bc + d01, hi1 = bc + d23;
          S0[4 * q4] = lo.x; S0[4 * q4 + 1] = lo.y; S0[4 * q4 + 2] = hi.x; S0[4 * q4 + 3] = hi.y; S1[4 * q4] = lo1.x; S1[4 * q4 + 1] = lo1.y; S1[4 * q4 + 2] = hi1.x; S1[4 * q4 + 3] = hi1.y; } }
    __builtin_amdgcn_sched_barrier(0);
#pragma unroll
    for (int s4 = 0; s4 < 4; ++s4) { S0 = __builtin_amdgcn_mfma_f32_32x32x16_bf16(kf[0][s4], qf[s4], S0, 0, 0, 0); S1 = __builtin_amdgcn_mfma_f32_32x32x16_bf16(kf[1][s4], qf[s4], S1, 0, 0, 0); }
    __builtin_amdgcn_sched_barrier(0);
}
__device__ __forceinline__ void att_mask(int sub, int h, int lim_lo, int lim_hi, f32x16& S) {
    const int hi2 = lim_hi - 32 * sub - 4 * h, lo2 = lim_lo - 32 * sub - 4 * h;
#pragma unroll
    for (int i = 0; i < 16; ++i) S[i] = (CI_(i) <= hi2 && CI_(i) > lo2) ? S[i] : -__builtin_inff();
}
template <bool IMP>
__device__ __forceinline__ void att_softmax_pv64(const bool MASKED, const LAS unsigned char* Vb, int lim_lo, int lim_hi, f32x16& S0, f32x16& S1, AttState& st, int h, int lane, LAS float* irow = nullptr, int ct = 0) {
    const int qd = (lane & 15) >> 2, pp = lane & 3, blk = (lane >> 4) & 1;
    const LAS unsigned char* vrow = Vb + (4 * h + qd) * 128 + (pp & 1) * 8;
    bf16x8 vf[2][4];
#pragma unroll
    for (int dt = 0; dt < 2; ++dt) { const int coff = ((dt * 4 + blk * 2 + (pp >> 1)) ^ (qd << 1)) << 4;
#pragma unroll
        for (int ks = 0; ks < 4; ++ks) { const s16x4 lo = vtr(vrow + coff + (16 * ks) * 128), hi = vtr(vrow + coff + (16 * ks + 8) * 128);
            vf[dt][ks] = __builtin_shufflevector(lo, hi, 0, 1, 2, 3, 4, 5, 6, 7); } }
    __builtin_amdgcn_sched_barrier(0);
    if (MASKED) { att_mask(0, h, lim_lo, lim_hi, S0); att_mask(1, h, lim_lo, lim_hi, S1); }
    float mx = max3f(S0[0], S0[1], S0[2]), my = max3f(S1[0], S1[1], S1[2]);
    mx = max3f(mx, S0[3], S0[4]); my = max3f(my, S1[3], S1[4]); mx = max3f(mx, S0[5], S0[6]); my = max3f(my, S1[5], S1[6]); mx = max3f(mx, S0[7], S0[8]); my = max3f(my, S1[7], S1[8]);
    mx = max3f(mx, S0[9], S0[10]); my = max3f(my, S1[9], S1[10]); mx = max3f(mx, S0[11], S0[12]); my = max3f(my, S1[11], S1[12]); mx = max3f(mx, S0[13], S0[14]); my = max3f(my, S1[13], S1[14]);
    mx = xhalf_max(max3f(mx, my, max3f(S0[15], S1[15], S1[15])));
    const bool fin = mx > -1e30f;
    const bool rb = fin && (mx > 8.f || st.fresh);
    if (__any(rb)) { const float d = rb ? mx : 0.f; const float corr = st.fresh ? 1.f : __builtin_amdgcn_exp2f(-d); st.l *= corr; st.m += d;
#pragma unroll
        for (int i = 0; i < 16; ++i) { st.O[0][i] *= corr; st.O[1][i] *= corr; S0[i] -= d; S1[i] -= d; }
        if (IMP) { if (h == 0 && corr != 1.f) { for (int j = 0; j < 64; ++j) irow[j] *= corr; } }
    }
    st.fresh = st.fresh && !fin;
    float ps = 0.f, pt = 0.f;
#pragma unroll
    for (int i = 0; i < 16; ++i) { S0[i] = __builtin_amdgcn_exp2f(S0[i]); S1[i] = __builtin_amdgcn_exp2f(S1[i]); ps += S0[i]; pt += S1[i]; }
    st.l += ps + pt;
    if (IMP) {
        float prev3 = 0.f; const int partner = (lane ^ 32) << 2;
#pragma unroll
        for (int f = 0; f < 8; ++f) { const f32x16& S_ = (f >> 2) ? S1 : S0; const int q4 = f & 3; const float p3 = S_[4 * q4 + 3];
            const float own = 2.f * (S_[4 * q4] + S_[4 * q4 + 1] + S_[4 * q4 + 2]) + p3;
            const float inc = __builtin_bit_cast(float, __builtin_amdgcn_ds_bpermute(partner, __builtin_bit_cast(int, h ? prev3 : p3)));
            irow[16 * ct + 2 * f + h] = own + inc;
            prev3 = p3; }
        if (h && ct < 3) __hip_atomic_fetch_add(irow + 16 * ct + 16, prev3, __ATOMIC_RELAXED, __HIP_MEMORY_SCOPE_WORKGROUP); }
    u32x4 pk[4];
#pragma unroll
    for (int s2 = 0; s2 < 2; ++s2) { pk[s2].x = cvtpk(S0[8 * s2], S0[8 * s2 + 1]); pk[s2].y = cvtpk(S0[8 * s2 + 2], S0[8 * s2 + 3]); pk[s2].z = cvtpk(S0[8 * s2 + 4], S0[8 * s2 + 5]); pk[s2].w = cvtpk(S0[8 * s2 + 6], S0[8 * s2 + 7]);
        pk[2 + s2].x = cvtpk(S1[8 * s2], S1[8 * s2 + 1]); pk[2 + s2].y = cvtpk(S1[8 * s2 + 2], S1[8 * s2 + 3]); pk[2 + s2].z = cvtpk(S1[8 * s2 + 4], S1[8 * s2 + 5]); pk[2 + s2].w = cvtpk(S1[8 * s2 + 6], S1[8 * s2 + 7]); }
    __builtin_amdgcn_sched_barrier(0);
#pragma unroll
    for (int ks = 0; ks < 4; ++ks)
#pragma unroll
        for (int dt = 0; dt < 2; ++dt) st.O[dt] = __builtin_amdgcn_mfma_f32_32x32x16_bf16(vf[dt][ks], __builtin_bit_cast(bf16x8, pk[ks]), st.O[dt], 0, 0, 0);
    __builtin_amdgcn_sched_barrier(0);
}
__device__ __forceinline__ void att_state_reset(AttState& st) {
#pragma unroll
    for (int i = 0; i < 16; ++i) { st.O[0][i] = 0.f; st.O[1][i] = 0.f; }
    st.m = 0.f; st.l = 0.f; st.fresh = true;
}
#define ATT_WAIT_BAR() asm volatile("s_waitcnt vmcnt(0) lgkmcnt(0)\n\ts_barrier" ::: "memory")
#define ATT_WAIT_BAR_PD() asm volatile("s_waitcnt vmcnt(4) lgkmcnt(0)\n\ts_barrier" ::: "memory")
#define ATT_WAIT_BAR_2() asm volatile("s_waitcnt vmcnt(2) lgkmcnt(0)\n\ts_barrier" ::: "memory")

__device__ __forceinline__ int opq_v(int x) { asm volatile("" : "+v"(x)); return x; }
__device__ __forceinline__ int opq_s(int x) { asm volatile("" : "+s"(x)); return x; }
#define ATT_IDS const int lane = opq_v(lane0), wave = opq_s(wave0); const int r = wave >> 1, th = wave & 1, rq = lane & 31, h = lane >> 5, tl = 32 * th + rq, t = qb * 64 + tl, tok = b * SEQ + t; (void)r; (void)t; (void)tok;
__device__ __forceinline__ void att_unit_mfma(KArgs args, int b, int qb, LAS unsigned char* lds, int wave0, int lane0, int tid0) {
    unsigned char* ws = args->ws;
    const bf16* z = (const bf16*)(ws + WS_Z); bf16* mixed = (bf16*)(ws + WS_MIXED);
    LAS float* imp = (LAS float*)(lds + ATT_IMP);
    LAS float* sc = (LAS float*)(lds + ATT_SC);
    LAS unsigned* maskw = (LAS unsigned*)(lds + ATT_MASK);
    LAS unsigned* unionw = (LAS unsigned*)(lds + ATT_UNION);
    LAS float* red = (LAS float*)(lds + ATT_RED);
    unsigned OUTP[16];
    const unsigned ZPB = ZP * 2;
#pragma unroll 1
    for (int g = 0; g < 2; ++g) {
        const int hd = 4 * g + (wave0 >> 1);
        bf16x8 qf[4]; float slope2, g0, g1, g2;
        { ATT_IDS const int tid = opq_v(tid0);
          const bf16* zrow = z + (size_t)tok * ZP;
#pragma unroll
          for (int s4 = 0; s4 < 4; ++s4) qf[s4] = *(const bf16x8*)(zrow + ZC_Q + hd * 64 + 16 * s4 + 8 * h);
          slope2 = exp2f(-(float)(hd + 1)) * LOG2E;
          g0 = fsigmoid(bf2f(zrow[ZC_NG + hd * 3 + 0])); g1 = fsigmoid(bf2f(zrow[ZC_NG + hd * 3 + 1])); g2 = fsigmoid(bf2f(zrow[ZC_NG + hd * 3 + 2]));
          LAS float* row = imp + (r * 64 + tl) * 65 + 32 * h;
#pragma unroll
          for (int j = 0; j < 32; ++j) row[j] = 0.f;
          if (tid < 128) maskw[tid] = 0u;
          if (tid < 2) unionw[tid] = 0u; }
        AttState st;
        { ATT_IDS
        const int jlo = qb - 8 > 0 ? qb - 8 : 0, nw = qb - jlo + 1;
        const int nk = (4 * qb + 3) < 255 ? (4 * qb + 3) : 255, nc = (nk + 63) >> 6, nA = nw + nc;
        const int nmax_t = (t >= 31) ? ((t - 31) >> 4) : -1;
        const char* kwb = (const char*)(z + (size_t)(b * SEQ) * ZP + ZC_KW + g * 64);
        const char* kcb = (const char*)(ws + WS_KCMP) + (size_t)((b * 2 + g) * 256) * 128; const char* vcb = (const char*)(ws + WS_VCMP) + (size_t)((b * 2 + g) * 256) * 128;
        const float sF = 16.f * slope2;
        float il_c = 0.f;
        LAS float* irow = imp + (r * 64 + tl) * 65;
#define ATT_STAGE_A(idx_) do { int ix_ = (idx_) < nA ? (idx_) : nA - 1; const int sl_ = (idx_) & 3; \
            if (ix_ < nw) { const char* kp_ = kwb + (size_t)(64 * (qb - ix_)) * ZPB; att_stage(lds, sl_, kp_, kp_ + (ZC_VW - ZC_KW) * 2, ZPB, wave, lane); } \
            else { ix_ -= nw; const size_t o_ = (size_t)(nc - 1 - ix_) * 64 * 128; att_stage(lds, sl_, kcb + o_, vcb + o_, 128, wave, lane); } } while (0)
        att_state_reset(st);
        ATT_STAGE_A(0); ATT_STAGE_A(1); ATT_STAGE_A(2);
        f32x16 Sa, Sb;
#pragma unroll 1
        for (int i = 0; i < nA; ++i) {
            ATT_WAIT_BAR_PD();
            ATT_STAGE_A(i + ATT_PD);
            const LAS unsigned char* Kb = lds + (i & 3) * 16384; const LAS unsigned char* Vb = Kb + 8192;
            if (i < nw) {
                const int j = qb - i;
                att_qk64(Kb, qf, slope2, slope2 * (float)(64 * j) - st.m, rq, h, Sa, Sb);
                att_softmax_pv64<false>((j == qb) || (j == qb - 8), Vb, (j == qb - 8) ? tl : -1, (j == qb) ? tl : 63, Sa, Sb, st, h, lane);
                if (i == nw - 1) { const float lt = xhalf_sum(st.l); const float go = g2 / fmaxf(lt, 1e-30f);
#pragma unroll
                    for (int k = 0; k < 8; ++k) { OUTP[k] = cvtpk(st.O[0][2 * k] * go, st.O[0][2 * k + 1] * go); OUTP[8 + k] = cvtpk(st.O[1][2 * k] * go, st.O[1][2 * k + 1] * go); }
                    att_state_reset(st); }
            } else {
                const int ct = nc - 1 - (i - nw);
                att_qk64(Kb, qf, sF, sF * (float)(64 * ct) - st.m, rq, h, Sa, Sb);
                att_softmax_pv64<true>(true, Vb, -1, nmax_t - 64 * ct, Sa, Sb, st, h, lane, irow, ct);
                if (i == nA - 1) { const float lt = xhalf_sum(st.l); il_c = 1.f / fmaxf(lt, 1e-30f); const float go = g0 * il_c;
                    if (h == 0) ((LAS float*)(lds + ATT_SC))[r * 64 + tl] = il_c;
#pragma unroll
                    for (int k = 0; k < 8; ++k) { OUTP[k] = cvtpk(bflo(OUTP[k]) + st.O[0][2 * k] * go, bfhi(OUTP[k]) + st.O[0][2 * k + 1] * go); OUTP[8 + k] = cvtpk(bflo(OUTP[8 + k]) + st.O[1][2 * k] * go, bfhi(OUTP[8 + k]) + st.O[1][2 * k + 1] * go); } }
            }
        }
#undef ATT_STAGE_A
        }
        ATT_WAIT_BAR();
        { ATT_IDS const char* ksb0 = (const char*)(z + (size_t)(b * SEQ) * ZP + ZC_KS + g * 64);
          const char* kp0 = ksb0 + (size_t)(64 * qb) * ZPB; att_stage(lds, 0, kp0, kp0 + (ZC_VS - ZC_KS) * 2, ZPB, wave, lane);
          const char* kp1 = ksb0 + (size_t)(64 * (qb > 0 ? qb - 1 : 0)) * ZPB; att_stage(lds, 1, kp1, kp1 + (ZC_VS - ZC_KS) * 2, ZPB, wave, lane); }
        { const int tid = opq_v(tid0); const int stok = tid >> 3, e8 = tid & 7; const LAS float* ilc = (const LAS float*)(lds + ATT_SC);
          unsigned key[8];
#pragma unroll
          for (int k = 0; k < 8; ++k) { const int j = 8 * e8 + k; const float v = imp[(0 * 64 + stok) * 65 + j] * ilc[stok] + imp[(1 * 64 + stok) * 65 + j] * ilc[64 + stok] + imp[(2 * 64 + stok) * 65 + j] * ilc[128 + stok] + imp[(3 * 64 + stok) * 65 + j] * ilc[192 + stok];
              const bool valid = j <= qb, forced = valid && (j == 0 || j == qb || j == qb - 1);
              const unsigned bits_ = __builtin_bit_cast(unsigned, forced ? 1e30f : (valid ? v : -1e30f));
              key[k] = ((bits_ ^ ((bits_ >> 31) ? 0xFFFFFFFFu : 0x80000000u)) & ~63u) | (unsigned)(63 - j); }
          unsigned T = 0u;
#pragma unroll 1
          for (int bit = 31; bit >= 0; --bit) { const unsigned cand = T | (1u << bit); int c = 0;
#pragma unroll
              for (int k = 0; k < 8; ++k) c += key[k] >= cand ? 1 : 0;
              c += __builtin_amdgcn_update_dpp(0, c, 0xB1, 0xf, 0xf, true);
              c += __builtin_amdgcn_update_dpp(0, c, 0x4E, 0xf, 0xf, true);
              c += __builtin_amdgcn_update_dpp(0, c, 0x141, 0xf, 0xf, true);
              T = c >= NTOP ? cand : T; }
          unsigned bits = 0u;
#pragma unroll
          for (int k = 0; k < 8; ++k) bits |= (key[k] >= T && 8 * e8 + k <= qb) ? (1u << k) : 0u;
          if (bits) { __hip_atomic_fetch_or(maskw + stok * 2 + (e8 >> 2), bits << (8 * (e8 & 3)), __ATOMIC_RELAXED, __HIP_MEMORY_SCOPE_WORKGROUP); __hip_atomic_fetch_or(unionw + (e8 >> 2), bits << (8 * (e8 & 3)), __ATOMIC_RELAXED, __HIP_MEMORY_SCOPE_WORKGROUP); }
        }
        __syncthreads();
        { ATT_IDS
        const unsigned mlo = maskw[tl * 2], mhi = maskw[tl * 2 + 1];
        unsigned long long un = ((unsigned long long)unionw[1] << 32) | unionw[0];
        const char* ksb = (const char*)(z + (size_t)(b * SEQ) * ZP + ZC_KS + g * 64);
        att_state_reset(st);
        int jq[4];
#pragma unroll
        for (int p = 0; p < 4; ++p) { if (un) { jq[p] = 63 - __builtin_clzll(un); un &= ~(1ull << jq[p]); } else jq[p] = -1; }
        int jlast = jq[0];
#pragma unroll
        for (int p = 0; p < 3; ++p) { if (jq[p] >= 0) jlast = jq[p]; if (p == 2) { const char* kp_ = ksb + (size_t)(64 * jlast) * ZPB; att_stage(lds, p, kp_, kp_ + (ZC_VS - ZC_KS) * 2, ZPB, wave, lane); } }
        f32x16 Sa, Sb;
#pragma unroll 1
        for (int i = 0; jq[0] >= 0; ++i) {
            ATT_WAIT_BAR_PD();
            { if (jq[3] >= 0) jlast = jq[3]; const char* kp_ = ksb + (size_t)(64 * jlast) * ZPB; att_stage(lds, (i + 3) & 3, kp_, kp_ + (ZC_VS - ZC_KS) * 2, ZPB, wave, lane); }
            const LAS unsigned char* Kb = lds + (i & 3) * 16384; const LAS unsigned char* Vb = Kb + 8192;
            const int j = jq[0];
            const bool bit = ((j < 32 ? (mlo >> j) : (mhi >> (j - 32))) & 1u) != 0u;
            att_qk64(Kb, qf, slope2, bit ? slope2 * (float)(64 * j) - st.m : -__builtin_inff(), rq, h, Sa, Sb);
            att_softmax_pv64<false>(j == qb, Vb, -1, tl, Sa, Sb, st, h, lane);
            jq[0] = jq[1]; jq[1] = jq[2]; jq[2] = jq[3];
            if (un) { jq[3] = 63 - __builtin_clzll(un); un &= ~(1ull << jq[3]); } else jq[3] = -1;
        }
        { const float lt = xhalf_sum(st.l); const float go = g1 / fmaxf(lt, 1e-30f);
          float ss = 0.f;
#pragma unroll
          for (int i = 0; i < 8; ++i) { const float a0 = bflo(OUTP[i]) + st.O[0][2 * i] * go, a1 = bfhi(OUTP[i]) + st.O[0][2 * i + 1] * go, c0 = bflo(OUTP[8 + i]) + st.O[1][2 * i] * go, c1 = bfhi(OUTP[8 + i]) + st.O[1][2 * i + 1] * go;
              ss += (a0 * a0 + a1 * a1) + (c0 * c0 + c1 * c1); OUTP[i] = cvtpk(a0, a1); OUTP[8 + i] = cvtpk(c0, c1); }
          ss = xhalf_sum(ss);
          if (h == 0) red[hd * 64 + tl] = ss;
          if (g == 0) { bf16* orow = mixed + (size_t)tok * DM + 512 + hd * 64;
#pragma unroll
              for (int dt = 0; dt < 2; ++dt)
#pragma unroll
                  for (int q4 = 0; q4 < 4; ++q4) { u32x2 w; w.x = OUTP[8 * dt + 2 * q4]; w.y = OUTP[8 * dt + 2 * q4 + 1]; *(u32x2*)(orow + 32 * dt + 8 * q4 + 4 * h) = w; } } }
        }
        ATT_WAIT_BAR();
    }
    ATT_IDS
    float tot = 0.f;
#pragma unroll
    for (int h2 = 0; h2 < 8; ++h2) tot += red[h2 * 64 + tl];
    const float rstd = rsqrtf(tot * (1.f / 512.f) + EPS);
    { bf16* orow = mixed + (size_t)tok * DM + 512 + (4 + r) * 64;
#pragma unroll
      for (int dt = 0; dt < 2; ++dt)
#pragma unroll
          for (int q4 = 0; q4 < 4; ++q4) { u32x2 w; const unsigned p0 = OUTP[8 * dt + 2 * q4], p1 = OUTP[8 * dt + 2 * q4 + 1];
              w.x = cvtpk(bflo(p0) * rstd, bfhi(p0) * rstd); w.y = cvtpk(bflo(p1) * rstd, bfhi(p1) * rstd);
              *(u32x2*)(orow + 32 * dt + 8 * q4 + 4 * h) = w; } }
    { bf16* orow = mixed + (size_t)tok * DM + 512 + r * 64;
#pragma unroll
      for (int dt = 0; dt < 2; ++dt)
#pragma unroll
          for (int q4 = 0; q4 < 4; ++q4) { u32x2 w = *(const u32x2*)(orow + 32 * dt + 8 * q4 + 4 * h);
              w.x = cvtpk(bflo(w.x) * rstd, bfhi(w.x) * rstd); w.y = cvtpk(bflo(w.y) * rstd, bfhi(w.y) * rstd);
              *(u32x2*)(orow + 32 * dt + 8 * q4 + 4 * h) = w; } }
    __syncthreads();
}

constexpr int NPH_LAYER = 11, PH_FINAL = 1 + DEPTH * NPH_LAYER, N_PHASES = PH_FINAL + 1;
__global__ void __launch_bounds__(NWAVES * 64, 2) fwd_kernel(Args args) {
    extern __shared__ __attribute__((aligned(16))) unsigned char lds_raw[];
    LAS unsigned char* lds = (LAS unsigned char*)lds_raw;
    volatile LAS unsigned* MISC = (volatile LAS unsigned*)(lds + MISC_OFF);
    const int G0 = gridDim.x, bid0 = blockIdx.x;
    const int wave_s = __builtin_amdgcn_readfirstlane(threadIdx.x >> 6);
#define PHASE_IDS KArgs ka = ka_get(); int G = G0, bid = bid0; asm volatile("" : "+s"(G), "+s"(bid)); unsigned char* ws = ka->ws; (void)ws; int tid = wave_s * 64 + lane_id(); asm volatile("" : "+v"(tid)); const int lane = tid & 63, wave = wave_s; const int gw = bid * NWAVES + wave, NGW = G * NWAVES; (void)lane; (void)gw; (void)NGW;
    if (wave_s == 0) MISC[lane_id()] = 0u;
    __syncthreads();
#if MK_MULTI
#define GRID_BAR() do { } while (0)
#else
    XcdBarrier bar = xcd_barrier_post((unsigned*)(args.ws + WS_CTL) + CW_BAR, MISC + 8, wave_s);
#define GRID_BAR() xcd_barrier(bar)
#endif
#ifndef PH_MASK
#define PH_MASK 0xFFFF
#endif
#define IN(k) (ka_get()->ph_lo <= (k) && (k) < ka_get()->ph_hi)
#define EN(j) ((PH_MASK >> (j)) & 1)
#define SEAM(k) do { if (IN(k) && IN((k) + 1)) GRID_BAR(); } while (0)
#define HC_ ((bf16*)(ws + ((L & 1) ? WS_U : WS_H16)))
#define HN_ ((bf16*)(ws + ((L & 1) ? WS_H16 : WS_U)))
#define Z_ ((bf16*)(ws + WS_Z))
#define MIXED_ ((bf16*)(ws + WS_MIXED))
#define WL_ (ws + WS_W + (size_t)L * W_LAYER)

    if (EN(11) && IN(0)) { PHASE_IDS REP_(11) { phase_prologue(ka, lds, G, bid, tid, wave, lane); __syncthreads(); } SEAM(0); }

    for (int L = 0; L < DEPTH; ++L) {
        const int P = 1 + L * NPH_LAYER;
        if (EN(0) && IN(P + 0)) { PHASE_IDS REP_(0) phase_norm1(L == 0 ? ka->in[I_X] : nullptr, HC_, (float*)(ws + WS_RS1), gw, NGW, lane); SEAM(P + 0); }
        if (EN(1) && IN(P + 1)) {
            PHASE_IDS
            pg8::DenseSched S; S.init(HC_, DM, (const bf16*)(WL_ + WO_IN), NTOK, ZP, DM, G, bid);
            pg8::EpiBf16<0> E{Z_, ZP, nullptr, 0, 0, (const float*)(ws + WS_RS1)};
            REP_(1) pg8::gemm_phase(lds, DM, S, E, wave_s);
            SEAM(P + 1);
        }
        if (EN(2) && IN(P + 2)) {
            { PHASE_IDS
            if (EN(12)) REP_(2) for (int unit = bid; unit < BATCH * 16; unit += G) rec1_unit(ka, L, unit, lds, wave, lane);
            { const int ncv = G > 64 ? G - 64 : G, mycv = G > 64 ? bid - 64 : bid;
              if (mycv >= 0) tr_run<1>(ka, (LAS float*)(lds + wave * 16384), lane, mycv * NWAVES + wave, ncv * NWAVES, L); }
            }
            __syncthreads();
            if (EN(13)) { PHASE_IDS
            pg8::CmpSched S{Z_, (const bf16*)(WL_ + WO_K1), (const bf16*)(WL_ + WO_V1), G, bid};
            pg8::EpiBf16<1> E{(bf16*)(ws + WS_HIDC), 256, (const float*)(ws + WS_BK1) + L * 512, (size_t)8192 * 256, 256, nullptr};
            REP_(2) pg8::gemm_phase(lds, 2048, S, E, wave_s); }
            SEAM(P + 2);
        }
        if (EN(3) && IN(P + 3)) { PHASE_IDS REP_(3) phase_mid(ka, L, G, bid, tid, wave, lane); SEAM(P + 3); }
        if (EN(4) && IN(P + 4)) {
            PHASE_IDS
            REP_(4)
            if (G == 256) { for (int i = 0; i < 4; ++i) att_unit_mfma(ka, 2 * (bid & 7) + (i >> 1), (i & 1) ? 63 - (bid >> 3) : (bid >> 3), lds, wave, lane, tid); }
            else { for (int unit = bid; unit < BATCH * 64; unit += G) att_unit_mfma(ka, unit >> 6, unit & 63, lds, wave, lane, tid); }
            REP_(12) rec2_rows(ka, gw, NGW, lane);
            SEAM(P + 4);
        }
        if (EN(5) && IN(P + 5)) {
            PHASE_IDS
            pg8::DenseSched S; S.init(MIXED_, DM, (const bf16*)(WL_ + WO_OUT), NTOK, DM, DM, G, bid);
            pg8::EpiResid E{HC_};
            pg8::gemm_phase(lds, DM, S, E, wave_s);
            SEAM(P + 5);
        }
        if (EN(6) && IN(P + 6)) { PHASE_IDS phase_norm2(ka, HC_, L, lds, G, bid, tid, wave, lane); SEAM(P + 6); }
        if ((EN(7) || EN(8)) && (IN(P + 7) || IN(P + 8))) {
            LAS int* tab = (LAS int*)(lds + TAB_OFF);
            { PHASE_IDS
            __syncthreads();
            if (tid < 64) { const int c = (int)__hip_atomic_load((gu32*)(ws + WS_CTL) + CW_CNT + L * 64 + tid, RLX_AGENT); tab[80 + tid] = c; tab[160 + tid] = (c + 255) >> 8; }
            __syncthreads();
            if (tid == 0) { int s = 0; for (int i = 0; i < 64; ++i) { tab[i] = s; s += tab[160 + i]; } tab[64] = s; }
            __syncthreads(); }
            if (EN(7) && IN(P + 7)) { PHASE_IDS
                pg8::MoeSched<1> S{tab, HC_, (const bf16*)(WL_ + WO_GU), (const int*)(ws + WS_LTOK), G, bid};
                pg8::EpiSwiglu E{(bf16*)(ws + WS_HID), tab, (const float*)(ws + WS_LRS)};
                REP_(7) pg8::gemm_phase(lds, DM, S, E, wave_s);
                SEAM(P + 7);
            }
            if (EN(8) && IN(P + 8)) { PHASE_IDS
                pg8::MoeSched<2> S{tab, (const bf16*)(ws + WS_HID), (const bf16*)(WL_ + WO_D), (const int*)(ws + WS_LTOK), G, bid};
                pg8::EpiMoeDown E{tab, (const int*)(ws + WS_LTOK), (const float*)(ws + WS_LGATE), (bf16*)(ws + WS_Y0), (bf16*)(ws + WS_Y1)};
                REP_(8) pg8::gemm_phase(lds, DEXP, S, E, wave_s);
                SEAM(P + 8);
            }
        }
        if (EN(9) && IN(P + 9)) { PHASE_IDS phase_norm3(HC_, (const bf16*)(ws + WS_Y0), (const bf16*)(ws + WS_Y1), (float*)(ws + WS_RS3), ka->in[I_P] + (size_t)L * NTOK * D_PLE, (bf16*)(ws + WS_PB), gw, NGW, lane); SEAM(P + 9); }
        if (EN(10) && IN(P + 10)) {
            if (EN(14)) { PHASE_IDS pg8::DenseSched S; S.init(HC_, DM, (const bf16*)(WL_ + WO_PG), NTOK, DM, DM, G, bid);
              pg8::EpiBf16<2> E{(bf16*)(ws + WS_G), DM, ka->in[I_BPG] + L * DM, 0, 0, (const float*)(ws + WS_RS3)};
              REP_(10) pg8::gemm_phase(lds, DM, S, E, wave_s); }
            __syncthreads();
            if (EN(15)) { PHASE_IDS pg8::DenseSched S; S.init((const bf16*)(ws + WS_PB), D_PLE, (const bf16*)(WL_ + WO_PU), NTOK, DM, D_PLE, G, bid);
              pg8::EpiPleB E{HC_, HN_, (const bf16*)(ws + WS_G)};
              pg8::gemm_phase(lds, D_PLE, S, E, wave_s); }
            SEAM(P + 10);
        }
    }
    if (IN(PH_FINAL)) { PHASE_IDS phase_final((const bf16*)(ws + ((DEPTH & 1) ? WS_U : WS_H16)), ka->out, ka->in[I_FINN], gw, NGW, lane); }
#undef IN
#undef SEAM
}

extern "C" void kernel_launch(void* const* d_in, const int* in_sizes, int n_in, void* d_out, int out_size, void* d_ws, size_t ws_size, hipStream_t stream) {
    static int grid = 0;
    if (grid == 0) {
        if (n_in != 37 || in_sizes[0] != NTOK * DM || out_size != NTOK * DM || ws_size < WS_END) {
            fprintf(stderr, "kernel_launch: unexpected shapes (n_in %d, in0 %d, out %d, ws %zu < %zu); nothing launched\n", n_in, n_in > 0 ? in_sizes[0] : -1, out_size, ws_size, (size_t)WS_END); grid = -1; return; }
        int dev = 0, cus = 0, per_cu = 0;
        if (hipGetDevice(&dev) != hipSuccess || hipDeviceGetAttribute(&cus, hipDeviceAttributeMultiprocessorCount, dev) != hipSuccess) { grid = -1; return; }
        if (hipFuncSetAttribute((const void*)fwd_kernel, hipFuncAttributeMaxDynamicSharedMemorySize, LDS_BYTES) != hipSuccess) { fprintf(stderr, "kernel_launch: hipFuncSetAttribute failed\n"); grid = -1; return; }
        if (hipOccupancyMaxActiveBlocksPerMultiprocessor(&per_cu, (const void*)fwd_kernel, NWAVES * 64, LDS_BYTES) != hipSuccess || per_cu < 1)
            fprintf(stderr, "kernel_launch: note: occupancy query reports %d workgroups per CU\n", per_cu);
        (void)hipGetLastError();
        grid = cus;
    }
    if (grid < 0) return;
    if (hipMemsetAsync((char*)d_ws + WS_CTL, 0, CTL_ZERO_BYTES, stream) != hipSuccess) return;
    Args a{};
    for (int i = 0; i < 37; ++i) a.in[i] = (const float*)d_in[i];
    a.out = (float*)d_out; a.ws = (unsigned char*)d_ws;
#if MK_MULTI
    for (int p = 0; p < N_PHASES; ++p) { a.ph_lo = p; a.ph_hi = p + 1; hipLaunchKernelGGL(fwd_kernel, dim3(grid), dim3(NWAVES * 64), LDS_BYTES, stream, a); }
#else
    a.ph_lo = 0; a.ph_hi = N_PHASES;
    hipLaunchKernelGGL(fwd_kernel, dim3(grid), dim3(NWAVES * 64), LDS_BYTES, stream, a);
#endif
    const hipError_t le = hipPeekAtLastError();
    if (le != hipSuccess) fprintf(stderr, "kernel_launch: launch failed: %s\n", hipGetErrorName(le));
}
```

```cpp
#include <hip/hip_runtime.h>
#include <cstdio>
#include <cstdint>

#ifndef PROBE_MASK
#define PROBE_MASK 0
#endif
#define REP_(j) for (int rep_ = 0; rep_ < 1 + ((PROBE_MASK >> (j)) & 1); ++rep_)
#ifndef MK_MULTI
#define MK_MULTI 0
#endif

#define GAS __attribute__((address_space(1)))
#define LAS __attribute__((address_space(3)))
typedef unsigned short bf16;
typedef float f32x4 __attribute__((ext_vector_type(4)));
typedef float f32x2 __attribute__((ext_vector_type(2)));
typedef unsigned u32x4 __attribute__((ext_vector_type(4)));
typedef unsigned u32x2 __attribute__((ext_vector_type(2)));
typedef short bf16x8 __attribute__((ext_vector_type(8)));
typedef GAS unsigned gu32;
#define RLX_AGENT __ATOMIC_RELAXED, __HIP_MEMORY_SCOPE_AGENT
#define LDS_WAIT() asm volatile("s_waitcnt lgkmcnt(0)" ::: "memory")
#define VM_WAIT() asm volatile("s_waitcnt vmcnt(0)" ::: "memory")

constexpr int BATCH = 16, SEQ = 4096, DM = 1024, DEPTH = 4, NTOK = BATCH * SEQ;
constexpr int D_PLE = 256, D_REC = 512, NH = 8, HD = 64, NKV = 2;
constexpr int D_IN = 2328, ZP = 2560;
constexpr int ZC_XR = 0, ZC_GR = 512, ZC_Q = 1024, ZC_KC = 1536, ZC_VC = 1664, ZC_KS = 1792, ZC_VS = 1920, ZC_KW = 2048, ZC_VW = 2176, ZC_NG = 2304;
constexpr int NCMP = 255, NSELB = 64, NTOP = 16, WIN = 512;
constexpr int NEXP = 32, DEXP = 512, NSEG = 64;
constexpr float EPS = 1e-6f;
constexpr float LOG2E = 1.4426950408889634f;
constexpr int NWAVES = 8;

constexpr size_t MiB = 1u << 20;
constexpr size_t WS_CTL = 0, CTL_ZERO_BYTES = 1 * MiB;
constexpr size_t WS_BK1 = 1 * MiB;
constexpr size_t WS_C8 = WS_BK1 + 8192;
constexpr size_t WS_WRT = WS_C8 + 8192;
constexpr size_t WS_AGG = 2 * MiB;
constexpr size_t WS_CARRY = 3 * MiB;
constexpr size_t WS_W2T = 4 * MiB;
constexpr size_t WS_KCMP = 5 * MiB, WS_VCMP = 7 * MiB;
constexpr size_t WS_RS1 = 6 * MiB, WS_RS3 = 6 * MiB + 512 * 1024;
constexpr size_t WS_HIDC = 9 * MiB;
constexpr size_t WS_LTOK = 17 * MiB, WS_LGATE = 33 * MiB;
constexpr size_t WS_PB = 49 * MiB;
constexpr size_t WS_W = 81 * MiB, W_LAYER = 108 * MiB;
constexpr size_t WO_IN = 0, WO_OUT = 5 * MiB, WO_PG = 7 * MiB, WO_PU = 9 * MiB, WO_K1 = 9 * MiB + 512 * 1024, WO_V1 = 10 * MiB + 512 * 1024, WO_GU = 12 * MiB, WO_D = 76 * MiB;
constexpr size_t WS_U = 513 * MiB;
constexpr size_t WS_Z = 641 * MiB;
constexpr size_t WS_HID = WS_Z;
constexpr size_t WS_G = WS_Z + 160 * MiB;
constexpr size_t WS_MIXED = 962 * MiB;
constexpr size_t WS_HLOC = 1090 * MiB, WS_CUMA = 1154 * MiB;
constexpr size_t WS_Y0 = WS_MIXED, WS_Y1 = WS_HLOC;
constexpr size_t WS_LRS = 1218 * MiB;
constexpr size_t WS_H16 = 1234 * MiB;
constexpr size_t WS_END = 1362 * MiB;
constexpr int CW_BAR = 4096;
constexpr int CW_CNT = 16384;
constexpr int CW_BK1 = 32768;
constexpr int LDS_BYTES = 163840;
constexpr int TAB_OFF = 147456;
constexpr int MISC_OFF = 147456 + 4096;

typedef float pk2_f32x2 __attribute__((ext_vector_type(2)));
typedef __bf16 pk2_bf16x2 __attribute__((ext_vector_type(2)));
__device__ __forceinline__ unsigned pk2(float lo, float hi) { const pk2_f32x2 v = {lo, hi}; return __builtin_bit_cast(unsigned, __builtin_convertvector(v, pk2_bf16x2)); }
__device__ __forceinline__ unsigned f2bf(float f) { return pk2(f, 0.f) & 0xffffu; }
__device__ __forceinline__ float bflo(unsigned u) { return __builtin_bit_cast(float, u << 16); }
__device__ __forceinline__ float bfhi(unsigned u) { return __builtin_bit_cast(float, u & 0xffff0000u); }
__device__ __forceinline__ float bf2f(bf16 b) { return __builtin_bit_cast(float, (unsigned)b << 16); }
__device__ __forceinline__ float fsigmoid(float x) { return __builtin_amdgcn_rcpf(1.f + __builtin_amdgcn_exp2f(-x * LOG2E)); }
__device__ __forceinline__ float fgelu(float x) { const float y = 1.5957691216057308f * (x + 0.044715f * x * x * x); return x * __builtin_amdgcn_rcpf(1.f + __builtin_amdgcn_exp2f(-y * LOG2E)); }
__device__ __forceinline__ int lane_id() { int x; asm volatile("v_mbcnt_lo_u32_b32 %0, -1, 0\n\tv_mbcnt_hi_u32_b32 %0, -1, %0" : "=v"(x)); return x; }
template <int CTRL> __device__ __forceinline__ float dpp_mov(float src) {
    return __builtin_bit_cast(float, __builtin_amdgcn_update_dpp(0, __builtin_bit_cast(int, src), CTRL, 0xf, 0xf, true));
}
__device__ __forceinline__ float wave_sum(float v) {
    v += dpp_mov<0xB1>(v);
    v += dpp_mov<0x4E>(v);
    v += dpp_mov<0x141>(v);
    v += dpp_mov<0x140>(v);
    const float r0 = __builtin_bit_cast(float, __builtin_amdgcn_readlane(__builtin_bit_cast(int, v), 0)), r1 = __builtin_bit_cast(float, __builtin_amdgcn_readlane(__builtin_bit_cast(int, v), 16));
    const float r2 = __builtin_bit_cast(float, __builtin_amdgcn_readlane(__builtin_bit_cast(int, v), 32)), r3 = __builtin_bit_cast(float, __builtin_amdgcn_readlane(__builtin_bit_cast(int, v), 48));
    return (r0 + r1) + (r2 + r3);
}

namespace pg8 {
#define PG8_LAS __attribute__((address_space(3)))
typedef unsigned short bf16_t;
constexpr int BM = 256, BK = 64, HALF = 128, HTB = HALF * BK * 2, STAGE_BYTES = 8 * HTB, NXCD = 8, WGM = 8;
__host__ __device__ __forceinline__ int lds_byte(int r, int c) { const int st = (r >> 4) * 2 + (c >> 5), rr = r & 15, cc = c & 31, ob = rr * 64 + cc * 2; return st * 1024 + (ob ^ (((ob >> 9) & 1) << 5)); }
__host__ __device__ __forceinline__ void stage_rc(int b, int& R, int& C) { const int st = b / 1024, sb = b % 1024, swz = sb ^ (((sb >> 9) & 1) << 5); R = (st >> 1) * 16 + swz / 64; C = (st & 1) * 32 + (swz % 64) / 2; }
__host__ __device__ __forceinline__ int perm32(int rho) { const int n = rho >> 4, i = rho & 15; return 8 * (i >> 2) + 4 * n + (i & 3); }
struct Unit { int pm, pn, a0, a1; };
__device__ __forceinline__ unsigned cvt_pk_bf16(float lo, float hi) { unsigned r; asm volatile("v_cvt_pk_bf16_f32 %0, %1, %2" : "=v"(r) : "v"(lo), "v"(hi)); return r; }

template <class Epi, class Sched>
__device__ __forceinline__ void gemm_phase(PG8_LAS unsigned char* lds, const int K, const Sched& S, const Epi& E, const int wave_s) {
    int tid_o = wave_s * 64 + lane_id(); asm volatile("" : "+v"(tid_o));
    const int tid = tid_o, wid = __builtin_amdgcn_readfirstlane(tid >> 6), lane = tid & 63, wr = wid >> 2, wc = wid & 3, fr = lane & 15, fq = lane >> 4;
    const int nt = K / BK;
    int Rr[2], Cc[2]; unsigned voffB[2];
#pragma unroll
    for (int i = 0; i < 2; ++i) { int R, C; stage_rc(tid * 16 + i * 8192, R, C); Rr[i] = R; Cc[i] = C; const int Rb = (R & ~31) + perm32(R & 31); voffB[i] = (unsigned)(Rb * K + C) * 2u; }
    const size_t kstepB = (size_t)(BK * 2), kstepA = S.kstepA();
    const size_t hstepB = (size_t)HALF * K * 2;
    const unsigned ldsw = (unsigned)wid * 1024u;
    const int aoff = lds_byte(wr * 64 + fr, fq * 8), boff = lds_byte(wc * 32 + fr, fq * 8);
#define PG8_SA(b, h) (((b) * 2 + (h)) * HTB)
#define PG8_SB(b, h) ((4 + (b) * 2 + (h)) * HTB)
#define PG8_STAGE(bufoff, gbase, voff) do { _Pragma("unroll") for (int _i = 0; _i < 2; ++_i) \
        __builtin_amdgcn_global_load_lds((const unsigned*)((const char*)(gbase) + (voff)[_i]), (PG8_LAS unsigned*)(lds + (bufoff) + ldsw + _i * 8192), 16, 0, 0); } while (0)
#define PG8_LDA(dst, b, h) do { _Pragma("unroll") for (int m = 0; m < 4; ++m) _Pragma("unroll") for (int k = 0; k < 2; ++k) dst[m][k] = *(const PG8_LAS bf16x8*)(lds + PG8_SA(b, h) + aoff + m * 2048 + k * 1024); } while (0)
#define PG8_LDB(dst, b, h) do { _Pragma("unroll") for (int n = 0; n < 2; ++n) _Pragma("unroll") for (int k = 0; k < 2; ++k) dst[n][k] = *(const PG8_LAS bf16x8*)(lds + PG8_SB(b, h) + boff + n * 2048 + k * 1024); } while (0)
#define PG8_MMA(ai, bj, At, Bt) do { __builtin_amdgcn_s_setprio(1); _Pragma("unroll") for (int m = 0; m < 4; ++m) _Pragma("unroll") for (int n = 0; n < 2; ++n) _Pragma("unroll") for (int k = 0; k < 2; ++k) \
        acc[ai][bj][m][n] = __builtin_amdgcn_mfma_f32_16x16x32_bf16(Bt[n][k], At[m][k], acc[ai][bj][m][n], 0, 0, 0); __builtin_amdgcn_s_setprio(0); } while (0)
#define PG8_WAIT_V(n) asm volatile("s_waitcnt vmcnt(" #n ")" ::: "memory")
#define PG8_WAIT_L(n) asm volatile("s_waitcnt lgkmcnt(" #n ")" ::: "memory")
#define PG8_BAR __builtin_amdgcn_s_barrier()
#define PG8_SCHED __builtin_amdgcn_sched_barrier(0)
    Unit cur, nxt; int ui = 0;
    if (!S.next(0, cur)) return;
    f32x4 acc[2][2][4][2];
#pragma unroll
    for (int a = 0; a < 2; ++a)
#pragma unroll
        for (int b = 0; b < 2; ++b)
#pragma unroll
            for (int m = 0; m < 4; ++m)
#pragma unroll
                for (int n = 0; n < 2; ++n) acc[a][b][m][n] = (f32x4){0.f, 0.f, 0.f, 0.f};
    bf16x8 At[4][2], B0[2][2], B1[2][2];
    unsigned vA[2][2], vN[2][2];
    S.a_voff(cur, Rr, Cc, vA);
    const char* cA = S.a_base(cur); const char* cB = S.b_base(cur);
    PG8_STAGE(PG8_SB(0, 0), cB, voffB); PG8_STAGE(PG8_SB(0, 1), cB + hstepB, voffB); PG8_STAGE(PG8_SA(0, 0), cA, vA[0]); PG8_STAGE(PG8_SA(0, 1), cA, vA[1]);
    if (wr == 1) PG8_BAR;
    PG8_WAIT_V(2); PG8_BAR;
    PG8_STAGE(PG8_SB(1, 0), cB + kstepB, voffB); PG8_STAGE(PG8_SA(1, 0), cA + kstepA, vA[0]); PG8_STAGE(PG8_SB(1, 1), cB + hstepB + kstepB, voffB);
    PG8_WAIT_V(6); PG8_BAR;
    for (;;) {
        const bool has_next = S.next(ui + 1, nxt);
        const char* nA = cA; const char* nB = cB;
#pragma unroll
        for (int h = 0; h < 2; ++h)
#pragma unroll
            for (int i = 0; i < 2; ++i) vN[h][i] = vA[h][i];
        if (has_next) { nA = S.a_base(nxt); nB = S.b_base(nxt); S.a_voff(nxt, Rr, Cc, vN); }
#pragma unroll 1
        for (int t = 0; t < nt; t += 2) {
            const bool last = (t == nt - 2);
            const char* a1 = cA + (size_t)(t + 1) * kstepA;
            const char* a2 = last ? nA : cA + (size_t)(t + 2) * kstepA; const char* b2 = last ? nB : cB + (size_t)(t + 2) * kstepB;
            const char* a3 = a2 + kstepA; const char* b3 = b2 + kstepB;
            unsigned v2[2][2];
#pragma unroll
            for (int h = 0; h < 2; ++h)
#pragma unroll
                for (int i = 0; i < 2; ++i) v2[h][i] = last ? vN[h][i] : vA[h][i];
            PG8_LDB(B0, 0, 0); PG8_LDB(B1, 0, 1); PG8_SCHED; PG8_LDA(At, 0, 0); PG8_STAGE(PG8_SA(1, 1), a1, vA[1]);
            PG8_WAIT_V(8); PG8_WAIT_L(0); PG8_BAR; PG8_MMA(0, 0, At, B0); PG8_MMA(0, 1, At, B1); PG8_BAR; PG8_SCHED;
            PG8_LDA(At, 0, 1); PG8_STAGE(PG8_SB(0, 0), b2, voffB); PG8_STAGE(PG8_SB(0, 1), b2 + hstepB, voffB); PG8_STAGE(PG8_SA(0, 0), a2, v2[0]);
            PG8_WAIT_V(8); PG8_WAIT_L(0); PG8_BAR; PG8_MMA(1, 0, At, B0); PG8_MMA(1, 1, At, B1); PG8_BAR; PG8_SCHED;
            PG8_LDB(B0, 1, 0); PG8_LDB(B1, 1, 1); PG8_SCHED; PG8_LDA(At, 1, 0); PG8_STAGE(PG8_SA(0, 1), a2, v2[1]);
            PG8_WAIT_V(8); PG8_WAIT_L(0); PG8_BAR; PG8_MMA(0, 0, At, B0); PG8_MMA(0, 1, At, B1); PG8_BAR; PG8_SCHED;
            PG8_LDA(At, 1, 1); PG8_STAGE(PG8_SB(1, 0), b3, voffB); PG8_STAGE(PG8_SB(1, 1), b3 + hstepB, voffB); PG8_STAGE(PG8_SA(1, 0), a3, v2[0]);
            PG8_WAIT_V(8); PG8_WAIT_L(0); PG8_BAR; PG8_MMA(1, 0, At, B0); PG8_MMA(1, 1, At, B1); PG8_BAR; PG8_SCHED;
        }
        if (wr == 0) PG8_BAR;
        E(acc, cur, wr, wc, fr, fq);
        if (!has_next) break;
#pragma unroll
        for (int a = 0; a < 2; ++a)
#pragma unroll
            for (int b = 0; b < 2; ++b)
#pragma unroll
                for (int m = 0; m < 4; ++m)
#pragma unroll
                    for (int n = 0; n < 2; ++n) acc[a][b][m][n] = (f32x4){0.f, 0.f, 0.f, 0.f};
        cur = nxt; cA = nA; cB = nB; ++ui;
#pragma unroll
        for (int h = 0; h < 2; ++h)
#pragma unroll
            for (int i = 0; i < 2; ++i) vA[h][i] = vN[h][i];
        if (wr == 1) PG8_BAR;
    }
    PG8_WAIT_V(0);
    PG8_BAR;
#undef PG8_SA
#undef PG8_SB
#undef PG8_STAGE
#undef PG8_LDA
#undef PG8_LDB
#undef PG8_MMA
#undef PG8_WAIT_V
#undef PG8_WAIT_L
#undef PG8_BAR
#undef PG8_SCHED
}

struct DenseSched {
    const bf16_t* A; const bf16_t* Bt; int lda, K; int nM, nN, nwg, G, c;
    __device__ __forceinline__ void init(const bf16_t* A_, int lda_, const bf16_t* Bt_, int M, int N, int K_, int G_, int c_) { A = A_; lda = lda_; Bt = Bt_; K = K_; nM = M / BM; nN = N / BM; nwg = nM * nN; G = G_; c = c_; }
    __device__ __forceinline__ size_t kstepA() const { return (size_t)(BK * 2); }
    __device__ __forceinline__ bool next(int i, Unit& u) const {
        const long L = (long)i * G + c; if (L >= nwg) return false;
        int wgid = (int)L; { const int q = nwg / NXCD, r = nwg % NXCD, xcd = wgid % NXCD, off = wgid / NXCD; wgid = (xcd < r ? xcd * (q + 1) : r * (q + 1) + (xcd - r) * q) + off; }
        const int nig = WGM * nN, gid = wgid / nig, fm = gid * WGM, gsz = (nM - fm) < WGM ? (nM - fm) : WGM;
        u.pm = fm + ((wgid % nig) % gsz); u.pn = (wgid % nig) / gsz; u.a0 = 0; u.a1 = 0; return true;
    }
    __device__ __forceinline__ const char* a_base(const Unit& u) const { return (const char*)A + (size_t)u.pm * BM * lda * 2; }
    __device__ __forceinline__ const char* b_base(const Unit& u) const { return (const char*)Bt + (size_t)u.pn * BM * K * 2; }
    __device__ __forceinline__ void a_voff(const Unit&, const int (&R)[2], const int (&C)[2], unsigned (&v)[2][2]) const {
#pragma unroll
        for (int h = 0; h < 2; ++h)
#pragma unroll
            for (int i = 0; i < 2; ++i) v[h][i] = (unsigned)((h * HALF + R[i]) * lda + C[i]) * 2u;
    }
};
}

#define XB_TMO      128
#define XB_XCNT(j)  (256  + 64 * (j))
#define XB_XSUB(j)  (1280 + 64 * (j))
#define XB_XGEN(j)  (2304 + 64 * (j))
#define XB_TOP      3328
#define XB_TOPGEN   3392
#define XCD_BAR_WORDS 3456
#define XB_SPIN_CAP (1u << 22)
__device__ __forceinline__ unsigned xb_ld(unsigned* p)              { return __hip_atomic_load(p, __ATOMIC_RELAXED, __HIP_MEMORY_SCOPE_AGENT); }
__device__ __forceinline__ unsigned xb_add(unsigned* p, unsigned v) { return __hip_atomic_fetch_add(p, v, __ATOMIC_RELAXED, __HIP_MEMORY_SCOPE_AGENT); }
__device__ __forceinline__ unsigned xb_xcc_id() { return (unsigned)__builtin_amdgcn_s_getreg((3 << 11) | 20) & 0xFu; }
#define XB_SPIN(cond, bar) do { unsigned _sp = 0; while (cond) { __builtin_amdgcn_s_sleep(1); \
    if ((++_sp & 255u) == 0u) { if (xb_ld(&(bar)[XB_TMO])) break; if (_sp > XB_SPIN_CAP) { atomicAdd(&(bar)[XB_TMO], 1u); break; } } } } while (0)
struct XcdBarrier { unsigned* bar; unsigned x; volatile LAS unsigned* st; int wave; };
__device__ __forceinline__ XcdBarrier xcd_barrier_post(unsigned* bar, volatile LAS unsigned* st, int wave) {
    XcdBarrier b; b.bar = bar; b.x = xb_xcc_id(); b.st = st; b.wave = wave;
    if (wave == 0 && lane_id() == 0) (void)xb_add(&bar[XB_XCNT(b.x)], 1u);
    return b;
}
__device__ __forceinline__ void xcd_barrier_complete(unsigned* bar, unsigned x, unsigned& nloc, unsigned& nx) {
    const unsigned G = gridDim.x * gridDim.y * gridDim.z;
    unsigned sum, cnt, mine, sp = 0u;
    for (;;) {
        sum = 0u; cnt = 0u; mine = 0u;
#pragma unroll
        for (unsigned j = 0; j < 16; ++j) { const unsigned c = xb_ld(&bar[XB_XCNT(j)]); sum += c; cnt += (c > 0u) ? 1u : 0u; }
        mine = xb_ld(&bar[XB_XCNT(x)]);
        if (sum == G) break;
        __builtin_amdgcn_s_sleep(1);
        if ((++sp & 255u) == 0u) { if (xb_ld(&bar[XB_TMO])) break; if (sp > XB_SPIN_CAP) { atomicAdd(&bar[XB_TMO], 1u); break; } }
    }
    nloc = mine > 0u ? mine : 1u; nx = cnt > 0u ? cnt : 1u;
}
__device__ __forceinline__ void xcd_barrier(const XcdBarrier& b) {
    asm volatile("s_waitcnt vmcnt(0)" ::: "memory");
    __syncthreads();
    if (b.wave == 0 && lane_id() == 0) {
        unsigned* bar = b.bar; asm volatile("" : "+s"(bar)); unsigned bx = b.x; asm volatile("" : "+s"(bx));
        __builtin_amdgcn_s_waitcnt(0);
        unsigned nloc = b.st[0], nx = b.st[1];
        if (nloc == 0u) { xcd_barrier_complete(bar, bx, nloc, nx); b.st[0] = nloc; b.st[1] = nx; }
        const unsigned old = xb_add(&bar[XB_XSUB(bx)], 1u);
        const unsigned gen = old / nloc;
        if (old + 1u == (gen + 1u) * nloc) {
            __builtin_amdgcn_fence(__ATOMIC_RELEASE, "agent");
            asm volatile("s_waitcnt vmcnt(0)" ::: "memory");
            const unsigned og = xb_add(&bar[XB_TOP], 1u);
            const unsigned tg = og / nx;
            if (og + 1u == (tg + 1u) * nx) xb_add(&bar[XB_TOPGEN], 1u);
            else XB_SPIN(xb_ld(&bar[XB_TOPGEN]) == tg, bar);
            __builtin_amdgcn_fence(__ATOMIC_ACQUIRE, "agent");
            xb_add(&bar[XB_XGEN(bx)], 1u);
            asm volatile("s_waitcnt vmcnt(0)" ::: "memory");
        } else {
            XB_SPIN(xb_ld(&bar[XB_XGEN(bx)]) == gen, bar);
            __builtin_amdgcn_fence(__ATOMIC_ACQUIRE, "agent");
            asm volatile("s_waitcnt vmcnt(0)" ::: "memory");
        }
    }
    __syncthreads();
}

struct Args { const float* in[37]; float* out; unsigned char* ws; int ph_lo, ph_hi; };
typedef const __attribute__((address_space(4))) Args* KArgs;
__device__ __forceinline__ KArgs ka_get() { KArgs k = (KArgs)__builtin_amdgcn_kernarg_segment_ptr(); asm volatile("" : "+s"(k)); return k; }
enum { I_X = 0, I_P, I_MIXN, I_WIN, I_CONVW, I_CONVB, I_WA, I_BA, I_WX, I_BX, I_LAM, I_PEK, I_PEV, I_WK1, I_BK1, I_WK2, I_BK2, I_WV1, I_BV1, I_WV2, I_BV2,
       I_RECN, I_ATTN, I_WOUT, I_FFNN, I_WGR, I_BGR, I_WER, I_BER, I_WGATE, I_WUP, I_WDOWN, I_PLEN, I_WPG, I_BPG, I_WPU, I_FINN };

namespace pg8 {
struct CmpSched {
    const bf16_t* z; const bf16_t* W1k; const bf16_t* W1v; int G, c;
    __device__ __forceinline__ size_t kstepA() const { return (size_t)ZP * 2; }
    __device__ __forceinline__ bool next(int i, Unit& u) const { const int L = i * G + c; if (L >= 64) return false; u.pm = L >> 1; u.pn = 0; u.a0 = L & 1; u.a1 = 0; return true; }
    __device__ __forceinline__ const char* a_base(const Unit& u) const { const int b = u.pm >> 1, g = u.pm & 1; return (const char*)(z + (size_t)b * SEQ * ZP + (u.a0 ? ZC_VC : ZC_KC) + g * 64); }
    __device__ __forceinline__ const char* b_base(const Unit& u) const { return (const char*)(u.a0 ? W1v : W1k); }
    __device__ __forceinline__ void a_voff(const Unit&, const int (&R)[2], const int (&C)[2], unsigned (&v)[2][2]) const {
#pragma unroll
        for (int h = 0; h < 2; ++h)
#pragma unroll
            for (int i = 0; i < 2; ++i) v[h][i] = (unsigned)(16 * (h * HALF + R[i]) * ZP + C[i]) * 2u;
    }
};
template <int PHASE>
struct MoeSched {
    const PG8_LAS int* tab; const bf16_t* A; const bf16_t* W; const int* ltok; int G, c;
    __device__ __forceinline__ size_t kstepA() const { return (size_t)(BK * 2); }
    __device__ __forceinline__ bool next(int i, Unit& u) const {
        const int TT = tab[64]; int rt, pn;
        if (G == 256) { const int x = c & 7, y = c >> 3, Q = (TT + 7) >> 3, rl = i * 8 + (y >> 2); pn = y & 3; if (rl >= Q) return false; rt = x * Q + rl; }
        else { const int L = i * G + c; rt = L >> 2; pn = L & 3; }
        if (rt >= TT) return false;
        int lo = 0, hi = 64;
        while (hi - lo > 1) { const int mid = (lo + hi) >> 1; if (tab[mid] <= rt) lo = mid; else hi = mid; }
        u.pm = rt; u.pn = pn; u.a0 = lo; u.a1 = rt - tab[lo]; return true;
    }
    __device__ __forceinline__ const char* a_base(const Unit& u) const { return PHASE == 1 ? (const char*)A : (const char*)A + (size_t)u.pm * BM * DEXP * 2; }
    __device__ __forceinline__ const char* b_base(const Unit& u) const {
        const int e = u.a0 & 31;
        return PHASE == 1 ? (const char*)W + ((size_t)e * 1024 + (size_t)u.pn * BM) * 1024 * 2 : (const char*)W + ((size_t)e * 1024 + (size_t)u.pn * BM) * DEXP * 2;
    }
    __device__ __forceinline__ void a_voff(const Unit& u, const int (&R)[2], const int (&C)[2], unsigned (&v)[2][2]) const {
        if (PHASE == 1) {
            const int cnt = tab[80 + u.a0];
#pragma unroll
            for (int h = 0; h < 2; ++h)
#pragma unroll
                for (int i = 0; i < 2; ++i) { const int rank = u.a1 * BM + h * HALF + R[i]; const int tok = rank < cnt ? ltok[(size_t)u.a0 * NTOK + rank] : 0; v[h][i] = (unsigned)(tok * DM + C[i]) * 2u; }
        } else {
#pragma unroll
            for (int h = 0; h < 2; ++h)
#pragma unroll
                for (int i = 0; i < 2; ++i) v[h][i] = (unsigned)((h * HALF + R[i]) * DEXP + C[i]) * 2u;
        }
    }
};

template <int ACT  > struct EpiBf16 {
    bf16_t* O; int ldc; const float* bias; size_t a0_stride; int a0_bias_stride;
    const float* rs;
    __device__ __forceinline__ void operator()(const f32x4 (&acc)[2][2][4][2], const Unit& u, int wr, int wc, int fr, int fq) const {
        const int row0 = u.pm * BM + wr * 64 + fr, col0 = u.pn * BM + wc * 32 + 8 * fq;
        bf16_t* base = O + (size_t)u.a0 * a0_stride; const float* bs = bias ? bias + u.a0 * a0_bias_stride : nullptr;
        float rsv[2][4];
#pragma unroll
        for (int ai = 0; ai < 2; ++ai)
#pragma unroll
            for (int m = 0; m < 4; ++m) rsv[ai][m] = rs ? rs[row0 + ai * HALF + m * 16] : 1.f;
        f32x4 bv[2][2];
#pragma unroll
        for (int bj = 0; bj < 2; ++bj)
#pragma unroll
            for (int n = 0; n < 2; ++n) bv[bj][n] = bs ? *(const f32x4*)(bs + col0 + bj * HALF + 4 * n) : (f32x4){0.f, 0.f, 0.f, 0.f};
#pragma unroll
        for (int ai = 0; ai < 2; ++ai)
#pragma unroll
            for (int m = 0; m < 4; ++m) { bf16_t* rowp = base + (size_t)(row0 + ai * HALF + m * 16) * ldc + col0; const float sc = rsv[ai][m];
#pragma unroll
                for (int bj = 0; bj < 2; ++bj) { f32x4 v0 = acc[ai][bj][m][0], v1 = acc[ai][bj][m][1];
                    if (rs) { v0 *= sc; v1 *= sc; }
                    v0 += bv[bj][0]; v1 += bv[bj][1];
                    if (ACT == 1) { for (int e = 0; e < 4; ++e) { v0[e] = fgelu(v0[e]); v1[e] = fgelu(v1[e]); } }
                    if (ACT == 2) { for (int e = 0; e < 4; ++e) { v0[e] = fsigmoid(v0[e]); v1[e] = fsigmoid(v1[e]); } }
                    u32x4 w; w.x = cvt_pk_bf16(v0[0], v0[1]); w.y = cvt_pk_bf16(v0[2], v0[3]); w.z = cvt_pk_bf16(v1[0], v1[1]); w.w = cvt_pk_bf16(v1[2], v1[3]);
                    *(u32x4*)(rowp + bj * HALF) = w; } }
    }
};
struct EpiResid {
    bf16_t* h;
    __device__ __forceinline__ void operator()(const f32x4 (&acc)[2][2][4][2], const Unit& u, int wr, int wc, int fr, int fq) const {
        const int row0 = u.pm * BM + wr * 64 + fr, col0 = u.pn * BM + wc * 32 + 8 * fq;
#pragma unroll
        for (int ai = 0; ai < 2; ++ai) {
            bf16_t* rp0 = h + (size_t)(row0 + ai * HALF) * DM + col0;
            u32x4 hv[4][2];
#pragma unroll
            for (int m = 0; m < 4; ++m)
#pragma unroll
                for (int bj = 0; bj < 2; ++bj) hv[m][bj] = *(const u32x4*)(rp0 + (size_t)m * 16 * DM + bj * HALF);
#pragma unroll
            for (int m = 0; m < 4; ++m)
#pragma unroll
                for (int bj = 0; bj < 2; ++bj) { const u32x4 x = hv[m][bj]; const f32x4 a0 = acc[ai][bj][m][0], a1 = acc[ai][bj][m][1];
                    u32x4 w; w.x = cvt_pk_bf16(bflo(x.x) + a0[0], bfhi(x.x) + a0[1]); w.y = cvt_pk_bf16(bflo(x.y) + a0[2], bfhi(x.y) + a0[3]); w.z = cvt_pk_bf16(bflo(x.z) + a1[0], bfhi(x.z) + a1[1]); w.w = cvt_pk_bf16(bflo(x.w) + a1[2], bfhi(x.w) + a1[3]);
                    *(u32x4*)(rp0 + (size_t)m * 16 * DM + bj * HALF) = w; }
            asm volatile("" ::: "memory");
        }
    }
};
struct EpiPleB {
    const bf16_t* h; bf16_t* hn; const bf16_t* Gt;
    __device__ __forceinline__ void operator()(const f32x4 (&acc)[2][2][4][2], const Unit& u, int wr, int wc, int fr, int fq) const {
        const int row0 = u.pm * BM + wr * 64 + fr, col0 = u.pn * BM + wc * 32 + 8 * fq;
#pragma unroll
        for (int ai = 0; ai < 2; ++ai) {
            const size_t ro0 = (size_t)(row0 + ai * HALF) * DM + col0;
            u32x4 hv[4][2], gv[4][2];
#pragma unroll
            for (int m = 0; m < 4; ++m)
#pragma unroll
                for (int bj = 0; bj < 2; ++bj) { hv[m][bj] = *(const u32x4*)(h + ro0 + (size_t)m * 16 * DM + bj * HALF); gv[m][bj] = *(const u32x4*)(Gt + ro0 + (size_t)m * 16 * DM + bj * HALF); }
#pragma unroll
            for (int m = 0; m < 4; ++m)
#pragma unroll
                for (int bj = 0; bj < 2; ++bj) { const u32x4 x = hv[m][bj], g = gv[m][bj]; const f32x4 a0 = acc[ai][bj][m][0], a1 = acc[ai][bj][m][1];
                    u32x4 w; w.x = cvt_pk_bf16(bflo(x.x) + a0[0] * bflo(g.x), bfhi(x.x) + a0[1] * bfhi(g.x)); w.y = cvt_pk_bf16(bflo(x.y) + a0[2] * bflo(g.y), bfhi(x.y) + a0[3] * bfhi(g.y));
                    w.z = cvt_pk_bf16(bflo(x.z) + a1[0] * bflo(g.z), bfhi(x.z) + a1[1] * bfhi(g.z)); w.w = cvt_pk_bf16(bflo(x.w) + a1[2] * bflo(g.w), bfhi(x.w) + a1[3] * bfhi(g.w));
                    *(u32x4*)(hn + ro0 + (size_t)m * 16 * DM + bj * HALF) = w; }
            asm volatile("" ::: "memory");
        }
    }
};
struct EpiSwiglu {
    bf16_t* Hd; const PG8_LAS int* tab; const float* lrs;
    __device__ __forceinline__ void operator()(const f32x4 (&acc)[2][2][4][2], const Unit& u, int wr, int wc, int fr, int fq) const {
        const int row0 = u.pm * BM + wr * 64 + fr, col0 = u.pn * HALF + wc * 32 + 8 * fq; const int seg = u.a0, cnt = tab[80 + seg];
        float rsv[2][4];
#pragma unroll
        for (int ai = 0; ai < 2; ++ai)
#pragma unroll
            for (int m = 0; m < 4; ++m) { const int rank = u.a1 * BM + ai * HALF + wr * 64 + m * 16 + fr; const float v = lrs[(size_t)seg * NTOK + (rank < cnt ? rank : 0)]; rsv[ai][m] = rank < cnt ? v : 0.f; }
#pragma unroll
        for (int ai = 0; ai < 2; ++ai)
#pragma unroll
            for (int m = 0; m < 4; ++m) { const float rs = rsv[ai][m];
                float r[8];
#pragma unroll
                for (int n = 0; n < 2; ++n)
#pragma unroll
                    for (int e = 0; e < 4; ++e) { const float gt = acc[ai][0][m][n][e] * rs, up = acc[ai][1][m][n][e] * rs; r[4 * n + e] = gt * fsigmoid(gt) * up; }
                u32x4 w; w.x = cvt_pk_bf16(r[0], r[1]); w.y = cvt_pk_bf16(r[2], r[3]); w.z = cvt_pk_bf16(r[4], r[5]); w.w = cvt_pk_bf16(r[6], r[7]);
                *(u32x4*)(Hd + (size_t)(row0 + ai * HALF + m * 16) * DEXP + col0) = w; }
    }
};
struct EpiMoeDown {
    const PG8_LAS int* tab; const int* ltok; const float* lgate; bf16_t* y0; bf16_t* y1;
    __device__ __forceinline__ void operator()(const f32x4 (&acc)[2][2][4][2], const Unit& u, int wr, int wc, int fr, int fq) const {
        const int seg = u.a0, cnt = tab[80 + seg]; bf16_t* yb = (seg >= 32) ? y1 : y0;
        const int col0 = u.pn * BM + wc * 32 + 8 * fq;
        int tk[2][4]; float gtv[2][4];
#pragma unroll
        for (int ai = 0; ai < 2; ++ai)
#pragma unroll
            for (int m = 0; m < 4; ++m) { const int rank = u.a1 * BM + ai * HALF + wr * 64 + m * 16 + fr; const size_t o = (size_t)seg * NTOK + (rank < cnt ? rank : 0); tk[ai][m] = ltok[o]; gtv[ai][m] = lgate[o]; }
#pragma unroll
        for (int ai = 0; ai < 2; ++ai)
#pragma unroll
            for (int m = 0; m < 4; ++m) { const int rank = u.a1 * BM + ai * HALF + wr * 64 + m * 16 + fr;
                if (rank < cnt) { const int tok = tk[ai][m]; const float gt = gtv[ai][m];
#pragma unroll
                    for (int bj = 0; bj < 2; ++bj) { const f32x4 v0 = acc[ai][bj][m][0] * gt, v1 = acc[ai][bj][m][1] * gt;
                        u32x4 w; w.x = cvt_pk_bf16(v0[0], v0[1]); w.y = cvt_pk_bf16(v0[2], v0[3]); w.z = cvt_pk_bf16(v1[0], v1[1]); w.w = cvt_pk_bf16(v1[2], v1[3]);
                        *(u32x4*)(yb + (size_t)tok * DM + col0 + bj * HALF) = w; } } }
    }
};
}

struct TrItem { const float* W; const float* gain; bf16* WT; int K, N, dest_row0, k0, n0; float cs; };
__device__ __forceinline__ void tr_load(const TrItem& t, f32x4 (&v)[8], int lane) {
    const int c4 = lane & 7, kr = lane >> 3; const bool ok = t.n0 + 4 * c4 < t.N;
#pragma unroll
    for (int i = 0; i < 8; ++i) v[i] = ok ? *(const f32x4*)(t.W + (size_t)(t.k0 + 8 * i + kr) * t.N + t.n0 + 4 * c4) : (f32x4){0.f, 0.f, 0.f, 0.f};
}
__device__ __forceinline__ void tr_store(const TrItem& t, const f32x4 (&v)[8], LAS float* scr, int lane) {
    const int c4 = lane & 7, kr = lane >> 3;
#pragma unroll
    for (int i = 0; i < 8; ++i) { const int kk = 8 * i + kr; const float gsc = (t.gain ? t.gain[t.k0 + kk] : 1.f) * t.cs; LAS float* d = scr + kk * 33 + 4 * c4;
        d[0] = v[i].x * gsc; d[1] = v[i].y * gsc; d[2] = v[i].z * gsc; d[3] = v[i].w * gsc; }
    LDS_WAIT();
    const int c = lane & 7;
#pragma unroll
    for (int j = 0; j < 4; ++j) { const int n = (lane >> 3) + 8 * j; const LAS float* sp = scr + (8 * c) * 33 + n;
        u32x4 o; o.x = pk2(sp[0], sp[33]); o.y = pk2(sp[66], sp[99]); o.z = pk2(sp[132], sp[165]); o.w = pk2(sp[198], sp[231]);
        *(u32x4*)(t.WT + (size_t)(t.dest_row0 + n) * t.K + t.k0 + 8 * c) = o; }
    LDS_WAIT();
}
constexpr int IT_IN = 16 * 80, IT_OUT = 16 * 32, IT_PG = 16 * 32, IT_PU = 4 * 32, IT_K1 = 32 * 8, IT_V1 = 32 * 8, IT_E = 768;
constexpr int IT_LAYER = IT_IN + IT_OUT + IT_PG + IT_PU + IT_K1 + IT_V1 + NEXP * IT_E;

constexpr int IT_SMALL = IT_IN + IT_OUT + IT_PG + IT_PU + IT_K1 + IT_V1;
template <int MODE>
__device__ __forceinline__ void tr_run(KArgs args, LAS float* scr, int lane, int q0, int qstep, int Lsel) {
    unsigned char* ws = args->ws;
    const int nq = MODE == 0 ? DEPTH * IT_SMALL : NEXP * IT_E;
#define Q2IT_(q) (MODE == 0 ? ((q) / IT_SMALL) * IT_LAYER + (q) % IT_SMALL : Lsel * IT_LAYER + IT_SMALL + (q))
#define TR_DECODE(it_, t_) do { const int L = (it_) / IT_LAYER; int r = (it_) % IT_LAYER; unsigned char* wl = ws + WS_W + (size_t)L * W_LAYER; t_.cs = 1.f; t_.gain = nullptr; \
        if (r < IT_IN) { const int kb = r / 80, nb = r % 80; t_.W = args->in[I_WIN] + (size_t)L * DM * D_IN; t_.K = DM; t_.N = D_IN; t_.gain = args->in[I_MIXN] + L * DM; t_.WT = (bf16*)(wl + WO_IN); t_.dest_row0 = 32 * nb; t_.k0 = 64 * kb; t_.n0 = 32 * nb; \
            t_.cs = (32 * nb >= ZC_Q && 32 * nb < ZC_KC) ? 0.125f * LOG2E : 1.f; break; } r -= IT_IN; \
        if (r < IT_OUT) { const int kb = r / 32, nb = r % 32; t_.W = args->in[I_WOUT] + (size_t)L * DM * DM; t_.K = DM; t_.N = DM; t_.gain = kb < 8 ? args->in[I_RECN] + L * 512 : args->in[I_ATTN] + L * 512 - 512; t_.WT = (bf16*)(wl + WO_OUT); t_.dest_row0 = 32 * nb; t_.k0 = 64 * kb; t_.n0 = 32 * nb; break; } r -= IT_OUT; \
        if (r < IT_PG) { const int kb = r / 32, nb = r % 32; t_.W = args->in[I_WPG] + (size_t)L * DM * DM; t_.K = DM; t_.N = DM; t_.gain = args->in[I_PLEN] + L * DM; t_.WT = (bf16*)(wl + WO_PG); t_.dest_row0 = 32 * nb; t_.k0 = 64 * kb; t_.n0 = 32 * nb; break; } r -= IT_PG; \
        if (r < IT_PU) { const int kb = r / 32, nb = r % 32; t_.W = args->in[I_WPU] + (size_t)L * D_PLE * DM; t_.K = D_PLE; t_.N = DM; t_.WT = (bf16*)(wl + WO_PU); t_.dest_row0 = 32 * nb; t_.k0 = 64 * kb; t_.n0 = 32 * nb; break; } r -= IT_PU; \
        if (r < IT_K1) { const int kb = r / 8, nb = r % 8; t_.W = args->in[I_WK1] + (size_t)L * 2048 * 256; t_.K = 2048; t_.N = 256; t_.WT = (bf16*)(wl + WO_K1); t_.dest_row0 = 32 * nb; t_.k0 = 64 * kb; t_.n0 = 32 * nb; break; } r -= IT_K1; \
        if (r < IT_V1) { const int kb = r / 8, nb = r % 8; t_.W = args->in[I_WV1] + (size_t)L * 2048 * 256; t_.K = 2048; t_.N = 256; t_.WT = (bf16*)(wl + WO_V1); t_.dest_row0 = 32 * nb; t_.k0 = 64 * kb; t_.n0 = 32 * nb; break; } r -= IT_V1; \
        const int e = r / IT_E; int rr = r % IT_E; \
        if (rr < 512) { const int up = rr >> 8; rr &= 255; const int kb = rr / 16, nb = rr % 16, n0 = 32 * nb;     \
            t_.W = (up ? args->in[I_WUP] : args->in[I_WGATE]) + ((size_t)L * NEXP + e) * DM * DEXP; t_.K = DM; t_.N = DEXP; t_.gain = args->in[I_FFNN] + L * DM; t_.WT = (bf16*)(wl + WO_GU) + (size_t)e * 1024 * 1024; \
            t_.dest_row0 = 256 * (n0 >> 7) + (n0 & 127) + 128 * up; t_.k0 = 64 * kb; t_.n0 = n0; } \
        else { rr -= 512; const int kb = rr / 32, nb = rr % 32; t_.W = args->in[I_WDOWN] + ((size_t)L * NEXP + e) * DEXP * DM; t_.K = DEXP; t_.N = DM; t_.WT = (bf16*)(wl + WO_D) + (size_t)e * 1024 * DEXP; t_.dest_row0 = 32 * nb; t_.k0 = 64 * kb; t_.n0 = 32 * nb; } \
    } while (0)
    int q = q0; TrItem cur; f32x4 vc[8];
    if (q < nq) { TR_DECODE(Q2IT_(q), cur); tr_load(cur, vc, lane); }
    while (q < nq) {
        const int qn = q + qstep; TrItem nxt; f32x4 vn[8];
        const bool hn = qn < nq;
        if (hn) { TR_DECODE(Q2IT_(qn), nxt); tr_load(nxt, vn, lane); }
        tr_store(cur, vc, scr, lane);
        if (hn) { cur = nxt;
#pragma unroll
            for (int i = 0; i < 8; ++i) vc[i] = vn[i]; }
        q = qn; }
#undef TR_DECODE
#undef Q2IT_
}
__device__ __forceinline__ void phase_prologue(KArgs args, LAS unsigned char* lds, int G, int bid, int tid, int wave, int lane) {
    unsigned char* ws = args->ws;
    LAS float* scr = (LAS float*)(lds + wave * 16384);
    const int gw = bid * NWAVES + wave, NGW = G * NWAVES;
    tr_run<0>(args, scr, lane, gw, NGW, 0);
    const int gt = bid * (NWAVES * 64) + tid, NGT = G * NWAVES * 64;
    float* c8 = (float*)(ws + WS_C8); float* wrt = (float*)(ws + WS_WRT);
    for (int i = gt; i < DEPTH * 512; i += NGT) { const float lam = args->in[I_LAM][i]; c8[i] = -8.f * log1pf(expf(-lam)) * LOG2E; }
    for (int i = gt; i < DEPTH * 36 * 1024; i += NGT) { const int L = i / (36 * 1024), j = (i / 1024) % 36, k = i % 1024;
        const float w = (j < 32 ? args->in[I_WER][((size_t)L * DM + k) * 32 + j] : args->in[I_WGR][((size_t)L * DM + k) * 4 + (j - 32)]) * args->in[I_FFNN][L * DM + k];
        const unsigned hi = f2bf(w), lo = f2bf(w - bf2f((bf16)hi));
        ((bf16*)wrt)[((size_t)(L * 2 + 0) * 36 + j) * 1024 + k] = (bf16)hi; ((bf16*)wrt)[((size_t)(L * 2 + 1) * 36 + j) * 1024 + k] = (bf16)lo; }
    { bf16* w2t = (bf16*)(ws + WS_W2T);
      for (int i = gt; i < DEPTH * 2 * 64 * 256; i += NGT) { const int L = i >> 15, kv = (i >> 14) & 1, n = (i >> 8) & 63, k = i & 255;
          w2t[i] = (bf16)f2bf((kv ? args->in[I_WV2] : args->in[I_WK2])[((size_t)L * 256 + k) * 64 + n]); } }
    if (bid < 8) { const int pair = bid, L = pair >> 1, kv = pair & 1, j = tid & 255, half = tid >> 8;
        const float* pe = (kv ? args->in[I_PEV] : args->in[I_PEK]) + L * 2048 + 1024 * half; const float* w1 = (kv ? args->in[I_WV1] : args->in[I_WK1]) + ((size_t)L * 2048 + 1024 * half) * 256 + j;
        float s0 = 0.f, s1 = 0.f, s2 = 0.f, s3 = 0.f;
#pragma unroll 4
        for (int k = 0; k < 1024; k += 4) { s0 += pe[k] * w1[(size_t)k * 256]; s1 += pe[k + 1] * w1[(size_t)(k + 1) * 256]; s2 += pe[k + 2] * w1[(size_t)(k + 2) * 256]; s3 += pe[k + 3] * w1[(size_t)(k + 3) * 256]; }
        LAS float* red = (LAS float*)(lds + 8 * 16384);
        if (half) red[j] = (s0 + s1) + (s2 + s3);
        __syncthreads();
        if (!half) ((float*)(ws + WS_BK1))[pair * 256 + j] = (kv ? args->in[I_BV1] : args->in[I_BK1])[L * 256 + j] + ((s0 + s1) + (s2 + s3)) + red[j]; }
}

__device__ __forceinline__ void store_row_bf16(bf16* orow, const f32x4 (&v)[4], float sc, int lane) {
    unsigned long long* o8 = (unsigned long long*)orow + lane;
#pragma unroll
    for (int j = 0; j < 4; ++j) o8[64 * j] = (unsigned long long)pk2(v[j].x * sc, v[j].y * sc) | ((unsigned long long)pk2(v[j].z * sc, v[j].w * sc) << 32);
}
__device__ __forceinline__ float row_ss_bf16(const u32x2 (&v)[4]) { float s = 0.f;
#pragma unroll
    for (int j = 0; j < 4; ++j) { const float a = bflo(v[j].x), b = bfhi(v[j].x), c = bflo(v[j].y), d = bfhi(v[j].y); s += (a * a + b * b) + (c * c + d * d); }
    return s; }
__device__ __forceinline__ void store_row_bf16_from16(bf16* orow, const u32x2 (&v)[4], float sc, int lane) {
    u32x2* o8 = (u32x2*)orow + lane;
#pragma unroll
    for (int j = 0; j < 4; ++j) { u32x2 w; w.x = pk2(bflo(v[j].x) * sc, bfhi(v[j].x) * sc); w.y = pk2(bflo(v[j].y) * sc, bfhi(v[j].y) * sc); o8[64 * j] = w; }
}
__device__ __forceinline__ float ss_u4(const u32x4& v) {
    const float a = bflo(v.x), b = bfhi(v.x), c = bflo(v.y), d = bfhi(v.y), e = bflo(v.z), f = bfhi(v.z), g = bflo(v.w), h = bfhi(v.w);
    return ((a * a + b * b) + (c * c + d * d)) + ((e * e + f * f) + (g * g + h * h)); }
__device__ __forceinline__ u32x4 scale_u4(const u32x4& v, float sc) { u32x4 w;
    w.x = pg8::cvt_pk_bf16(bflo(v.x) * sc, bfhi(v.x) * sc); w.y = pg8::cvt_pk_bf16(bflo(v.y) * sc, bfhi(v.y) * sc); w.z = pg8::cvt_pk_bf16(bflo(v.z) * sc, bfhi(v.z) * sc); w.w = pg8::cvt_pk_bf16(bflo(v.w) * sc, bfhi(v.w) * sc); return w; }
__device__ __forceinline__ u32x4 add3_u4(const u32x4& h, const u32x4& a, const u32x4& b) { u32x4 w;
    w.x = pg8::cvt_pk_bf16(bflo(h.x) + bflo(a.x) + bflo(b.x), bfhi(h.x) + bfhi(a.x) + bfhi(b.x)); w.y = pg8::cvt_pk_bf16(bflo(h.y) + bflo(a.y) + bflo(b.y), bfhi(h.y) + bfhi(a.y) + bfhi(b.y));
    w.z = pg8::cvt_pk_bf16(bflo(h.z) + bflo(a.z) + bflo(b.z), bfhi(h.z) + bfhi(a.z) + bfhi(b.z)); w.w = pg8::cvt_pk_bf16(bflo(h.w) + bflo(a.w) + bflo(b.w), bfhi(h.w) + bfhi(a.w) + bfhi(b.w)); return w; }
constexpr int N1_PITCH = 2064, ZN_IN = 2304;
__device__ __forceinline__ void phase_norm1(KArgs args, const float* x, bf16* H, float* rs, int L, LAS unsigned char* lds, int G, int bid, int tid, int wave, int lane) {
    unsigned char* ws = args->ws;
    { const u32x4* src = (const u32x4*)(ws + WS_W + (size_t)L * W_LAYER + WO_IN + (size_t)ZN_IN * DM * 2);
      for (int i = tid; i < 24 * 128; i += NWAVES * 64) { const int row = i >> 7, c = i & 127; *(LAS u32x4*)(lds + row * N1_PITCH + c * 16) = src[i]; } }
    __syncthreads();
    bf16* z = (bf16*)(ws + WS_Z);
    const int gw = bid * NWAVES + wave, NGW = G * NWAVES, fr = lane & 15, fq = lane >> 4;
    const int arow1 = 16 + (fr & 7);
    for (int grp = gw; grp < NTOK / 16; grp += NGW) {
        if (x) {
#pragma unroll 1
            for (int r0 = 0; r0 < 16; r0 += 2) { f32x4 v[2][4];
#pragma unroll
                for (int r = 0; r < 2; ++r)
#pragma unroll
                    for (int j = 0; j < 4; ++j) v[r][j] = ((const f32x4*)(x + (size_t)(grp * 16 + r0 + r) * DM))[lane + 64 * j];
#pragma unroll
                for (int r = 0; r < 2; ++r) store_row_bf16(H + (size_t)(grp * 16 + r0 + r) * DM, v[r], 1.f, lane); }
            VM_WAIT();
        }
        const int tok = grp * 16 + fr;
        const bf16* hrow = H + (size_t)tok * DM + 8 * fq;
        f32x4 acc0 = {0.f, 0.f, 0.f, 0.f}, acc1 = {0.f, 0.f, 0.f, 0.f}; float ss = 0.f;
#pragma unroll 1
        for (int k0 = 0; k0 < 32; k0 += 16) {
            u32x4 xhv[16];
#pragma unroll
            for (int kq = 0; kq < 16; ++kq) xhv[kq] = *(const u32x4*)(hrow + 32 * (k0 + kq));
#pragma unroll
            for (int kq = 0; kq < 16; ++kq) { const int kk = k0 + kq; const u32x4 xh = xhv[kq];
                ss += ss_u4(xh);
                const bf16x8 bh = __builtin_bit_cast(bf16x8, xh);
                const bf16x8 a0 = *(const LAS bf16x8*)(lds + fr * N1_PITCH + 64 * kk + 16 * fq), a1 = *(const LAS bf16x8*)(lds + arow1 * N1_PITCH + 64 * kk + 16 * fq);
                acc0 = __builtin_amdgcn_mfma_f32_16x16x32_bf16(a0, bh, acc0, 0, 0, 0); acc1 = __builtin_amdgcn_mfma_f32_16x16x32_bf16(a1, bh, acc1, 0, 0, 0); } }
        ss += __builtin_bit_cast(float, __builtin_amdgcn_ds_bpermute((lane ^ 16) << 2, __builtin_bit_cast(int, ss)));
        ss += __builtin_bit_cast(float, __builtin_amdgcn_ds_bpermute((lane ^ 32) << 2, __builtin_bit_cast(int, ss)));
        const float rstd = rsqrtf(ss * (1.f / DM) + EPS);
        if (fq == 0) rs[tok] = rstd;
        bf16* zg = z + (size_t)tok * ZP + ZC_NG;
        { u32x2 w; w.x = pk2(acc0[0] * rstd, acc0[1] * rstd); w.y = pk2(acc0[2] * rstd, acc0[3] * rstd); *(u32x2*)(zg + 4 * fq) = w; }
        if (fq < 2) { u32x2 w; w.x = pk2(acc1[0] * rstd, acc1[1] * rstd); w.y = pk2(acc1[2] * rstd, acc1[3] * rstd); *(u32x2*)(zg + 16 + 4 * fq) = w; }
    }
}
__device__ __forceinline__ void phase_final(const bf16* H, float* out, const float* gain, int gw, int NGW, int lane) {
    constexpr int NR = 4;
    f32x4 gv[2][2];
#pragma unroll
    for (int j = 0; j < 2; ++j) { gv[j][0] = ((const f32x4*)gain)[2 * lane + 128 * j]; gv[j][1] = ((const f32x4*)gain)[2 * lane + 128 * j + 1]; }
    for (int m0 = gw * NR; m0 < NTOK; m0 += NGW * NR) { u32x4 v[NR][2];
#pragma unroll
        for (int r = 0; r < NR; ++r)
#pragma unroll
            for (int j = 0; j < 2; ++j) v[r][j] = ((const u32x4*)(H + (size_t)(m0 + r) * DM))[lane + 64 * j];
#pragma unroll
        for (int r = 0; r < NR; ++r) { const float rstd = rsqrtf(wave_sum(ss_u4(v[r][0]) + ss_u4(v[r][1])) * (1.f / DM) + EPS);
            f32x4* xr = (f32x4*)(out + (size_t)(m0 + r) * DM);
#pragma unroll
            for (int j = 0; j < 2; ++j) { const u32x4 w = v[r][j];
                xr[2 * lane + 128 * j] = (f32x4){bflo(w.x), bfhi(w.x), bflo(w.y), bfhi(w.y)} * rstd * gv[j][0];
                xr[2 * lane + 128 * j + 1] = (f32x4){bflo(w.z), bfhi(w.z), bflo(w.w), bfhi(w.w)} * rstd * gv[j][1]; } } }
}
__device__ __forceinline__ void phase_norm3(bf16* H, const bf16* y0, const bf16* y1, float* rs, const float* pL, bf16* pb, int gw, int NGW, int lane) {
    constexpr int NR = 4;
    for (int m0 = gw * NR; m0 < NTOK; m0 += NGW * NR) { u32x4 hv[NR][2], av[NR][2], bv[NR][2]; f32x4 pv[NR];
#pragma unroll
        for (int r = 0; r < NR; ++r) { const size_t ro = (size_t)(m0 + r) * DM;
#pragma unroll
            for (int j = 0; j < 2; ++j) { hv[r][j] = ((const u32x4*)(H + ro))[lane + 64 * j]; av[r][j] = ((const u32x4*)(y0 + ro))[lane + 64 * j]; bv[r][j] = ((const u32x4*)(y1 + ro))[lane + 64 * j]; }
            pv[r] = ((const f32x4*)(pL + (size_t)(m0 + r) * D_PLE))[lane]; }
        float rr[NR];
#pragma unroll
        for (int r = 0; r < NR; ++r) { const size_t ro = (size_t)(m0 + r) * DM;
            const u32x4 w0 = add3_u4(hv[r][0], av[r][0], bv[r][0]), w1 = add3_u4(hv[r][1], av[r][1], bv[r][1]);
            ((u32x4*)(H + ro))[lane] = w0; ((u32x4*)(H + ro))[lane + 64] = w1;
            rr[r] = rsqrtf(wave_sum(ss_u4(w0) + ss_u4(w1)) * (1.f / DM) + EPS);
            u32x2 q; q.x = pg8::cvt_pk_bf16(pv[r].x, pv[r].y); q.y = pg8::cvt_pk_bf16(pv[r].z, pv[r].w);
            ((u32x2*)(pb + (size_t)(m0 + r) * D_PLE))[lane] = q; }
        if (lane == 0) *(f32x4*)(rs + m0) = (f32x4){rr[0], rr[1], rr[2], rr[3]}; }
}
constexpr int N2_PITCH = 2064, N2_WL = 36 * N2_PITCH;
__device__ __forceinline__ void phase_norm2(KArgs args, const bf16* H, int L, LAS unsigned char* lds, int G, int bid, int tid, int wave, int lane) {
    unsigned char* ws = args->ws;
    { const u32x4* src = (const u32x4*)(ws + WS_WRT + (size_t)L * 2 * 36 * 2048);
      for (int i = tid; i < 2 * 36 * 128; i += NWAVES * 64) { const int hl = i / (36 * 128), row = (i >> 7) % 36, c = i & 127; *(LAS u32x4*)(lds + hl * N2_WL + row * N2_PITCH + c * 16) = src[i]; } }
    __syncthreads();
    gu32* cnt = (gu32*)(ws + WS_CTL) + CW_CNT + L * 64;
    int* ltok = (int*)(ws + WS_LTOK); float* lgate = (float*)(ws + WS_LGATE); float* lrs = (float*)(ws + WS_LRS);
    const float* bgr = args->in[I_BGR] + L * 4; const float* ber = args->in[I_BER] + L * 32;
    const int gw = bid * NWAVES + wave, NGW = G * NWAVES, fr = lane & 15, fq = lane >> 4;
    const int arow[3] = {8 * (fr >> 2) + (fr & 3), 8 * (fr >> 2) + (fr & 3) + 4, 32 + (fr & 3)};
    for (int grp = gw; grp < NTOK / 16; grp += NGW) {
        const int tok = grp * 16 + fr;
        const bf16* hrow = H + (size_t)tok * DM + 8 * fq;
        f32x4 acc[3]; float ss = 0.f;
#pragma unroll
        for (int t3 = 0; t3 < 3; ++t3) acc[t3] = (f32x4){0.f, 0.f, 0.f, 0.f};
#pragma unroll 1
        for (int k0 = 0; k0 < 32; k0 += 16) {
        u32x4 xhv[16];
#pragma unroll
        for (int kq = 0; kq < 16; ++kq) xhv[kq] = *(const u32x4*)(hrow + 32 * (k0 + kq));
#pragma unroll
        for (int kq = 0; kq < 16; ++kq) { const int kk = k0 + kq;
            const u32x4 xh = xhv[kq];
            { const float a0 = bflo(xh.x), a1 = bfhi(xh.x), a2 = bflo(xh.y), a3 = bfhi(xh.y), a4 = bflo(xh.z), a5 = bfhi(xh.z), a6 = bflo(xh.w), a7 = bfhi(xh.w);
              ss += (a0 * a0 + a1 * a1) + (a2 * a2 + a3 * a3) + (a4 * a4 + a5 * a5) + (a6 * a6 + a7 * a7); }
            const bf16x8 bh = __builtin_bit_cast(bf16x8, xh);
#pragma unroll
            for (int t3 = 0; t3 < 3; ++t3) { const bf16x8 ah = *(const LAS bf16x8*)(lds + arow[t3] * N2_PITCH + 64 * kk + 16 * fq), al = *(const LAS bf16x8*)(lds + N2_WL + arow[t3] * N2_PITCH + 64 * kk + 16 * fq);
                acc[t3] = __builtin_amdgcn_mfma_f32_16x16x32_bf16(ah, bh, acc[t3], 0, 0, 0); acc[t3] = __builtin_amdgcn_mfma_f32_16x16x32_bf16(al, bh, acc[t3], 0, 0, 0); }
        }
        }
        ss += __builtin_bit_cast(float, __builtin_amdgcn_ds_bpermute((lane ^ 16) << 2, __builtin_bit_cast(int, ss)));
        ss += __builtin_bit_cast(float, __builtin_amdgcn_ds_bpermute((lane ^ 32) << 2, __builtin_bit_cast(int, ss)));
        const float rstd = rsqrtf(ss * (1.f / DM) + EPS);
        float gl[4]; int gi = 0;
#pragma unroll
        for (int j = 0; j < 4; ++j) gl[j] = acc[2][j] * rstd + bgr[j];
        float gmax = gl[0];
#pragma unroll
        for (int j = 1; j < 4; ++j) if (gl[j] > gmax) { gmax = gl[j]; gi = j; }
        if (fq == gi) {
            float den = 0.f;
#pragma unroll
            for (int j = 0; j < 4; ++j) den += expf(gl[j] - gmax);
            const float pg = 1.f / den;
            float b1 = -3.0e38f, b2 = -3.0e38f; int j1 = 0, j2 = 0;
#pragma unroll
            for (int e = 0; e < 8; ++e) { const float x = (e < 4 ? acc[0][e & 3] : acc[1][e & 3]) * rstd + ber[gi * 8 + e];
                if (x > b1) { b2 = b1; j2 = j1; b1 = x; j1 = e; } else if (x > b2) { b2 = x; j2 = e; } }
            const float w1 = 1.f / (1.f + expf(b2 - b1)), w2 = 1.f - w1;
            const int s0 = gi * 8 + j1, s1 = 32 + gi * 8 + j2;
            const unsigned r0 = __hip_atomic_fetch_add(cnt + s0, 1u, RLX_AGENT), r1 = __hip_atomic_fetch_add(cnt + s1, 1u, RLX_AGENT);
            ltok[(size_t)s0 * NTOK + r0] = tok; lgate[(size_t)s0 * NTOK + r0] = pg * w1; lrs[(size_t)s0 * NTOK + r0] = rstd;
            ltok[(size_t)s1 * NTOK + r1] = tok; lgate[(size_t)s1 * NTOK + r1] = pg * w2; lrs[(size_t)s1 * NTOK + r1] = rstd;
        }
    }
}
template <int CTRL> __device__ __forceinline__ float dpp_row_shr(float old, float src) {
    return __builtin_bit_cast(float, __builtin_amdgcn_update_dpp(__builtin_bit_cast(int, old), __builtin_bit_cast(int, src), CTRL, 0xf, 0xf, false));
}
__device__ __forceinline__ void rec1_unit(KArgs args, int L, int unit, LAS unsigned char* lds, int wave, int lane) {
    unsigned char* ws = args->ws;
    const bf16* z = (const bf16*)(ws + WS_Z);
    bf16* hloc = (bf16*)(ws + WS_HLOC); bf16* cumA = (bf16*)(ws + WS_CUMA); float* agg = (float*)(ws + WS_AGG);
    const int b = unit >> 4, chk = unit & 15, t0 = chk * 256, fr = lane & 15, q = lane >> 4, hb = wave;
    const float* Wa = args->in[I_WA] + ((size_t)(L * 8 + hb)) * 4096; const float* Wx = args->in[I_WX] + ((size_t)(L * 8 + hb)) * 4096;
    LAS unsigned char* wl = lds + wave * 16384;
#pragma unroll 1
    for (int f = 0; f < 16; ++f) { const int mat = f >> 3, n = (f >> 1) & 3, kk = f & 1; const float* W = mat ? Wx : Wa;
        const int jout = 8 * (fr >> 2) + (fr & 3) + 4 * (n & 1) + 32 * (n >> 1); const float* wp = W + (32 * kk + 8 * q) * 64 + jout;
        u32x4 w; w.x = pk2(wp[0], wp[64]); w.y = pk2(wp[128], wp[192]); w.z = pk2(wp[256], wp[320]); w.w = pk2(wp[384], wp[448]);
        *(LAS u32x4*)(wl + f * 1024 + lane * 16) = w; }
    LAS float* ct = (LAS float*)(lds + 131072 + wave * 2048);
    { const int c = 64 * hb + lane; const float* cw = args->in[I_CONVW] + (size_t)L * 4 * 512;
      ct[lane * 8 + 0] = cw[c]; ct[lane * 8 + 1] = cw[512 + c]; ct[lane * 8 + 2] = cw[1024 + c]; ct[lane * 8 + 3] = cw[1536 + c];
      ct[lane * 8 + 4] = args->in[I_CONVB][L * 512 + c]; ct[lane * 8 + 5] = args->in[I_BA][L * 512 + c]; ct[lane * 8 + 6] = args->in[I_BX][L * 512 + c];
      ct[lane * 8 + 7] = ((const float*)(ws + WS_C8))[L * 512 + c]; }
    LDS_WAIT();
    float Acar[2][8], Hcar[2][8];
#pragma unroll
    for (int kk = 0; kk < 2; ++kk)
#pragma unroll
        for (int e = 0; e < 8; ++e) { Acar[kk][e] = 1.f; Hcar[kk][e] = 0.f; }
    const bf16* zb = z + (size_t)(b * SEQ) * ZP + ZC_XR + 64 * hb;
    const int bidx15 = ((lane & ~15) | 15) << 2;
    u32x4 rawc[2][4];
#define REC_LOAD_TILE(dst_, tile_) do { const int t_ = t0 + (tile_) * 16 + fr; _Pragma("unroll") for (int kk_ = 0; kk_ < 2; ++kk_) _Pragma("unroll") for (int j_ = 0; j_ < 4; ++j_) { const int tt_ = t_ - 3 + j_; \
        dst_[kk_][j_] = *(const u32x4*)(zb + (size_t)(tt_ > 0 ? tt_ : 0) * ZP + 32 * kk_ + 8 * q); } } while (0)
    REC_LOAD_TILE(rawc, 0);
#pragma unroll 1
    for (int tile = 0; tile < 16; ++tile) {
        const int t = t0 + tile * 16 + fr; const bool edge = (t0 + tile * 16) == 0;
        u32x4 rawn[2][4];
        REC_LOAD_TILE(rawn, tile < 15 ? tile + 1 : 15);
        u32x4 xb[2];
#pragma unroll
        for (int kk = 0; kk < 2; ++kk) {
            float xc[8];
#pragma unroll
            for (int e = 0; e < 8; ++e) xc[e] = ct[(32 * kk + 8 * q + e) * 8 + 4];
#pragma unroll
            for (int j = 0; j < 4; ++j) { const int tt = t - 3 + j;
                u32x4 raw = rawc[kk][j];
                if (edge && tt < 0) raw = (u32x4){0u, 0u, 0u, 0u};
                const float xv[8] = {bflo(raw.x), bfhi(raw.x), bflo(raw.y), bfhi(raw.y), bflo(raw.z), bfhi(raw.z), bflo(raw.w), bfhi(raw.w)};
#pragma unroll
                for (int e = 0; e < 8; ++e) xc[e] += ct[(32 * kk + 8 * q + e) * 8 + j] * xv[e]; }
            xb[kk].x = pk2(xc[0], xc[1]); xb[kk].y = pk2(xc[2], xc[3]); xb[kk].z = pk2(xc[4], xc[5]); xb[kk].w = pk2(xc[6], xc[7]);
        }
        asm volatile("" ::: "memory");
#pragma unroll
        for (int kh = 0; kh < 2; ++kh) {
            f32x4 racc[2], iacc[2];
#pragma unroll
            for (int nn = 0; nn < 2; ++nn) { racc[nn] = (f32x4){0.f, 0.f, 0.f, 0.f}; iacc[nn] = (f32x4){0.f, 0.f, 0.f, 0.f};
#pragma unroll
                for (int kk = 0; kk < 2; ++kk) { const int n = 2 * kh + nn;
                    const bf16x8 fa = *(const LAS bf16x8*)(wl + ((0 * 4 + n) * 2 + kk) * 1024 + lane * 16), fx = *(const LAS bf16x8*)(wl + ((1 * 4 + n) * 2 + kk) * 1024 + lane * 16);
                    const bf16x8 xk = __builtin_bit_cast(bf16x8, xb[kk]);
                    racc[nn] = __builtin_amdgcn_mfma_f32_16x16x32_bf16(fa, xk, racc[nn], 0, 0, 0); iacc[nn] = __builtin_amdgcn_mfma_f32_16x16x32_bf16(fx, xk, iacc[nn], 0, 0, 0); } }
            const unsigned xw[4] = {xb[kh].x, xb[kh].y, xb[kh].z, xb[kh].w};
            float hv[8], av[8];
#pragma unroll
            for (int e = 0; e < 8; ++e) {
                const int nn = e >> 2, jj = e & 3; const int cb = (32 * kh + 8 * q + e) * 8;
                const float xcv = (e & 1) ? bfhi(xw[e >> 1]) : bflo(xw[e >> 1]);
                const float r = fsigmoid(racc[nn][jj] + ct[cb + 5]), ig = fsigmoid(iacc[nn][jj] + ct[cb + 6]);
                float a = __builtin_amdgcn_exp2f(ct[cb + 7] * r);
                float bb = __builtin_amdgcn_sqrtf(fmaxf(1.f - a * a, 0.f)) * (ig * xcv);
#define REC_SCAN_STEP(N_) asm volatile("s_nop 1\n\tv_fmac_f32_dpp %0, %0, %1 row_shr:" #N_ " row_mask:0xf bank_mask:0xf\n\ts_nop 1\n\tv_mul_f32_dpp %1, %1, %1 row_shr:" #N_ " row_mask:0xf bank_mask:0xf" : "+v"(bb), "+v"(a))
                REC_SCAN_STEP(1); REC_SCAN_STEP(2); REC_SCAN_STEP(4); REC_SCAN_STEP(8);
#undef REC_SCAN_STEP
                const float hl = a * Hcar[kh][e] + bb, ca = a * Acar[kh][e];
                hv[e] = hl; av[e] = ca;
                Hcar[kh][e] = __builtin_bit_cast(float, __builtin_amdgcn_ds_bpermute(bidx15, __builtin_bit_cast(int, hl))); Acar[kh][e] = __builtin_bit_cast(float, __builtin_amdgcn_ds_bpermute(bidx15, __builtin_bit_cast(int, ca)));
            }
            const size_t o = (size_t)(b * SEQ + t) * D_REC + 64 * hb + 32 * kh + 8 * q;
            u32x4 w; w.x = pk2(hv[0], hv[1]); w.y = pk2(hv[2], hv[3]); w.z = pk2(hv[4], hv[5]); w.w = pk2(hv[6], hv[7]);
            *(u32x4*)(hloc + o) = w;
            w.x = pk2(av[0], av[1]); w.y = pk2(av[2], av[3]); w.z = pk2(av[4], av[5]); w.w = pk2(av[6], av[7]);
            *(u32x4*)(cumA + o) = w;
            asm volatile("" ::: "memory");
        }
#pragma unroll
        for (int kk = 0; kk < 2; ++kk)
#pragma unroll
            for (int j = 0; j < 4; ++j) rawc[kk][j] = rawn[kk][j];
    }
#undef REC_LOAD_TILE
    if (fr == 0) {
#pragma unroll
        for (int kk = 0; kk < 2; ++kk)
#pragma unroll
            for (int e = 0; e < 8; ++e) { const int c = 64 * hb + 32 * kk + 8 * q + e; float* ap = agg + ((size_t)(b * 16 + chk) * 512 + c) * 2; ap[0] = Acar[kk][e]; ap[1] = Hcar[kk][e]; }
    }
}
__device__ __forceinline__ void rec2_rows(KArgs args, int gw, int NGW, int lane) {
    unsigned char* ws = args->ws;
    const bf16* z = (const bf16*)(ws + WS_Z); const bf16* hloc = (const bf16*)(ws + WS_HLOC); const bf16* cumA = (const bf16*)(ws + WS_CUMA);
    const float* carry = (const float*)(ws + WS_CARRY); bf16* mixed = (bf16*)(ws + WS_MIXED);
    constexpr int NR = 4;
    for (int m0 = gw * NR; m0 < NTOK; m0 += NGW * NR) {
        const int b = m0 >> 12, chk = (m0 & 4095) >> 8;
        u32x4 hl[NR], ca[NR], gr[NR];
#pragma unroll
        for (int r = 0; r < NR; ++r) { const size_t m = (size_t)(m0 + r); hl[r] = *(const u32x4*)(hloc + m * D_REC + 8 * lane); ca[r] = *(const u32x4*)(cumA + m * D_REC + 8 * lane); gr[r] = *(const u32x4*)(z + m * ZP + ZC_GR + 8 * lane); }
        const f32x4 c0 = *(const f32x4*)(carry + (size_t)(b * 16 + chk) * 512 + 8 * lane), c1 = *(const f32x4*)(carry + (size_t)(b * 16 + chk) * 512 + 8 * lane + 4);
#pragma unroll
        for (int r = 0; r < NR; ++r) { float v[8];
            v[0] = (bflo(hl[r].x) + bflo(ca[r].x) * c0.x) * fgelu(bflo(gr[r].x)); v[1] = (bfhi(hl[r].x) + bfhi(ca[r].x) * c0.y) * fgelu(bfhi(gr[r].x));
            v[2] = (bflo(hl[r].y) + bflo(ca[r].y) * c0.z) * fgelu(bflo(gr[r].y)); v[3] = (bfhi(hl[r].y) + bfhi(ca[r].y) * c0.w) * fgelu(bfhi(gr[r].y));
            v[4] = (bflo(hl[r].z) + bflo(ca[r].z) * c1.x) * fgelu(bflo(gr[r].z)); v[5] = (bfhi(hl[r].z) + bfhi(ca[r].z) * c1.y) * fgelu(bfhi(gr[r].z));
            v[6] = (bflo(hl[r].w) + bflo(ca[r].w) * c1.z) * fgelu(bflo(gr[r].w)); v[7] = (bfhi(hl[r].w) + bfhi(ca[r].w) * c1.w) * fgelu(bfhi(gr[r].w));
            float s = 0.f;
#pragma unroll
            for (int e = 0; e < 8; ++e) s += v[e] * v[e];
            const float rstd = rsqrtf(wave_sum(s) * (1.f / D_REC) + EPS);
            u32x4 w; w.x = pk2(v[0] * rstd, v[1] * rstd); w.y = pk2(v[2] * rstd, v[3] * rstd); w.z = pk2(v[4] * rstd, v[5] * rstd); w.w = pk2(v[6] * rstd, v[7] * rstd);
            *(u32x4*)(mixed + (size_t)(m0 + r) * DM + 8 * lane) = w; }
    }
}
__device__ __forceinline__ void phase_mid(KArgs args, int L, int G, int bid, int tid, int wave, int lane) {
    unsigned char* ws = args->ws;
    const float* agg = (const float*)(ws + WS_AGG); float* carry = (float*)(ws + WS_CARRY);
    const int gt = bid * (NWAVES * 64) + tid, NGT = G * NWAVES * 64;
    for (int i = gt; i < BATCH * 512; i += NGT) { const int b = i >> 9, c = i & 511; float Ak[16], Hk[16];
#pragma unroll
        for (int k = 0; k < 16; ++k) { const size_t o = (size_t)(b * 16 + k) * 512 + c; Ak[k] = agg[o * 2]; Hk[k] = agg[o * 2 + 1]; }
        float H = 0.f;
#pragma unroll
        for (int k = 0; k < 16; ++k) { carry[(size_t)(b * 16 + k) * 512 + c] = H; H = Ak[k] * H + Hk[k]; } }
    const bf16* hid = (const bf16*)(ws + WS_HIDC); const bf16* w2t = (const bf16*)(ws + WS_W2T);
    const int gw = bid * NWAVES + wave, NGW = G * NWAVES, fr = lane & 15, fq = lane >> 4;
    for (int task = gw; task < 2 * 512; task += NGW) {
        const int kv = task >> 9, grp = task & 511;
        const bf16* ar = hid + ((size_t)kv * 8192 + grp * 16 + fr) * 256 + 8 * fq;
        const bf16* br = w2t + ((size_t)(L * 2 + kv) * 64 + fr) * 256 + 8 * fq;
        const float* b2 = (kv ? args->in[I_BV2] : args->in[I_BK2]) + L * 64;
        f32x4 acc[4];
#pragma unroll
        for (int nt = 0; nt < 4; ++nt) { const float bb = b2[16 * nt + fr]; acc[nt] = (f32x4){bb, bb, bb, bb}; }
#pragma unroll
        for (int kk = 0; kk < 8; ++kk) { const bf16x8 a = *(const bf16x8*)(ar + 32 * kk);
#pragma unroll
            for (int nt = 0; nt < 4; ++nt) { const bf16x8 bfr = *(const bf16x8*)(br + (size_t)(16 * nt) * 256 + 32 * kk); acc[nt] = __builtin_amdgcn_mfma_f32_16x16x32_bf16(a, bfr, acc[nt], 0, 0, 0); } }
        bf16* outp = (bf16*)(ws + (kv ? WS_VCMP : WS_KCMP));
#pragma unroll
        for (int jj = 0; jj < 4; ++jj) { const int row = grp * 16 + 4 * fq + jj; const bool real = (row & 255) != 255;
#pragma unroll
            for (int nt = 0; nt < 4; ++nt) outp[(size_t)row * 64 + 16 * nt + fr] = real ? (bf16)f2bf(acc[nt][jj]) : (bf16)0; }
    }
}

typedef float f32x16 __attribute__((ext_vector_type(16)));
typedef short s16x4 __attribute__((ext_vector_type(4)));
typedef float f32x2_t __attribute__((ext_vector_type(2)));
typedef __bf16 bf16x2_t __attribute__((ext_vector_type(2)));
__device__ __forceinline__ unsigned cvtpk(float lo, float hi) { f32x2_t v = {lo, hi}; bf16x2_t b = __builtin_convertvector(v, bf16x2_t); return __builtin_bit_cast(unsigned, b); }
__device__ __forceinline__ void xhalf_pair(float m, float& lo, float& hi) {
    unsigned a = __builtin_bit_cast(unsigned, m), b = a; asm volatile("" : "+v"(b));
    auto rr = __builtin_amdgcn_permlane32_swap(a, b, false, false);
    unsigned r0 = rr[0], r1 = rr[1]; asm volatile("" : "+v"(r0), "+v"(r1));
    lo = __builtin_bit_cast(float, r0); hi = __builtin_bit_cast(float, r1);
}
__device__ __forceinline__ float xhalf_max(float m) { float a, b; xhalf_pair(m, a, b); return fmaxf(a, b); }
__device__ __forceinline__ float xhalf_sum(float m) { float a, b; xhalf_pair(m, a, b); return a + b; }
__device__ __forceinline__ s16x4 vtr(const LAS unsigned char* p) { return __builtin_bit_cast(s16x4, __builtin_amdgcn_ds_read_tr16_b64_v4i16((LAS s16x4*)p)); }
constexpr int ATT_NS = 4, ATT_PD = 3;
constexpr int ATT_IMP = 65536, ATT_SC = ATT_IMP + 4 * 64 * 65 * 4, ATT_MASK = ATT_SC + 64 * 65 * 4, ATT_UNION = ATT_MASK + 512, ATT_RED = ATT_UNION + 64;
static_assert(ATT_RED + 2048 <= MISC_OFF, "attention LDS map");
#define CI_(i) (((i) & 3) + 8 * ((i) >> 2))
__device__ __forceinline__ float max3f(float a, float b, float c) { float r; asm("v_max3_f32 %0, %1, %2, %3" : "=v"(r) : "v"(a), "v"(b), "v"(c)); return r; }

struct AttState { f32x16 O[2]; float m, l; bool fresh; };
__device__ __forceinline__ void att_stage(LAS unsigned char* lds, int slot, const char* kp, const char* vp, unsigned pitch, int wave, int lane) {
    const int key = 8 * wave + (lane >> 3), pc = lane & 7;
    const char* ks = kp + (size_t)key * pitch + ((pc ^ ((key >> 1) & 7)) << 4);
    const char* vs = vp + (size_t)key * pitch + ((pc ^ ((key & 3) << 1)) << 4);
    const unsigned dk = (unsigned)(unsigned long)(lds + slot * 16384 + wave * 1024), dv = dk + 8192u; unsigned keep;
    asm volatile("s_mov_b32 %0, m0\n\ts_mov_b32 m0, %2\n\ts_nop 0\n\tglobal_load_lds_dwordx4 %1, off\n\ts_mov_b32 m0, %0" : "=&s"(keep) : "v"(ks), "s"(dk) : "memory");
    asm volatile("s_mov_b32 %0, m0\n\ts_mov_b32 m0, %2\n\ts_nop 0\n\tglobal_load_lds_dwordx4 %1, off\n\ts_mov_b32 m0, %0" : "=&s"(keep) : "v"(vs), "s"(dv) : "memory");
}
__device__ __forceinline__ void att_qk64(const LAS unsigned char* Kb, const bf16x8 (&qf)[4], float sF, float cb, int rq, int h, f32x16& S0, f32x16& S1) {
    const LAS unsigned char* rowp = Kb + rq * 128; const int sw = (rq >> 1) & 7;
    bf16x8 kf[2][4];
#pragma unroll
    for (int sub = 0; sub < 2; ++sub)
#pragma unroll
        for (int s4 = 0; s4 < 4; ++s4) kf[sub][s4] = *(const LAS bf16x8*)(rowp + sub * 4096 + (((2 * s4 + h) ^ sw) << 4));
    const float base = cb + sF * (float)(4 * h);
    { const f32x2 d01 = {0.f, sF}, d23 = {sF + sF, 3.f * sF};
#pragma unroll
      for (int q4 = 0; q4 < 4; ++q4) { const float bq = fmaf(sF, (float)(8 * q4), base), bq1 = fmaf(sF, (float)(8 * q4 + 32), base);
          const f32x2 bb = {bq, bq}, bc = {bq1, bq1}; const f32x2 lo = bb + d01, hi = bb + d23, lo1 = bc + d01, hi1 = bc + d23;
          S0[4 * q4] = lo.x; S0[4 * q4 + 1] = lo.y; S0[4 * q4 + 2] = hi.x; S0[4 * q4 + 3] = hi.y; S1[4 * q4] = lo1.x; S1[4 * q4 + 1] = lo1.y; S1[4 * q4 + 2] = hi1.x; S1[4 * q4 + 3] = hi1.y; } }
    __builtin_amdgcn_sched_barrier(0);
#pragma unroll
    for (int s4 = 0; s4 < 4; ++s4) { S0 = __builtin_amdgcn_mfma_f32_32x32x16_bf16(kf[0][s4], qf[s4], S0, 0, 0, 0); S1 = __builtin_amdgcn_mfma_f32_32x32x16_bf16(kf[1][s4], qf[s4], S1, 0, 0, 0); }
    __builtin_amdgcn_sched_barrier(0);
}
__device__ __forceinline__ void att_mask(int sub, int h, int lim_lo, int lim_hi, f32x16& S) {
    const int hi2 = lim_hi - 32 * sub - 4 * h, lo2 = lim_lo - 32 * sub - 4 * h;
#pragma unroll
    for (int i = 0; i < 16; ++i) S[i] = (CI_(i) <= hi2 && CI_(i) > lo2) ? S[i] : -__builtin_inff();
}
template <bool IMP>
__device__ __forceinline__ void att_softmax_pv64(const bool MASKED, const LAS unsigned char* Vb, int lim_lo, int lim_hi, f32x16& S0, f32x16& S1, AttState& st, int h, int lane, LAS float* irow = nullptr, int ct = 0) {
    const int qd = (lane & 15) >> 2, pp = lane & 3, blk = (lane >> 4) & 1;
    const LAS unsigned char* vrow = Vb + (4 * h + qd) * 128 + (pp & 1) * 8;
    bf16x8 vf[2][4];
#pragma unroll
    for (int dt = 0; dt < 2; ++dt) { const int coff = ((dt * 4 + blk * 2 + (pp >> 1)) ^ (qd << 1)) << 4;
#pragma unroll
        for (int ks = 0; ks < 4; ++ks) { const s16x4 lo = vtr(vrow + coff + (16 * ks) * 128), hi = vtr(vrow + coff + (16 * ks + 8) * 128);
            vf[dt][ks] = __builtin_shufflevector(lo, hi, 0, 1, 2, 3, 4, 5, 6, 7); } }
    __builtin_amdgcn_sched_barrier(0);
    if (MASKED) { att_mask(0, h, lim_lo, lim_hi, S0); att_mask(1, h, lim_lo, lim_hi, S1); }
    float mx = max3f(S0[0], S0[1], S0[2]), my = max3f(S1[0], S1[1], S1[2]);
    mx = max3f(mx, S0[3], S0[4]); my = max3f(my, S1[3], S1[4]); mx = max3f(mx, S0[5], S0[6]); my = max3f(my, S1[5], S1[6]); mx = max3f(mx, S0[7], S0[8]); my = max3f(my, S1[7], S1[8]);
    mx = max3f(mx, S0[9], S0[10]); my = max3f(my, S1[9], S1[10]); mx = max3f(mx, S0[11], S0[12]); my = max3f(my, S1[11], S1[12]); mx = max3f(mx, S0[13], S0[14]); my = max3f(my, S1[13], S1[14]);
    mx = xhalf_max(max3f(mx, my, max3f(S0[15], S1[15], S1[15])));
    const bool fin = mx > -1e30f;
    const bool rb = fin && (mx > 8.f || st.fresh);
    if (__any(rb)) { const float d = rb ? mx : 0.f; const float corr = st.fresh ? 1.f : __builtin_amdgcn_exp2f(-d); st.l *= corr; st.m += d;
#pragma unroll
        for (int i = 0; i < 16; ++i) { st.O[0][i] *= corr; st.O[1][i] *= corr; S0[i] -= d; S1[i] -= d; }
        if (IMP) { if (h == 0 && corr != 1.f) { for (int j = 0; j < 64; ++j) irow[j] *= corr; } }
    }
    st.fresh = st.fresh && !fin;
    float ps = 0.f, pt = 0.f;
#pragma unroll
    for (int i = 0; i < 16; ++i) { S0[i] = __builtin_amdgcn_exp2f(S0[i]); S1[i] = __builtin_amdgcn_exp2f(S1[i]); ps += S0[i]; pt += S1[i]; }
    st.l += ps + pt;
    if (IMP) {
        float prev3 = 0.f; const int partner = (lane ^ 32) << 2;
#pragma unroll
        for (int f = 0; f < 8; ++f) { const f32x16& S_ = (f >> 2) ? S1 : S0; const int q4 = f & 3; const float p3 = S_[4 * q4 + 3];
            const float own = 2.f * (S_[4 * q4] + S_[4 * q4 + 1] + S_[4 * q4 + 2]) + p3;
            const float inc = __builtin_bit_cast(float, __builtin_amdgcn_ds_bpermute(partner, __builtin_bit_cast(int, h ? prev3 : p3)));
            irow[16 * ct + 2 * f + h] = own + inc;
            prev3 = p3; }
        if (h && ct < 3) __hip_atomic_fetch_add(irow + 16 * ct + 16, prev3, __ATOMIC_RELAXED, __HIP_MEMORY_SCOPE_WORKGROUP); }
    u32x4 pk[4];
#pragma unroll
    for (int s2 = 0; s2 < 2; ++s2) { pk[s2].x = cvtpk(S0[8 * s2], S0[8 * s2 + 1]); pk[s2].y = cvtpk(S0[8 * s2 + 2], S0[8 * s2 + 3]); pk[s2].z = cvtpk(S0[8 * s2 + 4], S0[8 * s2 + 5]); pk[s2].w = cvtpk(S0[8 * s2 + 6], S0[8 * s2 + 7]);
        pk[2 + s2].x = cvtpk(S1[8 * s2], S1[8 * s2 + 1]); pk[2 + s2].y = cvtpk(S1[8 * s2 + 2], S1[8 * s2 + 3]); pk[2 + s2].z = cvtpk(S1[8 * s2 + 4], S1[8 * s2 + 5]); pk[2 + s2].w = cvtpk(S1[8 * s2 + 6], S1[8 * s2 + 7]); }
    __builtin_amdgcn_sched_barrier(0);
#pragma unroll
    for (int ks = 0; ks < 4; ++ks)
#pragma unroll
        for (int dt = 0; dt < 2; ++dt) st.O[dt] = __builtin_amdgcn_mfma_f32_32x32x16_bf16(vf[dt][ks], __builtin_bit_cast(bf16x8, pk[ks]), st.O[dt], 0, 0, 0);
    __builtin_amdgcn_sched_barrier(0);
}
__device__ __forceinline__ void att_state_reset(AttState& st) {
#pragma unroll
    for (int i = 0; i < 16; ++i) { st.O[0][i] = 0.f; st.O[1][i] = 0.f; }
    st.m = 0.f; st.l = 0.f; st.fresh = true;
}
#define ATT_WAIT_BAR() asm volatile("s_waitcnt vmcnt(0) lgkmcnt(0)\n\ts_barrier" ::: "memory")
#define ATT_WAIT_BAR_PD() asm volatile("s_waitcnt vmcnt(4) lgkmcnt(0)\n\ts_barrier" ::: "memory")
#define ATT_WAIT_BAR_2() asm volatile("s_waitcnt vmcnt(2) lgkmcnt(0)\n\ts_barrier" ::: "memory")

__device__ __forceinline__ int opq_v(int x) { asm volatile("" : "+v"(x)); return x; }
__device__ __forceinline__ int opq_s(int x) { asm volatile("" : "+s"(x)); return x; }
#define ATT_IDS const int lane = opq_v(lane0), wave = opq_s(wave0); const int r = wave >> 1, th = wave & 1, rq = lane & 31, h = lane >> 5, tl = 32 * th + rq, t = qb * 64 + tl, tok = b * SEQ + t; (void)r; (void)t; (void)tok;
__device__ __forceinline__ void att_unit_mfma(KArgs args, int b, int qb, LAS unsigned char* lds, int wave0, int lane0, int tid0) {
    unsigned char* ws = args->ws;
    const bf16* z = (const bf16*)(ws + WS_Z); bf16* mixed = (bf16*)(ws + WS_MIXED);
    LAS float* imp = (LAS float*)(lds + ATT_IMP);
    LAS float* sc = (LAS float*)(lds + ATT_SC);
    LAS unsigned* maskw = (LAS unsigned*)(lds + ATT_MASK);
    LAS unsigned* unionw = (LAS unsigned*)(lds + ATT_UNION);
    LAS float* red = (LAS float*)(lds + ATT_RED);
    unsigned OUTP[16];
    const unsigned ZPB = ZP * 2;
#pragma unroll 1
    for (int g = 0; g < 2; ++g) {
        const int hd = 4 * g + (wave0 >> 1);
        bf16x8 qf[4]; float slope2, g0, g1, g2;
        { ATT_IDS const int tid = opq_v(tid0);
          const bf16* zrow = z + (size_t)tok * ZP;
#pragma unroll
          for (int s4 = 0; s4 < 4; ++s4) qf[s4] = *(const bf16x8*)(zrow + ZC_Q + hd * 64 + 16 * s4 + 8 * h);
          slope2 = exp2f(-(float)(hd + 1)) * LOG2E;
          g0 = fsigmoid(bf2f(zrow[ZC_NG + hd * 3 + 0])); g1 = fsigmoid(bf2f(zrow[ZC_NG + hd * 3 + 1])); g2 = fsigmoid(bf2f(zrow[ZC_NG + hd * 3 + 2]));
          LAS float* row = imp + (r * 64 + tl) * 65 + 32 * h;
#pragma unroll
          for (int j = 0; j < 32; ++j) row[j] = 0.f;
          if (tid < 128) maskw[tid] = 0u;
          if (tid < 2) unionw[tid] = 0u; }
        AttState st;
        { ATT_IDS
        const int jlo = qb - 8 > 0 ? qb - 8 : 0, nw = qb - jlo + 1;
        const int nk = (4 * qb + 3) < 255 ? (4 * qb + 3) : 255, nc = (nk + 63) >> 6, nA = nw + nc;
        const int nmax_t = (t >= 31) ? ((t - 31) >> 4) : -1;
        const char* kwb = (const char*)(z + (size_t)(b * SEQ) * ZP + ZC_KW + g * 64);
        const char* kcb = (const char*)(ws + WS_KCMP) + (size_t)((b * 2 + g) * 256) * 128; const char* vcb = (const char*)(ws + WS_VCMP) + (size_t)((b * 2 + g) * 256) * 128;
        const float sF = 16.f * slope2;
        float il_c = 0.f;
        LAS float* irow = imp + (r * 64 + tl) * 65;
#define ATT_STAGE_A(idx_) do { int ix_ = (idx_) < nA ? (idx_) : nA - 1; const int sl_ = (idx_) & 3; \
            if (ix_ < nw) { const char* kp_ = kwb + (size_t)(64 * (qb - ix_)) * ZPB; att_stage(lds, sl_, kp_, kp_ + (ZC_VW - ZC_KW) * 2, ZPB, wave, lane); } \
            else { ix_ -= nw; const size_t o_ = (size_t)(nc - 1 - ix_) * 64 * 128; att_stage(lds, sl_, kcb + o_, vcb + o_, 128, wave, lane); } } while (0)
        att_state_reset(st);
        ATT_STAGE_A(0); ATT_STAGE_A(1); ATT_STAGE_A(2);
        f32x16 Sa, Sb;
#pragma unroll 1
        for (int i = 0; i < nA; ++i) {
            ATT_WAIT_BAR_PD();
            ATT_STAGE_A(i + ATT_PD);
            const LAS unsigned char* Kb = lds + (i & 3) * 16384; const LAS unsigned char* Vb = Kb + 8192;
            if (i < nw) {
                const int j = qb - i;
                att_qk64(Kb, qf, slope2, slope2 * (float)(64 * j) - st.m, rq, h, Sa, Sb);
                att_softmax_pv64<false>((j == qb) || (j == qb - 8), Vb, (j == qb - 8) ? tl : -1, (j == qb) ? tl : 63, Sa, Sb, st, h, lane);
                if (i == nw - 1) { const float lt = xhalf_sum(st.l); const float go = g2 / fmaxf(lt, 1e-30f);
#pragma unroll
                    for (int k = 0; k < 8; ++k) { OUTP[k] = cvtpk(st.O[0][2 * k] * go, st.O[0][2 * k + 1] * go); OUTP[8 + k] = cvtpk(st.O[1][2 * k] * go, st.O[1][2 * k + 1] * go); }
                    att_state_reset(st); }
            } else {
                const int ct = nc - 1 - (i - nw);
                att_qk64(Kb, qf, sF, sF * (float)(64 * ct) - st.m, rq, h, Sa, Sb);
                att_softmax_pv64<true>(true, Vb, -1, nmax_t - 64 * ct, Sa, Sb, st, h, lane, irow, ct);
                if (i == nA - 1) { const float lt = xhalf_sum(st.l); il_c = 1.f / fmaxf(lt, 1e-30f); const float go = g0 * il_c;
                    if (h == 0) ((LAS float*)(lds + ATT_SC))[r * 64 + tl] = il_c;
#pragma unroll
                    for (int k = 0; k < 8; ++k) { OUTP[k] = cvtpk(bflo(OUTP[k]) + st.O[0][2 * k] * go, bfhi(OUTP[k]) + st.O[0][2 * k + 1] * go); OUTP[8 + k] = cvtpk(bflo(OUTP[8 + k]) + st.O[1][2 * k] * go, bfhi(OUTP[8 + k]) + st.O[1][2 * k + 1] * go); } }
            }
        }
#undef ATT_STAGE_A
        }
        ATT_WAIT_BAR();
        { ATT_IDS const char* ksb0 = (const char*)(z + (size_t)(b * SEQ) * ZP + ZC_KS + g * 64);
          const char* kp0 = ksb0 + (size_t)(64 * qb) * ZPB; att_stage(lds, 0, kp0, kp0 + (ZC_VS - ZC_KS) * 2, ZPB, wave, lane);
          const char* kp1 = ksb0 + (size_t)(64 * (qb > 0 ? qb - 1 : 0)) * ZPB; att_stage(lds, 1, kp1, kp1 + (ZC_VS - ZC_KS) * 2, ZPB, wave, lane); }
        { const int tid = opq_v(tid0); const int stok = tid >> 3, e8 = tid & 7; const LAS float* ilc = (const LAS float*)(lds + ATT_SC);
          unsigned key[8];
#pragma unroll
          for (int k = 0; k < 8; ++k) { const int j = 8 * e8 + k; const float v = imp[(0 * 64 + stok) * 65 + j] * ilc[stok] + imp[(1 * 64 + stok) * 65 + j] * ilc[64 + stok] + imp[(2 * 64 + stok) * 65 + j] * ilc[128 + stok] + imp[(3 * 64 + stok) * 65 + j] * ilc[192 + stok];
              const bool valid = j <= qb, forced = valid && (j == 0 || j == qb || j == qb - 1);
              const unsigned bits_ = __builtin_bit_cast(unsigned, forced ? 1e30f : (valid ? v : -1e30f));
              key[k] = ((bits_ ^ ((bits_ >> 31) ? 0xFFFFFFFFu : 0x80000000u)) & ~63u) | (unsigned)(63 - j); }
          unsigned T = 0u;
#pragma unroll 1
          for (int bit = 31; bit >= 0; --bit) { const unsigned cand = T | (1u << bit); int c = 0;
#pragma unroll
              for (int k = 0; k < 8; ++k) c += key[k] >= cand ? 1 : 0;
              c += __builtin_amdgcn_update_dpp(0, c, 0xB1, 0xf, 0xf, true);
              c += __builtin_amdgcn_update_dpp(0, c, 0x4E, 0xf, 0xf, true);
              c += __builtin_amdgcn_update_dpp(0, c, 0x141, 0xf, 0xf, true);
              T = c >= NTOP ? cand : T; }
          unsigned bits = 0u;
#pragma unroll
          for (int k = 0; k < 8; ++k) bits |= (key[k] >= T && 8 * e8 + k <= qb) ? (1u << k) : 0u;
          if (bits) { __hip_atomic_fetch_or(maskw + stok * 2 + (e8 >> 2), bits << (8 * (e8 & 3)), __ATOMIC_RELAXED, __HIP_MEMORY_SCOPE_WORKGROUP); __hip_atomic_fetch_or(unionw + (e8 >> 2), bits << (8 * (e8 & 3)), __ATOMIC_RELAXED, __HIP_MEMORY_SCOPE_WORKGROUP); }
        }
        __syncthreads();
        { ATT_IDS
        const unsigned mlo = maskw[tl * 2], mhi = maskw[tl * 2 + 1];
        unsigned long long un = ((unsigned long long)unionw[1] << 32) | unionw[0];
        const char* ksb = (const char*)(z + (size_t)(b * SEQ) * ZP + ZC_KS + g * 64);
        att_state_reset(st);
        int jq[4];
#pragma unroll
        for (int p = 0; p < 4; ++p) { if (un) { jq[p] = 63 - __builtin_clzll(un); un &= ~(1ull << jq[p]); } else jq[p] = -1; }
        int jlast = jq[0];
#pragma unroll
        for (int p = 0; p < 3; ++p) { if (jq[p] >= 0) jlast = jq[p]; if (p == 2) { const char* kp_ = ksb + (size_t)(64 * jlast) * ZPB; att_stage(lds, p, kp_, kp_ + (ZC_VS - ZC_KS) * 2, ZPB, wave, lane); } }
        f32x16 Sa, Sb;
#pragma unroll 1
        for (int i = 0; jq[0] >= 0; ++i) {
            ATT_WAIT_BAR_PD();
            { if (jq[3] >= 0) jlast = jq[3]; const char* kp_ = ksb + (size_t)(64 * jlast) * ZPB; att_stage(lds, (i + 3) & 3, kp_, kp_ + (ZC_VS - ZC_KS) * 2, ZPB, wave, lane); }
            const LAS unsigned char* Kb = lds + (i & 3) * 16384; const LAS unsigned char* Vb = Kb + 8192;
            const int j = jq[0];
            const bool bit = ((j < 32 ? (mlo >> j) : (mhi >> (j - 32))) & 1u) != 0u;
            att_qk64(Kb, qf, slope2, bit ? slope2 * (float)(64 * j) - st.m : -__builtin_inff(), rq, h, Sa, Sb);
            att_softmax_pv64<false>(j == qb, Vb, -1, tl, Sa, Sb, st, h, lane);
            jq[0] = jq[1]; jq[1] = jq[2]; jq[2] = jq[3];
            if (un) { jq[3] = 63 - __builtin_clzll(un); un &= ~(1ull << jq[3]); } else jq[3] = -1;
        }
        { const float lt = xhalf_sum(st.l); const float go = g1 / fmaxf(lt, 1e-30f);
          float ss = 0.f;
#pragma unroll
          for (int i = 0; i < 8; ++i) { const float a0 = bflo(OUTP[i]) + st.O[0][2 * i] * go, a1 = bfhi(OUTP[i]) + st.O[0][2 * i + 1] * go, c0 = bflo(OUTP[8 + i]) + st.O[1][2 * i] * go, c1 = bfhi(OUTP[8 + i]) + st.O[1][2 * i + 1] * go;
              ss += (a0 * a0 + a1 * a1) + (c0 * c0 + c1 * c1); OUTP[i] = cvtpk(a0, a1); OUTP[8 + i] = cvtpk(c0, c1); }
          ss = xhalf_sum(ss);
          if (h == 0) red[hd * 64 + tl] = ss;
          if (g == 0) { bf16* orow = mixed + (size_t)tok * DM + 512 + hd * 64;
#pragma unroll
              for (int dt = 0; dt < 2; ++dt)
#pragma unroll
                  for (int q4 = 0; q4 < 4; ++q4) { u32x2 w; w.x = OUTP[8 * dt + 2 * q4]; w.y = OUTP[8 * dt + 2 * q4 + 1]; *(u32x2*)(orow + 32 * dt + 8 * q4 + 4 * h) = w; } } }
        }
        ATT_WAIT_BAR();
    }
    ATT_IDS
    float tot = 0.f;
#pragma unroll
    for (int h2 = 0; h2 < 8; ++h2) tot += red[h2 * 64 + tl];
    const float rstd = rsqrtf(tot * (1.f / 512.f) + EPS);
    { bf16* orow = mixed + (size_t)tok * DM + 512 + (4 + r) * 64;
#pragma unroll
      for (int dt = 0; dt < 2; ++dt)
#pragma unroll
          for (int q4 = 0; q4 < 4; ++q4) { u32x2 w; const unsigned p0 = OUTP[8 * dt + 2 * q4], p1 = OUTP[8 * dt + 2 * q4 + 1];
              w.x = cvtpk(bflo(p0) * rstd, bfhi(p0) * rstd); w.y = cvtpk(bflo(p1) * rstd, bfhi(p1) * rstd);
              *(u32x2*)(orow + 32 * dt + 8 * q4 + 4 * h) = w; } }
    { bf16* orow = mixed + (size_t)tok * DM + 512 + r * 64;
#pragma unroll
      for (int dt = 0; dt < 2; ++dt)
#pragma unroll
          for (int q4 = 0; q4 < 4; ++q4) { u32x2 w = *(const u32x2*)(orow + 32 * dt + 8 * q4 + 4 * h);
              w.x = cvtpk(bflo(w.x) * rstd, bfhi(w.x) * rstd); w.y = cvtpk(bflo(w.y) * rstd, bfhi(w.y) * rstd);
              *(u32x2*)(orow + 32 * dt + 8 * q4 + 4 * h) = w; } }
    __syncthreads();
}

constexpr int NPH_LAYER = 11, PH_FINAL = 1 + DEPTH * NPH_LAYER, N_PHASES = PH_FINAL + 1;
__global__ void __launch_bounds__(NWAVES * 64, 2) fwd_kernel(Args args) {
    extern __shared__ __attribute__((aligned(16))) unsigned char lds_raw[];
    LAS unsigned char* lds = (LAS unsigned char*)lds_raw;
    volatile LAS unsigned* MISC = (volatile LAS unsigned*)(lds + MISC_OFF);
    const int G0 = gridDim.x, bid0 = blockIdx.x;
    const int wave_s = __builtin_amdgcn_readfirstlane(threadIdx.x >> 6);
#define PHASE_IDS KArgs ka = ka_get(); int G = G0, bid = bid0; asm volatile("" : "+s"(G), "+s"(bid)); unsigned char* ws = ka->ws; (void)ws; int tid = wave_s * 64 + lane_id(); asm volatile("" : "+v"(tid)); const int lane = tid & 63, wave = wave_s; const int gw = bid * NWAVES + wave, NGW = G * NWAVES; (void)lane; (void)gw; (void)NGW;
    if (wave_s == 0) MISC[lane_id()] = 0u;
    __syncthreads();
#if MK_MULTI
#define GRID_BAR() do { } while (0)
#else
    XcdBarrier bar = xcd_barrier_post((unsigned*)(args.ws + WS_CTL) + CW_BAR, MISC + 8, wave_s);
#define GRID_BAR() xcd_barrier(bar)
#endif
#ifndef PH_MASK
#define PH_MASK 0xFFFF
#endif
#define IN(k) (ka_get()->ph_lo <= (k) && (k) < ka_get()->ph_hi)
#define EN(j) ((PH_MASK >> (j)) & 1)
#define SEAM(k) do { if (IN(k) && IN((k) + 1)) GRID_BAR(); } while (0)
#define HC_ ((bf16*)(ws + ((L & 1) ? WS_U : WS_H16)))
#define HN_ ((bf16*)(ws + ((L & 1) ? WS_H16 : WS_U)))
#define Z_ ((bf16*)(ws + WS_Z))
#define MIXED_ ((bf16*)(ws + WS_MIXED))
#define WL_ (ws + WS_W + (size_t)L * W_LAYER)

    if (EN(11) && IN(0)) { PHASE_IDS REP_(11) { phase_prologue(ka, lds, G, bid, tid, wave, lane); __syncthreads(); } SEAM(0); }

    for (int L = 0; L < DEPTH; ++L) {
        const int P = 1 + L * NPH_LAYER;
        if (EN(0) && IN(P + 0)) { PHASE_IDS REP_(0) phase_norm1(ka, L == 0 ? ka->in[I_X] : nullptr, HC_, (float*)(ws + WS_RS1), L, lds, G, bid, tid, wave, lane); SEAM(P + 0); }
        if (EN(1) && IN(P + 1)) {
            PHASE_IDS
            pg8::DenseSched S; S.init(HC_, DM, (const bf16*)(WL_ + WO_IN), NTOK, ZN_IN, DM, G, bid);
            pg8::EpiBf16<0> E{Z_, ZP, nullptr, 0, 0, (const float*)(ws + WS_RS1)};
            REP_(1) pg8::gemm_phase(lds, DM, S, E, wave_s);
            SEAM(P + 1);
        }
        if (EN(2) && IN(P + 2)) {
            { PHASE_IDS
            if (EN(12)) REP_(2) for (int unit = bid; unit < BATCH * 16; unit += G) rec1_unit(ka, L, unit, lds, wave, lane);
            { const int ncv = G > 64 ? G - 64 : G, mycv = G > 64 ? bid - 64 : bid;
              if (mycv >= 0) tr_run<1>(ka, (LAS float*)(lds + wave * 16384), lane, mycv * NWAVES + wave, ncv * NWAVES, L); }
            }
            __syncthreads();
            if (EN(13)) { PHASE_IDS
            pg8::CmpSched S{Z_, (const bf16*)(WL_ + WO_K1), (const bf16*)(WL_ + WO_V1), G, bid};
            pg8::EpiBf16<1> E{(bf16*)(ws + WS_HIDC), 256, (const float*)(ws + WS_BK1) + L * 512, (size_t)8192 * 256, 256, nullptr};
            REP_(2) pg8::gemm_phase(lds, 2048, S, E, wave_s); }
            SEAM(P + 2);
        }
        if (EN(3) && IN(P + 3)) { PHASE_IDS REP_(3) phase_mid(ka, L, G, bid, tid, wave, lane); SEAM(P + 3); }
        if (EN(4) && IN(P + 4)) {
            PHASE_IDS
            REP_(4)
            if (G == 256) { for (int i = 0; i < 4; ++i) att_unit_mfma(ka, 2 * (bid & 7) + (i >> 1), (i & 1) ? 63 - (bid >> 3) : (bid >> 3), lds, wave, lane, tid); }
            else { for (int unit = bid; unit < BATCH * 64; unit += G) att_unit_mfma(ka, unit >> 6, unit & 63, lds, wave, lane, tid); }
            REP_(12) rec2_rows(ka, gw, NGW, lane);
            SEAM(P + 4);
        }
        if (EN(5) && IN(P + 5)) {
            PHASE_IDS
            pg8::DenseSched S; S.init(MIXED_, DM, (const bf16*)(WL_ + WO_OUT), NTOK, DM, DM, G, bid);
            pg8::EpiResid E{HC_};
            pg8::gemm_phase(lds, DM, S, E, wave_s);
            SEAM(P + 5);
        }
        if (EN(6) && IN(P + 6)) { PHASE_IDS phase_norm2(ka, HC_, L, lds, G, bid, tid, wave, lane); SEAM(P + 6); }
        if ((EN(7) || EN(8)) && (IN(P + 7) || IN(P + 8))) {
            LAS int* tab = (LAS int*)(lds + TAB_OFF);
            { PHASE_IDS
            __syncthreads();
            if (tid < 64) { const int c = (int)__hip_atomic_load((gu32*)(ws + WS_CTL) + CW_CNT + L * 64 + tid, RLX_AGENT); tab[80 + tid] = c; tab[160 + tid] = (c + 255) >> 8; }
            __syncthreads();
            if (tid == 0) { int s = 0; for (int i = 0; i < 64; ++i) { tab[i] = s; s += tab[160 + i]; } tab[64] = s; }
            __syncthreads(); }
            if (EN(7) && IN(P + 7)) { PHASE_IDS
                pg8::MoeSched<1> S{tab, HC_, (const bf16*)(WL_ + WO_GU), (const int*)(ws + WS_LTOK), G, bid};
                pg8::EpiSwiglu E{(bf16*)(ws + WS_HID), tab, (const float*)(ws + WS_LRS)};
                REP_(7) pg8::gemm_phase(lds, DM, S, E, wave_s);
                SEAM(P + 7);
            }
            if (EN(8) && IN(P + 8)) { PHASE_IDS
                pg8::MoeSched<2> S{tab, (const bf16*)(ws + WS_HID), (const bf16*)(WL_ + WO_D), (const int*)(ws + WS_LTOK), G, bid};
                pg8::EpiMoeDown E{tab, (const int*)(ws + WS_LTOK), (const float*)(ws + WS_LGATE), (bf16*)(ws + WS_Y0), (bf16*)(ws + WS_Y1)};
                REP_(8) pg8::gemm_phase(lds, DEXP, S, E, wave_s);
                SEAM(P + 8);
            }
        }
        if (EN(9) && IN(P + 9)) { PHASE_IDS phase_norm3(HC_, (const bf16*)(ws + WS_Y0), (const bf16*)(ws + WS_Y1), (float*)(ws + WS_RS3), ka->in[I_P] + (size_t)L * NTOK * D_PLE, (bf16*)(ws + WS_PB), gw, NGW, lane); SEAM(P + 9); }
        if (EN(10) && IN(P + 10)) {
            if (EN(14)) { PHASE_IDS pg8::DenseSched S; S.init(HC_, DM, (const bf16*)(WL_ + WO_PG), NTOK, DM, DM, G, bid);
              pg8::EpiBf16<2> E{(bf16*)(ws + WS_G), DM, ka->in[I_BPG] + L * DM, 0, 0, (const float*)(ws + WS_RS3)};
              REP_(10) pg8::gemm_phase(lds, DM, S, E, wave_s); }
            __syncthreads();
            if (EN(15)) { PHASE_IDS pg8::DenseSched S; S.init((const bf16*)(ws + WS_PB), D_PLE, (const bf16*)(WL_ + WO_PU), NTOK, DM, D_PLE, G, bid);
              pg8::EpiPleB E{HC_, HN_, (const bf16*)(ws + WS_G)};
              pg8::gemm_phase(lds, D_PLE, S, E, wave_s); }
            SEAM(P + 10);
        }
    }
    if (IN(PH_FINAL)) { PHASE_IDS phase_final((const bf16*)(ws + ((DEPTH & 1) ? WS_U : WS_H16)), ka->out, ka->in[I_FINN], gw, NGW, lane); }
#undef IN
#undef SEAM
}

extern "C" void kernel_launch(void* const* d_in, const int* in_sizes, int n_in, void* d_out, int out_size, void* d_ws, size_t ws_size, hipStream_t stream) {
    static int grid = 0;
    if (grid == 0) {
        if (n_in != 37 || in_sizes[0] != NTOK * DM || out_size != NTOK * DM || ws_size < WS_END) {
            fprintf(stderr, "kernel_launch: unexpected shapes (n_in %d, in0 %d, out %d, ws %zu < %zu); nothing launched\n", n_in, n_in > 0 ? in_sizes[0] : -1, out_size, ws_size, (size_t)WS_END); grid = -1; return; }
        int dev = 0, cus = 0, per_cu = 0;
        if (hipGetDevice(&dev) != hipSuccess || hipDeviceGetAttribute(&cus, hipDeviceAttributeMultiprocessorCount, dev) != hipSuccess) { grid = -1; return; }
        if (hipFuncSetAttribute((const void*)fwd_kernel, hipFuncAttributeMaxDynamicSharedMemorySize, LDS_BYTES) != hipSuccess) { fprintf(stderr, "kernel_launch: hipFuncSetAttribute failed\n"); grid = -1; return; }
        if (hipOccupancyMaxActiveBlocksPerMultiprocessor(&per_cu, (const void*)fwd_kernel, NWAVES * 64, LDS_BYTES) != hipSuccess || per_cu < 1)
            fprintf(stderr, "kernel_launch: note: occupancy query reports %d workgroups per CU\n", per_cu);
        (void)hipGetLastError();
        grid = cus;
    }
    if (grid < 0) return;
    if (hipMemsetAsync((char*)d_ws + WS_CTL, 0, CTL_ZERO_BYTES, stream) != hipSuccess) return;
    Args a{};
    for (int i = 0; i < 37; ++i) a.in[i] = (const float*)d_in[i];
    a.out = (float*)d_out; a.ws = (unsigned char*)d_ws;
#if MK_MULTI
    for (int p = 0; p < N_PHASES; ++p) { a.ph_lo = p; a.ph_hi = p + 1; hipLaunchKernelGGL(fwd_kernel, dim3(grid), dim3(NWAVES * 64), LDS_BYTES, stream, a); }
#else
    a.ph_lo = 0; a.ph_hi = N_PHASES;
    hipLaunchKernelGGL(fwd_kernel, dim3(grid), dim3(NWAVES * 64), LDS_BYTES, stream, a);
#endif
    const hipError_t le = hipPeekAtLastError();
    if (le != hipSuccess) fprintf(stderr, "kernel_launch: launch failed: %s\n", hipGetErrorName(le));
}
```

```cpp
#include <hip/hip_runtime.h>
#include <cstdio>
#include <cstdint>

#ifndef PROBE_MASK
#define PROBE_MASK 0
#endif
#define REP_(j) for (int rep_ = 0; rep_ < 1 + ((PROBE_MASK >> (j)) & 1); ++rep_)
#ifndef MK_MULTI
#define MK_MULTI 0
#endif

#define GAS __attribute__((address_space(1)))
#define LAS __attribute__((address_space(3)))
typedef unsigned short bf16;
typedef float f32x4 __attribute__((ext_vector_type(4)));
typedef float f32x2 __attribute__((ext_vector_type(2)));
typedef unsigned u32x4 __attribute__((ext_vector_type(4)));
typedef unsigned u32x2 __attribute__((ext_vector_type(2)));
typedef short bf16x8 __attribute__((ext_vector_type(8)));
typedef GAS unsigned gu32;
#define RLX_AGENT __ATOMIC_RELAXED, __HIP_MEMORY_SCOPE_AGENT
#define LDS_WAIT() asm volatile("s_waitcnt lgkmcnt(0)" ::: "memory")
#define VM_WAIT() asm volatile("s_waitcnt vmcnt(0)" ::: "memory")

constexpr int BATCH = 16, SEQ = 4096, DM = 1024, DEPTH = 4, NTOK = BATCH * SEQ;
constexpr int D_PLE = 256, D_REC = 512, NH = 8, HD = 64, NKV = 2;
constexpr int D_IN = 2328, ZP = 2560;
constexpr int ZC_XR = 0, ZC_GR = 512, ZC_Q = 1024, ZC_KC = 1536, ZC_VC = 1664, ZC_KS = 1792, ZC_VS = 1920, ZC_KW = 2048, ZC_VW = 2176, ZC_NG = 2304;
constexpr int NCMP = 255, NSELB = 64, NTOP = 16, WIN = 512;
constexpr int NEXP = 32, DEXP = 512, NSEG = 64;
constexpr float EPS = 1e-6f;
constexpr float LOG2E = 1.4426950408889634f;
constexpr int NWAVES = 8;

constexpr size_t MiB = 1u << 20;
constexpr size_t WS_CTL = 0, CTL_ZERO_BYTES = 1 * MiB;
constexpr size_t WS_BK1 = 1 * MiB;
constexpr size_t WS_C8 = WS_BK1 + 8192;
constexpr size_t WS_WRT = WS_C8 + 8192;
constexpr size_t WS_AGG = 2 * MiB;
constexpr size_t WS_CARRY = 3 * MiB;
constexpr size_t WS_W2T = 4 * MiB;
constexpr size_t WS_KCMP = 5 * MiB, WS_VCMP = 7 * MiB;
constexpr size_t WS_RS1 = 6 * MiB, WS_RS3 = 6 * MiB + 512 * 1024;
constexpr size_t WS_HIDC = 9 * MiB;
constexpr size_t WS_LTOK = 17 * MiB, WS_LGATE = 33 * MiB;
constexpr size_t WS_PB = 49 * MiB;
constexpr size_t WS_W = 81 * MiB, W_LAYER = 108 * MiB;
constexpr size_t WO_IN = 0, WO_OUT = 5 * MiB, WO_PG = 7 * MiB, WO_PU = 9 * MiB, WO_K1 = 9 * MiB + 512 * 1024, WO_V1 = 10 * MiB + 512 * 1024, WO_GU = 12 * MiB, WO_D = 76 * MiB;
constexpr size_t WS_U = 513 * MiB;
constexpr size_t WS_Z = 641 * MiB;
constexpr size_t WS_HID = WS_Z;
constexpr size_t WS_G = WS_Z + 160 * MiB;
constexpr size_t WS_MIXED = 962 * MiB;
constexpr size_t WS_HLOC = 1090 * MiB, WS_CUMA = 1154 * MiB;
constexpr size_t WS_Y0 = WS_MIXED, WS_Y1 = WS_HLOC;
constexpr size_t WS_LRS = 1218 * MiB;
constexpr size_t WS_H16 = 1234 * MiB;
constexpr size_t WS_END = 1362 * MiB;
constexpr int CW_BAR = 4096;
constexpr int CW_CNT = 16384;
constexpr int CW_BK1 = 32768;
constexpr int LDS_BYTES = 163840;
constexpr int TAB_OFF = 147456;
constexpr int MISC_OFF = 147456 + 4096;

typedef float pk2_f32x2 __attribute__((ext_vector_type(2)));
typedef __bf16 pk2_bf16x2 __attribute__((ext_vector_type(2)));
__device__ __forceinline__ unsigned pk2(float lo, float hi) { const pk2_f32x2 v = {lo, hi}; return __builtin_bit_cast(unsigned, __builtin_convertvector(v, pk2_bf16x2)); }
__device__ __forceinline__ unsigned f2bf(float f) { return pk2(f, 0.f) & 0xffffu; }
__device__ __forceinline__ float bflo(unsigned u) { return __builtin_bit_cast(float, u << 16); }
__device__ __forceinline__ float bfhi(unsigned u) { return __builtin_bit_cast(float, u & 0xffff0000u); }
__device__ __forceinline__ float bf2f(bf16 b) { return __builtin_bit_cast(float, (unsigned)b << 16); }
__device__ __forceinline__ float fsigmoid(float x) { return __builtin_amdgcn_rcpf(1.f + __builtin_amdgcn_exp2f(-x * LOG2E)); }
__device__ __forceinline__ float fgelu(float x) { const float y = 1.5957691216057308f * (x + 0.044715f * x * x * x); return x * __builtin_amdgcn_rcpf(1.f + __builtin_amdgcn_exp2f(-y * LOG2E)); }
__device__ __forceinline__ int lane_id() { int x; asm volatile("v_mbcnt_lo_u32_b32 %0, -1, 0\n\tv_mbcnt_hi_u32_b32 %0, -1, %0" : "=v"(x)); return x; }
template <int CTRL> __device__ __forceinline__ float dpp_mov(float src) {
    return __builtin_bit_cast(float, __builtin_amdgcn_update_dpp(0, __builtin_bit_cast(int, src), CTRL, 0xf, 0xf, true));
}
__device__ __forceinline__ float wave_sum(float v) {
    v += dpp_mov<0xB1>(v);
    v += dpp_mov<0x4E>(v);
    v += dpp_mov<0x141>(v);
    v += dpp_mov<0x140>(v);
    const float r0 = __builtin_bit_cast(float, __builtin_amdgcn_readlane(__builtin_bit_cast(int, v), 0)), r1 = __builtin_bit_cast(float, __builtin_amdgcn_readlane(__builtin_bit_cast(int, v), 16));
    const float r2 = __builtin_bit_cast(float, __builtin_amdgcn_readlane(__builtin_bit_cast(int, v), 32)), r3 = __builtin_bit_cast(float, __builtin_amdgcn_readlane(__builtin_bit_cast(int, v), 48));
    return (r0 + r1) + (r2 + r3);
}

namespace pg8 {
#define PG8_LAS __attribute__((address_space(3)))
typedef unsigned short bf16_t;
constexpr int BM = 256, BK = 64, HALF = 128, HTB = HALF * BK * 2, STAGE_BYTES = 8 * HTB, NXCD = 8, WGM = 8;
__host__ __device__ __forceinline__ int lds_byte(int r, int c) { const int st = (r >> 4) * 2 + (c >> 5), rr = r & 15, cc = c & 31, ob = rr * 64 + cc * 2; return st * 1024 + (ob ^ (((ob >> 9) & 1) << 5)); }
__host__ __device__ __forceinline__ void stage_rc(int b, int& R, int& C) { const int st = b / 1024, sb = b % 1024, swz = sb ^ (((sb >> 9) & 1) << 5); R = (st >> 1) * 16 + swz / 64; C = (st & 1) * 32 + (swz % 64) / 2; }
__host__ __device__ __forceinline__ int perm32(int rho) { const int n = rho >> 4, i = rho & 15; return 8 * (i >> 2) + 4 * n + (i & 3); }
struct Unit { int pm, pn, a0, a1; };
__device__ __forceinline__ unsigned cvt_pk_bf16(float lo, float hi) { unsigned r; asm volatile("v_cvt_pk_bf16_f32 %0, %1, %2" : "=v"(r) : "v"(lo), "v"(hi)); return r; }

template <class Epi, class Sched>
__device__ __forceinline__ void gemm_phase(PG8_LAS unsigned char* lds, const int K, const Sched& S, const Epi& E, const int wave_s) {
    int tid_o = wave_s * 64 + lane_id(); asm volatile("" : "+v"(tid_o));
    const int tid = tid_o, wid = __builtin_amdgcn_readfirstlane(tid >> 6), lane = tid & 63, wr = wid >> 2, wc = wid & 3, fr = lane & 15, fq = lane >> 4;
    const int nt = K / BK;
    int Rr[2], Cc[2]; unsigned voffB[2];
#pragma unroll
    for (int i = 0; i < 2; ++i) { int R, C; stage_rc(tid * 16 + i * 8192, R, C); Rr[i] = R; Cc[i] = C; const int Rb = (R & ~31) + perm32(R & 31); voffB[i] = (unsigned)(Rb * K + C) * 2u; }
    const size_t kstepB = (size_t)(BK * 2), kstepA = S.kstepA();
    const size_t hstepB = (size_t)HALF * K * 2;
    const unsigned ldsw = (unsigned)wid * 1024u;
    const int aoff = lds_byte(wr * 64 + fr, fq * 8), boff = lds_byte(wc * 32 + fr, fq * 8);
#define PG8_SA(b, h) (((b) * 2 + (h)) * HTB)
#define PG8_SB(b, h) ((4 + (b) * 2 + (h)) * HTB)
#define PG8_STAGE(bufoff, gbase, voff) do { _Pragma("unroll") for (int _i = 0; _i < 2; ++_i) \
        __builtin_amdgcn_global_load_lds((const unsigned*)((const char*)(gbase) + (voff)[_i]), (PG8_LAS unsigned*)(lds + (bufoff) + ldsw + _i * 8192), 16, 0, 0); } while (0)
#define PG8_LDA(dst, b, h) do { _Pragma("unroll") for (int m = 0; m < 4; ++m) _Pragma("unroll") for (int k = 0; k < 2; ++k) dst[m][k] = *(const PG8_LAS bf16x8*)(lds + PG8_SA(b, h) + aoff + m * 2048 + k * 1024); } while (0)
#define PG8_LDB(dst, b, h) do { _Pragma("unroll") for (int n = 0; n < 2; ++n) _Pragma("unroll") for (int k = 0; k < 2; ++k) dst[n][k] = *(const PG8_LAS bf16x8*)(lds + PG8_SB(b, h) + boff + n * 2048 + k * 1024); } while (0)
#define PG8_MMA(ai, bj, At, Bt) do { __builtin_amdgcn_s_setprio(1); _Pragma("unroll") for (int m = 0; m < 4; ++m) _Pragma("unroll") for (int n = 0; n < 2; ++n) _Pragma("unroll") for (int k = 0; k < 2; ++k) \
        acc[ai][bj][m][n] = __builtin_amdgcn_mfma_f32_16x16x32_bf16(Bt[n][k], At[m][k], acc[ai][bj][m][n], 0, 0, 0); __builtin_amdgcn_s_setprio(0); } while (0)
#define PG8_WAIT_V(n) asm volatile("s_waitcnt vmcnt(" #n ")" ::: "memory")
#define PG8_WAIT_L(n) asm volatile("s_waitcnt lgkmcnt(" #n ")" ::: "memory")
#define PG8_BAR __builtin_amdgcn_s_barrier()
#define PG8_SCHED __builtin_amdgcn_sched_barrier(0)
    Unit cur, nxt; int ui = 0;
    if (!S.next(0, cur)) return;
    f32x4 acc[2][2][4][2];
#pragma unroll
    for (int a = 0; a < 2; ++a)
#pragma unroll
        for (int b = 0; b < 2; ++b)
#pragma unroll
            for (int m = 0; m < 4; ++m)
#pragma unroll
                for (int n = 0; n < 2; ++n) acc[a][b][m][n] = (f32x4){0.f, 0.f, 0.f, 0.f};
    bf16x8 At[4][2], B0[2][2], B1[2][2];
    unsigned vA[2][2], vN[2][2];
    S.a_voff(cur, Rr, Cc, vA);
    const char* cA = S.a_base(cur); const char* cB = S.b_base(cur);
    PG8_STAGE(PG8_SB(0, 0), cB, voffB); PG8_STAGE(PG8_SB(0, 1), cB + hstepB, voffB); PG8_STAGE(PG8_SA(0, 0), cA, vA[0]); PG8_STAGE(PG8_SA(0, 1), cA, vA[1]);
    if (wr == 1) PG8_BAR;
    PG8_WAIT_V(2); PG8_BAR;
    PG8_STAGE(PG8_SB(1, 0), cB + kstepB, voffB); PG8_STAGE(PG8_SA(1, 0), cA + kstepA, vA[0]); PG8_STAGE(PG8_SB(1, 1), cB + hstepB + kstepB, voffB);
    PG8_WAIT_V(6); PG8_BAR;
    for (;;) {
        const bool has_next = S.next(ui + 1, nxt);
        const char* nA = cA; const char* nB = cB;
#pragma unroll
        for (int h = 0; h < 2; ++h)
#pragma unroll
            for (int i = 0; i < 2; ++i) vN[h][i] = vA[h][i];
        if (has_next) { nA = S.a_base(nxt); nB = S.b_base(nxt); S.a_voff(nxt, Rr, Cc, vN); }
#pragma unroll 1
        for (int t = 0; t < nt; t += 2) {
            const bool last = (t == nt - 2);
            const char* a1 = cA + (size_t)(t + 1) * kstepA;
            const char* a2 = last ? nA : cA + (size_t)(t + 2) * kstepA; const char* b2 = last ? nB : cB + (size_t)(t + 2) * kstepB;
            const char* a3 = a2 + kstepA; const char* b3 = b2 + kstepB;
            unsigned v2[2][2];
#pragma unroll
            for (int h = 0; h < 2; ++h)
#pragma unroll
                for (int i = 0; i < 2; ++i) v2[h][i] = last ? vN[h][i] : vA[h][i];
            PG8_LDB(B0, 0, 0); PG8_LDB(B1, 0, 1); PG8_SCHED; PG8_LDA(At, 0, 0); PG8_STAGE(PG8_SA(1, 1), a1, vA[1]);
            PG8_WAIT_V(8); PG8_WAIT_L(0); PG8_BAR; PG8_MMA(0, 0, At, B0); PG8_MMA(0, 1, At, B1); PG8_BAR; PG8_SCHED;
            PG8_LDA(At, 0, 1); PG8_STAGE(PG8_SB(0, 0), b2, voffB); PG8_STAGE(PG8_SB(0, 1), b2 + hstepB, voffB); PG8_STAGE(PG8_SA(0, 0), a2, v2[0]);
            PG8_WAIT_V(8); PG8_WAIT_L(0); PG8_BAR; PG8_MMA(1, 0, At, B0); PG8_MMA(1, 1, At, B1); PG8_BAR; PG8_SCHED;
            PG8_LDB(B0, 1, 0); PG8_LDB(B1, 1, 1); PG8_SCHED; PG8_LDA(At, 1, 0); PG8_STAGE(PG8_SA(0, 1), a2, v2[1]);
            PG8_WAIT_V(8); PG8_WAIT_L(0); PG8_BAR; PG8_MMA(0, 0, At, B0); PG8_MMA(0, 1, At, B1); PG8_BAR; PG8_SCHED;
            PG8_LDA(At, 1, 1); PG8_STAGE(PG8_SB(1, 0), b3, voffB); PG8_STAGE(PG8_SB(1, 1), b3 + hstepB, voffB); PG8_STAGE(PG8_SA(1, 0), a3, v2[0]);
            PG8_WAIT_V(8); PG8_WAIT_L(0); PG8_BAR; PG8_MMA(1, 0, At, B0); PG8_MMA(1, 1, At, B1); PG8_BAR; PG8_SCHED;
        }
        if (wr == 0) PG8_BAR;
        E(acc, cur, wr, wc, fr, fq);
        if (!has_next) break;
#pragma unroll
        for (int a = 0; a < 2; ++a)
#pragma unroll
            for (int b = 0; b < 2; ++b)
#pragma unroll
                for (int m = 0; m < 4; ++m)
#pragma unroll
                    for (int n = 0; n < 2; ++n) acc[a][b][m][n] = (f32x4){0.f, 0.f, 0.f, 0.f};
        cur = nxt; cA = nA; cB = nB; ++ui;
#pragma unroll
        for (int h = 0; h < 2; ++h)
#pragma unroll
            for (int i = 0; i < 2; ++i) vA[h][i] = vN[h][i];
        if (wr == 1) PG8_BAR;
    }
    PG8_WAIT_V(0);
    PG8_BAR;
#undef PG8_SA
#undef PG8_SB
#undef PG8_STAGE
#undef PG8_LDA
#undef PG8_LDB
#undef PG8_MMA
#undef PG8_WAIT_V
#undef PG8_WAIT_L
#undef PG8_BAR
#undef PG8_SCHED
}

struct DenseSched {
    const bf16_t* A; const bf16_t* Bt; int lda, K; int nM, nN, nwg, G, c;
    __device__ __forceinline__ void init(const bf16_t* A_, int lda_, const bf16_t* Bt_, int M, int N, int K_, int G_, int c_) { A = A_; lda = lda_; Bt = Bt_; K = K_; nM = M / BM; nN = N / BM; nwg = nM * nN; G = G_; c = c_; }
    __device__ __forceinline__ size_t kstepA() const { return (size_t)(BK * 2); }
    __device__ __forceinline__ bool next(int i, Unit& u) const {
        const long L = (long)i * G + c; if (L >= nwg) return false;
        int wgid = (int)L; { const int q = nwg / NXCD, r = nwg % NXCD, xcd = wgid % NXCD, off = wgid / NXCD; wgid = (xcd < r ? xcd * (q + 1) : r * (q + 1) + (xcd - r) * q) + off; }
        const int nig = WGM * nN, gid = wgid / nig, fm = gid * WGM, gsz = (nM - fm) < WGM ? (nM - fm) : WGM;
        u.pm = fm + ((wgid % nig) % gsz); u.pn = (wgid % nig) / gsz; u.a0 = 0; u.a1 = 0; return true;
    }
    __device__ __forceinline__ const char* a_base(const Unit& u) const { return (const char*)A + (size_t)u.pm * BM * lda * 2; }
    __device__ __forceinline__ const char* b_base(const Unit& u) const { return (const char*)Bt + (size_t)u.pn * BM * K * 2; }
    __device__ __forceinline__ void a_voff(const Unit&, const int (&R)[2], const int (&C)[2], unsigned (&v)[2][2]) const {
#pragma unroll
        for (int h = 0; h < 2; ++h)
#pragma unroll
            for (int i = 0; i < 2; ++i) v[h][i] = (unsigned)((h * HALF + R[i]) * lda + C[i]) * 2u;
    }
};
}

#define XB_TMO      128
#define XB_XCNT(j)  (256  + 64 * (j))
#define XB_XSUB(j)  (1280 + 64 * (j))
#define XB_XGEN(j)  (2304 + 64 * (j))
#define XB_TOP      3328
#define XB_TOPGEN   3392
#define XCD_BAR_WORDS 3456
#define XB_SPIN_CAP (1u << 22)
__device__ __forceinline__ unsigned xb_ld(unsigned* p)              { return __hip_atomic_load(p, __ATOMIC_RELAXED, __HIP_MEMORY_SCOPE_AGENT); }
__device__ __forceinline__ unsigned xb_add(unsigned* p, unsigned v) { return __hip_atomic_fetch_add(p, v, __ATOMIC_RELAXED, __HIP_MEMORY_SCOPE_AGENT); }
__device__ __forceinline__ unsigned xb_xcc_id() { return (unsigned)__builtin_amdgcn_s_getreg((3 << 11) | 20) & 0xFu; }
#define XB_SPIN(cond, bar) do { unsigned _sp = 0; while (cond) { __builtin_amdgcn_s_sleep(1); \
    if ((++_sp & 255u) == 0u) { if (xb_ld(&(bar)[XB_TMO])) break; if (_sp > XB_SPIN_CAP) { atomicAdd(&(bar)[XB_TMO], 1u); break; } } } } while (0)
struct XcdBarrier { unsigned* bar; unsigned x; volatile LAS unsigned* st; int wave; };
__device__ __forceinline__ XcdBarrier xcd_barrier_post(unsigned* bar, volatile LAS unsigned* st, int wave) {
    XcdBarrier b; b.bar = bar; b.x = xb_xcc_id(); b.st = st; b.wave = wave;
    if (wave == 0 && lane_id() == 0) (void)xb_add(&bar[XB_XCNT(b.x)], 1u);
    return b;
}
__device__ __forceinline__ void xcd_barrier_complete(unsigned* bar, unsigned x, unsigned& nloc, unsigned& nx) {
    const unsigned G = gridDim.x * gridDim.y * gridDim.z;
    unsigned sum, cnt, mine, sp = 0u;
    for (;;) {
        sum = 0u; cnt = 0u; mine = 0u;
#pragma unroll
        for (unsigned j = 0; j < 16; ++j) { const unsigned c = xb_ld(&bar[XB_XCNT(j)]); sum += c; cnt += (c > 0u) ? 1u : 0u; }
        mine = xb_ld(&bar[XB_XCNT(x)]);
        if (sum == G) break;
        __builtin_amdgcn_s_sleep(1);
        if ((++sp & 255u) == 0u) { if (xb_ld(&bar[XB_TMO])) break; if (sp > XB_SPIN_CAP) { atomicAdd(&bar[XB_TMO], 1u); break; } }
    }
    nloc = mine > 0u ? mine : 1u; nx = cnt > 0u ? cnt : 1u;
}
__device__ __forceinline__ void xcd_barrier(const XcdBarrier& b) {
    asm volatile("s_waitcnt vmcnt(0)" ::: "memory");
    __syncthreads();
    if (b.wave == 0 && lane_id() == 0) {
        unsigned* bar = b.bar; asm volatile("" : "+s"(bar)); unsigned bx = b.x; asm volatile("" : "+s"(bx));
        __builtin_amdgcn_s_waitcnt(0);
        unsigned nloc = b.st[0], nx = b.st[1];
        if (nloc == 0u) { xcd_barrier_complete(bar, bx, nloc, nx); b.st[0] = nloc; b.st[1] = nx; }
        const unsigned old = xb_add(&bar[XB_XSUB(bx)], 1u);
        const unsigned gen = old / nloc;
        if (old + 1u == (gen + 1u) * nloc) {
            __builtin_amdgcn_fence(__ATOMIC_RELEASE, "agent");
            asm volatile("s_waitcnt vmcnt(0)" ::: "memory");
            const unsigned og = xb_add(&bar[XB_TOP], 1u);
            const unsigned tg = og / nx;
            if (og + 1u == (tg + 1u) * nx) xb_add(&bar[XB_TOPGEN], 1u);
            else XB_SPIN(xb_ld(&bar[XB_TOPGEN]) == tg, bar);
            __builtin_amdgcn_fence(__ATOMIC_ACQUIRE, "agent");
            xb_add(&bar[XB_XGEN(bx)], 1u);
            asm volatile("s_waitcnt vmcnt(0)" ::: "memory");
        } else {
            XB_SPIN(xb_ld(&bar[XB_XGEN(bx)]) == gen, bar);
            __builtin_amdgcn_fence(__ATOMIC_ACQUIRE, "agent");
            asm volatile("s_waitcnt vmcnt(0)" ::: "memory");
        }
    }
    __syncthreads();
}

struct Args { const float* in[37]; float* out; unsigned char* ws; int ph_lo, ph_hi; };
typedef const __attribute__((address_space(4))) Args* KArgs;
__device__ __forceinline__ KArgs ka_get() { KArgs k = (KArgs)__builtin_amdgcn_kernarg_segment_ptr(); asm volatile("" : "+s"(k)); return k; }
enum { I_X = 0, I_P, I_MIXN, I_WIN, I_CONVW, I_CONVB, I_WA, I_BA, I_WX, I_BX, I_LAM, I_PEK, I_PEV, I_WK1, I_BK1, I_WK2, I_BK2, I_WV1, I_BV1, I_WV2, I_BV2,
       I_RECN, I_ATTN, I_WOUT, I_FFNN, I_WGR, I_BGR, I_WER, I_BER, I_WGATE, I_WUP, I_WDOWN, I_PLEN, I_WPG, I_BPG, I_WPU, I_FINN };

namespace pg8 {
struct CmpSched {
    const bf16_t* z; const bf16_t* W1k; const bf16_t* W1v; int G, c;
    __device__ __forceinline__ size_t kstepA() const { return (size_t)ZP * 2; }
    __device__ __forceinline__ bool next(int i, Unit& u) const { const int L = i * G + c; if (L >= 64) return false; u.pm = L >> 1; u.pn = 0; u.a0 = L & 1; u.a1 = 0; return true; }
    __device__ __forceinline__ const char* a_base(const Unit& u) const { const int b = u.pm >> 1, g = u.pm & 1; return (const char*)(z + (size_t)b * SEQ * ZP + (u.a0 ? ZC_VC : ZC_KC) + g * 64); }
    __device__ __forceinline__ const char* b_base(const Unit& u) const { return (const char*)(u.a0 ? W1v : W1k); }
    __device__ __forceinline__ void a_voff(const Unit&, const int (&R)[2], const int (&C)[2], unsigned (&v)[2][2]) const {
#pragma unroll
        for (int h = 0; h < 2; ++h)
#pragma unroll
            for (int i = 0; i < 2; ++i) v[h][i] = (unsigned)(16 * (h * HALF + R[i]) * ZP + C[i]) * 2u;
    }
};
template <int PHASE>
struct MoeSched {
    const PG8_LAS int* tab; const bf16_t* A; const bf16_t* W; const int* ltok; int G, c;
    __device__ __forceinline__ size_t kstepA() const { return (size_t)(BK * 2); }
    __device__ __forceinline__ bool next(int i, Unit& u) const {
        const int TT = tab[64]; int rt, pn;
        if (G == 256) { const int x = c & 7, y = c >> 3, Q = (TT + 7) >> 3, rl = i * 8 + (y >> 2); pn = y & 3; if (rl >= Q) return false; rt = x * Q + rl; }
        else { const int L = i * G + c; rt = L >> 2; pn = L & 3; }
        if (rt >= TT) return false;
        int lo = 0, hi = 64;
        while (hi - lo > 1) { const int mid = (lo + hi) >> 1; if (tab[mid] <= rt) lo = mid; else hi = mid; }
        u.pm = rt; u.pn = pn; u.a0 = lo; u.a1 = rt - tab[lo]; return true;
    }
    __device__ __forceinline__ const char* a_base(const Unit& u) const { return PHASE == 1 ? (const char*)A : (const char*)A + (size_t)u.pm * BM * DEXP * 2; }
    __device__ __forceinline__ const char* b_base(const Unit& u) const {
        const int e = u.a0 & 31;
        return PHASE == 1 ? (const char*)W + ((size_t)e * 1024 + (size_t)u.pn * BM) * 1024 * 2 : (const char*)W + ((size_t)e * 1024 + (size_t)u.pn * BM) * DEXP * 2;
    }
    __device__ __forceinline__ void a_voff(const Unit& u, const int (&R)[2], const int (&C)[2], unsigned (&v)[2][2]) const {
        if (PHASE == 1) {
            const int cnt = tab[80 + u.a0];
#pragma unroll
            for (int h = 0; h < 2; ++h)
#pragma unroll
                for (int i = 0; i < 2; ++i) { const int rank = u.a1 * BM + h * HALF + R[i]; const int tok = rank < cnt ? ltok[(size_t)u.a0 * NTOK + rank] : 0; v[h][i] = (unsigned)(tok * DM + C[i]) * 2u; }
        } else {
#pragma unroll
            for (int h = 0; h < 2; ++h)
#pragma unroll
                for (int i = 0; i < 2; ++i) v[h][i] = (unsigned)((h * HALF + R[i]) * DEXP + C[i]) * 2u;
        }
    }
};

template <int ACT  > struct EpiBf16 {
    bf16_t* O; int ldc; const float* bias; size_t a0_stride; int a0_bias_stride;
    const float* rs;
    __device__ __forceinline__ void operator()(const f32x4 (&acc)[2][2][4][2], const Unit& u, int wr, int wc, int fr, int fq) const {
        const int row0 = u.pm * BM + wr * 64 + fr, col0 = u.pn * BM + wc * 32 + 8 * fq;
        bf16_t* base = O + (size_t)u.a0 * a0_stride; const float* bs = bias ? bias + u.a0 * a0_bias_stride : nullptr;
        float rsv[2][4];
#pragma unroll
        for (int ai = 0; ai < 2; ++ai)
#pragma unroll
            for (int m = 0; m < 4; ++m) rsv[ai][m] = rs ? rs[row0 + ai * HALF + m * 16] : 1.f;
        f32x4 bv[2][2];
#pragma unroll
        for (int bj = 0; bj < 2; ++bj)
#pragma unroll
            for (int n = 0; n < 2; ++n) bv[bj][n] = bs ? *(const f32x4*)(bs + col0 + bj * HALF + 4 * n) : (f32x4){0.f, 0.f, 0.f, 0.f};
#pragma unroll
        for (int ai = 0; ai < 2; ++ai)
#pragma unroll
            for (int m = 0; m < 4; ++m) { bf16_t* rowp = base + (size_t)(row0 + ai * HALF + m * 16) * ldc + col0; const float sc = rsv[ai][m];
#pragma unroll
                for (int bj = 0; bj < 2; ++bj) { f32x4 v0 = acc[ai][bj][m][0], v1 = acc[ai][bj][m][1];
                    if (rs) { v0 *= sc; v1 *= sc; }
                    v0 += bv[bj][0]; v1 += bv[bj][1];
                    if (ACT == 1) { for (int e = 0; e < 4; ++e) { v0[e] = fgelu(v0[e]); v1[e] = fgelu(v1[e]); } }
                    if (ACT == 2) { for (int e = 0; e < 4; ++e) { v0[e] = fsigmoid(v0[e]); v1[e] = fsigmoid(v1[e]); } }
                    u32x4 w; w.x = cvt_pk_bf16(v0[0], v0[1]); w.y = cvt_pk_bf16(v0[2], v0[3]); w.z = cvt_pk_bf16(v1[0], v1[1]); w.w = cvt_pk_bf16(v1[2], v1[3]);
                    *(u32x4*)(rowp + bj * HALF) = w; } }
    }
};
struct EpiResid {
    bf16_t* h;
    __device__ __forceinline__ void operator()(const f32x4 (&acc)[2][2][4][2], const Unit& u, int wr, int wc, int fr, int fq) const {
        const int row0 = u.pm * BM + wr * 64 + fr, col0 = u.pn * BM + wc * 32 + 8 * fq;
#pragma unroll
        for (int ai = 0; ai < 2; ++ai) {
            bf16_t* rp0 = h + (size_t)(row0 + ai * HALF) * DM + col0;
            u32x4 hv[4][2];
#pragma unroll
            for (int m = 0; m < 4; ++m)
#pragma unroll
                for (int bj = 0; bj < 2; ++bj) hv[m][bj] = *(const u32x4*)(rp0 + (size_t)m * 16 * DM + bj * HALF);
#pragma unroll
            for (int m = 0; m < 4; ++m)
#pragma unroll
                for (int bj = 0; bj < 2; ++bj) { const u32x4 x = hv[m][bj]; const f32x4 a0 = acc[ai][bj][m][0], a1 = acc[ai][bj][m][1];
                    u32x4 w; w.x = cvt_pk_bf16(bflo(x.x) + a0[0], bfhi(x.x) + a0[1]); w.y = cvt_pk_bf16(bflo(x.y) + a0[2], bfhi(x.y) + a0[3]); w.z = cvt_pk_bf16(bflo(x.z) + a1[0], bfhi(x.z) + a1[1]); w.w = cvt_pk_bf16(bflo(x.w) + a1[2], bfhi(x.w) + a1[3]);
                    *(u32x4*)(rp0 + (size_t)m * 16 * DM + bj * HALF) = w; }
            asm volatile("" ::: "memory");
        }
    }
};
struct EpiPleB {
    const bf16_t* h; bf16_t* hn; const bf16_t* Gt;
    __device__ __forceinline__ void operator()(const f32x4 (&acc)[2][2][4][2], const Unit& u, int wr, int wc, int fr, int fq) const {
        const int row0 = u.pm * BM + wr * 64 + fr, col0 = u.pn * BM + wc * 32 + 8 * fq;
#pragma unroll
        for (int ai = 0; ai < 2; ++ai) {
            const size_t ro0 = (size_t)(row0 + ai * HALF) * DM + col0;
            u32x4 hv[4][2], gv[4][2];
#pragma unroll
            for (int m = 0; m < 4; ++m)
#pragma unroll
                for (int bj = 0; bj < 2; ++bj) { hv[m][bj] = *(const u32x4*)(h + ro0 + (size_t)m * 16 * DM + bj * HALF); gv[m][bj] = *(const u32x4*)(Gt + ro0 + (size_t)m * 16 * DM + bj * HALF); }
#pragma unroll
            for (int m = 0; m < 4; ++m)
#pragma unroll
                for (int bj = 0; bj < 2; ++bj) { const u32x4 x = hv[m][bj], g = gv[m][bj]; const f32x4 a0 = acc[ai][bj][m][0], a1 = acc[ai][bj][m][1];
                    u32x4 w; w.x = cvt_pk_bf16(bflo(x.x) + a0[0] * bflo(g.x), bfhi(x.x) + a0[1] * bfhi(g.x)); w.y = cvt_pk_bf16(bflo(x.y) + a0[2] * bflo(g.y), bfhi(x.y) + a0[3] * bfhi(g.y));
                    w.z = cvt_pk_bf16(bflo(x.z) + a1[0] * bflo(g.z), bfhi(x.z) + a1[1] * bfhi(g.z)); w.w = cvt_pk_bf16(bflo(x.w) + a1[2] * bflo(g.w), bfhi(x.w) + a1[3] * bfhi(g.w));
                    *(u32x4*)(hn + ro0 + (size_t)m * 16 * DM + bj * HALF) = w; }
            asm volatile("" ::: "memory");
        }
    }
};
struct EpiSwiglu {
    bf16_t* Hd; const PG8_LAS int* tab; const float* lrs;
    __device__ __forceinline__ void operator()(const f32x4 (&acc)[2][2][4][2], const Unit& u, int wr, int wc, int fr, int fq) const {
        const int row0 = u.pm * BM + wr * 64 + fr, col0 = u.pn * HALF + wc * 32 + 8 * fq; const int seg = u.a0, cnt = tab[80 + seg];
        float rsv[2][4];
#pragma unroll
        for (int ai = 0; ai < 2; ++ai)
#pragma unroll
            for (int m = 0; m < 4; ++m) { const int rank = u.a1 * BM + ai * HALF + wr * 64 + m * 16 + fr; const float v = lrs[(size_t)seg * NTOK + (rank < cnt ? rank : 0)]; rsv[ai][m] = rank < cnt ? v : 0.f; }
#pragma unroll
        for (int ai = 0; ai < 2; ++ai)
#pragma unroll
            for (int m = 0; m < 4; ++m) { const float rs = rsv[ai][m];
                float r[8];
#pragma unroll
                for (int n = 0; n < 2; ++n)
#pragma unroll
                    for (int e = 0; e < 4; ++e) { const float gt = acc[ai][0][m][n][e] * rs, up = acc[ai][1][m][n][e] * rs; r[4 * n + e] = gt * fsigmoid(gt) * up; }
                u32x4 w; w.x = cvt_pk_bf16(r[0], r[1]); w.y = cvt_pk_bf16(r[2], r[3]); w.z = cvt_pk_bf16(r[4], r[5]); w.w = cvt_pk_bf16(r[6], r[7]);
                *(u32x4*)(Hd + (size_t)(row0 + ai * HALF + m * 16) * DEXP + col0) = w; }
    }
};
struct EpiMoeDown {
    const PG8_LAS int* tab; const int* ltok; const float* lgate; bf16_t* y0; bf16_t* y1;
    __device__ __forceinline__ void operator()(const f32x4 (&acc)[2][2][4][2], const Unit& u, int wr, int wc, int fr, int fq) const {
        const int seg = u.a0, cnt = tab[80 + seg]; bf16_t* yb = (seg >= 32) ? y1 : y0;
        const int col0 = u.pn * BM + wc * 32 + 8 * fq;
        int tk[2][4]; float gtv[2][4];
#pragma unroll
        for (int ai = 0; ai < 2; ++ai)
#pragma unroll
            for (int m = 0; m < 4; ++m) { const int rank = u.a1 * BM + ai * HALF + wr * 64 + m * 16 + fr; const size_t o = (size_t)seg * NTOK + (rank < cnt ? rank : 0); tk[ai][m] = ltok[o]; gtv[ai][m] = lgate[o]; }
#pragma unroll
        for (int ai = 0; ai < 2; ++ai)
#pragma unroll
            for (int m = 0; m < 4; ++m) { const int rank = u.a1 * BM + ai * HALF + wr * 64 + m * 16 + fr;
                if (rank < cnt) { const int tok = tk[ai][m]; const float gt = gtv[ai][m];
#pragma unroll
                    for (int bj = 0; bj < 2; ++bj) { const f32x4 v0 = acc[ai][bj][m][0] * gt, v1 = acc[ai][bj][m][1] * gt;
                        u32x4 w; w.x = cvt_pk_bf16(v0[0], v0[1]); w.y = cvt_pk_bf16(v0[2], v0[3]); w.z = cvt_pk_bf16(v1[0], v1[1]); w.w = cvt_pk_bf16(v1[2], v1[3]);
                        *(u32x4*)(yb + (size_t)tok * DM + col0 + bj * HALF) = w; } } }
    }
};
}

struct TrItem { const float* W; const float* gain; bf16* WT; int K, N, dest_row0, k0, n0; float cs; };
__device__ __forceinline__ void tr_load(const TrItem& t, f32x4 (&v)[8], int lane) {
    const int c4 = lane & 7, kr = lane >> 3; const bool ok = t.n0 + 4 * c4 < t.N;
#pragma unroll
    for (int i = 0; i < 8; ++i) v[i] = ok ? *(const f32x4*)(t.W + (size_t)(t.k0 + 8 * i + kr) * t.N + t.n0 + 4 * c4) : (f32x4){0.f, 0.f, 0.f, 0.f};
}
__device__ __forceinline__ void tr_store(const TrItem& t, const f32x4 (&v)[8], LAS float* scr, int lane) {
    const int c4 = lane & 7, kr = lane >> 3;
#pragma unroll
    for (int i = 0; i < 8; ++i) { const int kk = 8 * i + kr; const float gsc = (t.gain ? t.gain[t.k0 + kk] : 1.f) * t.cs; LAS float* d = scr + kk * 33 + 4 * c4;
        d[0] = v[i].x * gsc; d[1] = v[i].y * gsc; d[2] = v[i].z * gsc; d[3] = v[i].w * gsc; }
    LDS_WAIT();
    const int c = lane & 7;
#pragma unroll
    for (int j = 0; j < 4; ++j) { const int n = (lane >> 3) + 8 * j; const LAS float* sp = scr + (8 * c) * 33 + n;
        u32x4 o; o.x = pk2(sp[0], sp[33]); o.y = pk2(sp[66], sp[99]); o.z = pk2(sp[132], sp[165]); o.w = pk2(sp[198], sp[231]);
        *(u32x4*)(t.WT + (size_t)(t.dest_row0 + n) * t.K + t.k0 + 8 * c) = o; }
    LDS_WAIT();
}
constexpr int IT_IN = 16 * 80, IT_OUT = 16 * 32, IT_PG = 16 * 32, IT_PU = 4 * 32, IT_K1 = 32 * 8, IT_V1 = 32 * 8, IT_E = 768;
constexpr int IT_LAYER = IT_IN + IT_OUT + IT_PG + IT_PU + IT_K1 + IT_V1 + NEXP * IT_E;

constexpr int IT_SMALL = IT_IN + IT_OUT + IT_PG + IT_PU + IT_K1 + IT_V1;
template <int MODE>
__device__ __forceinline__ void tr_run(KArgs args, LAS float* scr, int lane, int q0, int qstep, int Lsel) {
    unsigned char* ws = args->ws;
    const int nq = MODE == 0 ? DEPTH * IT_SMALL : NEXP * IT_E;
#define Q2IT_(q) (MODE == 0 ? ((q) / IT_SMALL) * IT_LAYER + (q) % IT_SMALL : Lsel * IT_LAYER + IT_SMALL + (q))
#define TR_DECODE(it_, t_) do { const int L = (it_) / IT_LAYER; int r = (it_) % IT_LAYER; unsigned char* wl = ws + WS_W + (size_t)L * W_LAYER; t_.cs = 1.f; t_.gain = nullptr; \
        if (r < IT_IN) { const int kb = r / 80, nb = r % 80; t_.W = args->in[I_WIN] + (size_t)L * DM * D_IN; t_.K = DM; t_.N = D_IN; t_.gain = args->in[I_MIXN] + L * DM; t_.WT = (bf16*)(wl + WO_IN); t_.dest_row0 = 32 * nb; t_.k0 = 64 * kb; t_.n0 = 32 * nb; \
            t_.cs = (32 * nb >= ZC_Q && 32 * nb < ZC_KC) ? 0.125f * LOG2E : 1.f; break; } r -= IT_IN; \
        if (r < IT_OUT) { const int kb = r / 32, nb = r % 32; t_.W = args->in[I_WOUT] + (size_t)L * DM * DM; t_.K = DM; t_.N = DM; t_.gain = kb < 8 ? args->in[I_RECN] + L * 512 : args->in[I_ATTN] + L * 512 - 512; t_.WT = (bf16*)(wl + WO_OUT); t_.dest_row0 = 32 * nb; t_.k0 = 64 * kb; t_.n0 = 32 * nb; break; } r -= IT_OUT; \
        if (r < IT_PG) { const int kb = r / 32, nb = r % 32; t_.W = args->in[I_WPG] + (size_t)L * DM * DM; t_.K = DM; t_.N = DM; t_.gain = args->in[I_PLEN] + L * DM; t_.WT = (bf16*)(wl + WO_PG); t_.dest_row0 = 32 * nb; t_.k0 = 64 * kb; t_.n0 = 32 * nb; break; } r -= IT_PG; \
        if (r < IT_PU) { const int kb = r / 32, nb = r % 32; t_.W = args->in[I_WPU] + (size_t)L * D_PLE * DM; t_.K = D_PLE; t_.N = DM; t_.WT = (bf16*)(wl + WO_PU); t_.dest_row0 = 32 * nb; t_.k0 = 64 * kb; t_.n0 = 32 * nb; break; } r -= IT_PU; \
        if (r < IT_K1) { const int kb = r / 8, nb = r % 8; t_.W = args->in[I_WK1] + (size_t)L * 2048 * 256; t_.K = 2048; t_.N = 256; t_.WT = (bf16*)(wl + WO_K1); t_.dest_row0 = 32 * nb; t_.k0 = 64 * kb; t_.n0 = 32 * nb; break; } r -= IT_K1; \
        if (r < IT_V1) { const int kb = r / 8, nb = r % 8; t_.W = args->in[I_WV1] + (size_t)L * 2048 * 256; t_.K = 2048; t_.N = 256; t_.WT = (bf16*)(wl + WO_V1); t_.dest_row0 = 32 * nb; t_.k0 = 64 * kb; t_.n0 = 32 * nb; break; } r -= IT_V1; \
        const int e = r / IT_E; int rr = r % IT_E; \
        if (rr < 512) { const int up = rr >> 8; rr &= 255; const int kb = rr / 16, nb = rr % 16, n0 = 32 * nb;     \
            t_.W = (up ? args->in[I_WUP] : args->in[I_WGATE]) + ((size_t)L * NEXP + e) * DM * DEXP; t_.K = DM; t_.N = DEXP; t_.gain = args->in[I_FFNN] + L * DM; t_.WT = (bf16*)(wl + WO_GU) + (size_t)e * 1024 * 1024; \
            t_.dest_row0 = 256 * (n0 >> 7) + (n0 & 127) + 128 * up; t_.k0 = 64 * kb; t_.n0 = n0; } \
        else { rr -= 512; const int kb = rr / 32, nb = rr % 32; t_.W = args->in[I_WDOWN] + ((size_t)L * NEXP + e) * DEXP * DM; t_.K = DEXP; t_.N = DM; t_.WT = (bf16*)(wl + WO_D) + (size_t)e * 1024 * DEXP; t_.dest_row0 = 32 * nb; t_.k0 = 64 * kb; t_.n0 = 32 * nb; } \
    } while (0)
    int q = q0; TrItem cur; f32x4 vc[8];
    if (q < nq) { TR_DECODE(Q2IT_(q), cur); tr_load(cur, vc, lane); }
    while (q < nq) {
        const int qn = q + qstep; TrItem nxt; f32x4 vn[8];
        const bool hn = qn < nq;
        if (hn) { TR_DECODE(Q2IT_(qn), nxt); tr_load(nxt, vn, lane); }
        tr_store(cur, vc, scr, lane);
        if (hn) { cur = nxt;
#pragma unroll
            for (int i = 0; i < 8; ++i) vc[i] = vn[i]; }
        q = qn; }
#undef TR_DECODE
#undef Q2IT_
}
__device__ __forceinline__ void phase_prologue(KArgs args, LAS unsigned char* lds, int G, int bid, int tid, int wave, int lane) {
    unsigned char* ws = args->ws;
    LAS float* scr = (LAS float*)(lds + wave * 16384);
    const int gw = bid * NWAVES + wave, NGW = G * NWAVES;
    tr_run<0>(args, scr, lane, gw, NGW, 0);
    const int gt = bid * (NWAVES * 64) + tid, NGT = G * NWAVES * 64;
    float* c8 = (float*)(ws + WS_C8); float* wrt = (float*)(ws + WS_WRT);
    for (int i = gt; i < DEPTH * 512; i += NGT) { const float lam = args->in[I_LAM][i]; c8[i] = -8.f * log1pf(expf(-lam)) * LOG2E; }
    for (int i = gt; i < DEPTH * 36 * 1024; i += NGT) { const int L = i / (36 * 1024), j = (i / 1024) % 36, k = i % 1024;
        const float w = (j < 32 ? args->in[I_WER][((size_t)L * DM + k) * 32 + j] : args->in[I_WGR][((size_t)L * DM + k) * 4 + (j - 32)]) * args->in[I_FFNN][L * DM + k];
        const unsigned hi = f2bf(w), lo = f2bf(w - bf2f((bf16)hi));
        ((bf16*)wrt)[((size_t)(L * 2 + 0) * 36 + j) * 1024 + k] = (bf16)hi; ((bf16*)wrt)[((size_t)(L * 2 + 1) * 36 + j) * 1024 + k] = (bf16)lo; }
    { bf16* w2t = (bf16*)(ws + WS_W2T);
      for (int i = gt; i < DEPTH * 2 * 64 * 256; i += NGT) { const int L = i >> 15, kv = (i >> 14) & 1, n = (i >> 8) & 63, k = i & 255;
          w2t[i] = (bf16)f2bf((kv ? args->in[I_WV2] : args->in[I_WK2])[((size_t)L * 256 + k) * 64 + n]); } }
    if (bid < 8) { const int pair = bid, L = pair >> 1, kv = pair & 1, j = tid & 255, half = tid >> 8;
        const float* pe = (kv ? args->in[I_PEV] : args->in[I_PEK]) + L * 2048 + 1024 * half; const float* w1 = (kv ? args->in[I_WV1] : args->in[I_WK1]) + ((size_t)L * 2048 + 1024 * half) * 256 + j;
        float s0 = 0.f, s1 = 0.f, s2 = 0.f, s3 = 0.f;
#pragma unroll 4
        for (int k = 0; k < 1024; k += 4) { s0 += pe[k] * w1[(size_t)k * 256]; s1 += pe[k + 1] * w1[(size_t)(k + 1) * 256]; s2 += pe[k + 2] * w1[(size_t)(k + 2) * 256]; s3 += pe[k + 3] * w1[(size_t)(k + 3) * 256]; }
        LAS float* red = (LAS float*)(lds + 8 * 16384);
        if (half) red[j] = (s0 + s1) + (s2 + s3);
        __syncthreads();
        if (!half) ((float*)(ws + WS_BK1))[pair * 256 + j] = (kv ? args->in[I_BV1] : args->in[I_BK1])[L * 256 + j] + ((s0 + s1) + (s2 + s3)) + red[j]; }
}

__device__ __forceinline__ void store_row_bf16(bf16* orow, const f32x4 (&v)[4], float sc, int lane) {
    unsigned long long* o8 = (unsigned long long*)orow + lane;
#pragma unroll
    for (int j = 0; j < 4; ++j) o8[64 * j] = (unsigned long long)pk2(v[j].x * sc, v[j].y * sc) | ((unsigned long long)pk2(v[j].z * sc, v[j].w * sc) << 32);
}
__device__ __forceinline__ float row_ss_bf16(const u32x2 (&v)[4]) { float s = 0.f;
#pragma unroll
    for (int j = 0; j < 4; ++j) { const float a = bflo(v[j].x), b = bfhi(v[j].x), c = bflo(v[j].y), d = bfhi(v[j].y); s += (a * a + b * b) + (c * c + d * d); }
    return s; }
__device__ __forceinline__ void store_row_bf16_from16(bf16* orow, const u32x2 (&v)[4], float sc, int lane) {
    u32x2* o8 = (u32x2*)orow + lane;
#pragma unroll
    for (int j = 0; j < 4; ++j) { u32x2 w; w.x = pk2(bflo(v[j].x) * sc, bfhi(v[j].x) * sc); w.y = pk2(bflo(v[j].y) * sc, bfhi(v[j].y) * sc); o8[64 * j] = w; }
}
__device__ __forceinline__ float ss_u4(const u32x4& v) {
    const float a = bflo(v.x), b = bfhi(v.x), c = bflo(v.y), d = bfhi(v.y), e = bflo(v.z), f = bfhi(v.z), g = bflo(v.w), h = bfhi(v.w);
    return ((a * a + b * b) + (c * c + d * d)) + ((e * e + f * f) + (g * g + h * h)); }
__device__ __forceinline__ u32x4 scale_u4(const u32x4& v, float sc) { u32x4 w;
    w.x = pg8::cvt_pk_bf16(bflo(v.x) * sc, bfhi(v.x) * sc); w.y = pg8::cvt_pk_bf16(bflo(v.y) * sc, bfhi(v.y) * sc); w.z = pg8::cvt_pk_bf16(bflo(v.z) * sc, bfhi(v.z) * sc); w.w = pg8::cvt_pk_bf16(bflo(v.w) * sc, bfhi(v.w) * sc); return w; }
__device__ __forceinline__ u32x4 add3_u4(const u32x4& h, const u32x4& a, const u32x4& b) { u32x4 w;
    w.x = pg8::cvt_pk_bf16(bflo(h.x) + bflo(a.x) + bflo(b.x), bfhi(h.x) + bfhi(a.x) + bfhi(b.x)); w.y = pg8::cvt_pk_bf16(bflo(h.y) + bflo(a.y) + bflo(b.y), bfhi(h.y) + bfhi(a.y) + bfhi(b.y));
    w.z = pg8::cvt_pk_bf16(bflo(h.z) + bflo(a.z) + bflo(b.z), bfhi(h.z) + bfhi(a.z) + bfhi(b.z)); w.w = pg8::cvt_pk_bf16(bflo(h.w) + bflo(a.w) + bflo(b.w), bfhi(h.w) + bfhi(a.w) + bfhi(b.w)); return w; }
constexpr int N1_PITCH = 2064, ZN_IN = 2304;
__device__ __forceinline__ void phase_norm1(KArgs args, const float* x, bf16* H, float* rs, int L, LAS unsigned char* lds, int G, int bid, int tid, int wave, int lane) {
    unsigned char* ws = args->ws;
    { const u32x4* src = (const u32x4*)(ws + WS_W + (size_t)L * W_LAYER + WO_IN + (size_t)ZN_IN * DM * 2);
      for (int i = tid; i < 24 * 128; i += NWAVES * 64) { const int row = i >> 7, c = i & 127; *(LAS u32x4*)(lds + row * N1_PITCH + c * 16) = src[i]; } }
    __syncthreads();
    bf16* z = (bf16*)(ws + WS_Z);
    const int gw = bid * NWAVES + wave, NGW = G * NWAVES, fr = lane & 15, fq = lane >> 4;
    const int arow1 = 16 + (fr & 7);
    for (int grp = gw; grp < NTOK / 16; grp += NGW) {
        if (x) {
#pragma unroll 1
            for (int r0 = 0; r0 < 16; r0 += 2) { f32x4 v[2][4];
#pragma unroll
                for (int r = 0; r < 2; ++r)
#pragma unroll
                    for (int j = 0; j < 4; ++j) v[r][j] = __builtin_nontemporal_load((const f32x4*)(x + (size_t)(grp * 16 + r0 + r) * DM) + lane + 64 * j);
#pragma unroll
                for (int r = 0; r < 2; ++r) store_row_bf16(H + (size_t)(grp * 16 + r0 + r) * DM, v[r], 1.f, lane); }
            VM_WAIT();
        }
        const int tok = grp * 16 + fr;
        const bf16* hrow = H + (size_t)tok * DM + 8 * fq;
        f32x4 acc0 = {0.f, 0.f, 0.f, 0.f}, acc1 = {0.f, 0.f, 0.f, 0.f}; float ss = 0.f;
#pragma unroll 1
        for (int k0 = 0; k0 < 32; k0 += 16) {
            u32x4 xhv[16];
#pragma unroll
            for (int kq = 0; kq < 16; ++kq) xhv[kq] = *(const u32x4*)(hrow + 32 * (k0 + kq));
#pragma unroll
            for (int kq = 0; kq < 16; ++kq) { const int kk = k0 + kq; const u32x4 xh = xhv[kq];
                ss += ss_u4(xh);
                const bf16x8 bh = __builtin_bit_cast(bf16x8, xh);
                const bf16x8 a0 = *(const LAS bf16x8*)(lds + fr * N1_PITCH + 64 * kk + 16 * fq), a1 = *(const LAS bf16x8*)(lds + arow1 * N1_PITCH + 64 * kk + 16 * fq);
                acc0 = __builtin_amdgcn_mfma_f32_16x16x32_bf16(a0, bh, acc0, 0, 0, 0); acc1 = __builtin_amdgcn_mfma_f32_16x16x32_bf16(a1, bh, acc1, 0, 0, 0); } }
        ss += __builtin_bit_cast(float, __builtin_amdgcn_ds_bpermute((lane ^ 16) << 2, __builtin_bit_cast(int, ss)));
        ss += __builtin_bit_cast(float, __builtin_amdgcn_ds_bpermute((lane ^ 32) << 2, __builtin_bit_cast(int, ss)));
        const float rstd = rsqrtf(ss * (1.f / DM) + EPS);
        if (fq == 0) rs[tok] = rstd;
        bf16* zg = z + (size_t)tok * ZP + ZC_NG;
        { u32x2 w; w.x = pk2(acc0[0] * rstd, acc0[1] * rstd); w.y = pk2(acc0[2] * rstd, acc0[3] * rstd); *(u32x2*)(zg + 4 * fq) = w; }
        if (fq < 2) { u32x2 w; w.x = pk2(acc1[0] * rstd, acc1[1] * rstd); w.y = pk2(acc1[2] * rstd, acc1[3] * rstd); *(u32x2*)(zg + 16 + 4 * fq) = w; }
    }
}
__device__ __forceinline__ void phase_final(const bf16* H, float* out, const float* gain, int gw, int NGW, int lane) {
    constexpr int NR = 4;
    f32x4 gv[2][2];
#pragma unroll
    for (int j = 0; j < 2; ++j) { gv[j][0] = ((const f32x4*)gain)[2 * lane + 128 * j]; gv[j][1] = ((const f32x4*)gain)[2 * lane + 128 * j + 1]; }
    for (int m0 = gw * NR; m0 < NTOK; m0 += NGW * NR) { u32x4 v[NR][2];
#pragma unroll
        for (int r = 0; r < NR; ++r)
#pragma unroll
            for (int j = 0; j < 2; ++j) v[r][j] = ((const u32x4*)(H + (size_t)(m0 + r) * DM))[lane + 64 * j];
#pragma unroll
        for (int r = 0; r < NR; ++r) { const float rstd = rsqrtf(wave_sum(ss_u4(v[r][0]) + ss_u4(v[r][1])) * (1.f / DM) + EPS);
            f32x4* xr = (f32x4*)(out + (size_t)(m0 + r) * DM);
#pragma unroll
            for (int j = 0; j < 2; ++j) { const u32x4 w = v[r][j];
                __builtin_nontemporal_store((f32x4){bflo(w.x), bfhi(w.x), bflo(w.y), bfhi(w.y)} * rstd * gv[j][0], xr + 2 * lane + 128 * j);
                __builtin_nontemporal_store((f32x4){bflo(w.z), bfhi(w.z), bflo(w.w), bfhi(w.w)} * rstd * gv[j][1], xr + 2 * lane + 128 * j + 1); } } }
}
__device__ __forceinline__ void phase_norm3(bf16* H, const bf16* y0, const bf16* y1, float* rs, const float* pL, bf16* pb, int gw, int NGW, int lane) {
    constexpr int NR = 4;
    for (int m0 = gw * NR; m0 < NTOK; m0 += NGW * NR) { u32x4 hv[NR][2], av[NR][2], bv[NR][2]; f32x4 pv[NR];
#pragma unroll
        for (int r = 0; r < NR; ++r) { const size_t ro = (size_t)(m0 + r) * DM;
#pragma unroll
            for (int j = 0; j < 2; ++j) { hv[r][j] = ((const u32x4*)(H + ro))[lane + 64 * j]; av[r][j] = __builtin_nontemporal_load((const u32x4*)(y0 + ro) + lane + 64 * j); bv[r][j] = __builtin_nontemporal_load((const u32x4*)(y1 + ro) + lane + 64 * j); }
            pv[r] = __builtin_nontemporal_load((const f32x4*)(pL + (size_t)(m0 + r) * D_PLE) + lane); }
        float rr[NR];
#pragma unroll
        for (int r = 0; r < NR; ++r) { const size_t ro = (size_t)(m0 + r) * DM;
            const u32x4 w0 = add3_u4(hv[r][0], av[r][0], bv[r][0]), w1 = add3_u4(hv[r][1], av[r][1], bv[r][1]);
            ((u32x4*)(H + ro))[lane] = w0; ((u32x4*)(H + ro))[lane + 64] = w1;
            rr[r] = rsqrtf(wave_sum(ss_u4(w0) + ss_u4(w1)) * (1.f / DM) + EPS);
            u32x2 q; q.x = pg8::cvt_pk_bf16(pv[r].x, pv[r].y); q.y = pg8::cvt_pk_bf16(pv[r].z, pv[r].w);
            ((u32x2*)(pb + (size_t)(m0 + r) * D_PLE))[lane] = q; }
        if (lane == 0) *(f32x4*)(rs + m0) = (f32x4){rr[0], rr[1], rr[2], rr[3]}; }
}
constexpr int N2_PITCH = 2064, N2_WL = 36 * N2_PITCH;
__device__ __forceinline__ void phase_norm2(KArgs args, const bf16* H, int L, LAS unsigned char* lds, int G, int bid, int tid, int wave, int lane) {
    unsigned char* ws = args->ws;
    { const u32x4* src = (const u32x4*)(ws + WS_WRT + (size_t)L * 2 * 36 * 2048);
      for (int i = tid; i < 2 * 36 * 128; i += NWAVES * 64) { const int hl = i / (36 * 128), row = (i >> 7) % 36, c = i & 127; *(LAS u32x4*)(lds + hl * N2_WL + row * N2_PITCH + c * 16) = src[i]; } }
    __syncthreads();
    gu32* cnt = (gu32*)(ws + WS_CTL) + CW_CNT + L * 64;
    int* ltok = (int*)(ws + WS_LTOK); float* lgate = (float*)(ws + WS_LGATE); float* lrs = (float*)(ws + WS_LRS);
    const float* bgr = args->in[I_BGR] + L * 4; const float* ber = args->in[I_BER] + L * 32;
    const int gw = bid * NWAVES + wave, NGW = G * NWAVES, fr = lane & 15, fq = lane >> 4;
    const int arow[3] = {8 * (fr >> 2) + (fr & 3), 8 * (fr >> 2) + (fr & 3) + 4, 32 + (fr & 3)};
    for (int grp = gw; grp < NTOK / 16; grp += NGW) {
        const int tok = grp * 16 + fr;
        const bf16* hrow = H + (size_t)tok * DM + 8 * fq;
        f32x4 acc[3]; float ss = 0.f;
#pragma unroll
        for (int t3 = 0; t3 < 3; ++t3) acc[t3] = (f32x4){0.f, 0.f, 0.f, 0.f};
#pragma unroll 1
        for (int k0 = 0; k0 < 32; k0 += 16) {
        u32x4 xhv[16];
#pragma unroll
        for (int kq = 0; kq < 16; ++kq) xhv[kq] = *(const u32x4*)(hrow + 32 * (k0 + kq));
#pragma unroll
        for (int kq = 0; kq < 16; ++kq) { const int kk = k0 + kq;
            const u32x4 xh = xhv[kq];
            { const float a0 = bflo(xh.x), a1 = bfhi(xh.x), a2 = bflo(xh.y), a3 = bfhi(xh.y), a4 = bflo(xh.z), a5 = bfhi(xh.z), a6 = bflo(xh.w), a7 = bfhi(xh.w);
              ss += (a0 * a0 + a1 * a1) + (a2 * a2 + a3 * a3) + (a4 * a4 + a5 * a5) + (a6 * a6 + a7 * a7); }
            const bf16x8 bh = __builtin_bit_cast(bf16x8, xh);
#pragma unroll
            for (int t3 = 0; t3 < 3; ++t3) { const bf16x8 ah = *(const LAS bf16x8*)(lds + arow[t3] * N2_PITCH + 64 * kk + 16 * fq), al = *(const LAS bf16x8*)(lds + N2_WL + arow[t3] * N2_PITCH + 64 * kk + 16 * fq);
                acc[t3] = __builtin_amdgcn_mfma_f32_16x16x32_bf16(ah, bh, acc[t3], 0, 0, 0); acc[t3] = __builtin_amdgcn_mfma_f32_16x16x32_bf16(al, bh, acc[t3], 0, 0, 0); }
        }
        }
        ss += __builtin_bit_cast(float, __builtin_amdgcn_ds_bpermute((lane ^ 16) << 2, __builtin_bit_cast(int, ss)));
        ss += __builtin_bit_cast(float, __builtin_amdgcn_ds_bpermute((lane ^ 32) << 2, __builtin_bit_cast(int, ss)));
        const float rstd = rsqrtf(ss * (1.f / DM) + EPS);
        float gl[4]; int gi = 0;
#pragma unroll
        for (int j = 0; j < 4; ++j) gl[j] = acc[2][j] * rstd + bgr[j];
        float gmax = gl[0];
#pragma unroll
        for (int j = 1; j < 4; ++j) if (gl[j] > gmax) { gmax = gl[j]; gi = j; }
        if (fq == gi) {
            float den = 0.f;
#pragma unroll
            for (int j = 0; j < 4; ++j) den += expf(gl[j] - gmax);
            const float pg = 1.f / den;
            float b1 = -3.0e38f, b2 = -3.0e38f; int j1 = 0, j2 = 0;
#pragma unroll
            for (int e = 0; e < 8; ++e) { const float x = (e < 4 ? acc[0][e & 3] : acc[1][e & 3]) * rstd + ber[gi * 8 + e];
                if (x > b1) { b2 = b1; j2 = j1; b1 = x; j1 = e; } else if (x > b2) { b2 = x; j2 = e; } }
            const float w1 = 1.f / (1.f + expf(b2 - b1)), w2 = 1.f - w1;
            const int s0 = gi * 8 + j1, s1 = 32 + gi * 8 + j2;
            const unsigned r0 = __hip_atomic_fetch_add(cnt + s0, 1u, RLX_AGENT), r1 = __hip_atomic_fetch_add(cnt + s1, 1u, RLX_AGENT);
            ltok[(size_t)s0 * NTOK + r0] = tok; lgate[(size_t)s0 * NTOK + r0] = pg * w1; lrs[(size_t)s0 * NTOK + r0] = rstd;
            ltok[(size_t)s1 * NTOK + r1] = tok; lgate[(size_t)s1 * NTOK + r1] = pg * w2; lrs[(size_t)s1 * NTOK + r1] = rstd;
        }
    }
}
template <int CTRL> __device__ __forceinline__ float dpp_row_shr(float old, float src) {
    return __builtin_bit_cast(float, __builtin_amdgcn_update_dpp(__builtin_bit_cast(int, old), __builtin_bit_cast(int, src), CTRL, 0xf, 0xf, false));
}
__device__ __forceinline__ void rec1_unit(KArgs args, int L, int unit, LAS unsigned char* lds, int wave, int lane) {
    unsigned char* ws = args->ws;
    const bf16* z = (const bf16*)(ws + WS_Z);
    bf16* hloc = (bf16*)(ws + WS_HLOC); bf16* cumA = (bf16*)(ws + WS_CUMA); float* agg = (float*)(ws + WS_AGG);
    const int b = unit >> 4, chk = unit & 15, t0 = chk * 256, fr = lane & 15, q = lane >> 4, hb = wave;
    const float* Wa = args->in[I_WA] + ((size_t)(L * 8 + hb)) * 4096; const float* Wx = args->in[I_WX] + ((size_t)(L * 8 + hb)) * 4096;
    LAS unsigned char* wl = lds + wave * 16384;
#pragma unroll 1
    for (int f = 0; f < 16; ++f) { const int mat = f >> 3, n = (f >> 1) & 3, kk = f & 1; const float* W = mat ? Wx : Wa;
        const int jout = 8 * (fr >> 2) + (fr & 3) + 4 * (n & 1) + 32 * (n >> 1); const float* wp = W + (32 * kk + 8 * q) * 64 + jout;
        u32x4 w; w.x = pk2(wp[0], wp[64]); w.y = pk2(wp[128], wp[192]); w.z = pk2(wp[256], wp[320]); w.w = pk2(wp[384], wp[448]);
        *(LAS u32x4*)(wl + f * 1024 + lane * 16) = w; }
    LAS float* ct = (LAS float*)(lds + 131072 + wave * 2048);
    { const int c = 64 * hb + lane; const float* cw = args->in[I_CONVW] + (size_t)L * 4 * 512;
      ct[lane * 8 + 0] = cw[c]; ct[lane * 8 + 1] = cw[512 + c]; ct[lane * 8 + 2] = cw[1024 + c]; ct[lane * 8 + 3] = cw[1536 + c];
      ct[lane * 8 + 4] = args->in[I_CONVB][L * 512 + c]; ct[lane * 8 + 5] = args->in[I_BA][L * 512 + c]; ct[lane * 8 + 6] = args->in[I_BX][L * 512 + c];
      ct[lane * 8 + 7] = ((const float*)(ws + WS_C8))[L * 512 + c]; }
    LDS_WAIT();
    float Acar[2][8], Hcar[2][8];
#pragma unroll
    for (int kk = 0; kk < 2; ++kk)
#pragma unroll
        for (int e = 0; e < 8; ++e) { Acar[kk][e] = 1.f; Hcar[kk][e] = 0.f; }
    const bf16* zb = z + (size_t)(b * SEQ) * ZP + ZC_XR + 64 * hb;
    const int bidx15 = ((lane & ~15) | 15) << 2;
    u32x4 rawc[2][4];
#define REC_LOAD_TILE(dst_, tile_) do { const int t_ = t0 + (tile_) * 16 + fr; _Pragma("unroll") for (int kk_ = 0; kk_ < 2; ++kk_) _Pragma("unroll") for (int j_ = 0; j_ < 4; ++j_) { const int tt_ = t_ - 3 + j_; \
        dst_[kk_][j_] = *(const u32x4*)(zb + (size_t)(tt_ > 0 ? tt_ : 0) * ZP + 32 * kk_ + 8 * q); } } while (0)
    REC_LOAD_TILE(rawc, 0);
#pragma unroll 1
    for (int tile = 0; tile < 16; ++tile) {
        const int t = t0 + tile * 16 + fr; const bool edge = (t0 + tile * 16) == 0;
        u32x4 rawn[2][4];
        REC_LOAD_TILE(rawn, tile < 15 ? tile + 1 : 15);
        u32x4 xb[2];
#pragma unroll
        for (int kk = 0; kk < 2; ++kk) {
            float xc[8];
#pragma unroll
            for (int e = 0; e < 8; ++e) xc[e] = ct[(32 * kk + 8 * q + e) * 8 + 4];
#pragma unroll
            for (int j = 0; j < 4; ++j) { const int tt = t - 3 + j;
                u32x4 raw = rawc[kk][j];
                if (edge && tt < 0) raw = (u32x4){0u, 0u, 0u, 0u};
                const float xv[8] = {bflo(raw.x), bfhi(raw.x), bflo(raw.y), bfhi(raw.y), bflo(raw.z), bfhi(raw.z), bflo(raw.w), bfhi(raw.w)};
#pragma unroll
                for (int e = 0; e < 8; ++e) xc[e] += ct[(32 * kk + 8 * q + e) * 8 + j] * xv[e]; }
            xb[kk].x = pk2(xc[0], xc[1]); xb[kk].y = pk2(xc[2], xc[3]); xb[kk].z = pk2(xc[4], xc[5]); xb[kk].w = pk2(xc[6], xc[7]);
        }
        asm volatile("" ::: "memory");
#pragma unroll
        for (int kh = 0; kh < 2; ++kh) {
            f32x4 racc[2], iacc[2];
#pragma unroll
            for (int nn = 0; nn < 2; ++nn) { racc[nn] = (f32x4){0.f, 0.f, 0.f, 0.f}; iacc[nn] = (f32x4){0.f, 0.f, 0.f, 0.f};
#pragma unroll
                for (int kk = 0; kk < 2; ++kk) { const int n = 2 * kh + nn;
                    const bf16x8 fa = *(const LAS bf16x8*)(wl + ((0 * 4 + n) * 2 + kk) * 1024 + lane * 16), fx = *(const LAS bf16x8*)(wl + ((1 * 4 + n) * 2 + kk) * 1024 + lane * 16);
                    const bf16x8 xk = __builtin_bit_cast(bf16x8, xb[kk]);
                    racc[nn] = __builtin_amdgcn_mfma_f32_16x16x32_bf16(fa, xk, racc[nn], 0, 0, 0); iacc[nn] = __builtin_amdgcn_mfma_f32_16x16x32_bf16(fx, xk, iacc[nn], 0, 0, 0); } }
            const unsigned xw[4] = {xb[kh].x, xb[kh].y, xb[kh].z, xb[kh].w};
            float hv[8], av[8];
#pragma unroll
            for (int e = 0; e < 8; ++e) {
                const int nn = e >> 2, jj = e & 3; const int cb = (32 * kh + 8 * q + e) * 8;
                const float xcv = (e & 1) ? bfhi(xw[e >> 1]) : bflo(xw[e >> 1]);
                const float r = fsigmoid(racc[nn][jj] + ct[cb + 5]), ig = fsigmoid(iacc[nn][jj] + ct[cb + 6]);
                float a = __builtin_amdgcn_exp2f(ct[cb + 7] * r);
                float bb = __builtin_amdgcn_sqrtf(fmaxf(1.f - a * a, 0.f)) * (ig * xcv);
#define REC_SCAN_STEP(N_) asm volatile("s_nop 1\n\tv_fmac_f32_dpp %0, %0, %1 row_shr:" #N_ " row_mask:0xf bank_mask:0xf\n\ts_nop 1\n\tv_mul_f32_dpp %1, %1, %1 row_shr:" #N_ " row_mask:0xf bank_mask:0xf" : "+v"(bb), "+v"(a))
                REC_SCAN_STEP(1); REC_SCAN_STEP(2); REC_SCAN_STEP(4); REC_SCAN_STEP(8);
#undef REC_SCAN_STEP
                const float hl = a * Hcar[kh][e] + bb, ca = a * Acar[kh][e];
                hv[e] = hl; av[e] = ca;
                Hcar[kh][e] = __builtin_bit_cast(float, __builtin_amdgcn_ds_bpermute(bidx15, __builtin_bit_cast(int, hl))); Acar[kh][e] = __builtin_bit_cast(float, __builtin_amdgcn_ds_bpermute(bidx15, __builtin_bit_cast(int, ca)));
            }
            const size_t o = (size_t)(b * SEQ + t) * D_REC + 64 * hb + 32 * kh + 8 * q;
            u32x4 w; w.x = pk2(hv[0], hv[1]); w.y = pk2(hv[2], hv[3]); w.z = pk2(hv[4], hv[5]); w.w = pk2(hv[6], hv[7]);
            *(u32x4*)(hloc + o) = w;
            w.x = pk2(av[0], av[1]); w.y = pk2(av[2], av[3]); w.z = pk2(av[4], av[5]); w.w = pk2(av[6], av[7]);
            *(u32x4*)(cumA + o) = w;
            asm volatile("" ::: "memory");
        }
#pragma unroll
        for (int kk = 0; kk < 2; ++kk)
#pragma unroll
            for (int j = 0; j < 4; ++j) rawc[kk][j] = rawn[kk][j];
    }
#undef REC_LOAD_TILE
    if (fr == 0) {
#pragma unroll
        for (int kk = 0; kk < 2; ++kk)
#pragma unroll
            for (int e = 0; e < 8; ++e) { const int c = 64 * hb + 32 * kk + 8 * q + e; float* ap = agg + ((size_t)(b * 16 + chk) * 512 + c) * 2; ap[0] = Acar[kk][e]; ap[1] = Hcar[kk][e]; }
    }
}
__device__ __forceinline__ void rec2_rows(KArgs args, int gw, int NGW, int lane) {
    unsigned char* ws = args->ws;
    const bf16* z = (const bf16*)(ws + WS_Z); const bf16* hloc = (const bf16*)(ws + WS_HLOC); const bf16* cumA = (const bf16*)(ws + WS_CUMA);
    const float* carry = (const float*)(ws + WS_CARRY); bf16* mixed = (bf16*)(ws + WS_MIXED);
    constexpr int NR = 4;
    for (int m0 = gw * NR; m0 < NTOK; m0 += NGW * NR) {
        const int b = m0 >> 12, chk = (m0 & 4095) >> 8;
        u32x4 hl[NR], ca[NR], gr[NR];
#pragma unroll
        for (int r = 0; r < NR; ++r) { const size_t m = (size_t)(m0 + r); hl[r] = __builtin_nontemporal_load((const u32x4*)(hloc + m * D_REC + 8 * lane)); ca[r] = __builtin_nontemporal_load((const u32x4*)(cumA + m * D_REC + 8 * lane)); gr[r] = __builtin_nontemporal_load((const u32x4*)(z + m * ZP + ZC_GR + 8 * lane)); }
        const f32x4 c0 = *(const f32x4*)(carry + (size_t)(b * 16 + chk) * 512 + 8 * lane), c1 = *(const f32x4*)(carry + (size_t)(b * 16 + chk) * 512 + 8 * lane + 4);
#pragma unroll
        for (int r = 0; r < NR; ++r) { float v[8];
            v[0] = (bflo(hl[r].x) + bflo(ca[r].x) * c0.x) * fgelu(bflo(gr[r].x)); v[1] = (bfhi(hl[r].x) + bfhi(ca[r].x) * c0.y) * fgelu(bfhi(gr[r].x));
            v[2] = (bflo(hl[r].y) + bflo(ca[r].y) * c0.z) * fgelu(bflo(gr[r].y)); v[3] = (bfhi(hl[r].y) + bfhi(ca[r].y) * c0.w) * fgelu(bfhi(gr[r].y));
            v[4] = (bflo(hl[r].z) + bflo(ca[r].z) * c1.x) * fgelu(bflo(gr[r].z)); v[5] = (bfhi(hl[r].z) + bfhi(ca[r].z) * c1.y) * fgelu(bfhi(gr[r].z));
            v[6] = (bflo(hl[r].w) + bflo(ca[r].w) * c1.z) * fgelu(bflo(gr[r].w)); v[7] = (bfhi(hl[r].w) + bfhi(ca[r].w) * c1.w) * fgelu(bfhi(gr[r].w));
            float s = 0.f;
#pragma unroll
            for (int e = 0; e < 8; ++e) s += v[e] * v[e];
            const float rstd = rsqrtf(wave_sum(s) * (1.f / D_REC) + EPS);
            u32x4 w; w.x = pk2(v[0] * rstd, v[1] * rstd); w.y = pk2(v[2] * rstd, v[3] * rstd); w.z = pk2(v[4] * rstd, v[5] * rstd); w.w = pk2(v[6] * rstd, v[7] * rstd);
            *(u32x4*)(mixed + (size_t)(m0 + r) * DM + 8 * lane) = w; }
    }
}
__device__ __forceinline__ void phase_mid(KArgs args, int L, int G, int bid, int tid, int wave, int lane) {
    unsigned char* ws = args->ws;
    const float* agg = (const float*)(ws + WS_AGG); float* carry = (float*)(ws + WS_CARRY);
    const int gt = bid * (NWAVES * 64) + tid, NGT = G * NWAVES * 64;
    for (int i = gt; i < BATCH * 512; i += NGT) { const int b = i >> 9, c = i & 511; float Ak[16], Hk[16];
#pragma unroll
        for (int k = 0; k < 16; ++k) { const size_t o = (size_t)(b * 16 + k) * 512 + c; Ak[k] = agg[o * 2]; Hk[k] = agg[o * 2 + 1]; }
        float H = 0.f;
#pragma unroll
        for (int k = 0; k < 16; ++k) { carry[(size_t)(b * 16 + k) * 512 + c] = H; H = Ak[k] * H + Hk[k]; } }
    const bf16* hid = (const bf16*)(ws + WS_HIDC); const bf16* w2t = (const bf16*)(ws + WS_W2T);
    const int gw = bid * NWAVES + wave, NGW = G * NWAVES, fr = lane & 15, fq = lane >> 4;
    for (int task = gw; task < 2 * 512; task += NGW) {
        const int kv = task >> 9, grp = task & 511;
        const bf16* ar = hid + ((size_t)kv * 8192 + grp * 16 + fr) * 256 + 8 * fq;
        const bf16* br = w2t + ((size_t)(L * 2 + kv) * 64 + fr) * 256 + 8 * fq;
        const float* b2 = (kv ? args->in[I_BV2] : args->in[I_BK2]) + L * 64;
        f32x4 acc[4];
#pragma unroll
        for (int nt = 0; nt < 4; ++nt) { const float bb = b2[16 * nt + fr]; acc[nt] = (f32x4){bb, bb, bb, bb}; }
#pragma unroll
        for (int kk = 0; kk < 8; ++kk) { const bf16x8 a = *(const bf16x8*)(ar + 32 * kk);
#pragma unroll
            for (int nt = 0; nt < 4; ++nt) { const bf16x8 bfr = *(const bf16x8*)(br + (size_t)(16 * nt) * 256 + 32 * kk); acc[nt] = __builtin_amdgcn_mfma_f32_16x16x32_bf16(a, bfr, acc[nt], 0, 0, 0); } }
        bf16* outp = (bf16*)(ws + (kv ? WS_VCMP : WS_KCMP));
#pragma unroll
        for (int jj = 0; jj < 4; ++jj) { const int row = grp * 16 + 4 * fq + jj; const bool real = (row & 255) != 255;
#pragma unroll
            for (int nt = 0; nt < 4; ++nt) outp[(size_t)row * 64 + 16 * nt + fr] = real ? (bf16)f2bf(acc[nt][jj]) : (bf16)0; }
    }
}

typedef float f32x16 __attribute__((ext_vector_type(16)));
typedef short s16x4 __attribute__((ext_vector_type(4)));
typedef float f32x2_t __attribute__((ext_vector_type(2)));
typedef __bf16 bf16x2_t __attribute__((ext_vector_type(2)));
__device__ __forceinline__ unsigned cvtpk(float lo, float hi) { f32x2_t v = {lo, hi}; bf16x2_t b = __builtin_convertvector(v, bf16x2_t); return __builtin_bit_cast(unsigned, b); }
__device__ __forceinline__ void xhalf_pair(float m, float& lo, float& hi) {
    unsigned a = __builtin_bit_cast(unsigned, m), b = a; asm volatile("" : "+v"(b));
    auto rr = __builtin_amdgcn_permlane32_swap(a, b, false, false);
    unsigned r0 = rr[0], r1 = rr[1]; asm volatile("" : "+v"(r0), "+v"(r1));
    lo = __builtin_bit_cast(float, r0); hi = __builtin_bit_cast(float, r1);
}
__device__ __forceinline__ float xhalf_max(float m) { float a, b; xhalf_pair(m, a, b); return fmaxf(a, b); }
__device__ __forceinline__ float xhalf_sum(float m) { float a, b; xhalf_pair(m, a, b); return a + b; }
__device__ __forceinline__ s16x4 vtr(const LAS unsigned char* p) { return __builtin_bit_cast(s16x4, __builtin_amdgcn_ds_read_tr16_b64_v4i16((LAS s16x4*)p)); }
constexpr int ATT_NS = 4, ATT_PD = 3;
constexpr int ATT_IMP = 65536, ATT_SC = ATT_IMP + 4 * 64 * 65 * 4, ATT_MASK = ATT_SC + 64 * 65 * 4, ATT_UNION = ATT_MASK + 512, ATT_RED = ATT_UNION + 64;
static_assert(ATT_RED + 2048 <= MISC_OFF, "attention LDS map");
#define CI_(i) (((i) & 3) + 8 * ((i) >> 2))
__device__ __forceinline__ float max3f(float a, float b, float c) { float r; asm("v_max3_f32 %0, %1, %2, %3" : "=v"(r) : "v"(a), "v"(b), "v"(c)); return r; }

struct AttState { f32x16 O[2]; float m, l; bool fresh; };
__device__ __forceinline__ void att_stage(LAS unsigned char* lds, int slot, const char* kp, const char* vp, unsigned pitch, int wave, int lane) {
    const int key = 8 * wave + (lane >> 3), pc = lane & 7;
    const char* ks = kp + (size_t)key * pitch + ((pc ^ ((key >> 1) & 7)) << 4);
    const char* vs = vp + (size_t)key * pitch + ((pc ^ ((key & 3) << 1)) << 4);
    const unsigned dk = (unsigned)(unsigned long)(lds + slot * 16384 + wave * 1024), dv = dk + 8192u; unsigned keep;
    asm volatile("s_mov_b32 %0, m0\n\ts_mov_b32 m0, %2\n\ts_nop 0\n\tglobal_load_lds_dwordx4 %1, off\n\ts_mov_b32 m0, %0" : "=&s"(keep) : "v"(ks), "s"(dk) : "memory");
    asm volatile("s_mov_b32 %0, m0\n\ts_mov_b32 m0, %2\n\ts_nop 0\n\tglobal_load_lds_dwordx4 %1, off\n\ts_mov_b32 m0, %0" : "=&s"(keep) : "v"(vs), "s"(dv) : "memory");
}
__device__ __forceinline__ void att_qk64(const LAS unsigned char* Kb, const bf16x8 (&qf)[4], float sF, float cb, int rq, int h, f32x16& S0, f32x16& S1) {
    const LAS unsigned char* rowp = Kb + rq * 128; const int sw = (rq >> 1) & 7;
    bf16x8 kf[2][4];
#pragma unroll
    for (int sub = 0; sub < 2; ++sub)
#pragma unroll
        for (int s4 = 0; s4 < 4; ++s4) kf[sub][s4] = *(const LAS bf16x8*)(rowp + sub * 4096 + (((2 * s4 + h) ^ sw) << 4));
    const float base = cb + sF * (float)(4 * h);
    { const f32x2 d01 = {0.f, sF}, d23 = {sF + sF, 3.f * sF};
#pragma unroll
      for (int q4 = 0; q4 < 4; ++q4) { const float bq = fmaf(sF, (float)(8 * q4), base), bq1 = fmaf(sF, (float)(8 * q4 + 32), base);
          const f32x2 bb = {bq, bq}, bc = {bq1, bq1}; const f32x2 lo = bb + d01, hi = bb + d23, lo1 = bc + d01, hi1 = bc + d23;
          S0[4 * q4] = lo.x; S0[4 * q4 + 1] = lo.y; S0[4 * q4 + 2] = hi.x; S0[4 * q4 + 3] = hi.y; S1[4 * q4] = lo1.x; S1[4 * q4 + 1] = lo1.y; S1[4 * q4 + 2] = hi1.x; S1[4 * q4 + 3] = hi1.y; } }
    __builtin_amdgcn_sched_barrier(0);
#pragma unroll
    for (int s4 = 0; s4 < 4; ++s4) { S0 = __builtin_amdgcn_mfma_f32_32x32x16_bf16(kf[0][s4], qf[s4], S0, 0, 0, 0); S1 = __builtin_amdgcn_mfma_f32_32x32x16_bf16(kf[1][s4], qf[s4], S1, 0, 0, 0); }
    __builtin_amdgcn_sched_barrier(0);
}
__device__ __forceinline__ void att_mask(int sub, int h, int lim_lo, int lim_hi, f32x16& S) {
    const int hi2 = lim_hi - 32 * sub - 4 * h, lo2 = lim_lo - 32 * sub - 4 * h;
#pragma unroll
    for (int i = 0; i < 16; ++i) S[i] = (CI_(i) <= hi2 && CI_(i) > lo2) ? S[i] : -__builtin_inff();
}
template <bool IMP>
__device__ __forceinline__ void att_softmax_pv64(const bool MASKED, const LAS unsigned char* Vb, int lim_lo, int lim_hi, f32x16& S0, f32x16& S1, AttState& st, int h, int lane, LAS float* irow = nullptr, int ct = 0) {
    const int qd = (lane & 15) >> 2, pp = lane & 3, blk = (lane >> 4) & 1;
    const LAS unsigned char* vrow = Vb + (4 * h + qd) * 128 + (pp & 1) * 8;
    bf16x8 vf[2][4];
#pragma unroll
    for (int dt = 0; dt < 2; ++dt) { const int coff = ((dt * 4 + blk * 2 + (pp >> 1)) ^ (qd << 1)) << 4;
#pragma unroll
        for (int ks = 0; ks < 4; ++ks) { const s16x4 lo = vtr(vrow + coff + (16 * ks) * 128), hi = vtr(vrow + coff + (16 * ks + 8) * 128);
            vf[dt][ks] = __builtin_shufflevector(lo, hi, 0, 1, 2, 3, 4, 5, 6, 7); } }
    __builtin_amdgcn_sched_barrier(0);
    if (MASKED) { att_mask(0, h, lim_lo, lim_hi, S0); att_mask(1, h, lim_lo, lim_hi, S1); }
    float mx = max3f(S0[0], S0[1], S0[2]), my = max3f(S1[0], S1[1], S1[2]);
    mx = max3f(mx, S0[3], S0[4]); my = max3f(my, S1[3], S1[4]); mx = max3f(mx, S0[5], S0[6]); my = max3f(my, S1[5], S1[6]); mx = max3f(mx, S0[7], S0[8]); my = max3f(my, S1[7], S1[8]);
    mx = max3f(mx, S0[9], S0[10]); my = max3f(my, S1[9], S1[10]); mx = max3f(mx, S0[11], S0[12]); my = max3f(my, S1[11], S1[12]); mx = max3f(mx, S0[13], S0[14]); my = max3f(my, S1[13], S1[14]);
    mx = xhalf_max(max3f(mx, my, max3f(S0[15], S1[15], S1[15])));
    const bool fin = mx > -1e30f;
    const bool rb = fin && (mx > 8.f || st.fresh);
    if (__any(rb)) { const float d = rb ? mx : 0.f; const float corr = st.fresh ? 1.f : __builtin_amdgcn_exp2f(-d); st.l *= corr; st.m += d;
#pragma unroll
        for (int i = 0; i < 16; ++i) { st.O[0][i] *= corr; st.O[1][i] *= corr; S0[i] -= d; S1[i] -= d; }
        if (IMP) { if (h == 0 && corr != 1.f) { for (int j = 0; j < 64; ++j) irow[j] *= corr; } }
    }
    st.fresh = st.fresh && !fin;
    float ps = 0.f, pt = 0.f;
#pragma unroll
    for (int i = 0; i < 16; ++i) { S0[i] = __builtin_amdgcn_exp2f(S0[i]); S1[i] = __builtin_amdgcn_exp2f(S1[i]); ps += S0[i]; pt += S1[i]; }
    st.l += ps + pt;
    if (IMP) {
        float prev3 = 0.f; const int partner = (lane ^ 32) << 2;
#pragma unroll
        for (int f = 0; f < 8; ++f) { const f32x16& S_ = (f >> 2) ? S1 : S0; const int q4 = f & 3; const float p3 = S_[4 * q4 + 3];
            const float own = 2.f * (S_[4 * q4] + S_[4 * q4 + 1] + S_[4 * q4 + 2]) + p3;
            const float inc = __builtin_bit_cast(float, __builtin_amdgcn_ds_bpermute(partner, __builtin_bit_cast(int, h ? prev3 : p3)));
            irow[16 * ct + 2 * f + h] = own + inc;
            prev3 = p3; }
        if (h && ct < 3) __hip_atomic_fetch_add(irow + 16 * ct + 16, prev3, __ATOMIC_RELAXED, __HIP_MEMORY_SCOPE_WORKGROUP); }
    u32x4 pk[4];
#pragma unroll
    for (int s2 = 0; s2 < 2; ++s2) { pk[s2].x = cvtpk(S0[8 * s2], S0[8 * s2 + 1]); pk[s2].y = cvtpk(S0[8 * s2 + 2], S0[8 * s2 + 3]); pk[s2].z = cvtpk(S0[8 * s2 + 4], S0[8 * s2 + 5]); pk[s2].w = cvtpk(S0[8 * s2 + 6], S0[8 * s2 + 7]);
        pk[2 + s2].x = cvtpk(S1[8 * s2], S1[8 * s2 + 1]); pk[2 + s2].y = cvtpk(S1[8 * s2 + 2], S1[8 * s2 + 3]); pk[2 + s2].z = cvtpk(S1[8 * s2 + 4], S1[8 * s2 + 5]); pk[2 + s2].w = cvtpk(S1[8 * s2 + 6], S1[8 * s2 + 7]); }
    __builtin_amdgcn_sched_barrier(0);
#pragma unroll
    for (int ks = 0; ks < 4; ++ks)
#pragma unroll
        for (int dt = 0; dt < 2; ++dt) st.O[dt] = __builtin_amdgcn_mfma_f32_32x32x16_bf16(vf[dt][ks], __builtin_bit_cast(bf16x8, pk[ks]), st.O[dt], 0, 0, 0);
    __builtin_amdgcn_sched_barrier(0);
}
__device__ __forceinline__ void att_state_reset(AttState& st) {
#pragma unroll
    for (int i = 0; i < 16; ++i) { st.O[0][i] = 0.f; st.O[1][i] = 0.f; }
    st.m = 0.f; st.l = 0.f; st.fresh = true;
}
#define ATT_WAIT_BAR() asm volatile("s_waitcnt vmcnt(0) lgkmcnt(0)\n\ts_barrier" ::: "memory")
#define ATT_WAIT_BAR_PD() asm volatile("s_waitcnt vmcnt(4) lgkmcnt(0)\n\ts_barrier" ::: "memory")
#define ATT_WAIT_BAR_2() asm volatile("s_waitcnt vmcnt(2) lgkmcnt(0)\n\ts_barrier" ::: "memory")

__device__ __forceinline__ int opq_v(int x) { asm volatile("" : "+v"(x)); return x; }
__device__ __forceinline__ int opq_s(int x) { asm volatile("" : "+s"(x)); return x; }
#define ATT_IDS const int lane = opq_v(lane0), wave = opq_s(wave0); const int r = wave >> 1, th = wave & 1, rq = lane & 31, h = lane >> 5, tl = 32 * th + rq, t = qb * 64 + tl, tok = b * SEQ + t; (void)r; (void)t; (void)tok;
__device__ __forceinline__ void att_unit_mfma(KArgs args, int b, int qb, LAS unsigned char* lds, int wave0, int lane0, int tid0) {
    unsigned char* ws = args->ws;
    const bf16* z = (const bf16*)(ws + WS_Z); bf16* mixed = (bf16*)(ws + WS_MIXED);
    LAS float* imp = (LAS float*)(lds + ATT_IMP);
    LAS float* sc = (LAS float*)(lds + ATT_SC);
    LAS unsigned* maskw = (LAS unsigned*)(lds + ATT_MASK);
    LAS unsigned* unionw = (LAS unsigned*)(lds + ATT_UNION);
    LAS float* red = (LAS float*)(lds + ATT_RED);
    unsigned OUTP[16];
    const unsigned ZPB = ZP * 2;
#pragma unroll 1
    for (int g = 0; g < 2; ++g) {
        const int hd = 4 * g + (wave0 >> 1);
        bf16x8 qf[4]; float slope2, g0, g1, g2;
        { ATT_IDS const int tid = opq_v(tid0);
          const bf16* zrow = z + (size_t)tok * ZP;
#pragma unroll
          for (int s4 = 0; s4 < 4; ++s4) qf[s4] = *(const bf16x8*)(zrow + ZC_Q + hd * 64 + 16 * s4 + 8 * h);
          slope2 = exp2f(-(float)(hd + 1)) * LOG2E;
          g0 = fsigmoid(bf2f(zrow[ZC_NG + hd * 3 + 0])); g1 = fsigmoid(bf2f(zrow[ZC_NG + hd * 3 + 1])); g2 = fsigmoid(bf2f(zrow[ZC_NG + hd * 3 + 2]));
          LAS float* row = imp + (r * 64 + tl) * 65 + 32 * h;
#pragma unroll
          for (int j = 0; j < 32; ++j) row[j] = 0.f;
          if (tid < 128) maskw[tid] = 0u;
          if (tid < 2) unionw[tid] = 0u; }
        AttState st;
        { ATT_IDS
        const int jlo = qb - 8 > 0 ? qb - 8 : 0, nw = qb - jlo + 1;
        const int nk = (4 * qb + 3) < 255 ? (4 * qb + 3) : 255, nc = (nk + 63) >> 6, nA = nw + nc;
        const int nmax_t = (t >= 31) ? ((t - 31) >> 4) : -1;
        const char* kwb = (const char*)(z + (size_t)(b * SEQ) * ZP + ZC_KW + g * 64);
        const char* kcb = (const char*)(ws + WS_KCMP) + (size_t)((b * 2 + g) * 256) * 128; const char* vcb = (const char*)(ws + WS_VCMP) + (size_t)((b * 2 + g) * 256) * 128;
        const float sF = 16.f * slope2;
        float il_c = 0.f;
        LAS float* irow = imp + (r * 64 + tl) * 65;
#define ATT_STAGE_A(idx_) do { int ix_ = (idx_) < nA ? (idx_) : nA - 1; const int sl_ = (idx_) & 3; \
            if (ix_ < nw) { const char* kp_ = kwb + (size_t)(64 * (qb - ix_)) * ZPB; att_stage(lds, sl_, kp_, kp_ + (ZC_VW - ZC_KW) * 2, ZPB, wave, lane); } \
            else { ix_ -= nw; const size_t o_ = (size_t)(nc - 1 - ix_) * 64 * 128; att_stage(lds, sl_, kcb + o_, vcb + o_, 128, wave, lane); } } while (0)
        att_state_reset(st);
        ATT_STAGE_A(0); ATT_STAGE_A(1); ATT_STAGE_A(2);
        f32x16 Sa, Sb;
#pragma unroll 1
        for (int i = 0; i < nA; ++i) {
            ATT_WAIT_BAR_PD();
            ATT_STAGE_A(i + ATT_PD);
            const LAS unsigned char* Kb = lds + (i & 3) * 16384; const LAS unsigned char* Vb = Kb + 8192;
            if (i < nw) {
                const int j = qb - i;
                att_qk64(Kb, qf, slope2, slope2 * (float)(64 * j) - st.m, rq, h, Sa, Sb);
                att_softmax_pv64<false>((j == qb) || (j == qb - 8), Vb, (j == qb - 8) ? tl : -1, (j == qb) ? tl : 63, Sa, Sb, st, h, lane);
                if (i == nw - 1) { const float lt = xhalf_sum(st.l); const float go = g2 / fmaxf(lt, 1e-30f);
#pragma unroll
                    for (int k = 0; k < 8; ++k) { OUTP[k] = cvtpk(st.O[0][2 * k] * go, st.O[0][2 * k + 1] * go); OUTP[8 + k] = cvtpk(st.O[1][2 * k] * go, st.O[1][2 * k + 1] * go); }
                    att_state_reset(st); }
            } else {
                const int ct = nc - 1 - (i - nw);
                att_qk64(Kb, qf, sF, sF * (float)(64 * ct) - st.m, rq, h, Sa, Sb);
                att_softmax_pv64<true>(true, Vb, -1, nmax_t - 64 * ct, Sa, Sb, st, h, lane, irow, ct);
                if (i == nA - 1) { const float lt = xhalf_sum(st.l); il_c = 1.f / fmaxf(lt, 1e-30f); const float go = g0 * il_c;
                    if (h == 0) ((LAS float*)(lds + ATT_SC))[r * 64 + tl] = il_c;
#pragma unroll
                    for (int k = 0; k < 8; ++k) { OUTP[k] = cvtpk(bflo(OUTP[k]) + st.O[0][2 * k] * go, bfhi(OUTP[k]) + st.O[0][2 * k + 1] * go); OUTP[8 + k] = cvtpk(bflo(OUTP[8 + k]) + st.O[1][2 * k] * go, bfhi(OUTP[8 + k]) + st.O[1][2 * k + 1] * go); } }
            }
        }
#undef ATT_STAGE_A
        }
        ATT_WAIT_BAR();
        { ATT_IDS const char* ksb0 = (const char*)(z + (size_t)(b * SEQ) * ZP + ZC_KS + g * 64);
          const char* kp0 = ksb0 + (size_t)(64 * qb) * ZPB; att_stage(lds, 0, kp0, kp0 + (ZC_VS - ZC_KS) * 2, ZPB, wave, lane);
          const char* kp1 = ksb0 + (size_t)(64 * (qb > 0 ? qb - 1 : 0)) * ZPB; att_stage(lds, 1, kp1, kp1 + (ZC_VS - ZC_KS) * 2, ZPB, wave, lane); }
        { const int tid = opq_v(tid0); const int stok = tid >> 3, e8 = tid & 7; const LAS float* ilc = (const LAS float*)(lds + ATT_SC);
          unsigned key[8];
#pragma unroll
          for (int k = 0; k < 8; ++k) { const int j = 8 * e8 + k; const float v = imp[(0 * 64 + stok) * 65 + j] * ilc[stok] + imp[(1 * 64 + stok) * 65 + j] * ilc[64 + stok] + imp[(2 * 64 + stok) * 65 + j] * ilc[128 + stok] + imp[(3 * 64 + stok) * 65 + j] * ilc[192 + stok];
              const bool valid = j <= qb, forced = valid && (j == 0 || j == qb || j == qb - 1);
              const unsigned bits_ = __builtin_bit_cast(unsigned, forced ? 1e30f : (valid ? v : -1e30f));
              key[k] = ((bits_ ^ ((bits_ >> 31) ? 0xFFFFFFFFu : 0x80000000u)) & ~63u) | (unsigned)(63 - j); }
          unsigned T = 0u;
#pragma unroll 1
          for (int bit = 31; bit >= 0; --bit) { const unsigned cand = T | (1u << bit); int c = 0;
#pragma unroll
              for (int k = 0; k < 8; ++k) c += key[k] >= cand ? 1 : 0;
              c += __builtin_amdgcn_update_dpp(0, c, 0xB1, 0xf, 0xf, true);
              c += __builtin_amdgcn_update_dpp(0, c, 0x4E, 0xf, 0xf, true);
              c += __builtin_amdgcn_update_dpp(0, c, 0x141, 0xf, 0xf, true);
              T = c >= NTOP ? cand : T; }
          unsigned bits = 0u;
#pragma unroll
          for (int k = 0; k < 8; ++k) bits |= (key[k] >= T && 8 * e8 + k <= qb) ? (1u << k) : 0u;
          if (bits) { __hip_atomic_fetch_or(maskw + stok * 2 + (e8 >> 2), bits << (8 * (e8 & 3)), __ATOMIC_RELAXED, __HIP_MEMORY_SCOPE_WORKGROUP); __hip_atomic_fetch_or(unionw + (e8 >> 2), bits << (8 * (e8 & 3)), __ATOMIC_RELAXED, __HIP_MEMORY_SCOPE_WORKGROUP); }
        }
        __syncthreads();
        { ATT_IDS
        const unsigned mlo = maskw[tl * 2], mhi = maskw[tl * 2 + 1];
        unsigned long long un = ((unsigned long long)unionw[1] << 32) | unionw[0];
        const char* ksb = (const char*)(z + (size_t)(b * SEQ) * ZP + ZC_KS + g * 64);
        att_state_reset(st);
        int jq[4];
#pragma unroll
        for (int p = 0; p < 4; ++p) { if (un) { jq[p] = 63 - __builtin_clzll(un); un &= ~(1ull << jq[p]); } else jq[p] = -1; }
        int jlast = jq[0];
#pragma unroll
        for (int p = 0; p < 3; ++p) { if (jq[p] >= 0) jlast = jq[p]; if (p == 2) { const char* kp_ = ksb + (size_t)(64 * jlast) * ZPB; att_stage(lds, p, kp_, kp_ + (ZC_VS - ZC_KS) * 2, ZPB, wave, lane); } }
        f32x16 Sa, Sb;
#pragma unroll 1
        for (int i = 0; jq[0] >= 0; ++i) {
            ATT_WAIT_BAR_PD();
            { if (jq[3] >= 0) jlast = jq[3]; const char* kp_ = ksb + (size_t)(64 * jlast) * ZPB; att_stage(lds, (i + 3) & 3, kp_, kp_ + (ZC_VS - ZC_KS) * 2, ZPB, wave, lane); }
            const LAS unsigned char* Kb = lds + (i & 3) * 16384; const LAS unsigned char* Vb = Kb + 8192;
            const int j = jq[0];
            const bool bit = ((j < 32 ? (mlo >> j) : (mhi >> (j - 32))) & 1u) != 0u;
            att_qk64(Kb, qf, slope2, bit ? slope2 * (float)(64 * j) - st.m : -__builtin_inff(), rq, h, Sa, Sb);
            att_softmax_pv64<false>(j == qb, Vb, -1, tl, Sa, Sb, st, h, lane);
            jq[0] = jq[1]; jq[1] = jq[2]; jq[2] = jq[3];
            if (un) { jq[3] = 63 - __builtin_clzll(un); un &= ~(1ull << jq[3]); } else jq[3] = -1;
        }
        { const float lt = xhalf_sum(st.l); const float go = g1 / fmaxf(lt, 1e-30f);
          float ss = 0.f;
#pragma unroll
          for (int i = 0; i < 8; ++i) { const float a0 = bflo(OUTP[i]) + st.O[0][2 * i] * go, a1 = bfhi(OUTP[i]) + st.O[0][2 * i + 1] * go, c0 = bflo(OUTP[8 + i]) + st.O[1][2 * i] * go, c1 = bfhi(OUTP[8 + i]) + st.O[1][2 * i + 1] * go;
              ss += (a0 * a0 + a1 * a1) + (c0 * c0 + c1 * c1); OUTP[i] = cvtpk(a0, a1); OUTP[8 + i] = cvtpk(c0, c1); }
          ss = xhalf_sum(ss);
          if (h == 0) red[hd * 64 + tl] = ss;
          if (g == 0) { bf16* orow = mixed + (size_t)tok * DM + 512 + hd * 64;
#pragma unroll
              for (int dt = 0; dt < 2; ++dt)
#pragma unroll
                  for (int q4 = 0; q4 < 4; ++q4) { u32x2 w; w.x = OUTP[8 * dt + 2 * q4]; w.y = OUTP[8 * dt + 2 * q4 + 1]; *(u32x2*)(orow + 32 * dt + 8 * q4 + 4 * h) = w; } } }
        }
        ATT_WAIT_BAR();
    }
    ATT_IDS
    float tot = 0.f;
#pragma unroll
    for (int h2 = 0; h2 < 8; ++h2) tot += red[h2 * 64 + tl];
    const float rstd = rsqrtf(tot * (1.f / 512.f) + EPS);
    { bf16* orow = mixed + (size_t)tok * DM + 512 + (4 + r) * 64;
#pragma unroll
      for (int dt = 0; dt < 2; ++dt)
#pragma unroll
          for (int q4 = 0; q4 < 4; ++q4) { u32x2 w; const unsigned p0 = OUTP[8 * dt + 2 * q4], p1 = OUTP[8 * dt + 2 * q4 + 1];
              w.x = cvtpk(bflo(p0) * rstd, bfhi(p0) * rstd); w.y = cvtpk(bflo(p1) * rstd, bfhi(p1) * rstd);
              *(u32x2*)(orow + 32 * dt + 8 * q4 + 4 * h) = w; } }
    { bf16* orow = mixed + (size_t)tok * DM + 512 + r * 64;
#pragma unroll
      for (int dt = 0; dt < 2; ++dt)
#pragma unroll
          for (int q4 = 0; q4 < 4; ++q4) { u32x2 w = *(const u32x2*)(orow + 32 * dt + 8 * q4 + 4 * h);
              w.x = cvtpk(bflo(w.x) * rstd, bfhi(w.x) * rstd); w.y = cvtpk(bflo(w.y) * rstd, bfhi(w.y) * rstd);
              *(u32x2*)(orow + 32 * dt + 8 * q4 + 4 * h) = w; } }
    __syncthreads();
}

constexpr int NPH_LAYER = 11, PH_FINAL = 1 + DEPTH * NPH_LAYER, N_PHASES = PH_FINAL + 1;
__global__ void __launch_bounds__(NWAVES * 64, 2) fwd_kernel(Args args) {
    extern __shared__ __attribute__((aligned(16))) unsigned char lds_raw[];
    LAS unsigned char* lds = (LAS unsigned char*)lds_raw;
    volatile LAS unsigned* MISC = (volatile LAS unsigned*)(lds + MISC_OFF);
    const int G0 = gridDim.x, bid0 = blockIdx.x;
    const int wave_s = __builtin_amdgcn_readfirstlane(threadIdx.x >> 6);
#define PHASE_IDS KArgs ka = ka_get(); int G = G0, bid = bid0; asm volatile("" : "+s"(G), "+s"(bid)); unsigned char* ws = ka->ws; (void)ws; int tid = wave_s * 64 + lane_id(); asm volatile("" : "+v"(tid)); const int lane = tid & 63, wave = wave_s; const int gw = bid * NWAVES + wave, NGW = G * NWAVES; (void)lane; (void)gw; (void)NGW;
    if (wave_s == 0) MISC[lane_id()] = 0u;
    __syncthreads();
#if MK_MULTI
#define GRID_BAR() do { } while (0)
#else
    XcdBarrier bar = xcd_barrier_post((unsigned*)(args.ws + WS_CTL) + CW_BAR, MISC + 8, wave_s);
#define GRID_BAR() xcd_barrier(bar)
#endif
#ifndef PH_MASK
#define PH_MASK 0xFFFF
#endif
#define IN(k) (ka_get()->ph_lo <= (k) && (k) < ka_get()->ph_hi)
#define EN(j) ((PH_MASK >> (j)) & 1)
#define SEAM(k) do { if (IN(k) && IN((k) + 1)) GRID_BAR(); } while (0)
#define HC_ ((bf16*)(ws + ((L & 1) ? WS_U : WS_H16)))
#define HN_ ((bf16*)(ws + ((L & 1) ? WS_H16 : WS_U)))
#define Z_ ((bf16*)(ws + WS_Z))
#define MIXED_ ((bf16*)(ws + WS_MIXED))
#define WL_ (ws + WS_W + (size_t)L * W_LAYER)

    if (EN(11) && IN(0)) { PHASE_IDS REP_(11) { phase_prologue(ka, lds, G, bid, tid, wave, lane); __syncthreads(); } SEAM(0); }

    for (int L = 0; L < DEPTH; ++L) {
        const int P = 1 + L * NPH_LAYER;
        if (EN(0) && IN(P + 0)) { PHASE_IDS REP_(0) phase_norm1(ka, L == 0 ? ka->in[I_X] : nullptr, HC_, (float*)(ws + WS_RS1), L, lds, G, bid, tid, wave, lane); SEAM(P + 0); }
        if (EN(1) && IN(P + 1)) {
            PHASE_IDS
            pg8::DenseSched S; S.init(HC_, DM, (const bf16*)(WL_ + WO_IN), NTOK, ZN_IN, DM, G, bid);
            pg8::EpiBf16<0> E{Z_, ZP, nullptr, 0, 0, (const float*)(ws + WS_RS1)};
            REP_(1) pg8::gemm_phase(lds, DM, S, E, wave_s);
            SEAM(P + 1);
        }
        if (EN(2) && IN(P + 2)) {
            { PHASE_IDS
            if (EN(12)) REP_(2) for (int unit = bid; unit < BATCH * 16; unit += G) rec1_unit(ka, L, unit, lds, wave, lane);
            { const int ncv = G > 64 ? G - 64 : G, mycv = G > 64 ? bid - 64 : bid;
              if (mycv >= 0) tr_run<1>(ka, (LAS float*)(lds + wave * 16384), lane, mycv * NWAVES + wave, ncv * NWAVES, L); }
            }
            __syncthreads();
            if (EN(13)) { PHASE_IDS
            pg8::CmpSched S{Z_, (const bf16*)(WL_ + WO_K1), (const bf16*)(WL_ + WO_V1), G, bid};
            pg8::EpiBf16<1> E{(bf16*)(ws + WS_HIDC), 256, (const float*)(ws + WS_BK1) + L * 512, (size_t)8192 * 256, 256, nullptr};
            REP_(2) pg8::gemm_phase(lds, 2048, S, E, wave_s); }
            SEAM(P + 2);
        }
        if (EN(3) && IN(P + 3)) { PHASE_IDS REP_(3) phase_mid(ka, L, G, bid, tid, wave, lane); SEAM(P + 3); }
        if (EN(4) && IN(P + 4)) {
            PHASE_IDS
            REP_(4)
            if (G == 256) { for (int i = 0; i < 4; ++i) att_unit_mfma(ka, 2 * (bid & 7) + (i >> 1), (i & 1) ? 63 - (bid >> 3) : (bid >> 3), lds, wave, lane, tid); }
            else { for (int unit = bid; unit < BATCH * 64; unit += G) att_unit_mfma(ka, unit >> 6, unit & 63, lds, wave, lane, tid); }
            REP_(12) rec2_rows(ka, gw, NGW, lane);
            SEAM(P + 4);
        }
        if (EN(5) && IN(P + 5)) {
            PHASE_IDS
            pg8::DenseSched S; S.init(MIXED_, DM, (const bf16*)(WL_ + WO_OUT), NTOK, DM, DM, G, bid);
            pg8::EpiResid E{HC_};
            pg8::gemm_phase(lds, DM, S, E, wave_s);
            SEAM(P + 5);
        }
        if (EN(6) && IN(P + 6)) { PHASE_IDS phase_norm2(ka, HC_, L, lds, G, bid, tid, wave, lane); SEAM(P + 6); }
        if ((EN(7) || EN(8)) && (IN(P + 7) || IN(P + 8))) {
            LAS int* tab = (LAS int*)(lds + TAB_OFF);
            { PHASE_IDS
            __syncthreads();
            if (tid < 64) { const int c = (int)__hip_atomic_load((gu32*)(ws + WS_CTL) + CW_CNT + L * 64 + tid, RLX_AGENT); tab[80 + tid] = c; tab[160 + tid] = (c + 255) >> 8; }
            __syncthreads();
            if (tid == 0) { int s = 0; for (int i = 0; i < 64; ++i) { tab[i] = s; s += tab[160 + i]; } tab[64] = s; }
            __syncthreads(); }
            if (EN(7) && IN(P + 7)) { PHASE_IDS
                pg8::MoeSched<1> S{tab, HC_, (const bf16*)(WL_ + WO_GU), (const int*)(ws + WS_LTOK), G, bid};
                pg8::EpiSwiglu E{(bf16*)(ws + WS_HID), tab, (const float*)(ws + WS_LRS)};
                REP_(7) pg8::gemm_phase(lds, DM, S, E, wave_s);
                SEAM(P + 7);
            }
            if (EN(8) && IN(P + 8)) { PHASE_IDS
                pg8::MoeSched<2> S{tab, (const bf16*)(ws + WS_HID), (const bf16*)(WL_ + WO_D), (const int*)(ws + WS_LTOK), G, bid};
                pg8::EpiMoeDown E{tab, (const int*)(ws + WS_LTOK), (const float*)(ws + WS_LGATE), (bf16*)(ws + WS_Y0), (bf16*)(ws + WS_Y1)};
                REP_(8) pg8::gemm_phase(lds, DEXP, S, E, wave_s);
                SEAM(P + 8);
            }
        }
        if (EN(9) && IN(P + 9)) { PHASE_IDS phase_norm3(HC_, (const bf16*)(ws + WS_Y0), (const bf16*)(ws + WS_Y1), (float*)(ws + WS_RS3), ka->in[I_P] + (size_t)L * NTOK * D_PLE, (bf16*)(ws + WS_PB), gw, NGW, lane); SEAM(P + 9); }
        if (EN(10) && IN(P + 10)) {
            if (EN(14)) { PHASE_IDS pg8::DenseSched S; S.init(HC_, DM, (const bf16*)(WL_ + WO_PG), NTOK, DM, DM, G, bid);
              pg8::EpiBf16<2> E{(bf16*)(ws + WS_G), DM, ka->in[I_BPG] + L * DM, 0, 0, (const float*)(ws + WS_RS3)};
              REP_(10) pg8::gemm_phase(lds, DM, S, E, wave_s); }
            __syncthreads();
            if (EN(15)) { PHASE_IDS pg8::DenseSched S; S.init((const bf16*)(ws + WS_PB), D_PLE, (const bf16*)(WL_ + WO_PU), NTOK, DM, D_PLE, G, bid);
              pg8::EpiPleB E{HC_, HN_, (const bf16*)(ws + WS_G)};
              pg8::gemm_phase(lds, D_PLE, S, E, wave_s); }
            SEAM(P + 10);
        }
    }
    if (IN(PH_FINAL)) { PHASE_IDS phase_final((const bf16*)(ws + ((DEPTH & 1) ? WS_U : WS_H16)), ka->out, ka->in[I_FINN], gw, NGW, lane); }
#undef IN
#undef SEAM
}

extern "C" void kernel_launch(void* const* d_in, const int* in_sizes, int n_in, void* d_out, int out_size, void* d_ws, size_t ws_size, hipStream_t stream) {
    static int grid = 0;
    if (grid == 0) {
        if (n_in != 37 || in_sizes[0] != NTOK * DM || out_size != NTOK * DM || ws_size < WS_END) {
            fprintf(stderr, "kernel_launch: unexpected shapes (n_in %d, in0 %d, out %d, ws %zu < %zu); nothing launched\n", n_in, n_in > 0 ? in_sizes[0] : -1, out_size, ws_size, (size_t)WS_END); grid = -1; return; }
        int dev = 0, cus = 0, per_cu = 0;
        if (hipGetDevice(&dev) != hipSuccess || hipDeviceGetAttribute(&cus, hipDeviceAttributeMultiprocessorCount, dev) != hipSuccess) { grid = -1; return; }
        if (hipFuncSetAttribute((const void*)fwd_kernel, hipFuncAttributeMaxDynamicSharedMemorySize, LDS_BYTES) != hipSuccess) { fprintf(stderr, "kernel_launch: hipFuncSetAttribute failed\n"); grid = -1; return; }
        if (hipOccupancyMaxActiveBlocksPerMultiprocessor(&per_cu, (const void*)fwd_kernel, NWAVES * 64, LDS_BYTES) != hipSuccess || per_cu < 1)
            fprintf(stderr, "kernel_launch: note: occupancy query reports %d workgroups per CU\n", per_cu);
        (void)hipGetLastError();
        grid = cus;
    }
    if (grid < 0) return;
    if (hipMemsetAsync((char*)d_ws + WS_CTL, 0, CTL_ZERO_BYTES, stream) != hipSuccess) return;
    Args a{};
    for (int i = 0; i < 37; ++i) a.in[i] = (const float*)d_in[i];
    a.out = (float*)d_out; a.ws = (unsigned char*)d_ws;
#if MK_MULTI
    for (int p = 0; p < N_PHASES; ++p) { a.ph_lo = p; a.ph_hi = p + 1; hipLaunchKernelGGL(fwd_kernel, dim3(grid), dim3(NWAVES * 64), LDS_BYTES, stream, a); }
#else
    a.ph_lo = 0; a.ph_hi = N_PHASES;
    hipLaunchKernelGGL(fwd_kernel, dim3(grid), dim3(NWAVES * 64), LDS_BYTES, stream, a);
#endif
    const hipError_t le = hipPeekAtLastError();
    if (le != hipSuccess) fprintf(stderr, "kernel_launch: launch failed: %s\n", hipGetErrorName(le));
}
```

```cpp
#include <hip/hip_runtime.h>
#include <cstdio>
#include <cstdint>

#ifndef PROBE_MASK
#define PROBE_MASK 0
#endif
#define REP_(j) for (int rep_ = 0; rep_ < 1 + ((PROBE_MASK >> (j)) & 1); ++rep_)
#ifndef MK_MULTI
#define MK_MULTI 0
#endif

#define GAS __attribute__((address_space(1)))
#define LAS __attribute__((address_space(3)))
typedef unsigned short bf16;
typedef float f32x4 __attribute__((ext_vector_type(4)));
typedef float f32x2 __attribute__((ext_vector_type(2)));
typedef unsigned u32x4 __attribute__((ext_vector_type(4)));
typedef unsigned u32x2 __attribute__((ext_vector_type(2)));
typedef short bf16x8 __attribute__((ext_vector_type(8)));
typedef GAS unsigned gu32;
#define RLX_AGENT __ATOMIC_RELAXED, __HIP_MEMORY_SCOPE_AGENT
#define LDS_WAIT() asm volatile("s_waitcnt lgkmcnt(0)" ::: "memory")
#define VM_WAIT() asm volatile("s_waitcnt vmcnt(0)" ::: "memory")

constexpr int BATCH = 16, SEQ = 4096, DM = 1024, DEPTH = 4, NTOK = BATCH * SEQ;
constexpr int D_PLE = 256, D_REC = 512, NH = 8, HD = 64, NKV = 2;
constexpr int D_IN = 2328, ZP = 2560;
constexpr int ZC_XR = 0, ZC_GR = 512, ZC_Q = 1024, ZC_KC = 1536, ZC_VC = 1664, ZC_KS = 1792, ZC_VS = 1920, ZC_KW = 2048, ZC_VW = 2176, ZC_NG = 2304;
constexpr int NCMP = 255, NSELB = 64, NTOP = 16, WIN = 512;
constexpr int NEXP = 32, DEXP = 512, NSEG = 64;
constexpr float EPS = 1e-6f;
constexpr float LOG2E = 1.4426950408889634f;
constexpr int NWAVES = 8;

constexpr size_t MiB = 1u << 20;
constexpr size_t WS_CTL = 0, CTL_ZERO_BYTES = 1 * MiB;
constexpr size_t WS_BK1 = 1 * MiB;
constexpr size_t WS_C8 = WS_BK1 + 8192;
constexpr size_t WS_WRT = WS_C8 + 8192;
constexpr size_t WS_AGG = 2 * MiB;
constexpr size_t WS_CARRY = 3 * MiB;
constexpr size_t WS_W2T = 4 * MiB;
constexpr size_t WS_KCMP = 5 * MiB, WS_VCMP = 7 * MiB;
constexpr size_t WS_RS1 = 6 * MiB, WS_RS3 = 6 * MiB + 512 * 1024;
constexpr size_t WS_HIDC = 9 * MiB;
constexpr size_t WS_LTOK = 17 * MiB, WS_LGATE = 33 * MiB;
constexpr size_t WS_PB = 49 * MiB;
constexpr size_t WS_W = 81 * MiB, W_LAYER = 108 * MiB;
constexpr size_t WO_IN = 0, WO_OUT = 5 * MiB, WO_PG = 7 * MiB, WO_PU = 9 * MiB, WO_K1 = 9 * MiB + 512 * 1024, WO_V1 = 10 * MiB + 512 * 1024, WO_GU = 12 * MiB, WO_D = 76 * MiB;
constexpr size_t WS_U = 513 * MiB;
constexpr size_t WS_Z = 641 * MiB;
constexpr size_t WS_HID = WS_Z;
constexpr size_t WS_G = WS_Z + 160 * MiB;
constexpr size_t WS_MIXED = 962 * MiB;
constexpr size_t WS_HLOC = 1090 * MiB, WS_CUMA = 1154 * MiB;
constexpr size_t WS_Y0 = WS_MIXED, WS_Y1 = WS_HLOC;
constexpr size_t WS_LRS = 1218 * MiB;
constexpr size_t WS_H16 = 1234 * MiB;
constexpr size_t WS_END = 1362 * MiB;
constexpr int CW_BAR = 4096;
constexpr int CW_CNT = 16384;
constexpr int CW_BK1 = 32768;
constexpr int LDS_BYTES = 163840;
constexpr int TAB_OFF = 147456;
constexpr int MISC_OFF = 147456 + 4096;

typedef float pk2_f32x2 __attribute__((ext_vector_type(2)));
typedef __bf16 pk2_bf16x2 __attribute__((ext_vector_type(2)));
__device__ __forceinline__ unsigned pk2(float lo, float hi) { const pk2_f32x2 v = {lo, hi}; return __builtin_bit_cast(unsigned, __builtin_convertvector(v, pk2_bf16x2)); }
__device__ __forceinline__ unsigned f2bf(float f) { return pk2(f, 0.f) & 0xffffu; }
__device__ __forceinline__ float bflo(unsigned u) { return __builtin_bit_cast(float, u << 16); }
__device__ __forceinline__ float bfhi(unsigned u) { return __builtin_bit_cast(float, u & 0xffff0000u); }
__device__ __forceinline__ float bf2f(bf16 b) { return __builtin_bit_cast(float, (unsigned)b << 16); }
__device__ __forceinline__ float fsigmoid(float x) { return __builtin_amdgcn_rcpf(1.f + __builtin_amdgcn_exp2f(-x * LOG2E)); }
__device__ __forceinline__ float fgelu(float x) { const float y = 1.5957691216057308f * (x + 0.044715f * x * x * x); return x * __builtin_amdgcn_rcpf(1.f + __builtin_amdgcn_exp2f(-y * LOG2E)); }
__device__ __forceinline__ int lane_id() { int x; asm volatile("v_mbcnt_lo_u32_b32 %0, -1, 0\n\tv_mbcnt_hi_u32_b32 %0, -1, %0" : "=v"(x)); return x; }
template <int CTRL> __device__ __forceinline__ float dpp_mov(float src) {
    return __builtin_bit_cast(float, __builtin_amdgcn_update_dpp(0, __builtin_bit_cast(int, src), CTRL, 0xf, 0xf, true));
}
__device__ __forceinline__ float wave_sum(float v) {
    v += dpp_mov<0xB1>(v);
    v += dpp_mov<0x4E>(v);
    v += dpp_mov<0x141>(v);
    v += dpp_mov<0x140>(v);
    const float r0 = __builtin_bit_cast(float, __builtin_amdgcn_readlane(__builtin_bit_cast(int, v), 0)), r1 = __builtin_bit_cast(float, __builtin_amdgcn_readlane(__builtin_bit_cast(int, v), 16));
    const float r2 = __builtin_bit_cast(float, __builtin_amdgcn_readlane(__builtin_bit_cast(int, v), 32)), r3 = __builtin_bit_cast(float, __builtin_amdgcn_readlane(__builtin_bit_cast(int, v), 48));
    return (r0 + r1) + (r2 + r3);
}

namespace pg8 {
#define PG8_LAS __attribute__((address_space(3)))
typedef unsigned short bf16_t;
constexpr int BM = 256, BK = 64, HALF = 128, HTB = HALF * BK * 2, STAGE_BYTES = 8 * HTB, NXCD = 8, WGM = 8;
__host__ __device__ __forceinline__ int lds_byte(int r, int c) { const int st = (r >> 4) * 2 + (c >> 5), rr = r & 15, cc = c & 31, ob = rr * 64 + cc * 2; return st * 1024 + (ob ^ (((ob >> 9) & 1) << 5)); }
__host__ __device__ __forceinline__ void stage_rc(int b, int& R, int& C) { const int st = b / 1024, sb = b % 1024, swz = sb ^ (((sb >> 9) & 1) << 5); R = (st >> 1) * 16 + swz / 64; C = (st & 1) * 32 + (swz % 64) / 2; }
__host__ __device__ __forceinline__ int perm32(int rho) { const int n = rho >> 4, i = rho & 15; return 8 * (i >> 2) + 4 * n + (i & 3); }
struct Unit { int pm, pn, a0, a1; };
__device__ __forceinline__ unsigned cvt_pk_bf16(float lo, float hi) { unsigned r; asm volatile("v_cvt_pk_bf16_f32 %0, %1, %2" : "=v"(r) : "v"(lo), "v"(hi)); return r; }

template <class Epi, class Sched>
__device__ __forceinline__ void gemm_phase(PG8_LAS unsigned char* lds, const int K, const Sched& S, const Epi& E, const int wave_s) {
    int tid_o = wave_s * 64 + lane_id(); asm volatile("" : "+v"(tid_o));
    const int tid = tid_o, wid = __builtin_amdgcn_readfirstlane(tid >> 6), lane = tid & 63, wr = wid >> 2, wc = wid & 3, fr = lane & 15, fq = lane >> 4;
    const int nt = K / BK;
    int Rr[2], Cc[2]; unsigned voffB[2];
#pragma unroll
    for (int i = 0; i < 2; ++i) { int R, C; stage_rc(tid * 16 + i * 8192, R, C); Rr[i] = R; Cc[i] = C; const int Rb = (R & ~31) + perm32(R & 31); voffB[i] = (unsigned)(Rb * K + C) * 2u; }
    const size_t kstepB = (size_t)(BK * 2), kstepA = S.kstepA();
    const size_t hstepB = (size_t)HALF * K * 2;
    const unsigned ldsw = (unsigned)wid * 1024u;
    const int aoff = lds_byte(wr * 64 + fr, fq * 8), boff = lds_byte(wc * 32 + fr, fq * 8);
#define PG8_SA(b, h) (((b) * 2 + (h)) * HTB)
#define PG8_SB(b, h) ((4 + (b) * 2 + (h)) * HTB)
#define PG8_STAGE(bufoff, gbase, voff) do { _Pragma("unroll") for (int _i = 0; _i < 2; ++_i) \
        __builtin_amdgcn_global_load_lds((const unsigned*)((const char*)(gbase) + (voff)[_i]), (PG8_LAS unsigned*)(lds + (bufoff) + ldsw + _i * 8192), 16, 0, 0); } while (0)
#define PG8_LDA(dst, b, h) do { _Pragma("unroll") for (int m = 0; m < 4; ++m) _Pragma("unroll") for (int k = 0; k < 2; ++k) dst[m][k] = *(const PG8_LAS bf16x8*)(lds + PG8_SA(b, h) + aoff + m * 2048 + k * 1024); } while (0)
#define PG8_LDB(dst, b, h) do { _Pragma("unroll") for (int n = 0; n < 2; ++n) _Pragma("unroll") for (int k = 0; k < 2; ++k) dst[n][k] = *(const PG8_LAS bf16x8*)(lds + PG8_SB(b, h) + boff + n * 2048 + k * 1024); } while (0)
#define PG8_MMA(ai, bj, At, Bt) do { __builtin_amdgcn_s_setprio(1); _Pragma("unroll") for (int m = 0; m < 4; ++m) _Pragma("unroll") for (int n = 0; n < 2; ++n) _Pragma("unroll") for (int k = 0; k < 2; ++k) \
        acc[ai][bj][m][n] = __builtin_amdgcn_mfma_f32_16x16x32_bf16(Bt[n][k], At[m][k], acc[ai][bj][m][n], 0, 0, 0); __builtin_amdgcn_s_setprio(0); } while (0)
#define PG8_WAIT_V(n) asm volatile("s_waitcnt vmcnt(" #n ")" ::: "memory")
#define PG8_WAIT_L(n) asm volatile("s_waitcnt lgkmcnt(" #n ")" ::: "memory")
#define PG8_BAR __builtin_amdgcn_s_barrier()
#define PG8_SCHED __builtin_amdgcn_sched_barrier(0)
    Unit cur, nxt; int ui = 0;
    if (!S.next(0, cur)) return;
    f32x4 acc[2][2][4][2];
#pragma unroll
    for (int a = 0; a < 2; ++a)
#pragma unroll
        for (int b = 0; b < 2; ++b)
#pragma unroll
            for (int m = 0; m < 4; ++m)
#pragma unroll
                for (int n = 0; n < 2; ++n) acc[a][b][m][n] = (f32x4){0.f, 0.f, 0.f, 0.f};
    bf16x8 At[4][2], B0[2][2], B1[2][2];
    unsigned vA[2][2], vN[2][2];
    S.a_voff(cur, Rr, Cc, vA);
    const char* cA = S.a_base(cur); const char* cB = S.b_base(cur);
    PG8_STAGE(PG8_SB(0, 0), cB, voffB); PG8_STAGE(PG8_SB(0, 1), cB + hstepB, voffB); PG8_STAGE(PG8_SA(0, 0), cA, vA[0]); PG8_STAGE(PG8_SA(0, 1), cA, vA[1]);
    if (wr == 1) PG8_BAR;
    PG8_WAIT_V(2); PG8_BAR;
    PG8_STAGE(PG8_SB(1, 0), cB + kstepB, voffB); PG8_STAGE(PG8_SA(1, 0), cA + kstepA, vA[0]); PG8_STAGE(PG8_SB(1, 1), cB + hstepB + kstepB, voffB);
    PG8_WAIT_V(6); PG8_BAR;
    for (;;) {
        const bool has_next = S.next(ui + 1, nxt);
        const char* nA = cA; const char* nB = cB;
#pragma unroll
        for (int h = 0; h < 2; ++h)
#pragma unroll
            for (int i = 0; i < 2; ++i) vN[h][i] = vA[h][i];
        if (has_next) { nA = S.a_base(nxt); nB = S.b_base(nxt); S.a_voff(nxt, Rr, Cc, vN); }
#pragma unroll 1
        for (int t = 0; t < nt; t += 2) {
            const bool last = (t == nt - 2);
            const char* a1 = cA + (size_t)(t + 1) * kstepA;
            const char* a2 = last ? nA : cA + (size_t)(t + 2) * kstepA; const char* b2 = last ? nB : cB + (size_t)(t + 2) * kstepB;
            const char* a3 = a2 + kstepA; const char* b3 = b2 + kstepB;
            unsigned v2[2][2];
#pragma unroll
            for (int h = 0; h < 2; ++h)
#pragma unroll
                for (int i = 0; i < 2; ++i) v2[h][i] = last ? vN[h][i] : vA[h][i];
            PG8_LDB(B0, 0, 0); PG8_LDB(B1, 0, 1); PG8_SCHED; PG8_LDA(At, 0, 0); PG8_STAGE(PG8_SA(1, 1), a1, vA[1]);
            PG8_WAIT_V(8); PG8_WAIT_L(0); PG8_BAR; PG8_MMA(0, 0, At, B0); PG8_MMA(0, 1, At, B1); PG8_BAR; PG8_SCHED;
            PG8_LDA(At, 0, 1); PG8_STAGE(PG8_SB(0, 0), b2, voffB); PG8_STAGE(PG8_SB(0, 1), b2 + hstepB, voffB); PG8_STAGE(PG8_SA(0, 0), a2, v2[0]);
            PG8_WAIT_V(8); PG8_WAIT_L(0); PG8_BAR; PG8_MMA(1, 0, At, B0); PG8_MMA(1, 1, At, B1); PG8_BAR; PG8_SCHED;
            PG8_LDB(B0, 1, 0); PG8_LDB(B1, 1, 1); PG8_SCHED; PG8_LDA(At, 1, 0); PG8_STAGE(PG8_SA(0, 1), a2, v2[1]);
            PG8_WAIT_V(8); PG8_WAIT_L(0); PG8_BAR; PG8_MMA(0, 0, At, B0); PG8_MMA(0, 1, At, B1); PG8_BAR; PG8_SCHED;
            PG8_LDA(At, 1, 1); PG8_STAGE(PG8_SB(1, 0), b3, voffB); PG8_STAGE(PG8_SB(1, 1), b3 + hstepB, voffB); PG8_STAGE(PG8_SA(1, 0), a3, v2[0]);
            PG8_WAIT_V(8); PG8_WAIT_L(0); PG8_BAR; PG8_MMA(1, 0, At, B0); PG8_MMA(1, 1, At, B1); PG8_BAR; PG8_SCHED;
        }
        if (wr == 0) PG8_BAR;
        E(acc, cur, wr, wc, fr, fq);
        if (!has_next) break;
#pragma unroll
        for (int a = 0; a < 2; ++a)
#pragma unroll
            for (int b = 0; b < 2; ++b)
#pragma unroll
                for (int m = 0; m < 4; ++m)
#pragma unroll
                    for (int n = 0; n < 2; ++n) acc[a][b][m][n] = (f32x4){0.f, 0.f, 0.f, 0.f};
        cur = nxt; cA = nA; cB = nB; ++ui;
#pragma unroll
        for (int h = 0; h < 2; ++h)
#pragma unroll
            for (int i = 0; i < 2; ++i) vA[h][i] = vN[h][i];
        if (wr == 1) PG8_BAR;
    }
    PG8_WAIT_V(0);
    PG8_BAR;
#undef PG8_SA
#undef PG8_SB
#undef PG8_STAGE
#undef PG8_LDA
#undef PG8_LDB
#undef PG8_MMA
#undef PG8_WAIT_V
#undef PG8_WAIT_L
#undef PG8_BAR
#undef PG8_SCHED
}

struct DenseSched {
    const bf16_t* A; const bf16_t* Bt; int lda, K; int nM, nN, nwg, G, c;
    __device__ __forceinline__ void init(const bf16_t* A_, int lda_, const bf16_t* Bt_, int M, int N, int K_, int G_, int c_) { A = A_; lda = lda_; Bt = Bt_; K = K_; nM = M / BM; nN = N / BM; nwg = nM * nN; G = G_; c = c_; }
    __device__ __forceinline__ size_t kstepA() const { return (size_t)(BK * 2); }
    __device__ __forceinline__ bool next(int i, Unit& u) const {
        const long L = (long)i * G + c; if (L >= nwg) return false;
        int wgid = (int)L; { const int q = nwg / NXCD, r = nwg % NXCD, xcd = wgid % NXCD, off = wgid / NXCD; wgid = (xcd < r ? xcd * (q + 1) : r * (q + 1) + (xcd - r) * q) + off; }
        const int nig = WGM * nN, gid = wgid / nig, fm = gid * WGM, gsz = (nM - fm) < WGM ? (nM - fm) : WGM;
        u.pm = fm + ((wgid % nig) % gsz); u.pn = (wgid % nig) / gsz; u.a0 = 0; u.a1 = 0; return true;
    }
    __device__ __forceinline__ const char* a_base(const Unit& u) const { return (const char*)A + (size_t)u.pm * BM * lda * 2; }
    __device__ __forceinline__ const char* b_base(const Unit& u) const { return (const char*)Bt + (size_t)u.pn * BM * K * 2; }
    __device__ __forceinline__ void a_voff(const Unit&, const int (&R)[2], const int (&C)[2], unsigned (&v)[2][2]) const {
#pragma unroll
        for (int h = 0; h < 2; ++h)
#pragma unroll
            for (int i = 0; i < 2; ++i) v[h][i] = (unsigned)((h * HALF + R[i]) * lda + C[i]) * 2u;
    }
};
}

#define XB_TMO      128
#define XB_XCNT(j)  (256  + 64 * (j))
#define XB_XSUB(j)  (1280 + 64 * (j))
#define XB_XGEN(j)  (2304 + 64 * (j))
#define XB_TOP      3328
#define XB_TOPGEN   3392
#define XCD_BAR_WORDS 3456
#define XB_SPIN_CAP (1u << 22)
__device__ __forceinline__ unsigned xb_ld(unsigned* p)              { return __hip_atomic_load(p, __ATOMIC_RELAXED, __HIP_MEMORY_SCOPE_AGENT); }
__device__ __forceinline__ unsigned xb_add(unsigned* p, unsigned v) { return __hip_atomic_fetch_add(p, v, __ATOMIC_RELAXED, __HIP_MEMORY_SCOPE_AGENT); }
__device__ __forceinline__ unsigned xb_xcc_id() { return (unsigned)__builtin_amdgcn_s_getreg((3 << 11) | 20) & 0xFu; }
#define XB_SPIN(cond, bar) do { unsigned _sp = 0; while (cond) { __builtin_amdgcn_s_sleep(1); \
    if ((++_sp & 255u) == 0u) { if (xb_ld(&(bar)[XB_TMO])) break; if (_sp > XB_SPIN_CAP) { atomicAdd(&(bar)[XB_TMO], 1u); break; } } } } while (0)
struct XcdBarrier { unsigned* bar; unsigned x; volatile LAS unsigned* st; int wave; };
__device__ __forceinline__ XcdBarrier xcd_barrier_post(unsigned* bar, volatile LAS unsigned* st, int wave) {
    XcdBarrier b; b.bar = bar; b.x = xb_xcc_id(); b.st = st; b.wave = wave;
    if (wave == 0 && lane_id() == 0) (void)xb_add(&bar[XB_XCNT(b.x)], 1u);
    return b;
}
__device__ __forceinline__ void xcd_barrier_complete(unsigned* bar, unsigned x, unsigned& nloc, unsigned& nx) {
    const unsigned G = gridDim.x * gridDim.y * gridDim.z;
    unsigned sum, cnt, mine, sp = 0u;
    for (;;) {
        sum = 0u; cnt = 0u; mine = 0u;
#pragma unroll
        for (unsigned j = 0; j < 16; ++j) { const unsigned c = xb_ld(&bar[XB_XCNT(j)]); sum += c; cnt += (c > 0u) ? 1u : 0u; }
        mine = xb_ld(&bar[XB_XCNT(x)]);
        if (sum == G) break;
        __builtin_amdgcn_s_sleep(1);
        if ((++sp & 255u) == 0u) { if (xb_ld(&bar[XB_TMO])) break; if (sp > XB_SPIN_CAP) { atomicAdd(&bar[XB_TMO], 1u); break; } }
    }
    nloc = mine > 0u ? mine : 1u; nx = cnt > 0u ? cnt : 1u;
}
__device__ __forceinline__ void xcd_barrier(const XcdBarrier& b) {
    asm volatile("s_waitcnt vmcnt(0)" ::: "memory");
    __syncthreads();
    if (b.wave == 0 && lane_id() == 0) {
        unsigned* bar = b.bar; asm volatile("" : "+s"(bar)); unsigned bx = b.x; asm volatile("" : "+s"(bx));
        __builtin_amdgcn_s_waitcnt(0);
        unsigned nloc = b.st[0], nx = b.st[1];
        if (nloc == 0u) { xcd_barrier_complete(bar, bx, nloc, nx); b.st[0] = nloc; b.st[1] = nx; }
        const unsigned old = xb_add(&bar[XB_XSUB(bx)], 1u);
        const unsigned gen = old / nloc;
        if (old + 1u == (gen + 1u) * nloc) {
            __builtin_amdgcn_fence(__ATOMIC_RELEASE, "agent");
            asm volatile("s_waitcnt vmcnt(0)" ::: "memory");
            const unsigned og = xb_add(&bar[XB_TOP], 1u);
            const unsigned tg = og / nx;
            if (og + 1u == (tg + 1u) * nx) xb_add(&bar[XB_TOPGEN], 1u);
            else XB_SPIN(xb_ld(&bar[XB_TOPGEN]) == tg, bar);
            __builtin_amdgcn_fence(__ATOMIC_ACQUIRE, "agent");
            xb_add(&bar[XB_XGEN(bx)], 1u);
            asm volatile("s_waitcnt vmcnt(0)" ::: "memory");
        } else {
            XB_SPIN(xb_ld(&bar[XB_XGEN(bx)]) == gen, bar);
            __builtin_amdgcn_fence(__ATOMIC_ACQUIRE, "agent");
            asm volatile("s_waitcnt vmcnt(0)" ::: "memory");
        }
    }
    __syncthreads();
}

struct Args { const float* in[37]; float* out; unsigned char* ws; int ph_lo, ph_hi; };
typedef const __attribute__((address_space(4))) Args* KArgs;
__device__ __forceinline__ KArgs ka_get() { KArgs k = (KArgs)__builtin_amdgcn_kernarg_segment_ptr(); asm volatile("" : "+s"(k)); return k; }
enum { I_X = 0, I_P, I_MIXN, I_WIN, I_CONVW, I_CONVB, I_WA, I_BA, I_WX, I_BX, I_LAM, I_PEK, I_PEV, I_WK1, I_BK1, I_WK2, I_BK2, I_WV1, I_BV1, I_WV2, I_BV2,
       I_RECN, I_ATTN, I_WOUT, I_FFNN, I_WGR, I_BGR, I_WER, I_BER, I_WGATE, I_WUP, I_WDOWN, I_PLEN, I_WPG, I_BPG, I_WPU, I_FINN };

namespace pg8 {
struct CmpSched {
    const bf16_t* z; const bf16_t* W1k; const bf16_t* W1v; int G, c;
    __device__ __forceinline__ size_t kstepA() const { return (size_t)ZP * 2; }
    __device__ __forceinline__ bool next(int i, Unit& u) const { const int L = i * G + c; if (L >= 64) return false; u.pm = L >> 1; u.pn = 0; u.a0 = L & 1; u.a1 = 0; return true; }
    __device__ __forceinline__ const char* a_base(const Unit& u) const { const int b = u.pm >> 1, g = u.pm & 1; return (const char*)(z + (size_t)b * SEQ * ZP + (u.a0 ? ZC_VC : ZC_KC) + g * 64); }
    __device__ __forceinline__ const char* b_base(const Unit& u) const { return (const char*)(u.a0 ? W1v : W1k); }
    __device__ __forceinline__ void a_voff(const Unit&, const int (&R)[2], const int (&C)[2], unsigned (&v)[2][2]) const {
#pragma unroll
        for (int h = 0; h < 2; ++h)
#pragma unroll
            for (int i = 0; i < 2; ++i) v[h][i] = (unsigned)(16 * (h * HALF + R[i]) * ZP + C[i]) * 2u;
    }
};
template <int PHASE>
struct MoeSched {
    const PG8_LAS int* tab; const bf16_t* A; const bf16_t* W; const int* ltok; int G, c;
    __device__ __forceinline__ size_t kstepA() const { return (size_t)(BK * 2); }
    __device__ __forceinline__ bool next(int i, Unit& u) const {
        const int TT = tab[64]; int rt, pn;
        if (G == 256) { const int x = c & 7, y = c >> 3, Q = (TT + 7) >> 3, rl = i * 8 + (y >> 2); pn = y & 3; if (rl >= Q) return false; rt = x * Q + rl; }
        else { const int L = i * G + c; rt = L >> 2; pn = L & 3; }
        if (rt >= TT) return false;
        int lo = 0, hi = 64;
        while (hi - lo > 1) { const int mid = (lo + hi) >> 1; if (tab[mid] <= rt) lo = mid; else hi = mid; }
        u.pm = rt; u.pn = pn; u.a0 = lo; u.a1 = rt - tab[lo]; return true;
    }
    __device__ __forceinline__ const char* a_base(const Unit& u) const { return PHASE == 1 ? (const char*)A : (const char*)A + (size_t)u.pm * BM * DEXP * 2; }
    __device__ __forceinline__ const char* b_base(const Unit& u) const {
        const int e = u.a0 & 31;
        return PHASE == 1 ? (const char*)W + ((size_t)e * 1024 + (size_t)u.pn * BM) * 1024 * 2 : (const char*)W + ((size_t)e * 1024 + (size_t)u.pn * BM) * DEXP * 2;
    }
    __device__ __forceinline__ void a_voff(const Unit& u, const int (&R)[2], const int (&C)[2], unsigned (&v)[2][2]) const {
        if (PHASE == 1) {
            const int cnt = tab[80 + u.a0];
#pragma unroll
            for (int h = 0; h < 2; ++h)
#pragma unroll
                for (int i = 0; i < 2; ++i) { const int rank = u.a1 * BM + h * HALF + R[i]; const int tok = rank < cnt ? ltok[(size_t)u.a0 * NTOK + rank] : 0; v[h][i] = (unsigned)(tok * DM + C[i]) * 2u; }
        } else {
#pragma unroll
            for (int h = 0; h < 2; ++h)
#pragma unroll
                for (int i = 0; i < 2; ++i) v[h][i] = (unsigned)((h * HALF + R[i]) * DEXP + C[i]) * 2u;
        }
    }
};

template <int ACT  > struct EpiBf16 {
    bf16_t* O; int ldc; const float* bias; size_t a0_stride; int a0_bias_stride;
    const float* rs;
    __device__ __forceinline__ void operator()(const f32x4 (&acc)[2][2][4][2], const Unit& u, int wr, int wc, int fr, int fq) const {
        const int row0 = u.pm * BM + wr * 64 + fr, col0 = u.pn * BM + wc * 32 + 8 * fq;
        bf16_t* base = O + (size_t)u.a0 * a0_stride; const float* bs = bias ? bias + u.a0 * a0_bias_stride : nullptr;
        float rsv[2][4];
#pragma unroll
        for (int ai = 0; ai < 2; ++ai)
#pragma unroll
            for (int m = 0; m < 4; ++m) rsv[ai][m] = rs ? rs[row0 + ai * HALF + m * 16] : 1.f;
        f32x4 bv[2][2];
#pragma unroll
        for (int bj = 0; bj < 2; ++bj)
#pragma unroll
            for (int n = 0; n < 2; ++n) bv[bj][n] = bs ? *(const f32x4*)(bs + col0 + bj * HALF + 4 * n) : (f32x4){0.f, 0.f, 0.f, 0.f};
#pragma unroll
        for (int ai = 0; ai < 2; ++ai)
#pragma unroll
            for (int m = 0; m < 4; ++m) { bf16_t* rowp = base + (size_t)(row0 + ai * HALF + m * 16) * ldc + col0; const float sc = rsv[ai][m];
#pragma unroll
                for (int bj = 0; bj < 2; ++bj) { f32x4 v0 = acc[ai][bj][m][0], v1 = acc[ai][bj][m][1];
                    if (rs) { v0 *= sc; v1 *= sc; }
                    v0 += bv[bj][0]; v1 += bv[bj][1];
                    if (ACT == 1) { for (int e = 0; e < 4; ++e) { v0[e] = fgelu(v0[e]); v1[e] = fgelu(v1[e]); } }
                    if (ACT == 2) { for (int e = 0; e < 4; ++e) { v0[e] = fsigmoid(v0[e]); v1[e] = fsigmoid(v1[e]); } }
                    u32x4 w; w.x = cvt_pk_bf16(v0[0], v0[1]); w.y = cvt_pk_bf16(v0[2], v0[3]); w.z = cvt_pk_bf16(v1[0], v1[1]); w.w = cvt_pk_bf16(v1[2], v1[3]);
                    *(u32x4*)(rowp + bj * HALF) = w; } }
    }
};
struct EpiResid {
    bf16_t* h;
    __device__ __forceinline__ void operator()(const f32x4 (&acc)[2][2][4][2], const Unit& u, int wr, int wc, int fr, int fq) const {
        const int row0 = u.pm * BM + wr * 64 + fr, col0 = u.pn * BM + wc * 32 + 8 * fq;
#pragma unroll
        for (int ai = 0; ai < 2; ++ai) {
            bf16_t* rp0 = h + (size_t)(row0 + ai * HALF) * DM + col0;
            u32x4 hv[4][2];
#pragma unroll
            for (int m = 0; m < 4; ++m)
#pragma unroll
                for (int bj = 0; bj < 2; ++bj) hv[m][bj] = *(const u32x4*)(rp0 + (size_t)m * 16 * DM + bj * HALF);
#pragma unroll
            for (int m = 0; m < 4; ++m)
#pragma unroll
                for (int bj = 0; bj < 2; ++bj) { const u32x4 x = hv[m][bj]; const f32x4 a0 = acc[ai][bj][m][0], a1 = acc[ai][bj][m][1];
                    u32x4 w; w.x = cvt_pk_bf16(bflo(x.x) + a0[0], bfhi(x.x) + a0[1]); w.y = cvt_pk_bf16(bflo(x.y) + a0[2], bfhi(x.y) + a0[3]); w.z = cvt_pk_bf16(bflo(x.z) + a1[0], bfhi(x.z) + a1[1]); w.w = cvt_pk_bf16(bflo(x.w) + a1[2], bfhi(x.w) + a1[3]);
                    *(u32x4*)(rp0 + (size_t)m * 16 * DM + bj * HALF) = w; }
            asm volatile("" ::: "memory");
        }
    }
};
struct EpiPleB {
    const bf16_t* h; bf16_t* hn; const bf16_t* Gt;
    __device__ __forceinline__ void operator()(const f32x4 (&acc)[2][2][4][2], const Unit& u, int wr, int wc, int fr, int fq) const {
        const int row0 = u.pm * BM + wr * 64 + fr, col0 = u.pn * BM + wc * 32 + 8 * fq;
#pragma unroll
        for (int ai = 0; ai < 2; ++ai) {
            const size_t ro0 = (size_t)(row0 + ai * HALF) * DM + col0;
            u32x4 hv[4][2], gv[4][2];
#pragma unroll
            for (int m = 0; m < 4; ++m)
#pragma unroll
                for (int bj = 0; bj < 2; ++bj) { hv[m][bj] = *(const u32x4*)(h + ro0 + (size_t)m * 16 * DM + bj * HALF); gv[m][bj] = *(const u32x4*)(Gt + ro0 + (size_t)m * 16 * DM + bj * HALF); }
#pragma unroll
            for (int m = 0; m < 4; ++m)
#pragma unroll
                for (int bj = 0; bj < 2; ++bj) { const u32x4 x = hv[m][bj], g = gv[m][bj]; const f32x4 a0 = acc[ai][bj][m][0], a1 = acc[ai][bj][m][1];
                    u32x4 w; w.x = cvt_pk_bf16(bflo(x.x) + a0[0] * bflo(g.x), bfhi(x.x) + a0[1] * bfhi(g.x)); w.y = cvt_pk_bf16(bflo(x.y) + a0[2] * bflo(g.y), bfhi(x.y) + a0[3] * bfhi(g.y));
                    w.z = cvt_pk_bf16(bflo(x.z) + a1[0] * bflo(g.z), bfhi(x.z) + a1[1] * bfhi(g.z)); w.w = cvt_pk_bf16(bflo(x.w) + a1[2] * bflo(g.w), bfhi(x.w) + a1[3] * bfhi(g.w));
                    *(u32x4*)(hn + ro0 + (size_t)m * 16 * DM + bj * HALF) = w; }
            asm volatile("" ::: "memory");
        }
    }
};
struct EpiSwiglu {
    bf16_t* Hd; const PG8_LAS int* tab; const float* lrs;
    __device__ __forceinline__ void operator()(const f32x4 (&acc)[2][2][4][2], const Unit& u, int wr, int wc, int fr, int fq) const {
        const int row0 = u.pm * BM + wr * 64 + fr, col0 = u.pn * HALF + wc * 32 + 8 * fq; const int seg = u.a0, cnt = tab[80 + seg];
        float rsv[2][4];
#pragma unroll
        for (int ai = 0; ai < 2; ++ai)
#pragma unroll
            for (int m = 0; m < 4; ++m) { const int rank = u.a1 * BM + ai * HALF + wr * 64 + m * 16 + fr; const float v = lrs[(size_t)seg * NTOK + (rank < cnt ? rank : 0)]; rsv[ai][m] = rank < cnt ? v : 0.f; }
#pragma unroll
        for (int ai = 0; ai < 2; ++ai)
#pragma unroll
            for (int m = 0; m < 4; ++m) { const float rs = rsv[ai][m];
                float r[8];
#pragma unroll
                for (int n = 0; n < 2; ++n)
#pragma unroll
                    for (int e = 0; e < 4; ++e) { const float gt = acc[ai][0][m][n][e] * rs, up = acc[ai][1][m][n][e] * rs; r[4 * n + e] = gt * fsigmoid(gt) * up; }
                u32x4 w; w.x = cvt_pk_bf16(r[0], r[1]); w.y = cvt_pk_bf16(r[2], r[3]); w.z = cvt_pk_bf16(r[4], r[5]); w.w = cvt_pk_bf16(r[6], r[7]);
                *(u32x4*)(Hd + (size_t)(row0 + ai * HALF + m * 16) * DEXP + col0) = w; }
    }
};
struct EpiMoeDown {
    const PG8_LAS int* tab; const int* ltok; const float* lgate; bf16_t* y0; bf16_t* y1;
    __device__ __forceinline__ void operator()(const f32x4 (&acc)[2][2][4][2], const Unit& u, int wr, int wc, int fr, int fq) const {
        const int seg = u.a0, cnt = tab[80 + seg]; bf16_t* yb = (seg >= 32) ? y1 : y0;
        const int col0 = u.pn * BM + wc * 32 + 8 * fq;
        int tk[2][4]; float gtv[2][4];
#pragma unroll
        for (int ai = 0; ai < 2; ++ai)
#pragma unroll
            for (int m = 0; m < 4; ++m) { const int rank = u.a1 * BM + ai * HALF + wr * 64 + m * 16 + fr; const size_t o = (size_t)seg * NTOK + (rank < cnt ? rank : 0); tk[ai][m] = ltok[o]; gtv[ai][m] = lgate[o]; }
#pragma unroll
        for (int ai = 0; ai < 2; ++ai)
#pragma unroll
            for (int m = 0; m < 4; ++m) { const int rank = u.a1 * BM + ai * HALF + wr * 64 + m * 16 + fr;
                if (rank < cnt) { const int tok = tk[ai][m]; const float gt = gtv[ai][m];
#pragma unroll
                    for (int bj = 0; bj < 2; ++bj) { const f32x4 v0 = acc[ai][bj][m][0] * gt, v1 = acc[ai][bj][m][1] * gt;
                        u32x4 w; w.x = cvt_pk_bf16(v0[0], v0[1]); w.y = cvt_pk_bf16(v0[2], v0[3]); w.z = cvt_pk_bf16(v1[0], v1[1]); w.w = cvt_pk_bf16(v1[2], v1[3]);
                        *(u32x4*)(yb + (size_t)tok * DM + col0 + bj * HALF) = w; } } }
    }
};
}

struct TrItem { const float* W; const float* gain; bf16* WT; int K, N, dest_row0, k0, n0; float cs; };
__device__ __forceinline__ void tr_load(const TrItem& t, f32x4 (&v)[8], int lane) {
    const int c4 = lane & 7, kr = lane >> 3; const bool ok = t.n0 + 4 * c4 < t.N;
#pragma unroll
    for (int i = 0; i < 8; ++i) v[i] = ok ? __builtin_nontemporal_load((const f32x4*)(t.W + (size_t)(t.k0 + 8 * i + kr) * t.N + t.n0 + 4 * c4)) : (f32x4){0.f, 0.f, 0.f, 0.f};
}
__device__ __forceinline__ void tr_store(const TrItem& t, const f32x4 (&v)[8], LAS float* scr, int lane) {
    const int c4 = lane & 7, kr = lane >> 3;
#pragma unroll
    for (int i = 0; i < 8; ++i) { const int kk = 8 * i + kr; const float gsc = (t.gain ? t.gain[t.k0 + kk] : 1.f) * t.cs; LAS float* d = scr + kk * 33 + 4 * c4;
        d[0] = v[i].x * gsc; d[1] = v[i].y * gsc; d[2] = v[i].z * gsc; d[3] = v[i].w * gsc; }
    LDS_WAIT();
    const int c = lane & 7;
#pragma unroll
    for (int j = 0; j < 4; ++j) { const int n = (lane >> 3) + 8 * j; const LAS float* sp = scr + (8 * c) * 33 + n;
        u32x4 o; o.x = pk2(sp[0], sp[33]); o.y = pk2(sp[66], sp[99]); o.z = pk2(sp[132], sp[165]); o.w = pk2(sp[198], sp[231]);
        *(u32x4*)(t.WT + (size_t)(t.dest_row0 + n) * t.K + t.k0 + 8 * c) = o; }
    LDS_WAIT();
}
constexpr int IT_IN = 16 * 80, IT_OUT = 16 * 32, IT_PG = 16 * 32, IT_PU = 4 * 32, IT_K1 = 32 * 8, IT_V1 = 32 * 8, IT_E = 768;
constexpr int IT_LAYER = IT_IN + IT_OUT + IT_PG + IT_PU + IT_K1 + IT_V1 + NEXP * IT_E;

constexpr int IT_SMALL = IT_IN + IT_OUT + IT_PG + IT_PU + IT_K1 + IT_V1;
template <int MODE>
__device__ __forceinline__ void tr_run(KArgs args, LAS float* scr, int lane, int q0, int qstep, int Lsel) {
    unsigned char* ws = args->ws;
    const int nq = MODE == 0 ? DEPTH * IT_SMALL : NEXP * IT_E;
#define Q2IT_(q) (MODE == 0 ? ((q) / IT_SMALL) * IT_LAYER + (q) % IT_SMALL : Lsel * IT_LAYER + IT_SMALL + (q))
#define TR_DECODE(it_, t_) do { const int L = (it_) / IT_LAYER; int r = (it_) % IT_LAYER; unsigned char* wl = ws + WS_W + (size_t)L * W_LAYER; t_.cs = 1.f; t_.gain = nullptr; \
        if (r < IT_IN) { const int kb = r / 80, nb = r % 80; t_.W = args->in[I_WIN] + (size_t)L * DM * D_IN; t_.K = DM; t_.N = D_IN; t_.gain = args->in[I_MIXN] + L * DM; t_.WT = (bf16*)(wl + WO_IN); t_.dest_row0 = 32 * nb; t_.k0 = 64 * kb; t_.n0 = 32 * nb; \
            t_.cs = (32 * nb >= ZC_Q && 32 * nb < ZC_KC) ? 0.125f * LOG2E : 1.f; break; } r -= IT_IN; \
        if (r < IT_OUT) { const int kb = r / 32, nb = r % 32; t_.W = args->in[I_WOUT] + (size_t)L * DM * DM; t_.K = DM; t_.N = DM; t_.gain = kb < 8 ? args->in[I_RECN] + L * 512 : args->in[I_ATTN] + L * 512 - 512; t_.WT = (bf16*)(wl + WO_OUT); t_.dest_row0 = 32 * nb; t_.k0 = 64 * kb; t_.n0 = 32 * nb; break; } r -= IT_OUT; \
        if (r < IT_PG) { const int kb = r / 32, nb = r % 32; t_.W = args->in[I_WPG] + (size_t)L * DM * DM; t_.K = DM; t_.N = DM; t_.gain = args->in[I_PLEN] + L * DM; t_.WT = (bf16*)(wl + WO_PG); t_.dest_row0 = 32 * nb; t_.k0 = 64 * kb; t_.n0 = 32 * nb; break; } r -= IT_PG; \
        if (r < IT_PU) { const int kb = r / 32, nb = r % 32; t_.W = args->in[I_WPU] + (size_t)L * D_PLE * DM; t_.K = D_PLE; t_.N = DM; t_.WT = (bf16*)(wl + WO_PU); t_.dest_row0 = 32 * nb; t_.k0 = 64 * kb; t_.n0 = 32 * nb; break; } r -= IT_PU; \
        if (r < IT_K1) { const int kb = r / 8, nb = r % 8; t_.W = args->in[I_WK1] + (size_t)L * 2048 * 256; t_.K = 2048; t_.N = 256; t_.WT = (bf16*)(wl + WO_K1); t_.dest_row0 = 32 * nb; t_.k0 = 64 * kb; t_.n0 = 32 * nb; break; } r -= IT_K1; \
        if (r < IT_V1) { const int kb = r / 8, nb = r % 8; t_.W = args->in[I_WV1] + (size_t)L * 2048 * 256; t_.K = 2048; t_.N = 256; t_.WT = (bf16*)(wl + WO_V1); t_.dest_row0 = 32 * nb; t_.k0 = 64 * kb; t_.n0 = 32 * nb; break; } r -= IT_V1; \
        const int e = r / IT_E; int rr = r % IT_E; \
        if (rr < 512) { const int up = rr >> 8; rr &= 255; const int kb = rr / 16, nb = rr % 16, n0 = 32 * nb;     \
            t_.W = (up ? args->in[I_WUP] : args->in[I_WGATE]) + ((size_t)L * NEXP + e) * DM * DEXP; t_.K = DM; t_.N = DEXP; t_.gain = args->in[I_FFNN] + L * DM; t_.WT = (bf16*)(wl + WO_GU) + (size_t)e * 1024 * 1024; \
            t_.dest_row0 = 256 * (n0 >> 7) + (n0 & 127) + 128 * up; t_.k0 = 64 * kb; t_.n0 = n0; } \
        else { rr -= 512; const int kb = rr / 32, nb = rr % 32; t_.W = args->in[I_WDOWN] + ((size_t)L * NEXP + e) * DEXP * DM; t_.K = DEXP; t_.N = DM; t_.WT = (bf16*)(wl + WO_D) + (size_t)e * 1024 * DEXP; t_.dest_row0 = 32 * nb; t_.k0 = 64 * kb; t_.n0 = 32 * nb; } \
    } while (0)
    int q = q0; TrItem cur; f32x4 vc[8];
    if (q < nq) { TR_DECODE(Q2IT_(q), cur); tr_load(cur, vc, lane); }
    while (q < nq) {
        const int qn = q + qstep; TrItem nxt; f32x4 vn[8];
        const bool hn = qn < nq;
        if (hn) { TR_DECODE(Q2IT_(qn), nxt); tr_load(nxt, vn, lane); }
        tr_store(cur, vc, scr, lane);
        if (hn) { cur = nxt;
#pragma unroll
            for (int i = 0; i < 8; ++i) vc[i] = vn[i]; }
        q = qn; }
#undef TR_DECODE
#undef Q2IT_
}
__device__ __forceinline__ void phase_prologue(KArgs args, LAS unsigned char* lds, int G, int bid, int tid, int wave, int lane) {
    unsigned char* ws = args->ws;
    LAS float* scr = (LAS float*)(lds + wave * 16384);
    const int gw = bid * NWAVES + wave, NGW = G * NWAVES;
    tr_run<0>(args, scr, lane, gw, NGW, 0);
    const int gt = bid * (NWAVES * 64) + tid, NGT = G * NWAVES * 64;
    float* c8 = (float*)(ws + WS_C8); float* wrt = (float*)(ws + WS_WRT);
    for (int i = gt; i < DEPTH * 512; i += NGT) { const float lam = args->in[I_LAM][i]; c8[i] = -8.f * log1pf(expf(-lam)) * LOG2E; }
    for (int i = gt; i < DEPTH * 36 * 1024; i += NGT) { const int L = i / (36 * 1024), j = (i / 1024) % 36, k = i % 1024;
        const float w = (j < 32 ? args->in[I_WER][((size_t)L * DM + k) * 32 + j] : args->in[I_WGR][((size_t)L * DM + k) * 4 + (j - 32)]) * args->in[I_FFNN][L * DM + k];
        const unsigned hi = f2bf(w), lo = f2bf(w - bf2f((bf16)hi));
        ((bf16*)wrt)[((size_t)(L * 2 + 0) * 36 + j) * 1024 + k] = (bf16)hi; ((bf16*)wrt)[((size_t)(L * 2 + 1) * 36 + j) * 1024 + k] = (bf16)lo; }
    { bf16* w2t = (bf16*)(ws + WS_W2T);
      for (int i = gt; i < DEPTH * 2 * 64 * 256; i += NGT) { const int L = i >> 15, kv = (i >> 14) & 1, n = (i >> 8) & 63, k = i & 255;
          w2t[i] = (bf16)f2bf((kv ? args->in[I_WV2] : args->in[I_WK2])[((size_t)L * 256 + k) * 64 + n]); } }
    if (bid < 8) { const int pair = bid, L = pair >> 1, kv = pair & 1, j = tid & 255, half = tid >> 8;
        const float* pe = (kv ? args->in[I_PEV] : args->in[I_PEK]) + L * 2048 + 1024 * half; const float* w1 = (kv ? args->in[I_WV1] : args->in[I_WK1]) + ((size_t)L * 2048 + 1024 * half) * 256 + j;
        float s0 = 0.f, s1 = 0.f, s2 = 0.f, s3 = 0.f;
#pragma unroll 4
        for (int k = 0; k < 1024; k += 4) { s0 += pe[k] * w1[(size_t)k * 256]; s1 += pe[k + 1] * w1[(size_t)(k + 1) * 256]; s2 += pe[k + 2] * w1[(size_t)(k + 2) * 256]; s3 += pe[k + 3] * w1[(size_t)(k + 3) * 256]; }
        LAS float* red = (LAS float*)(lds + 8 * 16384);
        if (half) red[j] = (s0 + s1) + (s2 + s3);
        __syncthreads();
        if (!half) ((float*)(ws + WS_BK1))[pair * 256 + j] = (kv ? args->in[I_BV1] : args->in[I_BK1])[L * 256 + j] + ((s0 + s1) + (s2 + s3)) + red[j]; }
}

__device__ __forceinline__ void store_row_bf16(bf16* orow, const f32x4 (&v)[4], float sc, int lane) {
    unsigned long long* o8 = (unsigned long long*)orow + lane;
#pragma unroll
    for (int j = 0; j < 4; ++j) o8[64 * j] = (unsigned long long)pk2(v[j].x * sc, v[j].y * sc) | ((unsigned long long)pk2(v[j].z * sc, v[j].w * sc) << 32);
}
__device__ __forceinline__ float row_ss_bf16(const u32x2 (&v)[4]) { float s = 0.f;
#pragma unroll
    for (int j = 0; j < 4; ++j) { const float a = bflo(v[j].x), b = bfhi(v[j].x), c = bflo(v[j].y), d = bfhi(v[j].y); s += (a * a + b * b) + (c * c + d * d); }
    return s; }
__device__ __forceinline__ void store_row_bf16_from16(bf16* orow, const u32x2 (&v)[4], float sc, int lane) {
    u32x2* o8 = (u32x2*)orow + lane;
#pragma unroll
    for (int j = 0; j < 4; ++j) { u32x2 w; w.x = pk2(bflo(v[j].x) * sc, bfhi(v[j].x) * sc); w.y = pk2(bflo(v[j].y) * sc, bfhi(v[j].y) * sc); o8[64 * j] = w; }
}
__device__ __forceinline__ float ss_u4(const u32x4& v) {
    const float a = bflo(v.x), b = bfhi(v.x), c = bflo(v.y), d = bfhi(v.y), e = bflo(v.z), f = bfhi(v.z), g = bflo(v.w), h = bfhi(v.w);
    return ((a * a + b * b) + (c * c + d * d)) + ((e * e + f * f) + (g * g + h * h)); }
__device__ __forceinline__ u32x4 scale_u4(const u32x4& v, float sc) { u32x4 w;
    w.x = pg8::cvt_pk_bf16(bflo(v.x) * sc, bfhi(v.x) * sc); w.y = pg8::cvt_pk_bf16(bflo(v.y) * sc, bfhi(v.y) * sc); w.z = pg8::cvt_pk_bf16(bflo(v.z) * sc, bfhi(v.z) * sc); w.w = pg8::cvt_pk_bf16(bflo(v.w) * sc, bfhi(v.w) * sc); return w; }
__device__ __forceinline__ u32x4 add3_u4(const u32x4& h, const u32x4& a, const u32x4& b) { u32x4 w;
    w.x = pg8::cvt_pk_bf16(bflo(h.x) + bflo(a.x) + bflo(b.x), bfhi(h.x) + bfhi(a.x) + bfhi(b.x)); w.y = pg8::cvt_pk_bf16(bflo(h.y) + bflo(a.y) + bflo(b.y), bfhi(h.y) + bfhi(a.y) + bfhi(b.y));
    w.z = pg8::cvt_pk_bf16(bflo(h.z) + bflo(a.z) + bflo(b.z), bfhi(h.z) + bfhi(a.z) + bfhi(b.z)); w.w = pg8::cvt_pk_bf16(bflo(h.w) + bflo(a.w) + bflo(b.w), bfhi(h.w) + bfhi(a.w) + bfhi(b.w)); return w; }
constexpr int N1_PITCH = 2064, ZN_IN = 2304;
__device__ __forceinline__ void phase_norm1(KArgs args, const float* x, bf16* H, float* rs, int L, LAS unsigned char* lds, int G, int bid, int tid, int wave, int lane) {
    unsigned char* ws = args->ws;
    { const u32x4* src = (const u32x4*)(ws + WS_W + (size_t)L * W_LAYER + WO_IN + (size_t)ZN_IN * DM * 2);
      for (int i = tid; i < 24 * 128; i += NWAVES * 64) { const int row = i >> 7, c = i & 127; *(LAS u32x4*)(lds + row * N1_PITCH + c * 16) = src[i]; } }
    __syncthreads();
    bf16* z = (bf16*)(ws + WS_Z);
    const int gw = bid * NWAVES + wave, NGW = G * NWAVES, fr = lane & 15, fq = lane >> 4;
    const int arow1 = 16 + (fr & 7);
    for (int grp = gw; grp < NTOK / 16; grp += NGW) {
        if (x) {
#pragma unroll 1
            for (int r0 = 0; r0 < 16; r0 += 2) { f32x4 v[2][4];
#pragma unroll
                for (int r = 0; r < 2; ++r)
#pragma unroll
                    for (int j = 0; j < 4; ++j) v[r][j] = __builtin_nontemporal_load((const f32x4*)(x + (size_t)(grp * 16 + r0 + r) * DM) + lane + 64 * j);
#pragma unroll
                for (int r = 0; r < 2; ++r) store_row_bf16(H + (size_t)(grp * 16 + r0 + r) * DM, v[r], 1.f, lane); }
            VM_WAIT();
        }
        const int tok = grp * 16 + fr;
        const bf16* hrow = H + (size_t)tok * DM + 8 * fq;
        f32x4 acc0 = {0.f, 0.f, 0.f, 0.f}, acc1 = {0.f, 0.f, 0.f, 0.f}; float ss = 0.f;
#pragma unroll 1
        for (int k0 = 0; k0 < 32; k0 += 16) {
            u32x4 xhv[16];
#pragma unroll
            for (int kq = 0; kq < 16; ++kq) xhv[kq] = *(const u32x4*)(hrow + 32 * (k0 + kq));
#pragma unroll
            for (int kq = 0; kq < 16; ++kq) { const int kk = k0 + kq; const u32x4 xh = xhv[kq];
                ss += ss_u4(xh);
                const bf16x8 bh = __builtin_bit_cast(bf16x8, xh);
                const bf16x8 a0 = *(const LAS bf16x8*)(lds + fr * N1_PITCH + 64 * kk + 16 * fq), a1 = *(const LAS bf16x8*)(lds + arow1 * N1_PITCH + 64 * kk + 16 * fq);
                acc0 = __builtin_amdgcn_mfma_f32_16x16x32_bf16(a0, bh, acc0, 0, 0, 0); acc1 = __builtin_amdgcn_mfma_f32_16x16x32_bf16(a1, bh, acc1, 0, 0, 0); } }
        ss += __builtin_bit_cast(float, __builtin_amdgcn_ds_bpermute((lane ^ 16) << 2, __builtin_bit_cast(int, ss)));
        ss += __builtin_bit_cast(float, __builtin_amdgcn_ds_bpermute((lane ^ 32) << 2, __builtin_bit_cast(int, ss)));
        const float rstd = rsqrtf(ss * (1.f / DM) + EPS);
        if (fq == 0) rs[tok] = rstd;
        bf16* zg = z + (size_t)tok * ZP + ZC_NG;
        { u32x2 w; w.x = pk2(acc0[0] * rstd, acc0[1] * rstd); w.y = pk2(acc0[2] * rstd, acc0[3] * rstd); *(u32x2*)(zg + 4 * fq) = w; }
        if (fq < 2) { u32x2 w; w.x = pk2(acc1[0] * rstd, acc1[1] * rstd); w.y = pk2(acc1[2] * rstd, acc1[3] * rstd); *(u32x2*)(zg + 16 + 4 * fq) = w; }
    }
}
__device__ __forceinline__ void phase_final(const bf16* H, float* out, const float* gain, int gw, int NGW, int lane) {
    constexpr int NR = 4;
    f32x4 gv[2][2];
#pragma unroll
    for (int j = 0; j < 2; ++j) { gv[j][0] = ((const f32x4*)gain)[2 * lane + 128 * j]; gv[j][1] = ((const f32x4*)gain)[2 * lane + 128 * j + 1]; }
    for (int m0 = gw * NR; m0 < NTOK; m0 += NGW * NR) { u32x4 v[NR][2];
#pragma unroll
        for (int r = 0; r < NR; ++r)
#pragma unroll
            for (int j = 0; j < 2; ++j) v[r][j] = ((const u32x4*)(H + (size_t)(m0 + r) * DM))[lane + 64 * j];
#pragma unroll
        for (int r = 0; r < NR; ++r) { const float rstd = rsqrtf(wave_sum(ss_u4(v[r][0]) + ss_u4(v[r][1])) * (1.f / DM) + EPS);
            f32x4* xr = (f32x4*)(out + (size_t)(m0 + r) * DM);
#pragma unroll
            for (int j = 0; j < 2; ++j) { const u32x4 w = v[r][j];
                xr[2 * lane + 128 * j] = (f32x4){bflo(w.x), bfhi(w.x), bflo(w.y), bfhi(w.y)} * rstd * gv[j][0];
                xr[2 * lane + 128 * j + 1] = (f32x4){bflo(w.z), bfhi(w.z), bflo(w.w), bfhi(w.w)} * rstd * gv[j][1]; } } }
}
__device__ __forceinline__ void phase_norm3(bf16* H, const bf16* y0, const bf16* y1, float* rs, const float* pL, bf16* pb, int gw, int NGW, int lane) {
    constexpr int NR = 4;
    for (int m0 = gw * NR; m0 < NTOK; m0 += NGW * NR) { u32x4 hv[NR][2], av[NR][2], bv[NR][2]; f32x4 pv[NR];
#pragma unroll
        for (int r = 0; r < NR; ++r) { const size_t ro = (size_t)(m0 + r) * DM;
#pragma unroll
            for (int j = 0; j < 2; ++j) { hv[r][j] = ((const u32x4*)(H + ro))[lane + 64 * j]; av[r][j] = __builtin_nontemporal_load((const u32x4*)(y0 + ro) + lane + 64 * j); bv[r][j] = __builtin_nontemporal_load((const u32x4*)(y1 + ro) + lane + 64 * j); }
            pv[r] = __builtin_nontemporal_load((const f32x4*)(pL + (size_t)(m0 + r) * D_PLE) + lane); }
        float rr[NR];
#pragma unroll
        for (int r = 0; r < NR; ++r) { const size_t ro = (size_t)(m0 + r) * DM;
            const u32x4 w0 = add3_u4(hv[r][0], av[r][0], bv[r][0]), w1 = add3_u4(hv[r][1], av[r][1], bv[r][1]);
            ((u32x4*)(H + ro))[lane] = w0; ((u32x4*)(H + ro))[lane + 64] = w1;
            rr[r] = rsqrtf(wave_sum(ss_u4(w0) + ss_u4(w1)) * (1.f / DM) + EPS);
            u32x2 q; q.x = pg8::cvt_pk_bf16(pv[r].x, pv[r].y); q.y = pg8::cvt_pk_bf16(pv[r].z, pv[r].w);
            ((u32x2*)(pb + (size_t)(m0 + r) * D_PLE))[lane] = q; }
        if (lane == 0) *(f32x4*)(rs + m0) = (f32x4){rr[0], rr[1], rr[2], rr[3]}; }
}
constexpr int N2_PITCH = 2064, N2_WL = 36 * N2_PITCH;
__device__ __forceinline__ void phase_norm2(KArgs args, const bf16* H, int L, LAS unsigned char* lds, int G, int bid, int tid, int wave, int lane) {
    unsigned char* ws = args->ws;
    { const u32x4* src = (const u32x4*)(ws + WS_WRT + (size_t)L * 2 * 36 * 2048);
      for (int i = tid; i < 2 * 36 * 128; i += NWAVES * 64) { const int hl = i / (36 * 128), row = (i >> 7) % 36, c = i & 127; *(LAS u32x4*)(lds + hl * N2_WL + row * N2_PITCH + c * 16) = src[i]; } }
    __syncthreads();
    gu32* cnt = (gu32*)(ws + WS_CTL) + CW_CNT + L * 64;
    int* ltok = (int*)(ws + WS_LTOK); float* lgate = (float*)(ws + WS_LGATE); float* lrs = (float*)(ws + WS_LRS);
    const float* bgr = args->in[I_BGR] + L * 4; const float* ber = args->in[I_BER] + L * 32;
    const int gw = bid * NWAVES + wave, NGW = G * NWAVES, fr = lane & 15, fq = lane >> 4;
    const int arow[3] = {8 * (fr >> 2) + (fr & 3), 8 * (fr >> 2) + (fr & 3) + 4, 32 + (fr & 3)};
    for (int grp = gw; grp < NTOK / 16; grp += NGW) {
        const int tok = grp * 16 + fr;
        const bf16* hrow = H + (size_t)tok * DM + 8 * fq;
        f32x4 acc[3]; float ss = 0.f;
#pragma unroll
        for (int t3 = 0; t3 < 3; ++t3) acc[t3] = (f32x4){0.f, 0.f, 0.f, 0.f};
#pragma unroll 1
        for (int k0 = 0; k0 < 32; k0 += 16) {
        u32x4 xhv[16];
#pragma unroll
        for (int kq = 0; kq < 16; ++kq) xhv[kq] = *(const u32x4*)(hrow + 32 * (k0 + kq));
#pragma unroll
        for (int kq = 0; kq < 16; ++kq) { const int kk = k0 + kq;
            const u32x4 xh = xhv[kq];
            { const float a0 = bflo(xh.x), a1 = bfhi(xh.x), a2 = bflo(xh.y), a3 = bfhi(xh.y), a4 = bflo(xh.z), a5 = bfhi(xh.z), a6 = bflo(xh.w), a7 = bfhi(xh.w);
              ss += (a0 * a0 + a1 * a1) + (a2 * a2 + a3 * a3) + (a4 * a4 + a5 * a5) + (a6 * a6 + a7 * a7); }
            const bf16x8 bh = __builtin_bit_cast(bf16x8, xh);
#pragma unroll
            for (int t3 = 0; t3 < 3; ++t3) { const bf16x8 ah = *(const LAS bf16x8*)(lds + arow[t3] * N2_PITCH + 64 * kk + 16 * fq), al = *(const LAS bf16x8*)(lds + N2_WL + arow[t3] * N2_PITCH + 64 * kk + 16 * fq);
                acc[t3] = __builtin_amdgcn_mfma_f32_16x16x32_bf16(ah, bh, acc[t3], 0, 0, 0); acc[t3] = __builtin_amdgcn_mfma_f32_16x16x32_bf16(al, bh, acc[t3], 0, 0, 0); }
        }
        }
        ss += __builtin_bit_cast(float, __builtin_amdgcn_ds_bpermute((lane ^ 16) << 2, __builtin_bit_cast(int, ss)));
        ss += __builtin_bit_cast(float, __builtin_amdgcn_ds_bpermute((lane ^ 32) << 2, __builtin_bit_cast(int, ss)));
        const float rstd = rsqrtf(ss * (1.f / DM) + EPS);
        float gl[4]; int gi = 0;
#pragma unroll
        for (int j = 0; j < 4; ++j) gl[j] = acc[2][j] * rstd + bgr[j];
        float gmax = gl[0];
#pragma unroll
        for (int j = 1; j < 4; ++j) if (gl[j] > gmax) { gmax = gl[j]; gi = j; }
        if (fq == gi) {
            float den = 0.f;
#pragma unroll
            for (int j = 0; j < 4; ++j) den += expf(gl[j] - gmax);
            const float pg = 1.f / den;
            float b1 = -3.0e38f, b2 = -3.0e38f; int j1 = 0, j2 = 0;
#pragma unroll
            for (int e = 0; e < 8; ++e) { const float x = (e < 4 ? acc[0][e & 3] : acc[1][e & 3]) * rstd + ber[gi * 8 + e];
                if (x > b1) { b2 = b1; j2 = j1; b1 = x; j1 = e; } else if (x > b2) { b2 = x; j2 = e; } }
            const float w1 = 1.f / (1.f + expf(b2 - b1)), w2 = 1.f - w1;
            const int s0 = gi * 8 + j1, s1 = 32 + gi * 8 + j2;
            const unsigned r0 = __hip_atomic_fetch_add(cnt + s0, 1u, RLX_AGENT), r1 = __hip_atomic_fetch_add(cnt + s1, 1u, RLX_AGENT);
            ltok[(size_t)s0 * NTOK + r0] = tok; lgate[(size_t)s0 * NTOK + r0] = pg * w1; lrs[(size_t)s0 * NTOK + r0] = rstd;
            ltok[(size_t)s1 * NTOK + r1] = tok; lgate[(size_t)s1 * NTOK + r1] = pg * w2; lrs[(size_t)s1 * NTOK + r1] = rstd;
        }
    }
}
template <int CTRL> __device__ __forceinline__ float dpp_row_shr(float old, float src) {
    return __builtin_bit_cast(float, __builtin_amdgcn_update_dpp(__builtin_bit_cast(int, old), __builtin_bit_cast(int, src), CTRL, 0xf, 0xf, false));
}
__device__ __forceinline__ void rec1_unit(KArgs args, int L, int unit, LAS unsigned char* lds, int wave, int lane) {
    unsigned char* ws = args->ws;
    const bf16* z = (const bf16*)(ws + WS_Z);
    bf16* hloc = (bf16*)(ws + WS_HLOC); bf16* cumA = (bf16*)(ws + WS_CUMA); float* agg = (float*)(ws + WS_AGG);
    const int b = unit >> 4, chk = unit & 15, t0 = chk * 256, fr = lane & 15, q = lane >> 4, hb = wave;
    const float* Wa = args->in[I_WA] + ((size_t)(L * 8 + hb)) * 4096; const float* Wx = args->in[I_WX] + ((size_t)(L * 8 + hb)) * 4096;
    LAS unsigned char* wl = lds + wave * 16384;
#pragma unroll 1
    for (int f = 0; f < 16; ++f) { const int mat = f >> 3, n = (f >> 1) & 3, kk = f & 1; const float* W = mat ? Wx : Wa;
        const int jout = 8 * (fr >> 2) + (fr & 3) + 4 * (n & 1) + 32 * (n >> 1); const float* wp = W + (32 * kk + 8 * q) * 64 + jout;
        u32x4 w; w.x = pk2(wp[0], wp[64]); w.y = pk2(wp[128], wp[192]); w.z = pk2(wp[256], wp[320]); w.w = pk2(wp[384], wp[448]);
        *(LAS u32x4*)(wl + f * 1024 + lane * 16) = w; }
    LAS float* ct = (LAS float*)(lds + 131072 + wave * 2048);
    { const int c = 64 * hb + lane; const float* cw = args->in[I_CONVW] + (size_t)L * 4 * 512;
      ct[lane * 8 + 0] = cw[c]; ct[lane * 8 + 1] = cw[512 + c]; ct[lane * 8 + 2] = cw[1024 + c]; ct[lane * 8 + 3] = cw[1536 + c];
      ct[lane * 8 + 4] = args->in[I_CONVB][L * 512 + c]; ct[lane * 8 + 5] = args->in[I_BA][L * 512 + c]; ct[lane * 8 + 6] = args->in[I_BX][L * 512 + c];
      ct[lane * 8 + 7] = ((const float*)(ws + WS_C8))[L * 512 + c]; }
    LDS_WAIT();
    float Acar[2][8], Hcar[2][8];
#pragma unroll
    for (int kk = 0; kk < 2; ++kk)
#pragma unroll
        for (int e = 0; e < 8; ++e) { Acar[kk][e] = 1.f; Hcar[kk][e] = 0.f; }
    const bf16* zb = z + (size_t)(b * SEQ) * ZP + ZC_XR + 64 * hb;
    const int bidx15 = ((lane & ~15) | 15) << 2;
    u32x4 rawc[2][4];
#define REC_LOAD_TILE(dst_, tile_) do { const int t_ = t0 + (tile_) * 16 + fr; _Pragma("unroll") for (int kk_ = 0; kk_ < 2; ++kk_) _Pragma("unroll") for (int j_ = 0; j_ < 4; ++j_) { const int tt_ = t_ - 3 + j_; \
        dst_[kk_][j_] = *(const u32x4*)(zb + (size_t)(tt_ > 0 ? tt_ : 0) * ZP + 32 * kk_ + 8 * q); } } while (0)
    REC_LOAD_TILE(rawc, 0);
#pragma unroll 1
    for (int tile = 0; tile < 16; ++tile) {
        const int t = t0 + tile * 16 + fr; const bool edge = (t0 + tile * 16) == 0;
        u32x4 rawn[2][4];
        REC_LOAD_TILE(rawn, tile < 15 ? tile + 1 : 15);
        u32x4 xb[2];
#pragma unroll
        for (int kk = 0; kk < 2; ++kk) {
            float xc[8];
#pragma unroll
            for (int e = 0; e < 8; ++e) xc[e] = ct[(32 * kk + 8 * q + e) * 8 + 4];
#pragma unroll
            for (int j = 0; j < 4; ++j) { const int tt = t - 3 + j;
                u32x4 raw = rawc[kk][j];
                if (edge && tt < 0) raw = (u32x4){0u, 0u, 0u, 0u};
                const float xv[8] = {bflo(raw.x), bfhi(raw.x), bflo(raw.y), bfhi(raw.y), bflo(raw.z), bfhi(raw.z), bflo(raw.w), bfhi(raw.w)};
#pragma unroll
                for (int e = 0; e < 8; ++e) xc[e] += ct[(32 * kk + 8 * q + e) * 8 + j] * xv[e]; }
            xb[kk].x = pk2(xc[0], xc[1]); xb[kk].y = pk2(xc[2], xc[3]); xb[kk].z = pk2(xc[4], xc[5]); xb[kk].w = pk2(xc[6], xc[7]);
        }
        asm volatile("" ::: "memory");
#pragma unroll
        for (int kh = 0; kh < 2; ++kh) {
            f32x4 racc[2], iacc[2];
#pragma unroll
            for (int nn = 0; nn < 2; ++nn) { racc[nn] = (f32x4){0.f, 0.f, 0.f, 0.f}; iacc[nn] = (f32x4){0.f, 0.f, 0.f, 0.f};
#pragma unroll
                for (int kk = 0; kk < 2; ++kk) { const int n = 2 * kh + nn;
                    const bf16x8 fa = *(const LAS bf16x8*)(wl + ((0 * 4 + n) * 2 + kk) * 1024 + lane * 16), fx = *(const LAS bf16x8*)(wl + ((1 * 4 + n) * 2 + kk) * 1024 + lane * 16);
                    const bf16x8 xk = __builtin_bit_cast(bf16x8, xb[kk]);
                    racc[nn] = __builtin_amdgcn_mfma_f32_16x16x32_bf16(fa, xk, racc[nn], 0, 0, 0); iacc[nn] = __builtin_amdgcn_mfma_f32_16x16x32_bf16(fx, xk, iacc[nn], 0, 0, 0); } }
            const unsigned xw[4] = {xb[kh].x, xb[kh].y, xb[kh].z, xb[kh].w};
            float hv[8], av[8];
#pragma unroll
            for (int e = 0; e < 8; ++e) {
                const int nn = e >> 2, jj = e & 3; const int cb = (32 * kh + 8 * q + e) * 8;
                const float xcv = (e & 1) ? bfhi(xw[e >> 1]) : bflo(xw[e >> 1]);
                const float r = fsigmoid(racc[nn][jj] + ct[cb + 5]), ig = fsigmoid(iacc[nn][jj] + ct[cb + 6]);
                float a = __builtin_amdgcn_exp2f(ct[cb + 7] * r);
                float bb = __builtin_amdgcn_sqrtf(fmaxf(1.f - a * a, 0.f)) * (ig * xcv);
#define REC_SCAN_STEP(N_) asm volatile("s_nop 1\n\tv_fmac_f32_dpp %0, %0, %1 row_shr:" #N_ " row_mask:0xf bank_mask:0xf\n\ts_nop 1\n\tv_mul_f32_dpp %1, %1, %1 row_shr:" #N_ " row_mask:0xf bank_mask:0xf" : "+v"(bb), "+v"(a))
                REC_SCAN_STEP(1); REC_SCAN_STEP(2); REC_SCAN_STEP(4); REC_SCAN_STEP(8);
#undef REC_SCAN_STEP
                const float hl = a * Hcar[kh][e] + bb, ca = a * Acar[kh][e];
                hv[e] = hl; av[e] = ca;
                Hcar[kh][e] = __builtin_bit_cast(float, __builtin_amdgcn_ds_bpermute(bidx15, __builtin_bit_cast(int, hl))); Acar[kh][e] = __builtin_bit_cast(float, __builtin_amdgcn_ds_bpermute(bidx15, __builtin_bit_cast(int, ca)));
            }
            const size_t o = (size_t)(b * SEQ + t) * D_REC + 64 * hb + 32 * kh + 8 * q;
            u32x4 w; w.x = pk2(hv[0], hv[1]); w.y = pk2(hv[2], hv[3]); w.z = pk2(hv[4], hv[5]); w.w = pk2(hv[6], hv[7]);
            *(u32x4*)(hloc + o) = w;
            w.x = pk2(av[0], av[1]); w.y = pk2(av[2], av[3]); w.z = pk2(av[4], av[5]); w.w = pk2(av[6], av[7]);
            *(u32x4*)(cumA + o) = w;
            asm volatile("" ::: "memory");
        }
#pragma unroll
        for (int kk = 0; kk < 2; ++kk)
#pragma unroll
            for (int j = 0; j < 4; ++j) rawc[kk][j] = rawn[kk][j];
    }
#undef REC_LOAD_TILE
    if (fr == 0) {
#pragma unroll
        for (int kk = 0; kk < 2; ++kk)
#pragma unroll
            for (int e = 0; e < 8; ++e) { const int c = 64 * hb + 32 * kk + 8 * q + e; float* ap = agg + ((size_t)(b * 16 + chk) * 512 + c) * 2; ap[0] = Acar[kk][e]; ap[1] = Hcar[kk][e]; }
    }
}
__device__ __forceinline__ void rec2_rows(KArgs args, int gw, int NGW, int lane) {
    unsigned char* ws = args->ws;
    const bf16* z = (const bf16*)(ws + WS_Z); const bf16* hloc = (const bf16*)(ws + WS_HLOC); const bf16* cumA = (const bf16*)(ws + WS_CUMA);
    const float* carry = (const float*)(ws + WS_CARRY); bf16* mixed = (bf16*)(ws + WS_MIXED);
    constexpr int NR = 4;
    for (int m0 = gw * NR; m0 < NTOK; m0 += NGW * NR) {
        const int b = m0 >> 12, chk = (m0 & 4095) >> 8;
        u32x4 hl[NR], ca[NR], gr[NR];
#pragma unroll
        for (int r = 0; r < NR; ++r) { const size_t m = (size_t)(m0 + r); hl[r] = __builtin_nontemporal_load((const u32x4*)(hloc + m * D_REC + 8 * lane)); ca[r] = __builtin_nontemporal_load((const u32x4*)(cumA + m * D_REC + 8 * lane)); gr[r] = __builtin_nontemporal_load((const u32x4*)(z + m * ZP + ZC_GR + 8 * lane)); }
        const f32x4 c0 = *(const f32x4*)(carry + (size_t)(b * 16 + chk) * 512 + 8 * lane), c1 = *(const f32x4*)(carry + (size_t)(b * 16 + chk) * 512 + 8 * lane + 4);
#pragma unroll
        for (int r = 0; r < NR; ++r) { float v[8];
            v[0] = (bflo(hl[r].x) + bflo(ca[r].x) * c0.x) * fgelu(bflo(gr[r].x)); v[1] = (bfhi(hl[r].x) + bfhi(ca[r].x) * c0.y) * fgelu(bfhi(gr[r].x));
            v[2] = (bflo(hl[r].y) + bflo(ca[r].y) * c0.z) * fgelu(bflo(gr[r].y)); v[3] = (bfhi(hl[r].y) + bfhi(ca[r].y) * c0.w) * fgelu(bfhi(gr[r].y));
            v[4] = (bflo(hl[r].z) + bflo(ca[r].z) * c1.x) * fgelu(bflo(gr[r].z)); v[5] = (bfhi(hl[r].z) + bfhi(ca[r].z) * c1.y) * fgelu(bfhi(gr[r].z));
            v[6] = (bflo(hl[r].w) + bflo(ca[r].w) * c1.z) * fgelu(bflo(gr[r].w)); v[7] = (bfhi(hl[r].w) + bfhi(ca[r].w) * c1.w) * fgelu(bfhi(gr[r].w));
            float s = 0.f;
#pragma unroll
            for (int e = 0; e < 8; ++e) s += v[e] * v[e];
            const float rstd = rsqrtf(wave_sum(s) * (1.f / D_REC) + EPS);
            u32x4 w; w.x = pk2(v[0] * rstd, v[1] * rstd); w.y = pk2(v[2] * rstd, v[3] * rstd); w.z = pk2(v[4] * rstd, v[5] * rstd); w.w = pk2(v[6] * rstd, v[7] * rstd);
            *(u32x4*)(mixed + (size_t)(m0 + r) * DM + 8 * lane) = w; }
    }
}
__device__ __forceinline__ void phase_mid(KArgs args, int L, int G, int bid, int tid, int wave, int lane) {
    unsigned char* ws = args->ws;
    const float* agg = (const float*)(ws + WS_AGG); float* carry = (float*)(ws + WS_CARRY);
    const int gt = bid * (NWAVES * 64) + tid, NGT = G * NWAVES * 64;
    for (int i = gt; i < BATCH * 512; i += NGT) { const int b = i >> 9, c = i & 511; float Ak[16], Hk[16];
#pragma unroll
        for (int k = 0; k < 16; ++k) { const size_t o = (size_t)(b * 16 + k) * 512 + c; Ak[k] = agg[o * 2]; Hk[k] = agg[o * 2 + 1]; }
        float H = 0.f;
#pragma unroll
        for (int k = 0; k < 16; ++k) { carry[(size_t)(b * 16 + k) * 512 + c] = H; H = Ak[k] * H + Hk[k]; } }
    const bf16* hid = (const bf16*)(ws + WS_HIDC); const bf16* w2t = (const bf16*)(ws + WS_W2T);
    const int gw = bid * NWAVES + wave, NGW = G * NWAVES, fr = lane & 15, fq = lane >> 4;
    for (int task = gw; task < 2 * 512; task += NGW) {
        const int kv = task >> 9, grp = task & 511;
        const bf16* ar = hid + ((size_t)kv * 8192 + grp * 16 + fr) * 256 + 8 * fq;
        const bf16* br = w2t + ((size_t)(L * 2 + kv) * 64 + fr) * 256 + 8 * fq;
        const float* b2 = (kv ? args->in[I_BV2] : args->in[I_BK2]) + L * 64;
        f32x4 acc[4];
#pragma unroll
        for (int nt = 0; nt < 4; ++nt) { const float bb = b2[16 * nt + fr]; acc[nt] = (f32x4){bb, bb, bb, bb}; }
#pragma unroll
        for (int kk = 0; kk < 8; ++kk) { const bf16x8 a = *(const bf16x8*)(ar + 32 * kk);
#pragma unroll
            for (int nt = 0; nt < 4; ++nt) { const bf16x8 bfr = *(const bf16x8*)(br + (size_t)(16 * nt) * 256 + 32 * kk); acc[nt] = __builtin_amdgcn_mfma_f32_16x16x32_bf16(a, bfr, acc[nt], 0, 0, 0); } }
        bf16* outp = (bf16*)(ws + (kv ? WS_VCMP : WS_KCMP));
#pragma unroll
        for (int jj = 0; jj < 4; ++jj) { const int row = grp * 16 + 4 * fq + jj; const bool real = (row & 255) != 255;
#pragma unroll
            for (int nt = 0; nt < 4; ++nt) outp[(size_t)row * 64 + 16 * nt + fr] = real ? (bf16)f2bf(acc[nt][jj]) : (bf16)0; }
    }
}

typedef float f32x16 __attribute__((ext_vector_type(16)));
typedef short s16x4 __attribute__((ext_vector_type(4)));
typedef float f32x2_t __attribute__((ext_vector_type(2)));
typedef __bf16 bf16x2_t __attribute__((ext_vector_type(2)));
__device__ __forceinline__ unsigned cvtpk(float lo, float hi) { f32x2_t v = {lo, hi}; bf16x2_t b = __builtin_convertvector(v, bf16x2_t); return __builtin_bit_cast(unsigned, b); }
__device__ __forceinline__ void xhalf_pair(float m, float& lo, float& hi) {
    unsigned a = __builtin_bit_cast(unsigned, m), b = a; asm volatile("" : "+v"(b));
    auto rr = __builtin_amdgcn_permlane32_swap(a, b, false, false);
    unsigned r0 = rr[0], r1 = rr[1]; asm volatile("" : "+v"(r0), "+v"(r1));
    lo = __builtin_bit_cast(float, r0); hi = __builtin_bit_cast(float, r1);
}
__device__ __forceinline__ float xhalf_max(float m) { float a, b; xhalf_pair(m, a, b); return fmaxf(a, b); }
__device__ __forceinline__ float xhalf_sum(float m) { float a, b; xhalf_pair(m, a, b); return a + b; }
__device__ __forceinline__ s16x4 vtr(const LAS unsigned char* p) { return __builtin_bit_cast(s16x4, __builtin_amdgcn_ds_read_tr16_b64_v4i16((LAS s16x4*)p)); }
constexpr int ATT_NS = 4, ATT_PD = 3;
constexpr int ATT_IMP = 65536, ATT_SC = ATT_IMP + 4 * 64 * 65 * 4, ATT_MASK = ATT_SC + 64 * 65 * 4, ATT_UNION = ATT_MASK + 512, ATT_RED = ATT_UNION + 64;
static_assert(ATT_RED + 2048 <= MISC_OFF, "attention LDS map");
#define CI_(i) (((i) & 3) + 8 * ((i) >> 2))
__device__ __forceinline__ float max3f(float a, float b, float c) { float r; asm("v_max3_f32 %0, %1, %2, %3" : "=v"(r) : "v"(a), "v"(b), "v"(c)); return r; }

struct AttState { f32x16 O[2]; float m, l; bool fresh; };
__device__ __forceinline__ void att_stage(LAS unsigned char* lds, int slot, const char* kp, const char* vp, unsigned pitch, int wave, int lane) {
    const int key = 8 * wave + (lane >> 3), pc = lane & 7;
    const char* ks = kp + (size_t)key * pitch + ((pc ^ ((key >> 1) & 7)) << 4);
    const char* vs = vp + (size_t)key * pitch + ((pc ^ ((key & 3) << 1)) << 4);
    const unsigned dk = (unsigned)(unsigned long)(lds + slot * 16384 + wave * 1024), dv = dk + 8192u; unsigned keep;
    asm volatile("s_mov_b32 %0, m0\n\ts_mov_b32 m0, %2\n\ts_nop 0\n\tglobal_load_lds_dwordx4 %1, off\n\ts_mov_b32 m0, %0" : "=&s"(keep) : "v"(ks), "s"(dk) : "memory");
    asm volatile("s_mov_b32 %0, m0\n\ts_mov_b32 m0, %2\n\ts_nop 0\n\tglobal_load_lds_dwordx4 %1, off\n\ts_mov_b32 m0, %0" : "=&s"(keep) : "v"(vs), "s"(dv) : "memory");
}
__device__ __forceinline__ void att_qk64(const LAS unsigned char* Kb, const bf16x8 (&qf)[4], float sF, float cb, int rq, int h, f32x16& S0, f32x16& S1) {
    const LAS unsigned char* rowp = Kb + rq * 128; const int sw = (rq >> 1) & 7;
    bf16x8 kf[2][4];
#pragma unroll
    for (int sub = 0; sub < 2; ++sub)
#pragma unroll
        for (int s4 = 0; s4 < 4; ++s4) kf[sub][s4] = *(const LAS bf16x8*)(rowp + sub * 4096 + (((2 * s4 + h) ^ sw) << 4));
    const float base = cb + sF * (float)(4 * h);
    { const f32x2 d01 = {0.f, sF}, d23 = {sF + sF, 3.f * sF};
#pragma unroll
      for (int q4 = 0; q4 < 4; ++q4) { const float bq = fmaf(sF, (float)(8 * q4), base), bq1 = fmaf(sF, (float)(8 * q4 + 32), base);
          const f32x2 bb = {bq, bq}, bc = {bq1, bq1}; const f32x2 lo = bb + d01, hi = bb + d23, lo1 = bc + d01, hi1 = bc + d23;
          S0[4 * q4] = lo.x; S0[4 * q4 + 1] = lo.y; S0[4 * q4 + 2] = hi.x; S0[4 * q4 + 3] = hi.y; S1[4 * q4] = lo1.x; S1[4 * q4 + 1] = lo1.y; S1[4 * q4 + 2] = hi1.x; S1[4 * q4 + 3] = hi1.y; } }
    __builtin_amdgcn_sched_barrier(0);
#pragma unroll
    for (int s4 = 0; s4 < 4; ++s4) { S0 = __builtin_amdgcn_mfma_f32_32x32x16_bf16(kf[0][s4], qf[s4], S0, 0, 0, 0); S1 = __builtin_amdgcn_mfma_f32_32x32x16_bf16(kf[1][s4], qf[s4], S1, 0, 0, 0); }
    __builtin_amdgcn_sched_barrier(0);
}
__device__ __forceinline__ void att_mask(int sub, int h, int lim_lo, int lim_hi, f32x16& S) {
    const int hi2 = lim_hi - 32 * sub - 4 * h, lo2 = lim_lo - 32 * sub - 4 * h;
#pragma unroll
    for (int i = 0; i < 16; ++i) S[i] = (CI_(i) <= hi2 && CI_(i) > lo2) ? S[i] : -__builtin_inff();
}
template <bool IMP>
__device__ __forceinline__ void att_softmax_pv64(const bool MASKED, const LAS unsigned char* Vb, int lim_lo, int lim_hi, f32x16& S0, f32x16& S1, AttState& st, int h, int lane, LAS float* irow = nullptr, int ct = 0) {
    const int qd = (lane & 15) >> 2, pp = lane & 3, blk = (lane >> 4) & 1;
    const LAS unsigned char* vrow = Vb + (4 * h + qd) * 128 + (pp & 1) * 8;
    bf16x8 vf[2][4];
#pragma unroll
    for (int dt = 0; dt < 2; ++dt) { const int coff = ((dt * 4 + blk * 2 + (pp >> 1)) ^ (qd << 1)) << 4;
#pragma unroll
        for (int ks = 0; ks < 4; ++ks) { const s16x4 lo = vtr(vrow + coff + (16 * ks) * 128), hi = vtr(vrow + coff + (16 * ks + 8) * 128);
            vf[dt][ks] = __builtin_shufflevector(lo, hi, 0, 1, 2, 3, 4, 5, 6, 7); } }
    __builtin_amdgcn_sched_barrier(0);
    if (MASKED) { att_mask(0, h, lim_lo, lim_hi, S0); att_mask(1, h, lim_lo, lim_hi, S1); }
    float mx = max3f(S0[0], S0[1], S0[2]), my = max3f(S1[0], S1[1], S1[2]);
    mx = max3f(mx, S0[3], S0[4]); my = max3f(my, S1[3], S1[4]); mx = max3f(mx, S0[5], S0[6]); my = max3f(my, S1[5], S1[6]); mx = max3f(mx, S0[7], S0[8]); my = max3f(my, S1[7], S1[8]);
    mx = max3f(mx, S0[9], S0[10]); my = max3f(my, S1[9], S1[10]); mx = max3f(mx, S0[11], S0[12]); my = max3f(my, S1[11], S1[12]); mx = max3f(mx, S0[13], S0[14]); my = max3f(my, S1[13], S1[14]);
    mx = xhalf_max(max3f(mx, my, max3f(S0[15], S1[15], S1[15])));
    const bool fin = mx > -1e30f;
    const bool rb = fin && (mx > 8.f || st.fresh);
    if (__any(rb)) { const float d = rb ? mx : 0.f; const float corr = st.fresh ? 1.f : __builtin_amdgcn_exp2f(-d); st.l *= corr; st.m += d;
#pragma unroll
        for (int i = 0; i < 16; ++i) { st.O[0][i] *= corr; st.O[1][i] *= corr; S0[i] -= d; S1[i] -= d; }
        if (IMP) { if (h == 0 && corr != 1.f) { for (int j = 0; j < 64; ++j) irow[j] *= corr; } }
    }
    st.fresh = st.fresh && !fin;
    float ps = 0.f, pt = 0.f;
#pragma unroll
    for (int i = 0; i < 16; ++i) { S0[i] = __builtin_amdgcn_exp2f(S0[i]); S1[i] = __builtin_amdgcn_exp2f(S1[i]); ps += S0[i]; pt += S1[i]; }
    st.l += ps + pt;
    if (IMP) {
        float prev3 = 0.f; const int partner = (lane ^ 32) << 2;
#pragma unroll
        for (int f = 0; f < 8; ++f) { const f32x16& S_ = (f >> 2) ? S1 : S0; const int q4 = f & 3; const float p3 = S_[4 * q4 + 3];
            const float own = 2.f * (S_[4 * q4] + S_[4 * q4 + 1] + S_[4 * q4 + 2]) + p3;
            const float inc = __builtin_bit_cast(float, __builtin_amdgcn_ds_bpermute(partner, __builtin_bit_cast(int, h ? prev3 : p3)));
            irow[16 * ct + 2 * f + h] = own + inc;
            prev3 = p3; }
        if (h && ct < 3) __hip_atomic_fetch_add(irow + 16 * ct + 16, prev3, __ATOMIC_RELAXED, __HIP_MEMORY_SCOPE_WORKGROUP); }
    u32x4 pk[4];
#pragma unroll
    for (int s2 = 0; s2 < 2; ++s2) { pk[s2].x = cvtpk(S0[8 * s2], S0[8 * s2 + 1]); pk[s2].y = cvtpk(S0[8 * s2 + 2], S0[8 * s2 + 3]); pk[s2].z = cvtpk(S0[8 * s2 + 4], S0[8 * s2 + 5]); pk[s2].w = cvtpk(S0[8 * s2 + 6], S0[8 * s2 + 7]);
        pk[2 + s2].x = cvtpk(S1[8 * s2], S1[8 * s2 + 1]); pk[2 + s2].y = cvtpk(S1[8 * s2 + 2], S1[8 * s2 + 3]); pk[2 + s2].z = cvtpk(S1[8 * s2 + 4], S1[8 * s2 + 5]); pk[2 + s2].w = cvtpk(S1[8 * s2 + 6], S1[8 * s2 + 7]); }
    __builtin_amdgcn_sched_barrier(0);
#pragma unroll
    for (int ks = 0; ks < 4; ++ks)
#pragma unroll
        for (int dt = 0; dt < 2; ++dt) st.O[dt] = __builtin_amdgcn_mfma_f32_32x32x16_bf16(vf[dt][ks], __builtin_bit_cast(bf16x8, pk[ks]), st.O[dt], 0, 0, 0);
    __builtin_amdgcn_sched_barrier(0);
}
__device__ __forceinline__ void att_state_reset(AttState& st) {
#pragma unroll
    for (int i = 0; i < 16; ++i) { st.O[0][i] = 0.f; st.O[1][i] = 0.f; }
    st.m = 0.f; st.l = 0.f; st.fresh = true;
}
#define ATT_WAIT_BAR() asm volatile("s_waitcnt vmcnt(0) lgkmcnt(0)\n\ts_barrier" ::: "memory")
#define ATT_WAIT_BAR_PD() asm volatile("s_waitcnt vmcnt(4) lgkmcnt(0)\n\ts_barrier" ::: "memory")
#define ATT_WAIT_BAR_2() asm volatile("s_waitcnt vmcnt(2) lgkmcnt(0)\n\ts_barrier" ::: "memory")

__device__ __forceinline__ int opq_v(int x) { asm volatile("" : "+v"(x)); return x; }
__device__ __forceinline__ int opq_s(int x) { asm volatile("" : "+s"(x)); return x; }
#define ATT_IDS const int lane = opq_v(lane0), wave = opq_s(wave0); const int r = wave >> 1, th = wave & 1, rq = lane & 31, h = lane >> 5, tl = 32 * th + rq, t = qb * 64 + tl, tok = b * SEQ + t; (void)r; (void)t; (void)tok;
__device__ __forceinline__ void att_unit_mfma(KArgs args, int b, int qb, LAS unsigned char* lds, int wave0, int lane0, int tid0) {
    unsigned char* ws = args->ws;
    const bf16* z = (const bf16*)(ws + WS_Z); bf16* mixed = (bf16*)(ws + WS_MIXED);
    LAS float* imp = (LAS float*)(lds + ATT_IMP);
    LAS float* sc = (LAS float*)(lds + ATT_SC);
    LAS unsigned* maskw = (LAS unsigned*)(lds + ATT_MASK);
    LAS unsigned* unionw = (LAS unsigned*)(lds + ATT_UNION);
    LAS float* red = (LAS float*)(lds + ATT_RED);
    unsigned OUTP[16];
    const unsigned ZPB = ZP * 2;
#pragma unroll 1
    for (int g = 0; g < 2; ++g) {
        const int hd = 4 * g + (wave0 >> 1);
        bf16x8 qf[4]; float slope2, g0, g1, g2;
        { ATT_IDS const int tid = opq_v(tid0);
          const bf16* zrow = z + (size_t)tok * ZP;
#pragma unroll
          for (int s4 = 0; s4 < 4; ++s4) qf[s4] = *(const bf16x8*)(zrow + ZC_Q + hd * 64 + 16 * s4 + 8 * h);
          slope2 = exp2f(-(float)(hd + 1)) * LOG2E;
          g0 = fsigmoid(bf2f(zrow[ZC_NG + hd * 3 + 0])); g1 = fsigmoid(bf2f(zrow[ZC_NG + hd * 3 + 1])); g2 = fsigmoid(bf2f(zrow[ZC_NG + hd * 3 + 2]));
          LAS float* row = imp + (r * 64 + tl) * 65 + 32 * h;
#pragma unroll
          for (int j = 0; j < 32; ++j) row[j] = 0.f;
          if (tid < 128) maskw[tid] = 0u;
          if (tid < 2) unionw[tid] = 0u; }
        AttState st;
        { ATT_IDS
        const int jlo = qb - 8 > 0 ? qb - 8 : 0, nw = qb - jlo + 1;
        const int nk = (4 * qb + 3) < 255 ? (4 * qb + 3) : 255, nc = (nk + 63) >> 6, nA = nw + nc;
        const int nmax_t = (t >= 31) ? ((t - 31) >> 4) : -1;
        const char* kwb = (const char*)(z + (size_t)(b * SEQ) * ZP + ZC_KW + g * 64);
        const char* kcb = (const char*)(ws + WS_KCMP) + (size_t)((b * 2 + g) * 256) * 128; const char* vcb = (const char*)(ws + WS_VCMP) + (size_t)((b * 2 + g) * 256) * 128;
        const float sF = 16.f * slope2;
        float il_c = 0.f;
        LAS float* irow = imp + (r * 64 + tl) * 65;
#define ATT_STAGE_A(idx_) do { int ix_ = (idx_) < nA ? (idx_) : nA - 1; const int sl_ = (idx_) & 3; \
            if (ix_ < nw) { const char* kp_ = kwb + (size_t)(64 * (qb - ix_)) * ZPB; att_stage(lds, sl_, kp_, kp_ + (ZC_VW - ZC_KW) * 2, ZPB, wave, lane); } \
            else { ix_ -= nw; const size_t o_ = (size_t)(nc - 1 - ix_) * 64 * 128; att_stage(lds, sl_, kcb + o_, vcb + o_, 128, wave, lane); } } while (0)
        att_state_reset(st);
        ATT_STAGE_A(0); ATT_STAGE_A(1); ATT_STAGE_A(2);
        f32x16 Sa, Sb;
#pragma unroll 1
        for (int i = 0; i < nA; ++i) {
            ATT_WAIT_BAR_PD();
            ATT_STAGE_A(i + ATT_PD);
            const LAS unsigned char* Kb = lds + (i & 3) * 16384; const LAS unsigned char* Vb = Kb + 8192;
            if (i < nw) {
                const int j = qb - i;
                att_qk64(Kb, qf, slope2, slope2 * (float)(64 * j) - st.m, rq, h, Sa, Sb);
                att_softmax_pv64<false>((j == qb) || (j == qb - 8), Vb, (j == qb - 8) ? tl : -1, (j == qb) ? tl : 63, Sa, Sb, st, h, lane);
                if (i == nw - 1) { const float lt = xhalf_sum(st.l); const float go = g2 / fmaxf(lt, 1e-30f);
#pragma unroll
                    for (int k = 0; k < 8; ++k) { OUTP[k] = cvtpk(st.O[0][2 * k] * go, st.O[0][2 * k + 1] * go); OUTP[8 + k] = cvtpk(st.O[1][2 * k] * go, st.O[1][2 * k + 1] * go); }
                    att_state_reset(st); }
            } else {
                const int ct = nc - 1 - (i - nw);
                att_qk64(Kb, qf, sF, sF * (float)(64 * ct) - st.m, rq, h, Sa, Sb);
                att_softmax_pv64<true>(true, Vb, -1, nmax_t - 64 * ct, Sa, Sb, st, h, lane, irow, ct);
                if (i == nA - 1) { const float lt = xhalf_sum(st.l); il_c = 1.f / fmaxf(lt, 1e-30f); const float go = g0 * il_c;
                    if (h == 0) ((LAS float*)(lds + ATT_SC))[r * 64 + tl] = il_c;
#pragma unroll
                    for (int k = 0; k < 8; ++k) { OUTP[k] = cvtpk(bflo(OUTP[k]) + st.O[0][2 * k] * go, bfhi(OUTP[k]) + st.O[0][2 * k + 1] * go); OUTP[8 + k] = cvtpk(bflo(OUTP[8 + k]) + st.O[1][2 * k] * go, bfhi(OUTP[8 + k]) + st.O[1][2 * k + 1] * go); } }
            }
        }
#undef ATT_STAGE_A
        }
        ATT_WAIT_BAR();
        { ATT_IDS const char* ksb0 = (const char*)(z + (size_t)(b * SEQ) * ZP + ZC_KS + g * 64);
          const char* kp0 = ksb0 + (size_t)(64 * qb) * ZPB; att_stage(lds, 0, kp0, kp0 + (ZC_VS - ZC_KS) * 2, ZPB, wave, lane);
          const char* kp1 = ksb0 + (size_t)(64 * (qb > 0 ? qb - 1 : 0)) * ZPB; att_stage(lds, 1, kp1, kp1 + (ZC_VS - ZC_KS) * 2, ZPB, wave, lane); }
        { const int tid = opq_v(tid0); const int stok = tid >> 3, e8 = tid & 7; const LAS float* ilc = (const LAS float*)(lds + ATT_SC);
          unsigned key[8];
#pragma unroll
          for (int k = 0; k < 8; ++k) { const int j = 8 * e8 + k; const float v = imp[(0 * 64 + stok) * 65 + j] * ilc[stok] + imp[(1 * 64 + stok) * 65 + j] * ilc[64 + stok] + imp[(2 * 64 + stok) * 65 + j] * ilc[128 + stok] + imp[(3 * 64 + stok) * 65 + j] * ilc[192 + stok];
              const bool valid = j <= qb, forced = valid && (j == 0 || j == qb || j == qb - 1);
              const unsigned bits_ = __builtin_bit_cast(unsigned, forced ? 1e30f : (valid ? v : -1e30f));
              key[k] = ((bits_ ^ ((bits_ >> 31) ? 0xFFFFFFFFu : 0x80000000u)) & ~63u) | (unsigned)(63 - j); }
          unsigned T = 0u;
#pragma unroll 1
          for (int bit = 31; bit >= 0; --bit) { const unsigned cand = T | (1u << bit); int c = 0;
#pragma unroll
              for (int k = 0; k < 8; ++k) c += key[k] >= cand ? 1 : 0;
              c += __builtin_amdgcn_update_dpp(0, c, 0xB1, 0xf, 0xf, true);
              c += __builtin_amdgcn_update_dpp(0, c, 0x4E, 0xf, 0xf, true);
              c += __builtin_amdgcn_update_dpp(0, c, 0x141, 0xf, 0xf, true);
              T = c >= NTOP ? cand : T; }
          unsigned bits = 0u;
#pragma unroll
          for (int k = 0; k < 8; ++k) bits |= (key[k] >= T && 8 * e8 + k <= qb) ? (1u << k) : 0u;
          if (bits) { __hip_atomic_fetch_or(maskw + stok * 2 + (e8 >> 2), bits << (8 * (e8 & 3)), __ATOMIC_RELAXED, __HIP_MEMORY_SCOPE_WORKGROUP); __hip_atomic_fetch_or(unionw + (e8 >> 2), bits << (8 * (e8 & 3)), __ATOMIC_RELAXED, __HIP_MEMORY_SCOPE_WORKGROUP); }
        }
        __syncthreads();
        { ATT_IDS
        const unsigned mlo = maskw[tl * 2], mhi = maskw[tl * 2 + 1];
        unsigned long long un = ((unsigned long long)unionw[1] << 32) | unionw[0];
        const char* ksb = (const char*)(z + (size_t)(b * SEQ) * ZP + ZC_KS + g * 64);
        att_state_reset(st);
        int jq[4];
#pragma unroll
        for (int p = 0; p < 4; ++p) { if (un) { jq[p] = 63 - __builtin_clzll(un); un &= ~(1ull << jq[p]); } else jq[p] = -1; }
        int jlast = jq[0];
#pragma unroll
        for (int p = 0; p < 3; ++p) { if (jq[p] >= 0) jlast = jq[p]; if (p == 2) { const char* kp_ = ksb + (size_t)(64 * jlast) * ZPB; att_stage(lds, p, kp_, kp_ + (ZC_VS - ZC_KS) * 2, ZPB, wave, lane); } }
        f32x16 Sa, Sb;
#pragma unroll 1
        for (int i = 0; jq[0] >= 0; ++i) {
            ATT_WAIT_BAR_PD();
            { if (jq[3] >= 0) jlast = jq[3]; const char* kp_ = ksb + (size_t)(64 * jlast) * ZPB; att_stage(lds, (i + 3) & 3, kp_, kp_ + (ZC_VS - ZC_KS) * 2, ZPB, wave, lane); }
            const LAS unsigned char* Kb = lds + (i & 3) * 16384; const LAS unsigned char* Vb = Kb + 8192;
            const int j = jq[0];
            const bool bit = ((j < 32 ? (mlo >> j) : (mhi >> (j - 32))) & 1u) != 0u;
            att_qk64(Kb, qf, slope2, bit ? slope2 * (float)(64 * j) - st.m : -__builtin_inff(), rq, h, Sa, Sb);
            att_softmax_pv64<false>(j == qb, Vb, -1, tl, Sa, Sb, st, h, lane);
            jq[0] = jq[1]; jq[1] = jq[2]; jq[2] = jq[3];
            if (un) { jq[3] = 63 - __builtin_clzll(un); un &= ~(1ull << jq[3]); } else jq[3] = -1;
        }
        { const float lt = xhalf_sum(st.l); const float go = g1 / fmaxf(lt, 1e-30f);
          float ss = 0.f;
#pragma unroll
          for (int i = 0; i < 8; ++i) { const float a0 = bflo(OUTP[i]) + st.O[0][2 * i] * go, a1 = bfhi(OUTP[i]) + st.O[0][2 * i + 1] * go, c0 = bflo(OUTP[8 + i]) + st.O[1][2 * i] * go, c1 = bfhi(OUTP[8 + i]) + st.O[1][2 * i + 1] * go;
              ss += (a0 * a0 + a1 * a1) + (c0 * c0 + c1 * c1); OUTP[i] = cvtpk(a0, a1); OUTP[8 + i] = cvtpk(c0, c1); }
          ss = xhalf_sum(ss);
          if (h == 0) red[hd * 64 + tl] = ss;
          if (g == 0) { bf16* orow = mixed + (size_t)tok * DM + 512 + hd * 64;
#pragma unroll
              for (int dt = 0; dt < 2; ++dt)
#pragma unroll
                  for (int q4 = 0; q4 < 4; ++q4) { u32x2 w; w.x = OUTP[8 * dt + 2 * q4]; w.y = OUTP[8 * dt + 2 * q4 + 1]; *(u32x2*)(orow + 32 * dt + 8 * q4 + 4 * h) = w; } } }
        }
        ATT_WAIT_BAR();
    }
    ATT_IDS
    float tot = 0.f;
#pragma unroll
    for (int h2 = 0; h2 < 8; ++h2) tot += red[h2 * 64 + tl];
    const float rstd = rsqrtf(tot * (1.f / 512.f) + EPS);
    { bf16* orow = mixed + (size_t)tok * DM + 512 + (4 + r) * 64;
#pragma unroll
      for (int dt = 0; dt < 2; ++dt)
#pragma unroll
          for (int q4 = 0; q4 < 4; ++q4) { u32x2 w; const unsigned p0 = OUTP[8 * dt + 2 * q4], p1 = OUTP[8 * dt + 2 * q4 + 1];
              w.x = cvtpk(bflo(p0) * rstd, bfhi(p0) * rstd); w.y = cvtpk(bflo(p1) * rstd, bfhi(p1) * rstd);
              *(u32x2*)(orow + 32 * dt + 8 * q4 + 4 * h) = w; } }
    { bf16* orow = mixed + (size_t)tok * DM + 512 + r * 64;
#pragma unroll
      for (int dt = 0; dt < 2; ++dt)
#pragma unroll
          for (int q4 = 0; q4 < 4; ++q4) { u32x2 w = *(const u32x2*)(orow + 32 * dt + 8 * q4 + 4 * h);
              w.x = cvtpk(bflo(w.x) * rstd, bfhi(w.x) * rstd); w.y = cvtpk(bflo(w.y) * rstd, bfhi(w.y) * rstd);
              *(u32x2*)(orow + 32 * dt + 8 * q4 + 4 * h) = w; } }
    __syncthreads();
}

constexpr int NPH_LAYER = 11, PH_FINAL = 1 + DEPTH * NPH_LAYER, N_PHASES = PH_FINAL + 1;
__global__ void __launch_bounds__(NWAVES * 64, 2) fwd_kernel(Args args) {
    extern __shared__ __attribute__((aligned(16))) unsigned char lds_raw[];
    LAS unsigned char* lds = (LAS unsigned char*)lds_raw;
    volatile LAS unsigned* MISC = (volatile LAS unsigned*)(lds + MISC_OFF);
    const int G0 = gridDim.x, bid0 = blockIdx.x;
    const int wave_s = __builtin_amdgcn_readfirstlane(threadIdx.x >> 6);
#define PHASE_IDS KArgs ka = ka_get(); int G = G0, bid = bid0; asm volatile("" : "+s"(G), "+s"(bid)); unsigned char* ws = ka->ws; (void)ws; int tid = wave_s * 64 + lane_id(); asm volatile("" : "+v"(tid)); const int lane = tid & 63, wave = wave_s; const int gw = bid * NWAVES + wave, NGW = G * NWAVES; (void)lane; (void)gw; (void)NGW;
    if (wave_s == 0) MISC[lane_id()] = 0u;
    __syncthreads();
#if MK_MULTI
#define GRID_BAR() do { } while (0)
#else
    XcdBarrier bar = xcd_barrier_post((unsigned*)(args.ws + WS_CTL) + CW_BAR, MISC + 8, wave_s);
#define GRID_BAR() xcd_barrier(bar)
#endif
#ifndef PH_MASK
#define PH_MASK 0xFFFF
#endif
#define IN(k) (ka_get()->ph_lo <= (k) && (k) < ka_get()->ph_hi)
#define EN(j) ((PH_MASK >> (j)) & 1)
#define SEAM(k) do { if (IN(k) && IN((k) + 1)) GRID_BAR(); } while (0)
#define HC_ ((bf16*)(ws + ((L & 1) ? WS_U : WS_H16)))
#define HN_ ((bf16*)(ws + ((L & 1) ? WS_H16 : WS_U)))
#define Z_ ((bf16*)(ws + WS_Z))
#define MIXED_ ((bf16*)(ws + WS_MIXED))
#define WL_ (ws + WS_W + (size_t)L * W_LAYER)

    if (EN(11) && IN(0)) { PHASE_IDS REP_(11) { phase_prologue(ka, lds, G, bid, tid, wave, lane); __syncthreads(); } SEAM(0); }

    for (int L = 0; L < DEPTH; ++L) {
        const int P = 1 + L * NPH_LAYER;
        if (EN(0) && IN(P + 0)) { PHASE_IDS REP_(0) phase_norm1(ka, L == 0 ? ka->in[I_X] : nullptr, HC_, (float*)(ws + WS_RS1), L, lds, G, bid, tid, wave, lane); SEAM(P + 0); }
        if (EN(1) && IN(P + 1)) {
            PHASE_IDS
            pg8::DenseSched S; S.init(HC_, DM, (const bf16*)(WL_ + WO_IN), NTOK, ZN_IN, DM, G, bid);
            pg8::EpiBf16<0> E{Z_, ZP, nullptr, 0, 0, (const float*)(ws + WS_RS1)};
            REP_(1) pg8::gemm_phase(lds, DM, S, E, wave_s);
            SEAM(P + 1);
        }
        if (EN(2) && IN(P + 2)) {
            { PHASE_IDS
            if (EN(12)) REP_(2) for (int unit = bid; unit < BATCH * 16; unit += G) rec1_unit(ka, L, unit, lds, wave, lane);
            { const int ncv = G > 64 ? G - 64 : G, mycv = G > 64 ? bid - 64 : bid;
              if (mycv >= 0) tr_run<1>(ka, (LAS float*)(lds + wave * 16384), lane, mycv * NWAVES + wave, ncv * NWAVES, L); }
            }
            __syncthreads();
            if (EN(13)) { PHASE_IDS
            pg8::CmpSched S{Z_, (const bf16*)(WL_ + WO_K1), (const bf16*)(WL_ + WO_V1), G, bid};
            pg8::EpiBf16<1> E{(bf16*)(ws + WS_HIDC), 256, (const float*)(ws + WS_BK1) + L * 512, (size_t)8192 * 256, 256, nullptr};
            REP_(2) pg8::gemm_phase(lds, 2048, S, E, wave_s); }
            SEAM(P + 2);
        }
        if (EN(3) && IN(P + 3)) { PHASE_IDS REP_(3) phase_mid(ka, L, G, bid, tid, wave, lane); SEAM(P + 3); }
        if (EN(4) && IN(P + 4)) {
            PHASE_IDS
            REP_(4)
            if (G == 256) { for (int i = 0; i < 4; ++i) att_unit_mfma(ka, 2 * (bid & 7) + (i >> 1), (i & 1) ? 63 - (bid >> 3) : (bid >> 3), lds, wave, lane, tid); }
            else { for (int unit = bid; unit < BATCH * 64; unit += G) att_unit_mfma(ka, unit >> 6, unit & 63, lds, wave, lane, tid); }
            REP_(12) rec2_rows(ka, gw, NGW, lane);
            SEAM(P + 4);
        }
        if (EN(5) && IN(P + 5)) {
            PHASE_IDS
            pg8::DenseSched S; S.init(MIXED_, DM, (const bf16*)(WL_ + WO_OUT), NTOK, DM, DM, G, bid);
            pg8::EpiResid E{HC_};
            pg8::gemm_phase(lds, DM, S, E, wave_s);
            SEAM(P + 5);
        }
        if (EN(6) && IN(P + 6)) { PHASE_IDS phase_norm2(ka, HC_, L, lds, G, bid, tid, wave, lane); SEAM(P + 6); }
        if ((EN(7) || EN(8)) && (IN(P + 7) || IN(P + 8))) {
            LAS int* tab = (LAS int*)(lds + TAB_OFF);
            { PHASE_IDS
            __syncthreads();
            if (tid < 64) { const int c = (int)__hip_atomic_load((gu32*)(ws + WS_CTL) + CW_CNT + L * 64 + tid, RLX_AGENT); tab[80 + tid] = c; tab[160 + tid] = (c + 255) >> 8; }
            __syncthreads();
            if (tid == 0) { int s = 0; for (int i = 0; i < 64; ++i) { tab[i] = s; s += tab[160 + i]; } tab[64] = s; }
            __syncthreads(); }
            if (EN(7) && IN(P + 7)) { PHASE_IDS
                pg8::MoeSched<1> S{tab, HC_, (const bf16*)(WL_ + WO_GU), (const int*)(ws + WS_LTOK), G, bid};
                pg8::EpiSwiglu E{(bf16*)(ws + WS_HID), tab, (const float*)(ws + WS_LRS)};
                REP_(7) pg8::gemm_phase(lds, DM, S, E, wave_s);
                SEAM(P + 7);
            }
            if (EN(8) && IN(P + 8)) { PHASE_IDS
                pg8::MoeSched<2> S{tab, (const bf16*)(ws + WS_HID), (const bf16*)(WL_ + WO_D), (const int*)(ws + WS_LTOK), G, bid};
                pg8::EpiMoeDown E{tab, (const int*)(ws + WS_LTOK), (const float*)(ws + WS_LGATE), (bf16*)(ws + WS_Y0), (bf16*)(ws + WS_Y1)};
                REP_(8) pg8::gemm_phase(lds, DEXP, S, E, wave_s);
                SEAM(P + 8);
            }
        }
        if (EN(9) && IN(P + 9)) { PHASE_IDS phase_norm3(HC_, (const bf16*)(ws + WS_Y0), (const bf16*)(ws + WS_Y1), (float*)(ws + WS_RS3), ka->in[I_P] + (size_t)L * NTOK * D_PLE, (bf16*)(ws + WS_PB), gw, NGW, lane); SEAM(P + 9); }
        if (EN(10) && IN(P + 10)) {
            if (EN(14)) { PHASE_IDS pg8::DenseSched S; S.init(HC_, DM, (const bf16*)(WL_ + WO_PG), NTOK, DM, DM, G, bid);
              pg8::EpiBf16<2> E{(bf16*)(ws + WS_G), DM, ka->in[I_BPG] + L * DM, 0, 0, (const float*)(ws + WS_RS3)};
              REP_(10) pg8::gemm_phase(lds, DM, S, E, wave_s); }
            __syncthreads();
            if (EN(15)) { PHASE_IDS pg8::DenseSched S; S.init((const bf16*)(ws + WS_PB), D_PLE, (const bf16*)(WL_ + WO_PU), NTOK, DM, D_PLE, G, bid);
              pg8::EpiPleB E{HC_, HN_, (const bf16*)(ws + WS_G)};
              pg8::gemm_phase(lds, D_PLE, S, E, wave_s); }
            SEAM(P + 10);
        }
    }
    if (IN(PH_FINAL)) { PHASE_IDS phase_final((const bf16*)(ws + ((DEPTH & 1) ? WS_U : WS_H16)), ka->out, ka->in[I_FINN], gw, NGW, lane); }
#undef IN
#undef SEAM
}

extern "C" void kernel_launch(void* const* d_in, const int* in_sizes, int n_in, void* d_out, int out_size, void* d_ws, size_t ws_size, hipStream_t stream) {
    static int grid = 0;
    if (grid == 0) {
        if (n_in != 37 || in_sizes[0] != NTOK * DM || out_size != NTOK * DM || ws_size < WS_END) {
            fprintf(stderr, "kernel_launch: unexpected shapes (n_in %d, in0 %d, out %d, ws %zu < %zu); nothing launched\n", n_in, n_in > 0 ? in_sizes[0] : -1, out_size, ws_size, (size_t)WS_END); grid = -1; return; }
        int dev = 0, cus = 0, per_cu = 0;
        if (hipGetDevice(&dev) != hipSuccess || hipDeviceGetAttribute(&cus, hipDeviceAttributeMultiprocessorCount, dev) != hipSuccess) { grid = -1; return; }
        if (hipFuncSetAttribute((const void*)fwd_kernel, hipFuncAttributeMaxDynamicSharedMemorySize, LDS_BYTES) != hipSuccess) { fprintf(stderr, "kernel_launch: hipFuncSetAttribute failed\n"); grid = -1; return; }
        if (hipOccupancyMaxActiveBlocksPerMultiprocessor(&per_cu, (const void*)fwd_kernel, NWAVES * 64, LDS_BYTES) != hipSuccess || per_cu < 1)
            fprintf(stderr, "kernel_launch: note: occupancy query reports %d workgroups per CU\n", per_cu);
        (void)hipGetLastError();
        grid = cus;
    }
    if (grid < 0) return;
    if (hipMemsetAsync((char*)d_ws + WS_CTL, 0, CTL_ZERO_BYTES, stream) != hipSuccess) return;
    Args a{};
    for (int i = 0; i < 37; ++i) a.in[i] = (const float*)d_in[i];
    a.out = (float*)d_out; a.ws = (unsigned char*)d_ws;
#if MK_MULTI
    for (int p = 0; p < N_PHASES; ++p) { a.ph_lo = p; a.ph_hi = p + 1; hipLaunchKernelGGL(fwd_kernel, dim3(grid), dim3(NWAVES * 64), LDS_BYTES, stream, a); }
#else
    a.ph_lo = 0; a.ph_hi = N_PHASES;
    hipLaunchKernelGGL(fwd_kernel, dim3(grid), dim3(NWAVES * 64), LDS_BYTES, stream, a);
#endif
    const hipError_t le = hipPeekAtLastError();
    if (le != hipSuccess) fprintf(stderr, "kernel_launch: launch failed: %s\n", hipGetErrorName(le));
}
```

```cpp
#include <hip/hip_runtime.h>
#include <cstdio>
#include <cstdint>

#ifndef PROBE_MASK
#define PROBE_MASK 0
#endif
#define REP_(j) for (int rep_ = 0; rep_ < 1 + ((PROBE_MASK >> (j)) & 1); ++rep_)
#ifndef MK_MULTI
#define MK_MULTI 0
#endif

#define GAS __attribute__((address_space(1)))
#define LAS __attribute__((address_space(3)))
typedef unsigned short bf16;
typedef float f32x4 __attribute__((ext_vector_type(4)));
typedef float f32x2 __attribute__((ext_vector_type(2)));
typedef unsigned u32x4 __attribute__((ext_vector_type(4)));
typedef unsigned u32x2 __attribute__((ext_vector_type(2)));
typedef short bf16x8 __attribute__((ext_vector_type(8)));
typedef GAS unsigned gu32;
#define RLX_AGENT __ATOMIC_RELAXED, __HIP_MEMORY_SCOPE_AGENT
#define LDS_WAIT() asm volatile("s_waitcnt lgkmcnt(0)" ::: "memory")
#define VM_WAIT() asm volatile("s_waitcnt vmcnt(0)" ::: "memory")

constexpr int BATCH = 16, SEQ = 4096, DM = 1024, DEPTH = 4, NTOK = BATCH * SEQ;
constexpr int D_PLE = 256, D_REC = 512, NH = 8, HD = 64, NKV = 2;
constexpr int D_IN = 2328, ZP = 2560;
constexpr int ZC_XR = 0, ZC_GR = 512, ZC_Q = 1024, ZC_KC = 1536, ZC_VC = 1664, ZC_KS = 1792, ZC_VS = 1920, ZC_KW = 2048, ZC_VW = 2176, ZC_NG = 2304;
constexpr int NCMP = 255, NSELB = 64, NTOP = 16, WIN = 512;
constexpr int NEXP = 32, DEXP = 512, NSEG = 64;
constexpr float EPS = 1e-6f;
constexpr float LOG2E = 1.4426950408889634f;
constexpr int NWAVES = 8;

constexpr size_t MiB = 1u << 20;
constexpr size_t WS_CTL = 0, CTL_ZERO_BYTES = 1 * MiB;
constexpr size_t WS_BK1 = 1 * MiB;
constexpr size_t WS_C8 = WS_BK1 + 8192;
constexpr size_t WS_WRT = WS_C8 + 8192;
constexpr size_t WS_AGG = 2 * MiB;
constexpr size_t WS_CARRY = 3 * MiB;
constexpr size_t WS_W2T = 4 * MiB;
constexpr size_t WS_KCMP = 5 * MiB, WS_VCMP = 7 * MiB;
constexpr size_t WS_RS1 = 6 * MiB, WS_RS3 = 6 * MiB + 512 * 1024;
constexpr size_t WS_HIDC = 9 * MiB;
constexpr size_t WS_LTOK = 17 * MiB, WS_LGATE = 33 * MiB;
constexpr size_t WS_PB = 49 * MiB;
constexpr size_t WS_W = 81 * MiB, W_LAYER = 108 * MiB;
constexpr size_t WO_IN = 0, WO_OUT = 5 * MiB, WO_PG = 7 * MiB, WO_PU = 9 * MiB, WO_K1 = 9 * MiB + 512 * 1024, WO_V1 = 10 * MiB + 512 * 1024, WO_GU = 12 * MiB, WO_D = 76 * MiB;
constexpr size_t WS_U = 513 * MiB;
constexpr size_t WS_Z = 641 * MiB;
constexpr size_t WS_HID = WS_Z;
constexpr size_t WS_G = WS_Z + 160 * MiB;
constexpr size_t WS_MIXED = 962 * MiB;
constexpr size_t WS_HLOC = 1090 * MiB, WS_CUMA = 1154 * MiB;
constexpr size_t WS_Y0 = WS_MIXED, WS_Y1 = WS_HLOC;
constexpr size_t WS_LRS = 1218 * MiB;
constexpr size_t WS_H16 = 1234 * MiB;
constexpr size_t WS_END = 1362 * MiB;
constexpr int CW_BAR = 4096;
constexpr int CW_CNT = 16384;
constexpr int CW_BK1 = 32768;
constexpr int LDS_BYTES = 163840;
constexpr int TAB_OFF = 147456;
constexpr int MISC_OFF = 147456 + 4096;

typedef float pk2_f32x2 __attribute__((ext_vector_type(2)));
typedef __bf16 pk2_bf16x2 __attribute__((ext_vector_type(2)));
__device__ __forceinline__ unsigned pk2(float lo, float hi) { const pk2_f32x2 v = {lo, hi}; return __builtin_bit_cast(unsigned, __builtin_convertvector(v, pk2_bf16x2)); }
__device__ __forceinline__ unsigned f2bf(float f) { return pk2(f, 0.f) & 0xffffu; }
__device__ __forceinline__ float bflo(unsigned u) { return __builtin_bit_cast(float, u << 16); }
__device__ __forceinline__ float bfhi(unsigned u) { return __builtin_bit_cast(float, u & 0xffff0000u); }
__device__ __forceinline__ float bf2f(bf16 b) { return __builtin_bit_cast(float, (unsigned)b << 16); }
__device__ __forceinline__ float fsigmoid(float x) { return __builtin_amdgcn_rcpf(1.f + __builtin_amdgcn_exp2f(-x * LOG2E)); }
__device__ __forceinline__ float fgelu(float x) { const float y = 1.5957691216057308f * (x + 0.044715f * x * x * x); return x * __builtin_amdgcn_rcpf(1.f + __builtin_amdgcn_exp2f(-y * LOG2E)); }
__device__ __forceinline__ int lane_id() { int x; asm volatile("v_mbcnt_lo_u32_b32 %0, -1, 0\n\tv_mbcnt_hi_u32_b32 %0, -1, %0" : "=v"(x)); return x; }
template <int CTRL> __device__ __forceinline__ float dpp_mov(float src) {
    return __builtin_bit_cast(float, __builtin_amdgcn_update_dpp(0, __builtin_bit_cast(int, src), CTRL, 0xf, 0xf, true));
}
__device__ __forceinline__ float wave_sum(float v) {
    v += dpp_mov<0xB1>(v);
    v += dpp_mov<0x4E>(v);
    v += dpp_mov<0x141>(v);
    v += dpp_mov<0x140>(v);
    const float r0 = __builtin_bit_cast(float, __builtin_amdgcn_readlane(__builtin_bit_cast(int, v), 0)), r1 = __builtin_bit_cast(float, __builtin_amdgcn_readlane(__builtin_bit_cast(int, v), 16));
    const float r2 = __builtin_bit_cast(float, __builtin_amdgcn_readlane(__builtin_bit_cast(int, v), 32)), r3 = __builtin_bit_cast(float, __builtin_amdgcn_readlane(__builtin_bit_cast(int, v), 48));
    return (r0 + r1) + (r2 + r3);
}

namespace pg8 {
#define PG8_LAS __attribute__((address_space(3)))
typedef unsigned short bf16_t;
constexpr int BM = 256, BK = 64, HALF = 128, HTB = HALF * BK * 2, STAGE_BYTES = 8 * HTB, NXCD = 8, WGM = 8;
__host__ __device__ __forceinline__ int lds_byte(int r, int c) { const int st = (r >> 4) * 2 + (c >> 5), rr = r & 15, cc = c & 31, ob = rr * 64 + cc * 2; return st * 1024 + (ob ^ (((ob >> 9) & 1) << 5)); }
__host__ __device__ __forceinline__ void stage_rc(int b, int& R, int& C) { const int st = b / 1024, sb = b % 1024, swz = sb ^ (((sb >> 9) & 1) << 5); R = (st >> 1) * 16 + swz / 64; C = (st & 1) * 32 + (swz % 64) / 2; }
__host__ __device__ __forceinline__ int perm32(int rho) { const int n = rho >> 4, i = rho & 15; return 8 * (i >> 2) + 4 * n + (i & 3); }
struct Unit { int pm, pn, a0, a1; };
__device__ __forceinline__ unsigned cvt_pk_bf16(float lo, float hi) { unsigned r; asm volatile("v_cvt_pk_bf16_f32 %0, %1, %2" : "=v"(r) : "v"(lo), "v"(hi)); return r; }

template <class Epi, class Sched>
__device__ __forceinline__ void gemm_phase(PG8_LAS unsigned char* lds, const int K, const Sched& S, const Epi& E, const int wave_s) {
    int tid_o = wave_s * 64 + lane_id(); asm volatile("" : "+v"(tid_o));
    const int tid = tid_o, wid = __builtin_amdgcn_readfirstlane(tid >> 6), lane = tid & 63, wr = wid >> 2, wc = wid & 3, fr = lane & 15, fq = lane >> 4;
    const int nt = K / BK;
    int Rr[2], Cc[2]; unsigned voffB[2];
#pragma unroll
    for (int i = 0; i < 2; ++i) { int R, C; stage_rc(tid * 16 + i * 8192, R, C); Rr[i] = R; Cc[i] = C; const int Rb = (R & ~31) + perm32(R & 31); voffB[i] = (unsigned)(Rb * K + C) * 2u; }
    const size_t kstepB = (size_t)(BK * 2), kstepA = S.kstepA();
    const size_t hstepB = (size_t)HALF * K * 2;
    const unsigned ldsw = (unsigned)wid * 1024u;
    const int aoff = lds_byte(wr * 64 + fr, fq * 8), boff = lds_byte(wc * 32 + fr, fq * 8);
#define PG8_SA(b, h) (((b) * 2 + (h)) * HTB)
#define PG8_SB(b, h) ((4 + (b) * 2 + (h)) * HTB)
#define PG8_STAGE(bufoff, gbase, voff) do { _Pragma("unroll") for (int _i = 0; _i < 2; ++_i) \
        __builtin_amdgcn_global_load_lds((const unsigned*)((const char*)(gbase) + (voff)[_i]), (PG8_LAS unsigned*)(lds + (bufoff) + ldsw + _i * 8192), 16, 0, 0); } while (0)
#define PG8_LDA(dst, b, h) do { _Pragma("unroll") for (int m = 0; m < 4; ++m) _Pragma("unroll") for (int k = 0; k < 2; ++k) dst[m][k] = *(const PG8_LAS bf16x8*)(lds + PG8_SA(b, h) + aoff + m * 2048 + k * 1024); } while (0)
#define PG8_LDB(dst, b, h) do { _Pragma("unroll") for (int n = 0; n < 2; ++n) _Pragma("unroll") for (int k = 0; k < 2; ++k) dst[n][k] = *(const PG8_LAS bf16x8*)(lds + PG8_SB(b, h) + boff + n * 2048 + k * 1024); } while (0)
#define PG8_MMA(ai, bj, At, Bt) do { __builtin_amdgcn_s_setprio(1); _Pragma("unroll") for (int m = 0; m < 4; ++m) _Pragma("unroll") for (int n = 0; n < 2; ++n) _Pragma("unroll") for (int k = 0; k < 2; ++k) \
        acc[ai][bj][m][n] = __builtin_amdgcn_mfma_f32_16x16x32_bf16(Bt[n][k], At[m][k], acc[ai][bj][m][n], 0, 0, 0); __builtin_amdgcn_s_setprio(0); } while (0)
#define PG8_WAIT_V(n) asm volatile("s_waitcnt vmcnt(" #n ")" ::: "memory")
#define PG8_WAIT_L(n) asm volatile("s_waitcnt lgkmcnt(" #n ")" ::: "memory")
#define PG8_BAR __builtin_amdgcn_s_barrier()
#define PG8_SCHED __builtin_amdgcn_sched_barrier(0)
    Unit cur, nxt; int ui = 0;
    if (!S.next(0, cur)) return;
    f32x4 acc[2][2][4][2];
#pragma unroll
    for (int a = 0; a < 2; ++a)
#pragma unroll
        for (int b = 0; b < 2; ++b)
#pragma unroll
            for (int m = 0; m < 4; ++m)
#pragma unroll
                for (int n = 0; n < 2; ++n) acc[a][b][m][n] = (f32x4){0.f, 0.f, 0.f, 0.f};
    bf16x8 At[4][2], B0[2][2], B1[2][2];
    unsigned vA[2][2], vN[2][2];
    S.a_voff(cur, Rr, Cc, vA);
    const char* cA = S.a_base(cur); const char* cB = S.b_base(cur);
    PG8_STAGE(PG8_SB(0, 0), cB, voffB); PG8_STAGE(PG8_SB(0, 1), cB + hstepB, voffB); PG8_STAGE(PG8_SA(0, 0), cA, vA[0]); PG8_STAGE(PG8_SA(0, 1), cA, vA[1]);
    if (wr == 1) PG8_BAR;
    PG8_WAIT_V(2); PG8_BAR;
    PG8_STAGE(PG8_SB(1, 0), cB + kstepB, voffB); PG8_STAGE(PG8_SA(1, 0), cA + kstepA, vA[0]); PG8_STAGE(PG8_SB(1, 1), cB + hstepB + kstepB, voffB);
    PG8_WAIT_V(6); PG8_BAR;
    for (;;) {
        const bool has_next = S.next(ui + 1, nxt);
        const char* nA = cA; const char* nB = cB;
#pragma unroll
        for (int h = 0; h < 2; ++h)
#pragma unroll
            for (int i = 0; i < 2; ++i) vN[h][i] = vA[h][i];
        if (has_next) { nA = S.a_base(nxt); nB = S.b_base(nxt); S.a_voff(nxt, Rr, Cc, vN); }
#pragma unroll 1
        for (int t = 0; t < nt; t += 2) {
            const bool last = (t == nt - 2);
            const char* a1 = cA + (size_t)(t + 1) * kstepA;
            const char* a2 = last ? nA : cA + (size_t)(t + 2) * kstepA; const char* b2 = last ? nB : cB + (size_t)(t + 2) * kstepB;
            const char* a3 = a2 + kstepA; const char* b3 = b2 + kstepB;
            unsigned v2[2][2];
#pragma unroll
            for (int h = 0; h < 2; ++h)
#pragma unroll
                for (int i = 0; i < 2; ++i) v2[h][i] = last ? vN[h][i] : vA[h][i];
            PG8_LDB(B0, 0, 0); PG8_LDB(B1, 0, 1); PG8_SCHED; PG8_LDA(At, 0, 0); PG8_STAGE(PG8_SA(1, 1), a1, vA[1]);
            PG8_WAIT_V(8); PG8_WAIT_L(0); PG8_BAR; PG8_MMA(0, 0, At, B0); PG8_MMA(0, 1, At, B1); PG8_BAR; PG8_SCHED;
            PG8_LDA(At, 0, 1); PG8_STAGE(PG8_SB(0, 0), b2, voffB); PG8_STAGE(PG8_SB(0, 1), b2 + hstepB, voffB); PG8_STAGE(PG8_SA(0, 0), a2, v2[0]);
            PG8_WAIT_V(8); PG8_WAIT_L(0); PG8_BAR; PG8_MMA(1, 0, At, B0); PG8_MMA(1, 1, At, B1); PG8_BAR; PG8_SCHED;
            PG8_LDB(B0, 1, 0); PG8_LDB(B1, 1, 1); PG8_SCHED; PG8_LDA(At, 1, 0); PG8_STAGE(PG8_SA(0, 1), a2, v2[1]);
            PG8_WAIT_V(8); PG8_WAIT_L(0); PG8_BAR; PG8_MMA(0, 0, At, B0); PG8_MMA(0, 1, At, B1); PG8_BAR; PG8_SCHED;
            PG8_LDA(At, 1, 1); PG8_STAGE(PG8_SB(1, 0), b3, voffB); PG8_STAGE(PG8_SB(1, 1), b3 + hstepB, voffB); PG8_STAGE(PG8_SA(1, 0), a3, v2[0]);
            PG8_WAIT_V(8); PG8_WAIT_L(0); PG8_BAR; PG8_MMA(1, 0, At, B0); PG8_MMA(1, 1, At, B1); PG8_BAR; PG8_SCHED;
        }
        if (wr == 0) PG8_BAR;
        E(acc, cur, wr, wc, fr, fq);
        if (!has_next) break;
#pragma unroll
        for (int a = 0; a < 2; ++a)
#pragma unroll
            for (int b = 0; b < 2; ++b)
#pragma unroll
                for (int m = 0; m < 4; ++m)
#pragma unroll
                    for (int n = 0; n < 2; ++n) acc[a][b][m][n] = (f32x4){0.f, 0.f, 0.f, 0.f};
        cur = nxt; cA = nA; cB = nB; ++ui;
#pragma unroll
        for (int h = 0; h < 2; ++h)
#pragma unroll
            for (int i = 0; i < 2; ++i) vA[h][i] = vN[h][i];
        if (wr == 1) PG8_BAR;
    }
    PG8_WAIT_V(0);
    PG8_BAR;
#undef PG8_SA
#undef PG8_SB
#undef PG8_STAGE
#undef PG8_LDA
#undef PG8_LDB
#undef PG8_MMA
#undef PG8_WAIT_V
#undef PG8_WAIT_L
#undef PG8_BAR
#undef PG8_SCHED
}

struct DenseSched {
    const bf16_t* A; const bf16_t* Bt; int lda, K; int nM, nN, nwg, G, c;
    __device__ __forceinline__ void init(const bf16_t* A_, int lda_, const bf16_t* Bt_, int M, int N, int K_, int G_, int c_) { A = A_; lda = lda_; Bt = Bt_; K = K_; nM = M / BM; nN = N / BM; nwg = nM * nN; G = G_; c = c_; }
    __device__ __forceinline__ size_t kstepA() const { return (size_t)(BK * 2); }
    __device__ __forceinline__ bool next(int i, Unit& u) const {
        const long L = (long)i * G + c; if (L >= nwg) return false;
        int wgid = (int)L; { const int q = nwg / NXCD, r = nwg % NXCD, xcd = wgid % NXCD, off = wgid / NXCD; wgid = (xcd < r ? xcd * (q + 1) : r * (q + 1) + (xcd - r) * q) + off; }
        const int nig = WGM * nN, gid = wgid / nig, fm = gid * WGM, gsz = (nM - fm) < WGM ? (nM - fm) : WGM;
        u.pm = fm + ((wgid % nig) % gsz); u.pn = (wgid % nig) / gsz; u.a0 = 0; u.a1 = 0; return true;
    }
    __device__ __forceinline__ const char* a_base(const Unit& u) const { return (const char*)A + (size_t)u.pm * BM * lda * 2; }
    __device__ __forceinline__ const char* b_base(const Unit& u) const { return (const char*)Bt + (size_t)u.pn * BM * K * 2; }
    __device__ __forceinline__ void a_voff(const Unit&, const int (&R)[2], const int (&C)[2], unsigned (&v)[2][2]) const {
#pragma unroll
        for (int h = 0; h < 2; ++h)
#pragma unroll
            for (int i = 0; i < 2; ++i) v[h][i] = (unsigned)((h * HALF + R[i]) * lda + C[i]) * 2u;
    }
};
}

#define XB_TMO      128
#define XB_XCNT(j)  (256  + 64 * (j))
#define XB_XSUB(j)  (1280 + 64 * (j))
#define XB_XGEN(j)  (2304 + 64 * (j))
#define XB_TOP      3328
#define XB_TOPGEN   3392
#define XCD_BAR_WORDS 3456
#define XB_SPIN_CAP (1u << 22)
__device__ __forceinline__ unsigned xb_ld(unsigned* p)              { return __hip_atomic_load(p, __ATOMIC_RELAXED, __HIP_MEMORY_SCOPE_AGENT); }
__device__ __forceinline__ unsigned xb_add(unsigned* p, unsigned v) { return __hip_atomic_fetch_add(p, v, __ATOMIC_RELAXED, __HIP_MEMORY_SCOPE_AGENT); }
__device__ __forceinline__ unsigned xb_xcc_id() { return (unsigned)__builtin_amdgcn_s_getreg((3 << 11) | 20) & 0xFu; }
#define XB_SPIN(cond, bar) do { unsigned _sp = 0; while (cond) { __builtin_amdgcn_s_sleep(1); \
    if ((++_sp & 255u) == 0u) { if (xb_ld(&(bar)[XB_TMO])) break; if (_sp > XB_SPIN_CAP) { atomicAdd(&(bar)[XB_TMO], 1u); break; } } } } while (0)
struct XcdBarrier { unsigned* bar; unsigned x; volatile LAS unsigned* st; int wave; };
__device__ __forceinline__ XcdBarrier xcd_barrier_post(unsigned* bar, volatile LAS unsigned* st, int wave) {
    XcdBarrier b; b.bar = bar; b.x = xb_xcc_id(); b.st = st; b.wave = wave;
    if (wave == 0 && lane_id() == 0) (void)xb_add(&bar[XB_XCNT(b.x)], 1u);
    return b;
}
__device__ __forceinline__ void xcd_barrier_complete(unsigned* bar, unsigned x, unsigned& nloc, unsigned& nx) {
    const unsigned G = gridDim.x * gridDim.y * gridDim.z;
    unsigned sum, cnt, mine, sp = 0u;
    for (;;) {
        sum = 0u; cnt = 0u; mine = 0u;
#pragma unroll
        for (unsigned j = 0; j < 16; ++j) { const unsigned c = xb_ld(&bar[XB_XCNT(j)]); sum += c; cnt += (c > 0u) ? 1u : 0u; }
        mine = xb_ld(&bar[XB_XCNT(x)]);
        if (sum == G) break;
        __builtin_amdgcn_s_sleep(1);
        if ((++sp & 255u) == 0u) { if (xb_ld(&bar[XB_TMO])) break; if (sp > XB_SPIN_CAP) { atomicAdd(&bar[XB_TMO], 1u); break; } }
    }
    nloc = mine > 0u ? mine : 1u; nx = cnt > 0u ? cnt : 1u;
}
__device__ __forceinline__ void xcd_barrier(const XcdBarrier& b) {
    asm volatile("s_waitcnt vmcnt(0)" ::: "memory");
    __syncthreads();
    if (b.wave == 0 && lane_id() == 0) {
        unsigned* bar = b.bar; asm volatile("" : "+s"(bar)); unsigned bx = b.x; asm volatile("" : "+s"(bx));
        __builtin_amdgcn_s_waitcnt(0);
        unsigned nloc = b.st[0], nx = b.st[1];
        if (nloc == 0u) { xcd_barrier_complete(bar, bx, nloc, nx); b.st[0] = nloc; b.st[1] = nx; }
        const unsigned old = xb_add(&bar[XB_XSUB(bx)], 1u);
        const unsigned gen = old / nloc;
        if (old + 1u == (gen + 1u) * nloc) {
            __builtin_amdgcn_fence(__ATOMIC_RELEASE, "agent");
            asm volatile("s_waitcnt vmcnt(0)" ::: "memory");
            const unsigned og = xb_add(&bar[XB_TOP], 1u);
            const unsigned tg = og / nx;
            if (og + 1u == (tg + 1u) * nx) xb_add(&bar[XB_TOPGEN], 1u);
            else XB_SPIN(xb_ld(&bar[XB_TOPGEN]) == tg, bar);
            __builtin_amdgcn_fence(__ATOMIC_ACQUIRE, "agent");
            xb_add(&bar[XB_XGEN(bx)], 1u);
            asm volatile("s_waitcnt vmcnt(0)" ::: "memory");
        } else {
            XB_SPIN(xb_ld(&bar[XB_XGEN(bx)]) == gen, bar);
            __builtin_amdgcn_fence(__ATOMIC_ACQUIRE, "agent");
            asm volatile("s_waitcnt vmcnt(0)" ::: "memory");
        }
    }
    __syncthreads();
}

struct Args { const float* in[37]; float* out; unsigned char* ws; int ph_lo, ph_hi; };
typedef const __attribute__((address_space(4))) Args* KArgs;
__device__ __forceinline__ KArgs ka_get() { KArgs k = (KArgs)__builtin_amdgcn_kernarg_segment_ptr(); asm volatile("" : "+s"(k)); return k; }
enum { I_X = 0, I_P, I_MIXN, I_WIN, I_CONVW, I_CONVB, I_WA, I_BA, I_WX, I_BX, I_LAM, I_PEK, I_PEV, I_WK1, I_BK1, I_WK2, I_BK2, I_WV1, I_BV1, I_WV2, I_BV2,
       I_RECN, I_ATTN, I_WOUT, I_FFNN, I_WGR, I_BGR, I_WER, I_BER, I_WGATE, I_WUP, I_WDOWN, I_PLEN, I_WPG, I_BPG, I_WPU, I_FINN };

namespace pg8 {
struct CmpSched {
    const bf16_t* z; const bf16_t* W1k; const bf16_t* W1v; int G, c;
    __device__ __forceinline__ size_t kstepA() const { return (size_t)ZP * 2; }
    __device__ __forceinline__ bool next(int i, Unit& u) const { const int L = i * G + c; if (L >= 64) return false; u.pm = L >> 1; u.pn = 0; u.a0 = L & 1; u.a1 = 0; return true; }
    __device__ __forceinline__ const char* a_base(const Unit& u) const { const int b = u.pm >> 1, g = u.pm & 1; return (const char*)(z + (size_t)b * SEQ * ZP + (u.a0 ? ZC_VC : ZC_KC) + g * 64); }
    __device__ __forceinline__ const char* b_base(const Unit& u) const { return (const char*)(u.a0 ? W1v : W1k); }
    __device__ __forceinline__ void a_voff(const Unit&, const int (&R)[2], const int (&C)[2], unsigned (&v)[2][2]) const {
#pragma unroll
        for (int h = 0; h < 2; ++h)
#pragma unroll
            for (int i = 0; i < 2; ++i) v[h][i] = (unsigned)(16 * (h * HALF + R[i]) * ZP + C[i]) * 2u;
    }
};
template <int PHASE>
struct MoeSched {
    const PG8_LAS int* tab; const bf16_t* A; const bf16_t* W; const int* ltok; int G, c;
    __device__ __forceinline__ size_t kstepA() const { return (size_t)(BK * 2); }
    __device__ __forceinline__ bool next(int i, Unit& u) const {
        const int TT = tab[64]; int rt, pn;
        if (G == 256) { const int x = c & 7, y = c >> 3, Q = (TT + 7) >> 3, rl = i * 8 + (y >> 2); pn = y & 3; if (rl >= Q) return false; rt = x * Q + rl; }
        else { const int L = i * G + c; rt = L >> 2; pn = L & 3; }
        if (rt >= TT) return false;
        int lo = 0, hi = 64;
        while (hi - lo > 1) { const int mid = (lo + hi) >> 1; if (tab[mid] <= rt) lo = mid; else hi = mid; }
        u.pm = rt; u.pn = pn; u.a0 = lo; u.a1 = rt - tab[lo]; return true;
    }
    __device__ __forceinline__ const char* a_base(const Unit& u) const { return PHASE == 1 ? (const char*)A : (const char*)A + (size_t)u.pm * BM * DEXP * 2; }
    __device__ __forceinline__ const char* b_base(const Unit& u) const {
        const int e = u.a0 & 31;
        return PHASE == 1 ? (const char*)W + ((size_t)e * 1024 + (size_t)u.pn * BM) * 1024 * 2 : (const char*)W + ((size_t)e * 1024 + (size_t)u.pn * BM) * DEXP * 2;
    }
    __device__ __forceinline__ void a_voff(const Unit& u, const int (&R)[2], const int (&C)[2], unsigned (&v)[2][2]) const {
        if (PHASE == 1) {
            const int cnt = tab[80 + u.a0];
#pragma unroll
            for (int h = 0; h < 2; ++h)
#pragma unroll
                for (int i = 0; i < 2; ++i) { const int rank = u.a1 * BM + h * HALF + R[i]; const int tok = rank < cnt ? ltok[(size_t)u.a0 * NTOK + rank] : 0; v[h][i] = (unsigned)(tok * DM + C[i]) * 2u; }
        } else {
#pragma unroll
            for (int h = 0; h < 2; ++h)
#pragma unroll
                for (int i = 0; i < 2; ++i) v[h][i] = (unsigned)((h * HALF + R[i]) * DEXP + C[i]) * 2u;
        }
    }
};

template <int ACT  > struct EpiBf16 {
    bf16_t* O; int ldc; const float* bias; size_t a0_stride; int a0_bias_stride;
    const float* rs;
    __device__ __forceinline__ void operator()(const f32x4 (&acc)[2][2][4][2], const Unit& u, int wr, int wc, int fr, int fq) const {
        const int row0 = u.pm * BM + wr * 64 + fr, col0 = u.pn * BM + wc * 32 + 8 * fq;
        bf16_t* base = O + (size_t)u.a0 * a0_stride; const float* bs = bias ? bias + u.a0 * a0_bias_stride : nullptr;
        float rsv[2][4];
#pragma unroll
        for (int ai = 0; ai < 2; ++ai)
#pragma unroll
            for (int m = 0; m < 4; ++m) rsv[ai][m] = rs ? rs[row0 + ai * HALF + m * 16] : 1.f;
        f32x4 bv[2][2];
#pragma unroll
        for (int bj = 0; bj < 2; ++bj)
#pragma unroll
            for (int n = 0; n < 2; ++n) bv[bj][n] = bs ? *(const f32x4*)(bs + col0 + bj * HALF + 4 * n) : (f32x4){0.f, 0.f, 0.f, 0.f};
#pragma unroll
        for (int ai = 0; ai < 2; ++ai)
#pragma unroll
            for (int m = 0; m < 4; ++m) { bf16_t* rowp = base + (size_t)(row0 + ai * HALF + m * 16) * ldc + col0; const float sc = rsv[ai][m];
#pragma unroll
                for (int bj = 0; bj < 2; ++bj) { f32x4 v0 = acc[ai][bj][m][0], v1 = acc[ai][bj][m][1];
                    if (rs) { v0 *= sc; v1 *= sc; }
                    v0 += bv[bj][0]; v1 += bv[bj][1];
                    if (ACT == 1) { for (int e = 0; e < 4; ++e) { v0[e] = fgelu(v0[e]); v1[e] = fgelu(v1[e]); } }
                    if (ACT == 2) { for (int e = 0; e < 4; ++e) { v0[e] = fsigmoid(v0[e]); v1[e] = fsigmoid(v1[e]); } }
                    u32x4 w; w.x = cvt_pk_bf16(v0[0], v0[1]); w.y = cvt_pk_bf16(v0[2], v0[3]); w.z = cvt_pk_bf16(v1[0], v1[1]); w.w = cvt_pk_bf16(v1[2], v1[3]);
                    *(u32x4*)(rowp + bj * HALF) = w; } }
    }
};
struct EpiResid {
    bf16_t* h;
    __device__ __forceinline__ void operator()(const f32x4 (&acc)[2][2][4][2], const Unit& u, int wr, int wc, int fr, int fq) const {
        const int row0 = u.pm * BM + wr * 64 + fr, col0 = u.pn * BM + wc * 32 + 8 * fq;
#pragma unroll
        for (int ai = 0; ai < 2; ++ai) {
            bf16_t* rp0 = h + (size_t)(row0 + ai * HALF) * DM + col0;
            u32x4 hv[4][2];
#pragma unroll
            for (int m = 0; m < 4; ++m)
#pragma unroll
                for (int bj = 0; bj < 2; ++bj) hv[m][bj] = *(const u32x4*)(rp0 + (size_t)m * 16 * DM + bj * HALF);
#pragma unroll
            for (int m = 0; m < 4; ++m)
#pragma unroll
                for (int bj = 0; bj < 2; ++bj) { const u32x4 x = hv[m][bj]; const f32x4 a0 = acc[ai][bj][m][0], a1 = acc[ai][bj][m][1];
                    u32x4 w; w.x = cvt_pk_bf16(bflo(x.x) + a0[0], bfhi(x.x) + a0[1]); w.y = cvt_pk_bf16(bflo(x.y) + a0[2], bfhi(x.y) + a0[3]); w.z = cvt_pk_bf16(bflo(x.z) + a1[0], bfhi(x.z) + a1[1]); w.w = cvt_pk_bf16(bflo(x.w) + a1[2], bfhi(x.w) + a1[3]);
                    *(u32x4*)(rp0 + (size_t)m * 16 * DM + bj * HALF) = w; }
            asm volatile("" ::: "memory");
        }
    }
};
struct EpiPleB {
    const bf16_t* h; bf16_t* hn; const bf16_t* Gt;
    __device__ __forceinline__ void operator()(const f32x4 (&acc)[2][2][4][2], const Unit& u, int wr, int wc, int fr, int fq) const {
        const int row0 = u.pm * BM + wr * 64 + fr, col0 = u.pn * BM + wc * 32 + 8 * fq;
#pragma unroll
        for (int ai = 0; ai < 2; ++ai) {
            const size_t ro0 = (size_t)(row0 + ai * HALF) * DM + col0;
            u32x4 hv[4][2], gv[4][2];
#pragma unroll
            for (int m = 0; m < 4; ++m)
#pragma unroll
                for (int bj = 0; bj < 2; ++bj) { hv[m][bj] = *(const u32x4*)(h + ro0 + (size_t)m * 16 * DM + bj * HALF); gv[m][bj] = *(const u32x4*)(Gt + ro0 + (size_t)m * 16 * DM + bj * HALF); }
#pragma unroll
            for (int m = 0; m < 4; ++m)
#pragma unroll
                for (int bj = 0; bj < 2; ++bj) { const u32x4 x = hv[m][bj], g = gv[m][bj]; const f32x4 a0 = acc[ai][bj][m][0], a1 = acc[ai][bj][m][1];
                    u32x4 w; w.x = cvt_pk_bf16(bflo(x.x) + a0[0] * bflo(g.x), bfhi(x.x) + a0[1] * bfhi(g.x)); w.y = cvt_pk_bf16(bflo(x.y) + a0[2] * bflo(g.y), bfhi(x.y) + a0[3] * bfhi(g.y));
                    w.z = cvt_pk_bf16(bflo(x.z) + a1[0] * bflo(g.z), bfhi(x.z) + a1[1] * bfhi(g.z)); w.w = cvt_pk_bf16(bflo(x.w) + a1[2] * bflo(g.w), bfhi(x.w) + a1[3] * bfhi(g.w));
                    *(u32x4*)(hn + ro0 + (size_t)m * 16 * DM + bj * HALF) = w; }
            asm volatile("" ::: "memory");
        }
    }
};
struct EpiSwiglu {
    bf16_t* Hd; const PG8_LAS int* tab; const float* lrs;
    __device__ __forceinline__ void operator()(const f32x4 (&acc)[2][2][4][2], const Unit& u, int wr, int wc, int fr, int fq) const {
        const int row0 = u.pm * BM + wr * 64 + fr, col0 = u.pn * HALF + wc * 32 + 8 * fq; const int seg = u.a0, cnt = tab[80 + seg];
        float rsv[2][4];
#pragma unroll
        for (int ai = 0; ai < 2; ++ai)
#pragma unroll
            for (int m = 0; m < 4; ++m) { const int rank = u.a1 * BM + ai * HALF + wr * 64 + m * 16 + fr; const float v = lrs[(size_t)seg * NTOK + (rank < cnt ? rank : 0)]; rsv[ai][m] = rank < cnt ? v : 0.f; }
#pragma unroll
        for (int ai = 0; ai < 2; ++ai)
#pragma unroll
            for (int m = 0; m < 4; ++m) { const float rs = rsv[ai][m];
                float r[8];
#pragma unroll
                for (int n = 0; n < 2; ++n)
#pragma unroll
                    for (int e = 0; e < 4; ++e) { const float gt = acc[ai][0][m][n][e] * rs, up = acc[ai][1][m][n][e] * rs; r[4 * n + e] = gt * fsigmoid(gt) * up; }
                u32x4 w; w.x = cvt_pk_bf16(r[0], r[1]); w.y = cvt_pk_bf16(r[2], r[3]); w.z = cvt_pk_bf16(r[4], r[5]); w.w = cvt_pk_bf16(r[6], r[7]);
                *(u32x4*)(Hd + (size_t)(row0 + ai * HALF + m * 16) * DEXP + col0) = w; }
    }
};
struct EpiMoeDown {
    const PG8_LAS int* tab; const int* ltok; const float* lgate; bf16_t* y0; bf16_t* y1;
    __device__ __forceinline__ void operator()(const f32x4 (&acc)[2][2][4][2], const Unit& u, int wr, int wc, int fr, int fq) const {
        const int seg = u.a0, cnt = tab[80 + seg]; bf16_t* yb = (seg >= 32) ? y1 : y0;
        const int col0 = u.pn * BM + wc * 32 + 8 * fq;
        int tk[2][4]; float gtv[2][4];
#pragma unroll
        for (int ai = 0; ai < 2; ++ai)
#pragma unroll
            for (int m = 0; m < 4; ++m) { const int rank = u.a1 * BM + ai * HALF + wr * 64 + m * 16 + fr; const size_t o = (size_t)seg * NTOK + (rank < cnt ? rank : 0); tk[ai][m] = ltok[o]; gtv[ai][m] = lgate[o]; }
#pragma unroll
        for (int ai = 0; ai < 2; ++ai)
#pragma unroll
            for (int m = 0; m < 4; ++m) { const int rank = u.a1 * BM + ai * HALF + wr * 64 + m * 16 + fr;
                if (rank < cnt) { const int tok = tk[ai][m]; const float gt = gtv[ai][m];
#pragma unroll
                    for (int bj = 0; bj < 2; ++bj) { const f32x4 v0 = acc[ai][bj][m][0] * gt, v1 = acc[ai][bj][m][1] * gt;
                        u32x4 w; w.x = cvt_pk_bf16(v0[0], v0[1]); w.y = cvt_pk_bf16(v0[2], v0[3]); w.z = cvt_pk_bf16(v1[0], v1[1]); w.w = cvt_pk_bf16(v1[2], v1[3]);
                        *(u32x4*)(yb + (size_t)tok * DM + col0 + bj * HALF) = w; } } }
    }
};
}

struct TrItem { const float* W; const float* gain; bf16* WT; int K, N, dest_row0, k0, n0; float cs; };
__device__ __forceinline__ void tr_load(const TrItem& t, f32x4 (&v)[8], int lane) {
    const int c4 = lane & 7, kr = lane >> 3; const bool ok = t.n0 + 4 * c4 < t.N;
#pragma unroll
    for (int i = 0; i < 8; ++i) v[i] = ok ? __builtin_nontemporal_load((const f32x4*)(t.W + (size_t)(t.k0 + 8 * i + kr) * t.N + t.n0 + 4 * c4)) : (f32x4){0.f, 0.f, 0.f, 0.f};
}
__device__ __forceinline__ void tr_store(const TrItem& t, const f32x4 (&v)[8], LAS float* scr, int lane) {
    const int c4 = lane & 7, kr = lane >> 3;
#pragma unroll
    for (int i = 0; i < 8; ++i) { const int kk = 8 * i + kr; const float gsc = (t.gain ? t.gain[t.k0 + kk] : 1.f) * t.cs; LAS float* d = scr + kk * 33 + 4 * c4;
        d[0] = v[i].x * gsc; d[1] = v[i].y * gsc; d[2] = v[i].z * gsc; d[3] = v[i].w * gsc; }
    LDS_WAIT();
    const int c = lane & 7;
#pragma unroll
    for (int j = 0; j < 4; ++j) { const int n = (lane >> 3) + 8 * j; const LAS float* sp = scr + (8 * c) * 33 + n;
        u32x4 o; o.x = pk2(sp[0], sp[33]); o.y = pk2(sp[66], sp[99]); o.z = pk2(sp[132], sp[165]); o.w = pk2(sp[198], sp[231]);
        *(u32x4*)(t.WT + (size_t)(t.dest_row0 + n) * t.K + t.k0 + 8 * c) = o; }
    LDS_WAIT();
}
constexpr int IT_IN = 16 * 80, IT_OUT = 16 * 32, IT_PG = 16 * 32, IT_PU = 4 * 32, IT_K1 = 32 * 8, IT_V1 = 32 * 8, IT_E = 768;
constexpr int IT_LAYER = IT_IN + IT_OUT + IT_PG + IT_PU + IT_K1 + IT_V1 + NEXP * IT_E;

constexpr int IT_SMALL = IT_IN + IT_OUT + IT_PG + IT_PU + IT_K1 + IT_V1;
template <int MODE>
__device__ __forceinline__ void tr_run(KArgs args, LAS float* scr, int lane, int q0, int qstep, int Lsel) {
    unsigned char* ws = args->ws;
    const int nq = MODE == 0 ? DEPTH * IT_SMALL : NEXP * IT_E;
#define Q2IT_(q) (MODE == 0 ? ((q) / IT_SMALL) * IT_LAYER + (q) % IT_SMALL : Lsel * IT_LAYER + IT_SMALL + (q))
#define TR_DECODE(it_, t_) do { const int L = (it_) / IT_LAYER; int r = (it_) % IT_LAYER; unsigned char* wl = ws + WS_W + (size_t)L * W_LAYER; t_.cs = 1.f; t_.gain = nullptr; \
        if (r < IT_IN) { const int kb = r / 80, nb = r % 80; t_.W = args->in[I_WIN] + (size_t)L * DM * D_IN; t_.K = DM; t_.N = D_IN; t_.gain = args->in[I_MIXN] + L * DM; t_.WT = (bf16*)(wl + WO_IN); t_.dest_row0 = 32 * nb; t_.k0 = 64 * kb; t_.n0 = 32 * nb; \
            t_.cs = (32 * nb >= ZC_Q && 32 * nb < ZC_KC) ? 0.125f * LOG2E : 1.f; break; } r -= IT_IN; \
        if (r < IT_OUT) { const int kb = r / 32, nb = r % 32; t_.W = args->in[I_WOUT] + (size_t)L * DM * DM; t_.K = DM; t_.N = DM; t_.gain = kb < 8 ? args->in[I_RECN] + L * 512 : args->in[I_ATTN] + L * 512 - 512; t_.WT = (bf16*)(wl + WO_OUT); t_.dest_row0 = 32 * nb; t_.k0 = 64 * kb; t_.n0 = 32 * nb; break; } r -= IT_OUT; \
        if (r < IT_PG) { const int kb = r / 32, nb = r % 32; t_.W = args->in[I_WPG] + (size_t)L * DM * DM; t_.K = DM; t_.N = DM; t_.gain = args->in[I_PLEN] + L * DM; t_.WT = (bf16*)(wl + WO_PG); t_.dest_row0 = 32 * nb; t_.k0 = 64 * kb; t_.n0 = 32 * nb; break; } r -= IT_PG; \
        if (r < IT_PU) { const int kb = r / 32, nb = r % 32; t_.W = args->in[I_WPU] + (size_t)L * D_PLE * DM; t_.K = D_PLE; t_.N = DM; t_.WT = (bf16*)(wl + WO_PU); t_.dest_row0 = 32 * nb; t_.k0 = 64 * kb; t_.n0 = 32 * nb; break; } r -= IT_PU; \
        if (r < IT_K1) { const int kb = r / 8, nb = r % 8; t_.W = args->in[I_WK1] + (size_t)L * 2048 * 256; t_.K = 2048; t_.N = 256; t_.WT = (bf16*)(wl + WO_K1); t_.dest_row0 = 32 * nb; t_.k0 = 64 * kb; t_.n0 = 32 * nb; break; } r -= IT_K1; \
        if (r < IT_V1) { const int kb = r / 8, nb = r % 8; t_.W = args->in[I_WV1] + (size_t)L * 2048 * 256; t_.K = 2048; t_.N = 256; t_.WT = (bf16*)(wl + WO_V1); t_.dest_row0 = 32 * nb; t_.k0 = 64 * kb; t_.n0 = 32 * nb; break; } r -= IT_V1; \
        const int e = r / IT_E; int rr = r % IT_E; \
        if (rr < 512) { const int up = rr >> 8; rr &= 255; const int kb = rr / 16, nb = rr % 16, n0 = 32 * nb;     \
            t_.W = (up ? args->in[I_WUP] : args->in[I_WGATE]) + ((size_t)L * NEXP + e) * DM * DEXP; t_.K = DM; t_.N = DEXP; t_.gain = args->in[I_FFNN] + L * DM; t_.WT = (bf16*)(wl + WO_GU) + (size_t)e * 1024 * 1024; \
            t_.dest_row0 = 256 * (n0 >> 7) + (n0 & 127) + 128 * up; t_.k0 = 64 * kb; t_.n0 = n0; } \
        else { rr -= 512; const int kb = rr / 32, nb = rr % 32; t_.W = args->in[I_WDOWN] + ((size_t)L * NEXP + e) * DEXP * DM; t_.K = DEXP; t_.N = DM; t_.WT = (bf16*)(wl + WO_D) + (size_t)e * 1024 * DEXP; t_.dest_row0 = 32 * nb; t_.k0 = 64 * kb; t_.n0 = 32 * nb; } \
    } while (0)
    int q = q0; TrItem cur; f32x4 vc[8];
    if (q < nq) { TR_DECODE(Q2IT_(q), cur); tr_load(cur, vc, lane); }
    while (q < nq) {
        const int qn = q + qstep; TrItem nxt; f32x4 vn[8];
        const bool hn = qn < nq;
        if (hn) { TR_DECODE(Q2IT_(qn), nxt); tr_load(nxt, vn, lane); }
        tr_store(cur, vc, scr, lane);
        if (hn) { cur = nxt;
#pragma unroll
            for (int i = 0; i < 8; ++i) vc[i] = vn[i]; }
        q = qn; }
#undef TR_DECODE
#undef Q2IT_
}
__device__ __forceinline__ void phase_prologue(KArgs args, LAS unsigned char* lds, int G, int bid, int tid, int wave, int lane) {
    unsigned char* ws = args->ws;
    LAS float* scr = (LAS float*)(lds + wave * 16384);
    const int gw = bid * NWAVES + wave, NGW = G * NWAVES;
    tr_run<0>(args, scr, lane, gw, NGW, 0);
    const int gt = bid * (NWAVES * 64) + tid, NGT = G * NWAVES * 64;
    float* c8 = (float*)(ws + WS_C8); float* wrt = (float*)(ws + WS_WRT);
    for (int i = gt; i < DEPTH * 512; i += NGT) { const float lam = args->in[I_LAM][i]; c8[i] = -8.f * log1pf(expf(-lam)) * LOG2E; }
    for (int i = gt; i < DEPTH * 36 * 1024; i += NGT) { const int L = i / (36 * 1024), j = (i / 1024) % 36, k = i % 1024;
        const float w = (j < 32 ? args->in[I_WER][((size_t)L * DM + k) * 32 + j] : args->in[I_WGR][((size_t)L * DM + k) * 4 + (j - 32)]) * args->in[I_FFNN][L * DM + k];
        const unsigned hi = f2bf(w), lo = f2bf(w - bf2f((bf16)hi));
        ((bf16*)wrt)[((size_t)(L * 2 + 0) * 36 + j) * 1024 + k] = (bf16)hi; ((bf16*)wrt)[((size_t)(L * 2 + 1) * 36 + j) * 1024 + k] = (bf16)lo; }
    { bf16* w2t = (bf16*)(ws + WS_W2T);
      for (int i = gt; i < DEPTH * 2 * 64 * 256; i += NGT) { const int L = i >> 15, kv = (i >> 14) & 1, n = (i >> 8) & 63, k = i & 255;
          w2t[i] = (bf16)f2bf((kv ? args->in[I_WV2] : args->in[I_WK2])[((size_t)L * 256 + k) * 64 + n]); } }
    if (bid < 8) { const int pair = bid, L = pair >> 1, kv = pair & 1, j = tid & 255, half = tid >> 8;
        const float* pe = (kv ? args->in[I_PEV] : args->in[I_PEK]) + L * 2048 + 1024 * half; const float* w1 = (kv ? args->in[I_WV1] : args->in[I_WK1]) + ((size_t)L * 2048 + 1024 * half) * 256 + j;
        float s0 = 0.f, s1 = 0.f, s2 = 0.f, s3 = 0.f;
#pragma unroll 4
        for (int k = 0; k < 1024; k += 4) { s0 += pe[k] * w1[(size_t)k * 256]; s1 += pe[k + 1] * w1[(size_t)(k + 1) * 256]; s2 += pe[k + 2] * w1[(size_t)(k + 2) * 256]; s3 += pe[k + 3] * w1[(size_t)(k + 3) * 256]; }
        LAS float* red = (LAS float*)(lds + 8 * 16384);
        if (half) red[j] = (s0 + s1) + (s2 + s3);
        __syncthreads();
        if (!half) ((float*)(ws + WS_BK1))[pair * 256 + j] = (kv ? args->in[I_BV1] : args->in[I_BK1])[L * 256 + j] + ((s0 + s1) + (s2 + s3)) + red[j]; }
}

__device__ __forceinline__ void store_row_bf16(bf16* orow, const f32x4 (&v)[4], float sc, int lane) {
    unsigned long long* o8 = (unsigned long long*)orow + lane;
#pragma unroll
    for (int j = 0; j < 4; ++j) o8[64 * j] = (unsigned long long)pk2(v[j].x * sc, v[j].y * sc) | ((unsigned long long)pk2(v[j].z * sc, v[j].w * sc) << 32);
}
__device__ __forceinline__ float row_ss_bf16(const u32x2 (&v)[4]) { float s = 0.f;
#pragma unroll
    for (int j = 0; j < 4; ++j) { const float a = bflo(v[j].x), b = bfhi(v[j].x), c = bflo(v[j].y), d = bfhi(v[j].y); s += (a * a + b * b) + (c * c + d * d); }
    return s; }
__device__ __forceinline__ void store_row_bf16_from16(bf16* orow, const u32x2 (&v)[4], float sc, int lane) {
    u32x2* o8 = (u32x2*)orow + lane;
#pragma unroll
    for (int j = 0; j < 4; ++j) { u32x2 w; w.x = pk2(bflo(v[j].x) * sc, bfhi(v[j].x) * sc); w.y = pk2(bflo(v[j].y) * sc, bfhi(v[j].y) * sc); o8[64 * j] = w; }
}
__device__ __forceinline__ float ss_u4(const u32x4& v) {
    const float a = bflo(v.x), b = bfhi(v.x), c = bflo(v.y), d = bfhi(v.y), e = bflo(v.z), f = bfhi(v.z), g = bflo(v.w), h = bfhi(v.w);
    return ((a * a + b * b) + (c * c + d * d)) + ((e * e + f * f) + (g * g + h * h)); }
__device__ __forceinline__ u32x4 scale_u4(const u32x4& v, float sc) { u32x4 w;
    w.x = pg8::cvt_pk_bf16(bflo(v.x) * sc, bfhi(v.x) * sc); w.y = pg8::cvt_pk_bf16(bflo(v.y) * sc, bfhi(v.y) * sc); w.z = pg8::cvt_pk_bf16(bflo(v.z) * sc, bfhi(v.z) * sc); w.w = pg8::cvt_pk_bf16(bflo(v.w) * sc, bfhi(v.w) * sc); return w; }
__device__ __forceinline__ u32x4 add3_u4(const u32x4& h, const u32x4& a, const u32x4& b) { u32x4 w;
    w.x = pg8::cvt_pk_bf16(bflo(h.x) + bflo(a.x) + bflo(b.x), bfhi(h.x) + bfhi(a.x) + bfhi(b.x)); w.y = pg8::cvt_pk_bf16(bflo(h.y) + bflo(a.y) + bflo(b.y), bfhi(h.y) + bfhi(a.y) + bfhi(b.y));
    w.z = pg8::cvt_pk_bf16(bflo(h.z) + bflo(a.z) + bflo(b.z), bfhi(h.z) + bfhi(a.z) + bfhi(b.z)); w.w = pg8::cvt_pk_bf16(bflo(h.w) + bflo(a.w) + bflo(b.w), bfhi(h.w) + bfhi(a.w) + bfhi(b.w)); return w; }
constexpr int N1_PITCH = 2064, ZN_IN = 2304;
__device__ __forceinline__ void phase_norm1(KArgs args, const float* x, bf16* H, float* rs, int L, LAS unsigned char* lds, int G, int bid, int tid, int wave, int lane) {
    unsigned char* ws = args->ws;
    { const u32x4* src = (const u32x4*)(ws + WS_W + (size_t)L * W_LAYER + WO_IN + (size_t)ZN_IN * DM * 2);
      for (int i = tid; i < 24 * 128; i += NWAVES * 64) { const int row = i >> 7, c = i & 127; *(LAS u32x4*)(lds + row * N1_PITCH + c * 16) = src[i]; } }
    __syncthreads();
    bf16* z = (bf16*)(ws + WS_Z);
    const int gw = bid * NWAVES + wave, NGW = G * NWAVES, fr = lane & 15, fq = lane >> 4;
    const int arow1 = 16 + (fr & 7);
    for (int grp = gw; grp < NTOK / 16; grp += NGW) {
        if (x) {
#pragma unroll 1
            for (int r0 = 0; r0 < 16; r0 += 2) { f32x4 v[2][4];
#pragma unroll
                for (int r = 0; r < 2; ++r)
#pragma unroll
                    for (int j = 0; j < 4; ++j) v[r][j] = __builtin_nontemporal_load((const f32x4*)(x + (size_t)(grp * 16 + r0 + r) * DM) + lane + 64 * j);
#pragma unroll
                for (int r = 0; r < 2; ++r) store_row_bf16(H + (size_t)(grp * 16 + r0 + r) * DM, v[r], 1.f, lane); }
            VM_WAIT();
        }
        const int tok = grp * 16 + fr;
        const bf16* hrow = H + (size_t)tok * DM + 8 * fq;
        f32x4 acc0 = {0.f, 0.f, 0.f, 0.f}, acc1 = {0.f, 0.f, 0.f, 0.f}; float ss = 0.f;
#pragma unroll 1
        for (int k0 = 0; k0 < 32; k0 += 16) {
            u32x4 xhv[16];
#pragma unroll
            for (int kq = 0; kq < 16; ++kq) xhv[kq] = *(const u32x4*)(hrow + 32 * (k0 + kq));
#pragma unroll
            for (int kq = 0; kq < 16; ++kq) { const int kk = k0 + kq; const u32x4 xh = xhv[kq];
                ss += ss_u4(xh);
                const bf16x8 bh = __builtin_bit_cast(bf16x8, xh);
                const bf16x8 a0 = *(const LAS bf16x8*)(lds + fr * N1_PITCH + 64 * kk + 16 * fq), a1 = *(const LAS bf16x8*)(lds + arow1 * N1_PITCH + 64 * kk + 16 * fq);
                acc0 = __builtin_amdgcn_mfma_f32_16x16x32_bf16(a0, bh, acc0, 0, 0, 0); acc1 = __builtin_amdgcn_mfma_f32_16x16x32_bf16(a1, bh, acc1, 0, 0, 0); } }
        ss += __builtin_bit_cast(float, __builtin_amdgcn_ds_bpermute((lane ^ 16) << 2, __builtin_bit_cast(int, ss)));
        ss += __builtin_bit_cast(float, __builtin_amdgcn_ds_bpermute((lane ^ 32) << 2, __builtin_bit_cast(int, ss)));
        const float rstd = rsqrtf(ss * (1.f / DM) + EPS);
        if (fq == 0) rs[tok] = rstd;
        bf16* zg = z + (size_t)tok * ZP + ZC_NG;
        { u32x2 w; w.x = pk2(acc0[0] * rstd, acc0[1] * rstd); w.y = pk2(acc0[2] * rstd, acc0[3] * rstd); *(u32x2*)(zg + 4 * fq) = w; }
        if (fq < 2) { u32x2 w; w.x = pk2(acc1[0] * rstd, acc1[1] * rstd); w.y = pk2(acc1[2] * rstd, acc1[3] * rstd); *(u32x2*)(zg + 16 + 4 * fq) = w; }
    }
}
__device__ __forceinline__ void phase_final(const bf16* H, float* out, const float* gain, int gw, int NGW, int lane) {
    constexpr int NR = 4;
    f32x4 gv[2][2];
#pragma unroll
    for (int j = 0; j < 2; ++j) { gv[j][0] = ((const f32x4*)gain)[2 * lane + 128 * j]; gv[j][1] = ((const f32x4*)gain)[2 * lane + 128 * j + 1]; }
    for (int m0 = gw * NR; m0 < NTOK; m0 += NGW * NR) { u32x4 v[NR][2];
#pragma unroll
        for (int r = 0; r < NR; ++r)
#pragma unroll
            for (int j = 0; j < 2; ++j) v[r][j] = ((const u32x4*)(H + (size_t)(m0 + r) * DM))[lane + 64 * j];
#pragma unroll
        for (int r = 0; r < NR; ++r) { const float rstd = rsqrtf(wave_sum(ss_u4(v[r][0]) + ss_u4(v[r][1])) * (1.f / DM) + EPS);
            f32x4* xr = (f32x4*)(out + (size_t)(m0 + r) * DM);
#pragma unroll
            for (int j = 0; j < 2; ++j) { const u32x4 w = v[r][j];
                xr[2 * lane + 128 * j] = (f32x4){bflo(w.x), bfhi(w.x), bflo(w.y), bfhi(w.y)} * rstd * gv[j][0];
                xr[2 * lane + 128 * j + 1] = (f32x4){bflo(w.z), bfhi(w.z), bflo(w.w), bfhi(w.w)} * rstd * gv[j][1]; } } }
}
__device__ __forceinline__ void phase_pconv(const float* pL, bf16* pb, int gw, int NGW, int lane) {
    constexpr int NR = 8;
    for (int m0 = gw * NR; m0 < NTOK; m0 += NGW * NR) { f32x4 pv[NR];
#pragma unroll
        for (int r = 0; r < NR; ++r) pv[r] = __builtin_nontemporal_load((const f32x4*)(pL + (size_t)(m0 + r) * D_PLE) + lane);
#pragma unroll
        for (int r = 0; r < NR; ++r) { u32x2 q; q.x = pg8::cvt_pk_bf16(pv[r].x, pv[r].y); q.y = pg8::cvt_pk_bf16(pv[r].z, pv[r].w); ((u32x2*)(pb + (size_t)(m0 + r) * D_PLE))[lane] = q; } }
}
__device__ __forceinline__ void phase_norm3(bf16* H, const bf16* y0, const bf16* y1, float* rs, int gw, int NGW, int lane) {
    constexpr int NR = 4;
    for (int m0 = gw * NR; m0 < NTOK; m0 += NGW * NR) { u32x4 hv[NR][2], av[NR][2], bv[NR][2];
#pragma unroll
        for (int r = 0; r < NR; ++r) { const size_t ro = (size_t)(m0 + r) * DM;
#pragma unroll
            for (int j = 0; j < 2; ++j) { hv[r][j] = ((const u32x4*)(H + ro))[lane + 64 * j]; av[r][j] = __builtin_nontemporal_load((const u32x4*)(y0 + ro) + lane + 64 * j); bv[r][j] = __builtin_nontemporal_load((const u32x4*)(y1 + ro) + lane + 64 * j); }
        }
        float rr[NR];
#pragma unroll
        for (int r = 0; r < NR; ++r) { const size_t ro = (size_t)(m0 + r) * DM;
            const u32x4 w0 = add3_u4(hv[r][0], av[r][0], bv[r][0]), w1 = add3_u4(hv[r][1], av[r][1], bv[r][1]);
            ((u32x4*)(H + ro))[lane] = w0; ((u32x4*)(H + ro))[lane + 64] = w1;
            rr[r] = rsqrtf(wave_sum(ss_u4(w0) + ss_u4(w1)) * (1.f / DM) + EPS); }
        if (lane == 0) *(f32x4*)(rs + m0) = (f32x4){rr[0], rr[1], rr[2], rr[3]}; }
}
constexpr int N2_PITCH = 2064, N2_WL = 36 * N2_PITCH;
__device__ __forceinline__ void phase_norm2(KArgs args, const bf16* H, int L, LAS unsigned char* lds, int G, int bid, int tid, int wave, int lane) {
    unsigned char* ws = args->ws;
    { const u32x4* src = (const u32x4*)(ws + WS_WRT + (size_t)L * 2 * 36 * 2048);
      for (int i = tid; i < 2 * 36 * 128; i += NWAVES * 64) { const int hl = i / (36 * 128), row = (i >> 7) % 36, c = i & 127; *(LAS u32x4*)(lds + hl * N2_WL + row * N2_PITCH + c * 16) = src[i]; } }
    __syncthreads();
    gu32* cnt = (gu32*)(ws + WS_CTL) + CW_CNT + L * 64;
    int* ltok = (int*)(ws + WS_LTOK); float* lgate = (float*)(ws + WS_LGATE); float* lrs = (float*)(ws + WS_LRS);
    const float* bgr = args->in[I_BGR] + L * 4; const float* ber = args->in[I_BER] + L * 32;
    const int gw = bid * NWAVES + wave, NGW = G * NWAVES, fr = lane & 15, fq = lane >> 4;
    const int arow[3] = {8 * (fr >> 2) + (fr & 3), 8 * (fr >> 2) + (fr & 3) + 4, 32 + (fr & 3)};
    for (int grp = gw; grp < NTOK / 16; grp += NGW) {
        const int tok = grp * 16 + fr;
        const bf16* hrow = H + (size_t)tok * DM + 8 * fq;
        f32x4 acc[3]; float ss = 0.f;
#pragma unroll
        for (int t3 = 0; t3 < 3; ++t3) acc[t3] = (f32x4){0.f, 0.f, 0.f, 0.f};
#pragma unroll 1
        for (int k0 = 0; k0 < 32; k0 += 16) {
        u32x4 xhv[16];
#pragma unroll
        for (int kq = 0; kq < 16; ++kq) xhv[kq] = *(const u32x4*)(hrow + 32 * (k0 + kq));
#pragma unroll
        for (int kq = 0; kq < 16; ++kq) { const int kk = k0 + kq;
            const u32x4 xh = xhv[kq];
            { const float a0 = bflo(xh.x), a1 = bfhi(xh.x), a2 = bflo(xh.y), a3 = bfhi(xh.y), a4 = bflo(xh.z), a5 = bfhi(xh.z), a6 = bflo(xh.w), a7 = bfhi(xh.w);
              ss += (a0 * a0 + a1 * a1) + (a2 * a2 + a3 * a3) + (a4 * a4 + a5 * a5) + (a6 * a6 + a7 * a7); }
            const bf16x8 bh = __builtin_bit_cast(bf16x8, xh);
#pragma unroll
            for (int t3 = 0; t3 < 3; ++t3) { const bf16x8 ah = *(const LAS bf16x8*)(lds + arow[t3] * N2_PITCH + 64 * kk + 16 * fq), al = *(const LAS bf16x8*)(lds + N2_WL + arow[t3] * N2_PITCH + 64 * kk + 16 * fq);
                acc[t3] = __builtin_amdgcn_mfma_f32_16x16x32_bf16(ah, bh, acc[t3], 0, 0, 0); acc[t3] = __builtin_amdgcn_mfma_f32_16x16x32_bf16(al, bh, acc[t3], 0, 0, 0); }
        }
        }
        ss += __builtin_bit_cast(float, __builtin_amdgcn_ds_bpermute((lane ^ 16) << 2, __builtin_bit_cast(int, ss)));
        ss += __builtin_bit_cast(float, __builtin_amdgcn_ds_bpermute((lane ^ 32) << 2, __builtin_bit_cast(int, ss)));
        const float rstd = rsqrtf(ss * (1.f / DM) + EPS);
        float gl[4]; int gi = 0;
#pragma unroll
        for (int j = 0; j < 4; ++j) gl[j] = acc[2][j] * rstd + bgr[j];
        float gmax = gl[0];
#pragma unroll
        for (int j = 1; j < 4; ++j) if (gl[j] > gmax) { gmax = gl[j]; gi = j; }
        if (fq == gi) {
            float den = 0.f;
#pragma unroll
            for (int j = 0; j < 4; ++j) den += expf(gl[j] - gmax);
            const float pg = 1.f / den;
            float b1 = -3.0e38f, b2 = -3.0e38f; int j1 = 0, j2 = 0;
#pragma unroll
            for (int e = 0; e < 8; ++e) { const float x = (e < 4 ? acc[0][e & 3] : acc[1][e & 3]) * rstd + ber[gi * 8 + e];
                if (x > b1) { b2 = b1; j2 = j1; b1 = x; j1 = e; } else if (x > b2) { b2 = x; j2 = e; } }
            const float w1 = 1.f / (1.f + expf(b2 - b1)), w2 = 1.f - w1;
            const int s0 = gi * 8 + j1, s1 = 32 + gi * 8 + j2;
            const unsigned r0 = __hip_atomic_fetch_add(cnt + s0, 1u, RLX_AGENT), r1 = __hip_atomic_fetch_add(cnt + s1, 1u, RLX_AGENT);
            ltok[(size_t)s0 * NTOK + r0] = tok; lgate[(size_t)s0 * NTOK + r0] = pg * w1; lrs[(size_t)s0 * NTOK + r0] = rstd;
            ltok[(size_t)s1 * NTOK + r1] = tok; lgate[(size_t)s1 * NTOK + r1] = pg * w2; lrs[(size_t)s1 * NTOK + r1] = rstd;
        }
    }
}
template <int CTRL> __device__ __forceinline__ float dpp_row_shr(float old, float src) {
    return __builtin_bit_cast(float, __builtin_amdgcn_update_dpp(__builtin_bit_cast(int, old), __builtin_bit_cast(int, src), CTRL, 0xf, 0xf, false));
}
__device__ __forceinline__ void rec1_unit(KArgs args, int L, int unit, LAS unsigned char* lds, int wave, int lane) {
    unsigned char* ws = args->ws;
    const bf16* z = (const bf16*)(ws + WS_Z);
    bf16* hloc = (bf16*)(ws + WS_HLOC); bf16* cumA = (bf16*)(ws + WS_CUMA); float* agg = (float*)(ws + WS_AGG);
    const int b = unit >> 4, chk = unit & 15, t0 = chk * 256, fr = lane & 15, q = lane >> 4, hb = wave;
    const float* Wa = args->in[I_WA] + ((size_t)(L * 8 + hb)) * 4096; const float* Wx = args->in[I_WX] + ((size_t)(L * 8 + hb)) * 4096;
    LAS unsigned char* wl = lds + wave * 16384;
#pragma unroll 1
    for (int f = 0; f < 16; ++f) { const int mat = f >> 3, n = (f >> 1) & 3, kk = f & 1; const float* W = mat ? Wx : Wa;
        const int jout = 8 * (fr >> 2) + (fr & 3) + 4 * (n & 1) + 32 * (n >> 1); const float* wp = W + (32 * kk + 8 * q) * 64 + jout;
        u32x4 w; w.x = pk2(wp[0], wp[64]); w.y = pk2(wp[128], wp[192]); w.z = pk2(wp[256], wp[320]); w.w = pk2(wp[384], wp[448]);
        *(LAS u32x4*)(wl + f * 1024 + lane * 16) = w; }
    LAS float* ct = (LAS float*)(lds + 131072 + wave * 2048);
    { const int c = 64 * hb + lane; const float* cw = args->in[I_CONVW] + (size_t)L * 4 * 512;
      ct[lane * 8 + 0] = cw[c]; ct[lane * 8 + 1] = cw[512 + c]; ct[lane * 8 + 2] = cw[1024 + c]; ct[lane * 8 + 3] = cw[1536 + c];
      ct[lane * 8 + 4] = args->in[I_CONVB][L * 512 + c]; ct[lane * 8 + 5] = args->in[I_BA][L * 512 + c]; ct[lane * 8 + 6] = args->in[I_BX][L * 512 + c];
      ct[lane * 8 + 7] = ((const float*)(ws + WS_C8))[L * 512 + c]; }
    LDS_WAIT();
    float Acar[2][8], Hcar[2][8];
#pragma unroll
    for (int kk = 0; kk < 2; ++kk)
#pragma unroll
        for (int e = 0; e < 8; ++e) { Acar[kk][e] = 1.f; Hcar[kk][e] = 0.f; }
    const bf16* zb = z + (size_t)(b * SEQ) * ZP + ZC_XR + 64 * hb;
    const int bidx15 = ((lane & ~15) | 15) << 2;
    u32x4 rawc[2][4];
#define REC_LOAD_TILE(dst_, tile_) do { const int t_ = t0 + (tile_) * 16 + fr; _Pragma("unroll") for (int kk_ = 0; kk_ < 2; ++kk_) _Pragma("unroll") for (int j_ = 0; j_ < 4; ++j_) { const int tt_ = t_ - 3 + j_; \
        dst_[kk_][j_] = *(const u32x4*)(zb + (size_t)(tt_ > 0 ? tt_ : 0) * ZP + 32 * kk_ + 8 * q); } } while (0)
    REC_LOAD_TILE(rawc, 0);
#pragma unroll 1
    for (int tile = 0; tile < 16; ++tile) {
        const int t = t0 + tile * 16 + fr; const bool edge = (t0 + tile * 16) == 0;
        u32x4 rawn[2][4];
        REC_LOAD_TILE(rawn, tile < 15 ? tile + 1 : 15);
        u32x4 xb[2];
#pragma unroll
        for (int kk = 0; kk < 2; ++kk) {
            float xc[8];
#pragma unroll
            for (int e = 0; e < 8; ++e) xc[e] = ct[(32 * kk + 8 * q + e) * 8 + 4];
#pragma unroll
            for (int j = 0; j < 4; ++j) { const int tt = t - 3 + j;
                u32x4 raw = rawc[kk][j];
                if (edge && tt < 0) raw = (u32x4){0u, 0u, 0u, 0u};
                const float xv[8] = {bflo(raw.x), bfhi(raw.x), bflo(raw.y), bfhi(raw.y), bflo(raw.z), bfhi(raw.z), bflo(raw.w), bfhi(raw.w)};
#pragma unroll
                for (int e = 0; e < 8; ++e) xc[e] += ct[(32 * kk + 8 * q + e) * 8 + j] * xv[e]; }
            xb[kk].x = pk2(xc[0], xc[1]); xb[kk].y = pk2(xc[2], xc[3]); xb[kk].z = pk2(xc[4], xc[5]); xb[kk].w = pk2(xc[6], xc[7]);
        }
        asm volatile("" ::: "memory");
#pragma unroll
        for (int kh = 0; kh < 2; ++kh) {
            f32x4 racc[2], iacc[2];
#pragma unroll
            for (int nn = 0; nn < 2; ++nn) { racc[nn] = (f32x4){0.f, 0.f, 0.f, 0.f}; iacc[nn] = (f32x4){0.f, 0.f, 0.f, 0.f};
#pragma unroll
                for (int kk = 0; kk < 2; ++kk) { const int n = 2 * kh + nn;
                    const bf16x8 fa = *(const LAS bf16x8*)(wl + ((0 * 4 + n) * 2 + kk) * 1024 + lane * 16), fx = *(const LAS bf16x8*)(wl + ((1 * 4 + n) * 2 + kk) * 1024 + lane * 16);
                    const bf16x8 xk = __builtin_bit_cast(bf16x8, xb[kk]);
                    racc[nn] = __builtin_amdgcn_mfma_f32_16x16x32_bf16(fa, xk, racc[nn], 0, 0, 0); iacc[nn] = __builtin_amdgcn_mfma_f32_16x16x32_bf16(fx, xk, iacc[nn], 0, 0, 0); } }
            const unsigned xw[4] = {xb[kh].x, xb[kh].y, xb[kh].z, xb[kh].w};
            float hv[8], av[8];
#pragma unroll
            for (int e = 0; e < 8; ++e) {
                const int nn = e >> 2, jj = e & 3; const int cb = (32 * kh + 8 * q + e) * 8;
                const float xcv = (e & 1) ? bfhi(xw[e >> 1]) : bflo(xw[e >> 1]);
                const float r = fsigmoid(racc[nn][jj] + ct[cb + 5]), ig = fsigmoid(iacc[nn][jj] + ct[cb + 6]);
                float a = __builtin_amdgcn_exp2f(ct[cb + 7] * r);
                float bb = __builtin_amdgcn_sqrtf(fmaxf(1.f - a * a, 0.f)) * (ig * xcv);
#define REC_SCAN_STEP(N_) asm volatile("s_nop 1\n\tv_fmac_f32_dpp %0, %0, %1 row_shr:" #N_ " row_mask:0xf bank_mask:0xf\n\ts_nop 1\n\tv_mul_f32_dpp %1, %1, %1 row_shr:" #N_ " row_mask:0xf bank_mask:0xf" : "+v"(bb), "+v"(a))
                REC_SCAN_STEP(1); REC_SCAN_STEP(2); REC_SCAN_STEP(4); REC_SCAN_STEP(8);
#undef REC_SCAN_STEP
                const float hl = a * Hcar[kh][e] + bb, ca = a * Acar[kh][e];
                hv[e] = hl; av[e] = ca;
                Hcar[kh][e] = __builtin_bit_cast(float, __builtin_amdgcn_ds_bpermute(bidx15, __builtin_bit_cast(int, hl))); Acar[kh][e] = __builtin_bit_cast(float, __builtin_amdgcn_ds_bpermute(bidx15, __builtin_bit_cast(int, ca)));
            }
            const size_t o = (size_t)(b * SEQ + t) * D_REC + 64 * hb + 32 * kh + 8 * q;
            u32x4 w; w.x = pk2(hv[0], hv[1]); w.y = pk2(hv[2], hv[3]); w.z = pk2(hv[4], hv[5]); w.w = pk2(hv[6], hv[7]);
            *(u32x4*)(hloc + o) = w;
            w.x = pk2(av[0], av[1]); w.y = pk2(av[2], av[3]); w.z = pk2(av[4], av[5]); w.w = pk2(av[6], av[7]);
            *(u32x4*)(cumA + o) = w;
            asm volatile("" ::: "memory");
        }
#pragma unroll
        for (int kk = 0; kk < 2; ++kk)
#pragma unroll
            for (int j = 0; j < 4; ++j) rawc[kk][j] = rawn[kk][j];
    }
#undef REC_LOAD_TILE
    if (fr == 0) {
#pragma unroll
        for (int kk = 0; kk < 2; ++kk)
#pragma unroll
            for (int e = 0; e < 8; ++e) { const int c = 64 * hb + 32 * kk + 8 * q + e; float* ap = agg + ((size_t)(b * 16 + chk) * 512 + c) * 2; ap[0] = Acar[kk][e]; ap[1] = Hcar[kk][e]; }
    }
}
__device__ __forceinline__ void rec2_rows(KArgs args, int gw, int NGW, int lane) {
    unsigned char* ws = args->ws;
    const bf16* z = (const bf16*)(ws + WS_Z); const bf16* hloc = (const bf16*)(ws + WS_HLOC); const bf16* cumA = (const bf16*)(ws + WS_CUMA);
    const float* carry = (const float*)(ws + WS_CARRY); bf16* mixed = (bf16*)(ws + WS_MIXED);
    constexpr int NR = 4;
    for (int m0 = gw * NR; m0 < NTOK; m0 += NGW * NR) {
        const int b = m0 >> 12, chk = (m0 & 4095) >> 8;
        u32x4 hl[NR], ca[NR], gr[NR];
#pragma unroll
        for (int r = 0; r < NR; ++r) { const size_t m = (size_t)(m0 + r); hl[r] = __builtin_nontemporal_load((const u32x4*)(hloc + m * D_REC + 8 * lane)); ca[r] = __builtin_nontemporal_load((const u32x4*)(cumA + m * D_REC + 8 * lane)); gr[r] = __builtin_nontemporal_load((const u32x4*)(z + m * ZP + ZC_GR + 8 * lane)); }
        const f32x4 c0 = *(const f32x4*)(carry + (size_t)(b * 16 + chk) * 512 + 8 * lane), c1 = *(const f32x4*)(carry + (size_t)(b * 16 + chk) * 512 + 8 * lane + 4);
#pragma unroll
        for (int r = 0; r < NR; ++r) { float v[8];
            v[0] = (bflo(hl[r].x) + bflo(ca[r].x) * c0.x) * fgelu(bflo(gr[r].x)); v[1] = (bfhi(hl[r].x) + bfhi(ca[r].x) * c0.y) * fgelu(bfhi(gr[r].x));
            v[2] = (bflo(hl[r].y) + bflo(ca[r].y) * c0.z) * fgelu(bflo(gr[r].y)); v[3] = (bfhi(hl[r].y) + bfhi(ca[r].y) * c0.w) * fgelu(bfhi(gr[r].y));
            v[4] = (bflo(hl[r].z) + bflo(ca[r].z) * c1.x) * fgelu(bflo(gr[r].z)); v[5] = (bfhi(hl[r].z) + bfhi(ca[r].z) * c1.y) * fgelu(bfhi(gr[r].z));
            v[6] = (bflo(hl[r].w) + bflo(ca[r].w) * c1.z) * fgelu(bflo(gr[r].w)); v[7] = (bfhi(hl[r].w) + bfhi(ca[r].w) * c1.w) * fgelu(bfhi(gr[r].w));
            float s = 0.f;
#pragma unroll
            for (int e = 0; e < 8; ++e) s += v[e] * v[e];
            const float rstd = rsqrtf(wave_sum(s) * (1.f / D_REC) + EPS);
            u32x4 w; w.x = pk2(v[0] * rstd, v[1] * rstd); w.y = pk2(v[2] * rstd, v[3] * rstd); w.z = pk2(v[4] * rstd, v[5] * rstd); w.w = pk2(v[6] * rstd, v[7] * rstd);
            *(u32x4*)(mixed + (size_t)(m0 + r) * DM + 8 * lane) = w; }
    }
}
__device__ __forceinline__ void phase_mid(KArgs args, int L, int G, int bid, int tid, int wave, int lane) {
    unsigned char* ws = args->ws;
    const float* agg = (const float*)(ws + WS_AGG); float* carry = (float*)(ws + WS_CARRY);
    const int gt = bid * (NWAVES * 64) + tid, NGT = G * NWAVES * 64;
    for (int i = gt; i < BATCH * 512; i += NGT) { const int b = i >> 9, c = i & 511; float Ak[16], Hk[16];
#pragma unroll
        for (int k = 0; k < 16; ++k) { const size_t o = (size_t)(b * 16 + k) * 512 + c; Ak[k] = agg[o * 2]; Hk[k] = agg[o * 2 + 1]; }
        float H = 0.f;
#pragma unroll
        for (int k = 0; k < 16; ++k) { carry[(size_t)(b * 16 + k) * 512 + c] = H; H = Ak[k] * H + Hk[k]; } }
    const bf16* hid = (const bf16*)(ws + WS_HIDC); const bf16* w2t = (const bf16*)(ws + WS_W2T);
    const int gw = bid * NWAVES + wave, NGW = G * NWAVES, fr = lane & 15, fq = lane >> 4;
    for (int task = gw; task < 2 * 512; task += NGW) {
        const int kv = task >> 9, grp = task & 511;
        const bf16* ar = hid + ((size_t)kv * 8192 + grp * 16 + fr) * 256 + 8 * fq;
        const bf16* br = w2t + ((size_t)(L * 2 + kv) * 64 + fr) * 256 + 8 * fq;
        const float* b2 = (kv ? args->in[I_BV2] : args->in[I_BK2]) + L * 64;
        f32x4 acc[4];
#pragma unroll
        for (int nt = 0; nt < 4; ++nt) { const float bb = b2[16 * nt + fr]; acc[nt] = (f32x4){bb, bb, bb, bb}; }
#pragma unroll
        for (int kk = 0; kk < 8; ++kk) { const bf16x8 a = *(const bf16x8*)(ar + 32 * kk);
#pragma unroll
            for (int nt = 0; nt < 4; ++nt) { const bf16x8 bfr = *(const bf16x8*)(br + (size_t)(16 * nt) * 256 + 32 * kk); acc[nt] = __builtin_amdgcn_mfma_f32_16x16x32_bf16(a, bfr, acc[nt], 0, 0, 0); } }
        bf16* outp = (bf16*)(ws + (kv ? WS_VCMP : WS_KCMP));
#pragma unroll
        for (int jj = 0; jj < 4; ++jj) { const int row = grp * 16 + 4 * fq + jj; const bool real = (row & 255) != 255;
#pragma unroll
            for (int nt = 0; nt < 4; ++nt) outp[(size_t)row * 64 + 16 * nt + fr] = real ? (bf16)f2bf(acc[nt][jj]) : (bf16)0; }
    }
}

typedef float f32x16 __attribute__((ext_vector_type(16)));
typedef short s16x4 __attribute__((ext_vector_type(4)));
typedef float f32x2_t __attribute__((ext_vector_type(2)));
typedef __bf16 bf16x2_t __attribute__((ext_vector_type(2)));
__device__ __forceinline__ unsigned cvtpk(float lo, float hi) { f32x2_t v = {lo, hi}; bf16x2_t b = __builtin_convertvector(v, bf16x2_t); return __builtin_bit_cast(unsigned, b); }
__device__ __forceinline__ void xhalf_pair(float m, float& lo, float& hi) {
    unsigned a = __builtin_bit_cast(unsigned, m), b = a; asm volatile("" : "+v"(b));
    auto rr = __builtin_amdgcn_permlane32_swap(a, b, false, false);
    unsigned r0 = rr[0], r1 = rr[1]; asm volatile("" : "+v"(r0), "+v"(r1));
    lo = __builtin_bit_cast(float, r0); hi = __builtin_bit_cast(float, r1);
}
__device__ __forceinline__ float xhalf_max(float m) { float a, b; xhalf_pair(m, a, b); return fmaxf(a, b); }
__device__ __forceinline__ float xhalf_sum(float m) { float a, b; xhalf_pair(m, a, b); return a + b; }
__device__ __forceinline__ s16x4 vtr(const LAS unsigned char* p) { return __builtin_bit_cast(s16x4, __builtin_amdgcn_ds_read_tr16_b64_v4i16((LAS s16x4*)p)); }
constexpr int ATT_NS = 4, ATT_PD = 3;
constexpr int ATT_IMP = 65536, ATT_SC = ATT_IMP + 4 * 64 * 65 * 4, ATT_MASK = ATT_SC + 64 * 65 * 4, ATT_UNION = ATT_MASK + 512, ATT_RED = ATT_UNION + 64;
static_assert(ATT_RED + 2048 <= MISC_OFF, "attention LDS map");
#define CI_(i) (((i) & 3) + 8 * ((i) >> 2))
__device__ __forceinline__ float max3f(float a, float b, float c) { float r; asm("v_max3_f32 %0, %1, %2, %3" : "=v"(r) : "v"(a), "v"(b), "v"(c)); return r; }

struct AttState { f32x16 O[2]; float m, l; bool fresh; };
__device__ __forceinline__ void att_stage(LAS unsigned char* lds, int slot, const char* kp, const char* vp, unsigned pitch, int wave, int lane) {
    const int key = 8 * wave + (lane >> 3), pc = lane & 7;
    const char* ks = kp + (size_t)key * pitch + ((pc ^ ((key >> 1) & 7)) << 4);
    const char* vs = vp + (size_t)key * pitch + ((pc ^ ((key & 3) << 1)) << 4);
    const unsigned dk = (unsigned)(unsigned long)(lds + slot * 16384 + wave * 1024), dv = dk + 8192u; unsigned keep;
    asm volatile("s_mov_b32 %0, m0\n\ts_mov_b32 m0, %2\n\ts_nop 0\n\tglobal_load_lds_dwordx4 %1, off\n\ts_mov_b32 m0, %0" : "=&s"(keep) : "v"(ks), "s"(dk) : "memory");
    asm volatile("s_mov_b32 %0, m0\n\ts_mov_b32 m0, %2\n\ts_nop 0\n\tglobal_load_lds_dwordx4 %1, off\n\ts_mov_b32 m0, %0" : "=&s"(keep) : "v"(vs), "s"(dv) : "memory");
}
__device__ __forceinline__ void att_qk64(const LAS unsigned char* Kb, const bf16x8 (&qf)[4], float sF, float cb, int rq, int h, f32x16& S0, f32x16& S1) {
    const LAS unsigned char* rowp = Kb + rq * 128; const int sw = (rq >> 1) & 7;
    bf16x8 kf[2][4];
#pragma unroll
    for (int sub = 0; sub < 2; ++sub)
#pragma unroll
        for (int s4 = 0; s4 < 4; ++s4) kf[sub][s4] = *(const LAS bf16x8*)(rowp + sub * 4096 + (((2 * s4 + h) ^ sw) << 4));
    const float base = cb + sF * (float)(4 * h);
#pragma unroll
    for (int i = 0; i < 16; ++i) { float t0 = fmaf(sF, (float)CI_(i), base); asm volatile("" : "+v"(t0)); S0[i] = t0; float t1 = fmaf(sF, (float)(CI_(i) + 32), base); asm volatile("" : "+v"(t1)); S1[i] = t1; }
    __builtin_amdgcn_sched_barrier(0);
#pragma unroll
    for (int s4 = 0; s4 < 4; ++s4) { S0 = __builtin_amdgcn_mfma_f32_32x32x16_bf16(kf[0][s4], qf[s4], S0, 0, 0, 0); S1 = __builtin_amdgcn_mfma_f32_32x32x16_bf16(kf[1][s4], qf[s4], S1, 0, 0, 0); }
    __builtin_amdgcn_sched_barrier(0);
}
__device__ __forceinline__ void att_mask(int sub, int h, int lim_lo, int lim_hi, f32x16& S) {
    const int hi2 = lim_hi - 32 * sub - 4 * h, lo2 = lim_lo - 32 * sub - 4 * h;
#pragma unroll
    for (int i = 0; i < 16; ++i) S[i] = (CI_(i) <= hi2 && CI_(i) > lo2) ? S[i] : -__builtin_inff();
}
template <bool IMP>
__device__ __forceinline__ void att_softmax_pv64(const bool MASKED, const LAS unsigned char* Vb, int lim_lo, int lim_hi, f32x16& S0, f32x16& S1, AttState& st, int h, int lane, LAS float* irow = nullptr, int ct = 0) {
    const int qd = (lane & 15) >> 2, pp = lane & 3, blk = (lane >> 4) & 1;
    const LAS unsigned char* vrow = Vb + (4 * h + qd) * 128 + (pp & 1) * 8;
    bf16x8 vf[2][4];
#pragma unroll
    for (int dt = 0; dt < 2; ++dt) { const int coff = ((dt * 4 + blk * 2 + (pp >> 1)) ^ (qd << 1)) << 4;
#pragma unroll
        for (int ks = 0; ks < 4; ++ks) { const s16x4 lo = vtr(vrow + coff + (16 * ks) * 128), hi = vtr(vrow + coff + (16 * ks + 8) * 128);
            vf[dt][ks] = __builtin_shufflevector(lo, hi, 0, 1, 2, 3, 4, 5, 6, 7); } }
    __builtin_amdgcn_sched_barrier(0);
    if (MASKED) { att_mask(0, h, lim_lo, lim_hi, S0); att_mask(1, h, lim_lo, lim_hi, S1); }
    float mx = max3f(S0[0], S0[1], S0[2]), my = max3f(S1[0], S1[1], S1[2]);
    mx = max3f(mx, S0[3], S0[4]); my = max3f(my, S1[3], S1[4]); mx = max3f(mx, S0[5], S0[6]); my = max3f(my, S1[5], S1[6]); mx = max3f(mx, S0[7], S0[8]); my = max3f(my, S1[7], S1[8]);
    mx = max3f(mx, S0[9], S0[10]); my = max3f(my, S1[9], S1[10]); mx = max3f(mx, S0[11], S0[12]); my = max3f(my, S1[11], S1[12]); mx = max3f(mx, S0[13], S0[14]); my = max3f(my, S1[13], S1[14]);
    mx = xhalf_max(max3f(mx, my, max3f(S0[15], S1[15], S1[15])));
    const bool fin = mx > -1e30f;
    const bool rb = fin && (mx > 8.f || st.fresh);
    if (__any(rb)) { const float d = rb ? mx : 0.f; const float corr = st.fresh ? 1.f : __builtin_amdgcn_exp2f(-d); st.l *= corr; st.m += d;
#pragma unroll
        for (int i = 0; i < 16; ++i) { st.O[0][i] *= corr; st.O[1][i] *= corr; S0[i] -= d; S1[i] -= d; }
        if (IMP) { if (h == 0 && corr != 1.f) { for (int j = 0; j < 64; ++j) irow[j] *= corr; } }
    }
    st.fresh = st.fresh && !fin;
    float ps = 0.f, pt = 0.f;
#pragma unroll
    for (int i = 0; i < 16; ++i) { S0[i] = __builtin_amdgcn_exp2f(S0[i]); S1[i] = __builtin_amdgcn_exp2f(S1[i]); ps += S0[i]; asm volatile("" : "+v"(ps)); pt += S1[i]; asm volatile("" : "+v"(pt)); }
    st.l += ps + pt;
    if (IMP) {
        float prev3 = 0.f; const int partner = (lane ^ 32) << 2;
#pragma unroll
        for (int f = 0; f < 8; ++f) { const f32x16& S_ = (f >> 2) ? S1 : S0; const int q4 = f & 3; const float p3 = S_[4 * q4 + 3];
            const float own = 2.f * (S_[4 * q4] + S_[4 * q4 + 1] + S_[4 * q4 + 2]) + p3;
            const float inc = __builtin_bit_cast(float, __builtin_amdgcn_ds_bpermute(partner, __builtin_bit_cast(int, h ? prev3 : p3)));
            irow[16 * ct + 2 * f + h] = own + inc;
            prev3 = p3; }
        if (h && ct < 3) __hip_atomic_fetch_add(irow + 16 * ct + 16, prev3, __ATOMIC_RELAXED, __HIP_MEMORY_SCOPE_WORKGROUP); }
    u32x4 pk[4];
#pragma unroll
    for (int s2 = 0; s2 < 2; ++s2) { pk[s2].x = cvtpk(S0[8 * s2], S0[8 * s2 + 1]); pk[s2].y = cvtpk(S0[8 * s2 + 2], S0[8 * s2 + 3]); pk[s2].z = cvtpk(S0[8 * s2 + 4], S0[8 * s2 + 5]); pk[s2].w = cvtpk(S0[8 * s2 + 6], S0[8 * s2 + 7]);
        pk[2 + s2].x = cvtpk(S1[8 * s2], S1[8 * s2 + 1]); pk[2 + s2].y = cvtpk(S1[8 * s2 + 2], S1[8 * s2 + 3]); pk[2 + s2].z = cvtpk(S1[8 * s2 + 4], S1[8 * s2 + 5]); pk[2 + s2].w = cvtpk(S1[8 * s2 + 6], S1[8 * s2 + 7]); }
    __builtin_amdgcn_sched_barrier(0);
#pragma unroll
    for (int ks = 0; ks < 4; ++ks)
#pragma unroll
        for (int dt = 0; dt < 2; ++dt) st.O[dt] = __builtin_amdgcn_mfma_f32_32x32x16_bf16(vf[dt][ks], __builtin_bit_cast(bf16x8, pk[ks]), st.O[dt], 0, 0, 0);
    __builtin_amdgcn_sched_barrier(0);
}
__device__ __forceinline__ void att_state_reset(AttState& st) {
#pragma unroll
    for (int i = 0; i < 16; ++i) { st.O[0][i] = 0.f; st.O[1][i] = 0.f; }
    st.m = 0.f; st.l = 0.f; st.fresh = true;
}
#define ATT_WAIT_BAR() asm volatile("s_waitcnt vmcnt(0) lgkmcnt(0)\n\ts_barrier" ::: "memory")
#define ATT_WAIT_BAR_PD() asm volatile("s_waitcnt vmcnt(4) lgkmcnt(0)\n\ts_barrier" ::: "memory")
#define ATT_WAIT_BAR_2() asm volatile("s_waitcnt vmcnt(2) lgkmcnt(0)\n\ts_barrier" ::: "memory")

__device__ __forceinline__ int opq_v(int x) { asm volatile("" : "+v"(x)); return x; }
__device__ __forceinline__ int opq_s(int x) { asm volatile("" : "+s"(x)); return x; }
#define ATT_IDS const int lane = opq_v(lane0), wave = opq_s(wave0); const int r = wave >> 1, th = wave & 1, rq = lane & 31, h = lane >> 5, tl = 32 * th + rq, t = qb * 64 + tl, tok = b * SEQ + t; (void)r; (void)t; (void)tok;
__device__ __forceinline__ void att_unit_mfma(KArgs args, int b, int qb, LAS unsigned char* lds, int wave0, int lane0, int tid0) {
    unsigned char* ws = args->ws;
    const bf16* z = (const bf16*)(ws + WS_Z); bf16* mixed = (bf16*)(ws + WS_MIXED);
    LAS float* imp = (LAS float*)(lds + ATT_IMP);
    LAS float* sc = (LAS float*)(lds + ATT_SC);
    LAS unsigned* maskw = (LAS unsigned*)(lds + ATT_MASK);
    LAS unsigned* unionw = (LAS unsigned*)(lds + ATT_UNION);
    LAS float* red = (LAS float*)(lds + ATT_RED);
    unsigned OUTP[16];
    const unsigned ZPB = ZP * 2;
#pragma unroll 1
    for (int g = 0; g < 2; ++g) {
        const int hd = 4 * g + (wave0 >> 1);
        bf16x8 qf[4]; float slope2, g0, g1, g2;
        { ATT_IDS const int tid = opq_v(tid0);
          const bf16* zrow = z + (size_t)tok * ZP;
#pragma unroll
          for (int s4 = 0; s4 < 4; ++s4) qf[s4] = *(const bf16x8*)(zrow + ZC_Q + hd * 64 + 16 * s4 + 8 * h);
          slope2 = exp2f(-(float)(hd + 1)) * LOG2E;
          g0 = fsigmoid(bf2f(zrow[ZC_NG + hd * 3 + 0])); g1 = fsigmoid(bf2f(zrow[ZC_NG + hd * 3 + 1])); g2 = fsigmoid(bf2f(zrow[ZC_NG + hd * 3 + 2]));
          LAS float* row = imp + (r * 64 + tl) * 65 + 32 * h;
#pragma unroll
          for (int j = 0; j < 32; ++j) row[j] = 0.f;
          if (tid < 128) maskw[tid] = 0u;
          if (tid < 2) unionw[tid] = 0u; }
        AttState st;
        { ATT_IDS
        const int jlo = qb - 8 > 0 ? qb - 8 : 0, nw = qb - jlo + 1;
        const int nk = (4 * qb + 3) < 255 ? (4 * qb + 3) : 255, nc = (nk + 63) >> 6, nA = nw + nc;
        const int nmax_t = (t >= 31) ? ((t - 31) >> 4) : -1;
        const char* kwb = (const char*)(z + (size_t)(b * SEQ) * ZP + ZC_KW + g * 64);
        const char* kcb = (const char*)(ws + WS_KCMP) + (size_t)((b * 2 + g) * 256) * 128; const char* vcb = (const char*)(ws + WS_VCMP) + (size_t)((b * 2 + g) * 256) * 128;
        const float sF = 16.f * slope2;
        float il_c = 0.f;
        LAS float* irow = imp + (r * 64 + tl) * 65;
#define ATT_STAGE_A(idx_) do { int ix_ = (idx_) < nA ? (idx_) : nA - 1; const int sl_ = (idx_) & 3; \
            if (ix_ < nw) { const char* kp_ = kwb + (size_t)(64 * (qb - ix_)) * ZPB; att_stage(lds, sl_, kp_, kp_ + (ZC_VW - ZC_KW) * 2, ZPB, wave, lane); } \
            else { ix_ -= nw; const size_t o_ = (size_t)(nc - 1 - ix_) * 64 * 128; att_stage(lds, sl_, kcb + o_, vcb + o_, 128, wave, lane); } } while (0)
        att_state_reset(st);
        ATT_STAGE_A(0); ATT_STAGE_A(1); ATT_STAGE_A(2);
        f32x16 Sa, Sb;
#pragma unroll 1
        for (int i = 0; i < nA; ++i) {
            ATT_WAIT_BAR_PD();
            ATT_STAGE_A(i + ATT_PD);
            const LAS unsigned char* Kb = lds + (i & 3) * 16384; const LAS unsigned char* Vb = Kb + 8192;
            if (i < nw) {
                const int j = qb - i;
                att_qk64(Kb, qf, slope2, slope2 * (float)(64 * j) - st.m, rq, h, Sa, Sb);
                att_softmax_pv64<false>((j == qb) || (j == qb - 8), Vb, (j == qb - 8) ? tl : -1, (j == qb) ? tl : 63, Sa, Sb, st, h, lane);
                if (i == nw - 1) { const float lt = xhalf_sum(st.l); const float go = g2 / fmaxf(lt, 1e-30f);
#pragma unroll
                    for (int k = 0; k < 8; ++k) { OUTP[k] = cvtpk(st.O[0][2 * k] * go, st.O[0][2 * k + 1] * go); OUTP[8 + k] = cvtpk(st.O[1][2 * k] * go, st.O[1][2 * k + 1] * go); }
                    att_state_reset(st); }
            } else {
                const int ct = nc - 1 - (i - nw);
                att_qk64(Kb, qf, sF, sF * (float)(64 * ct) - st.m, rq, h, Sa, Sb);
                att_softmax_pv64<true>(true, Vb, -1, nmax_t - 64 * ct, Sa, Sb, st, h, lane, irow, ct);
                if (i == nA - 1) { const float lt = xhalf_sum(st.l); il_c = 1.f / fmaxf(lt, 1e-30f); const float go = g0 * il_c;
                    if (h == 0) ((LAS float*)(lds + ATT_SC))[r * 64 + tl] = il_c;
#pragma unroll
                    for (int k = 0; k < 8; ++k) { OUTP[k] = cvtpk(bflo(OUTP[k]) + st.O[0][2 * k] * go, bfhi(OUTP[k]) + st.O[0][2 * k + 1] * go); OUTP[8 + k] = cvtpk(bflo(OUTP[8 + k]) + st.O[1][2 * k] * go, bfhi(OUTP[8 + k]) + st.O[1][2 * k + 1] * go); } }
            }
        }
#undef ATT_STAGE_A
        }
        ATT_WAIT_BAR();
        { ATT_IDS const char* ksb0 = (const char*)(z + (size_t)(b * SEQ) * ZP + ZC_KS + g * 64);
          const char* kp0 = ksb0 + (size_t)(64 * qb) * ZPB; att_stage(lds, 0, kp0, kp0 + (ZC_VS - ZC_KS) * 2, ZPB, wave, lane);
          const char* kp1 = ksb0 + (size_t)(64 * (qb > 0 ? qb - 1 : 0)) * ZPB; att_stage(lds, 1, kp1, kp1 + (ZC_VS - ZC_KS) * 2, ZPB, wave, lane); }
        { const int tid = opq_v(tid0); const int stok = tid >> 3, e8 = tid & 7; const LAS float* ilc = (const LAS float*)(lds + ATT_SC);
          unsigned key[8];
#pragma unroll
          for (int k = 0; k < 8; ++k) { const int j = 8 * e8 + k; const float v = imp[(0 * 64 + stok) * 65 + j] * ilc[stok] + imp[(1 * 64 + stok) * 65 + j] * ilc[64 + stok] + imp[(2 * 64 + stok) * 65 + j] * ilc[128 + stok] + imp[(3 * 64 + stok) * 65 + j] * ilc[192 + stok];
              const bool valid = j <= qb, forced = valid && (j == 0 || j == qb || j == qb - 1);
              const unsigned bits_ = __builtin_bit_cast(unsigned, forced ? 1e30f : (valid ? v : -1e30f));
              key[k] = ((bits_ ^ ((bits_ >> 31) ? 0xFFFFFFFFu : 0x80000000u)) & ~63u) | (unsigned)(63 - j); }
          unsigned T = 0u;
#pragma unroll 1
          for (int bit = 31; bit >= 0; --bit) { const unsigned cand = T | (1u << bit); int c = 0;
#pragma unroll
              for (int k = 0; k < 8; ++k) c += key[k] >= cand ? 1 : 0;
              c += __builtin_amdgcn_update_dpp(0, c, 0xB1, 0xf, 0xf, true);
              c += __builtin_amdgcn_update_dpp(0, c, 0x4E, 0xf, 0xf, true);
              c += __builtin_amdgcn_update_dpp(0, c, 0x141, 0xf, 0xf, true);
              T = c >= NTOP ? cand : T; }
          unsigned bits = 0u;
#pragma unroll
          for (int k = 0; k < 8; ++k) bits |= (key[k] >= T && 8 * e8 + k <= qb) ? (1u << k) : 0u;
          if (bits) { __hip_atomic_fetch_or(maskw + stok * 2 + (e8 >> 2), bits << (8 * (e8 & 3)), __ATOMIC_RELAXED, __HIP_MEMORY_SCOPE_WORKGROUP); __hip_atomic_fetch_or(unionw + (e8 >> 2), bits << (8 * (e8 & 3)), __ATOMIC_RELAXED, __HIP_MEMORY_SCOPE_WORKGROUP); }
        }
        __syncthreads();
        { ATT_IDS
        const unsigned mlo = maskw[tl * 2], mhi = maskw[tl * 2 + 1];
        unsigned long long un = ((unsigned long long)unionw[1] << 32) | unionw[0];
        const char* ksb = (const char*)(z + (size_t)(b * SEQ) * ZP + ZC_KS + g * 64);
        att_state_reset(st);
        int jq[4];
#pragma unroll
        for (int p = 0; p < 4; ++p) { if (un) { jq[p] = 63 - __builtin_clzll(un); un &= ~(1ull << jq[p]); } else jq[p] = -1; }
        int jlast = jq[0];
#pragma unroll
        for (int p = 0; p < 3; ++p) { if (jq[p] >= 0) jlast = jq[p]; if (p == 2) { const char* kp_ = ksb + (size_t)(64 * jlast) * ZPB; att_stage(lds, p, kp_, kp_ + (ZC_VS - ZC_KS) * 2, ZPB, wave, lane); } }
        f32x16 Sa, Sb;
#pragma unroll 1
        for (int i = 0; jq[0] >= 0; ++i) {
            ATT_WAIT_BAR_PD();
            { if (jq[3] >= 0) jlast = jq[3]; const char* kp_ = ksb + (size_t)(64 * jlast) * ZPB; att_stage(lds, (i + 3) & 3, kp_, kp_ + (ZC_VS - ZC_KS) * 2, ZPB, wave, lane); }
            const LAS unsigned char* Kb = lds + (i & 3) * 16384; const LAS unsigned char* Vb = Kb + 8192;
            const int j = jq[0];
            const bool bit = ((j < 32 ? (mlo >> j) : (mhi >> (j - 32))) & 1u) != 0u;
            att_qk64(Kb, qf, slope2, bit ? slope2 * (float)(64 * j) - st.m : -__builtin_inff(), rq, h, Sa, Sb);
            att_softmax_pv64<false>(j == qb, Vb, -1, tl, Sa, Sb, st, h, lane);
            jq[0] = jq[1]; jq[1] = jq[2]; jq[2] = jq[3];
            if (un) { jq[3] = 63 - __builtin_clzll(un); un &= ~(1ull << jq[3]); } else jq[3] = -1;
        }
        { const float lt = xhalf_sum(st.l); const float go = g1 / fmaxf(lt, 1e-30f);
          float ss = 0.f;
#pragma unroll
          for (int i = 0; i < 8; ++i) { const float a0 = bflo(OUTP[i]) + st.O[0][2 * i] * go, a1 = bfhi(OUTP[i]) + st.O[0][2 * i + 1] * go, c0 = bflo(OUTP[8 + i]) + st.O[1][2 * i] * go, c1 = bfhi(OUTP[8 + i]) + st.O[1][2 * i + 1] * go;
              ss += (a0 * a0 + a1 * a1) + (c0 * c0 + c1 * c1); OUTP[i] = cvtpk(a0, a1); OUTP[8 + i] = cvtpk(c0, c1); }
          ss = xhalf_sum(ss);
          if (h == 0) red[hd * 64 + tl] = ss;
          if (g == 0) { bf16* orow = mixed + (size_t)tok * DM + 512 + hd * 64;
#pragma unroll
              for (int dt = 0; dt < 2; ++dt)
#pragma unroll
                  for (int q4 = 0; q4 < 4; ++q4) { u32x2 w; w.x = OUTP[8 * dt + 2 * q4]; w.y = OUTP[8 * dt + 2 * q4 + 1]; *(u32x2*)(orow + 32 * dt + 8 * q4 + 4 * h) = w; } } }
        }
        ATT_WAIT_BAR();
    }
    ATT_IDS
    float tot = 0.f;
#pragma unroll
    for (int h2 = 0; h2 < 8; ++h2) tot += red[h2 * 64 + tl];
    const float rstd = rsqrtf(tot * (1.f / 512.f) + EPS);
    { bf16* orow = mixed + (size_t)tok * DM + 512 + (4 + r) * 64;
#pragma unroll
      for (int dt = 0; dt < 2; ++dt)
#pragma unroll
          for (int q4 = 0; q4 < 4; ++q4) { u32x2 w; const unsigned p0 = OUTP[8 * dt + 2 * q4], p1 = OUTP[8 * dt + 2 * q4 + 1];
              w.x = cvtpk(bflo(p0) * rstd, bfhi(p0) * rstd); w.y = cvtpk(bflo(p1) * rstd, bfhi(p1) * rstd);
              *(u32x2*)(orow + 32 * dt + 8 * q4 + 4 * h) = w; } }
    { bf16* orow = mixed + (size_t)tok * DM + 512 + r * 64;
#pragma unroll
      for (int dt = 0; dt < 2; ++dt)
#pragma unroll
          for (int q4 = 0; q4 < 4; ++q4) { u32x2 w = *(const u32x2*)(orow + 32 * dt + 8 * q4 + 4 * h);
              w.x = cvtpk(bflo(w.x) * rstd, bfhi(w.x) * rstd); w.y = cvtpk(bflo(w.y) * rstd, bfhi(w.y) * rstd);
              *(u32x2*)(orow + 32 * dt + 8 * q4 + 4 * h) = w; } }
    __syncthreads();
}

constexpr int NPH_LAYER = 11, PH_FINAL = 1 + DEPTH * NPH_LAYER, N_PHASES = PH_FINAL + 1;
__global__ void __launch_bounds__(NWAVES * 64, 2) fwd_kernel(Args args) {
    extern __shared__ __attribute__((aligned(16))) unsigned char lds_raw[];
    LAS unsigned char* lds = (LAS unsigned char*)lds_raw;
    volatile LAS unsigned* MISC = (volatile LAS unsigned*)(lds + MISC_OFF);
    const int G0 = gridDim.x, bid0 = blockIdx.x;
    const int wave_s = __builtin_amdgcn_readfirstlane(threadIdx.x >> 6);
#define PHASE_IDS KArgs ka = ka_get(); int G = G0, bid = bid0; asm volatile("" : "+s"(G), "+s"(bid)); unsigned char* ws = ka->ws; (void)ws; int tid = wave_s * 64 + lane_id(); asm volatile("" : "+v"(tid)); const int lane = tid & 63, wave = wave_s; const int gw = bid * NWAVES + wave, NGW = G * NWAVES; (void)lane; (void)gw; (void)NGW;
    if (wave_s == 0) MISC[lane_id()] = 0u;
    __syncthreads();
#if MK_MULTI
#define GRID_BAR() do { } while (0)
#else
    XcdBarrier bar = xcd_barrier_post((unsigned*)(args.ws + WS_CTL) + CW_BAR, MISC + 8, wave_s);
#define GRID_BAR() xcd_barrier(bar)
#endif
#ifndef PH_MASK
#define PH_MASK 0xFFFF
#endif
#define IN(k) (ka_get()->ph_lo <= (k) && (k) < ka_get()->ph_hi)
#define EN(j) ((PH_MASK >> (j)) & 1)
#define SEAM(k) do { if (IN(k) && IN((k) + 1)) GRID_BAR(); } while (0)
#define HC_ ((bf16*)(ws + ((L & 1) ? WS_U : WS_H16)))
#define HN_ ((bf16*)(ws + ((L & 1) ? WS_H16 : WS_U)))
#define Z_ ((bf16*)(ws + WS_Z))
#define MIXED_ ((bf16*)(ws + WS_MIXED))
#define WL_ (ws + WS_W + (size_t)L * W_LAYER)

    if (EN(11) && IN(0)) { PHASE_IDS REP_(11) { phase_prologue(ka, lds, G, bid, tid, wave, lane); __syncthreads(); } SEAM(0); }

    for (int L = 0; L < DEPTH; ++L) {
        const int P = 1 + L * NPH_LAYER;
        if (EN(0) && IN(P + 0)) { PHASE_IDS REP_(0) phase_norm1(ka, L == 0 ? ka->in[I_X] : nullptr, HC_, (float*)(ws + WS_RS1), L, lds, G, bid, tid, wave, lane); SEAM(P + 0); }
        if (EN(1) && IN(P + 1)) {
            PHASE_IDS
            pg8::DenseSched S; S.init(HC_, DM, (const bf16*)(WL_ + WO_IN), NTOK, ZN_IN, DM, G, bid);
            pg8::EpiBf16<0> E{Z_, ZP, nullptr, 0, 0, (const float*)(ws + WS_RS1)};
            REP_(1) pg8::gemm_phase(lds, DM, S, E, wave_s);
            SEAM(P + 1);
        }
        if (EN(2) && IN(P + 2)) {
            { PHASE_IDS
            if (EN(12)) REP_(2) for (int unit = bid; unit < BATCH * 16; unit += G) rec1_unit(ka, L, unit, lds, wave, lane);
            { const int ncv = G > 64 ? G - 64 : G, mycv = G > 64 ? bid - 64 : bid;
              if (mycv >= 0) tr_run<1>(ka, (LAS float*)(lds + wave * 16384), lane, mycv * NWAVES + wave, ncv * NWAVES, L); }
            }
            __syncthreads();
            if (EN(13)) { PHASE_IDS
            pg8::CmpSched S{Z_, (const bf16*)(WL_ + WO_K1), (const bf16*)(WL_ + WO_V1), G, bid};
            pg8::EpiBf16<1> E{(bf16*)(ws + WS_HIDC), 256, (const float*)(ws + WS_BK1) + L * 512, (size_t)8192 * 256, 256, nullptr};
            REP_(2) pg8::gemm_phase(lds, 2048, S, E, wave_s); }
            SEAM(P + 2);
        }
        if (EN(3) && IN(P + 3)) { PHASE_IDS REP_(3) phase_mid(ka, L, G, bid, tid, wave, lane); SEAM(P + 3); }
        if (EN(4) && IN(P + 4)) {
            PHASE_IDS
            REP_(4)
            if (G == 256) { for (int i = 0; i < 4; ++i) att_unit_mfma(ka, 2 * (bid & 7) + (i >> 1), (i & 1) ? 63 - (bid >> 3) : (bid >> 3), lds, wave, lane, tid); }
            else { for (int unit = bid; unit < BATCH * 64; unit += G) att_unit_mfma(ka, unit >> 6, unit & 63, lds, wave, lane, tid); }
            REP_(12) rec2_rows(ka, gw, NGW, lane);
            SEAM(P + 4);
        }
        if (EN(5) && IN(P + 5)) {
            PHASE_IDS
            pg8::DenseSched S; S.init(MIXED_, DM, (const bf16*)(WL_ + WO_OUT), NTOK, DM, DM, G, bid);
            pg8::EpiResid E{HC_};
            pg8::gemm_phase(lds, DM, S, E, wave_s);
            SEAM(P + 5);
        }
        if (EN(6) && IN(P + 6)) { PHASE_IDS phase_norm2(ka, HC_, L, lds, G, bid, tid, wave, lane); SEAM(P + 6); }
        if ((EN(7) || EN(8)) && (IN(P + 7) || IN(P + 8))) {
            LAS int* tab = (LAS int*)(lds + TAB_OFF);
            { PHASE_IDS
            __syncthreads();
            if (tid < 64) { const int c = (int)__hip_atomic_load((gu32*)(ws + WS_CTL) + CW_CNT + L * 64 + tid, RLX_AGENT); tab[80 + tid] = c; tab[160 + tid] = (c + 255) >> 8; }
            __syncthreads();
            if (tid == 0) { int s = 0; for (int i = 0; i < 64; ++i) { tab[i] = s; s += tab[160 + i]; } tab[64] = s; }
            __syncthreads(); }
            if (EN(7) && IN(P + 7)) { PHASE_IDS
                pg8::MoeSched<1> S{tab, HC_, (const bf16*)(WL_ + WO_GU), (const int*)(ws + WS_LTOK), G, bid};
                pg8::EpiSwiglu E{(bf16*)(ws + WS_HID), tab, (const float*)(ws + WS_LRS)};
                REP_(7) pg8::gemm_phase(lds, DM, S, E, wave_s);
                if (G != 256) phase_pconv(ka->in[I_P] + (size_t)L * NTOK * D_PLE, (bf16*)(ws + WS_PB), gw, NGW, lane);
                else if (bid >= 128) phase_pconv(ka->in[I_P] + (size_t)L * NTOK * D_PLE, (bf16*)(ws + WS_PB), (bid - 128) * NWAVES + wave, 128 * NWAVES, lane);
                SEAM(P + 7);
            }
            if (EN(8) && IN(P + 8)) { PHASE_IDS
                pg8::MoeSched<2> S{tab, (const bf16*)(ws + WS_HID), (const bf16*)(WL_ + WO_D), (const int*)(ws + WS_LTOK), G, bid};
                pg8::EpiMoeDown E{tab, (const int*)(ws + WS_LTOK), (const float*)(ws + WS_LGATE), (bf16*)(ws + WS_Y0), (bf16*)(ws + WS_Y1)};
                REP_(8) pg8::gemm_phase(lds, DEXP, S, E, wave_s);
                SEAM(P + 8);
            }
        }
        if (EN(9) && IN(P + 9)) { PHASE_IDS phase_norm3(HC_, (const bf16*)(ws + WS_Y0), (const bf16*)(ws + WS_Y1), (float*)(ws + WS_RS3), gw, NGW, lane); SEAM(P + 9); }
        if (EN(10) && IN(P + 10)) {
            if (EN(14)) { PHASE_IDS pg8::DenseSched S; S.init(HC_, DM, (const bf16*)(WL_ + WO_PG), NTOK, DM, DM, G, bid);
              pg8::EpiBf16<2> E{(bf16*)(ws + WS_G), DM, ka->in[I_BPG] + L * DM, 0, 0, (const float*)(ws + WS_RS3)};
              REP_(10) pg8::gemm_phase(lds, DM, S, E, wave_s); }
            __syncthreads();
            if (EN(15)) { PHASE_IDS pg8::DenseSched S; S.init((const bf16*)(ws + WS_PB), D_PLE, (const bf16*)(WL_ + WO_PU), NTOK, DM, D_PLE, G, bid);
              pg8::EpiPleB E{HC_, HN_, (const bf16*)(ws + WS_G)};
              pg8::gemm_phase(lds, D_PLE, S, E, wave_s); }
            SEAM(P + 10);
        }
    }
    if (IN(PH_FINAL)) { PHASE_IDS phase_final((const bf16*)(ws + ((DEPTH & 1) ? WS_U : WS_H16)), ka->out, ka->in[I_FINN], gw, NGW, lane); }
#undef IN
#undef SEAM
}

extern "C" void kernel_launch(void* const* d_in, const int* in_sizes, int n_in, void* d_out, int out_size, void* d_ws, size_t ws_size, hipStream_t stream) {
    static int grid = 0;
    if (grid == 0) {
        if (n_in != 37 || in_sizes[0] != NTOK * DM || out_size != NTOK * DM || ws_size < WS_END) {
            fprintf(stderr, "kernel_launch: unexpected shapes (n_in %d, in0 %d, out %d, ws %zu < %zu); nothing launched\n", n_in, n_in > 0 ? in_sizes[0] : -1, out_size, ws_size, (size_t)WS_END); grid = -1; return; }
        int dev = 0, cus = 0, per_cu = 0;
        if (hipGetDevice(&dev) != hipSuccess || hipDeviceGetAttribute(&cus, hipDeviceAttributeMultiprocessorCount, dev) != hipSuccess) { grid = -1; return; }
        if (hipFuncSetAttribute((const void*)fwd_kernel, hipFuncAttributeMaxDynamicSharedMemorySize, LDS_BYTES) != hipSuccess) { fprintf(stderr, "kernel_launch: hipFuncSetAttribute failed\n"); grid = -1; return; }
        if (hipOccupancyMaxActiveBlocksPerMultiprocessor(&per_cu, (const void*)fwd_kernel, NWAVES * 64, LDS_BYTES) != hipSuccess || per_cu < 1)
            fprintf(stderr, "kernel_launch: note: occupancy query reports %d workgroups per CU\n", per_cu);
        (void)hipGetLastError();
        grid = cus;
    }
    if (grid < 0) return;
    if (hipMemsetAsync((char*)d_ws + WS_CTL, 0, CTL_ZERO_BYTES, stream) != hipSuccess) return;
    Args a{};
    for (int i = 0; i < 37; ++i) a.in[i] = (const float*)d_in[i];
    a.out = (float*)d_out; a.ws = (unsigned char*)d_ws;
#if MK_MULTI
    for (int p = 0; p < N_PHASES; ++p) { a.ph_lo = p; a.ph_hi = p + 1; hipLaunchKernelGGL(fwd_kernel, dim3(grid), dim3(NWAVES * 64), LDS_BYTES, stream, a); }
#else
    a.ph_lo = 0; a.ph_hi = N_PHASES;
    hipLaunchKernelGGL(fwd_kernel, dim3(grid), dim3(NWAVES * 64), LDS_BYTES, stream, a);
#endif
    const hipError_t le = hipPeekAtLastError();
    if (le != hipSuccess) fprintf(stderr, "kernel_launch: launch failed: %s\n", hipGetErrorName(le));
}
```
